# Optimizing an MI355X kernel written in HIP

```python
import jax
import jax.numpy as jnp
from jax import lax
import numpy as np

D_MODEL = 1024
BATCH = 16
SEQ = 4096
DEPTH = 1

N_MEM = 256
RMS_EPS = 1e-6

RW_HEADS = 8
RW_HEAD_DIM = 64
RW_WIDTH = RW_HEADS * RW_HEAD_DIM
RW_DECAY_LORA = 64
RW_AAA_LORA = 64
RW_GATE_LORA = 128
RW_GN_EPS = 64e-5

DSA_HEADS = 8
DSA_HEAD_DIM = 64
DSA_WIDTH = DSA_HEADS * DSA_HEAD_DIM
DSA_KV_RANK = 128
IDX_HEADS = 4
IDX_DIM = 64
IDX_TOPK_MAX = 256
Q_BLOCK = 128

X_HEADS = 4
X_HEAD_DIM = 256
X_WIDTH = X_HEADS * X_HEAD_DIM

N_GROUPS = 4
EXPERTS_PER_GROUP = 8
N_EXPERTS = N_GROUPS * EXPERTS_PER_GROUP
TOP_K_INNER = 2
D_EXPERT = 512
MOE_BLOCK = 256

RW_SIZES = (RW_WIDTH, RW_WIDTH, RW_WIDTH, RW_DECAY_LORA, RW_AAA_LORA, RW_GATE_LORA)
DSA_SIZES = (DSA_WIDTH, DSA_KV_RANK, IDX_HEADS * IDX_DIM, IDX_DIM, IDX_HEADS)
RW_COLS = sum(RW_SIZES)
DSA_COLS = sum(DSA_SIZES)
GATE_COLS = 2 * D_MODEL
IN_COLS = RW_COLS + DSA_COLS + GATE_COLS

kernel_name = 'hybrid_rwkv7_dsa_hmoe_block'


def _split(t, sizes):
    cuts = [int(c) for c in np.cumsum(sizes)[:-1]]
    return jnp.split(t, cuts, axis=-1)


def rmsnorm(x, g):
    xf = x.astype(jnp.float32)
    y = xf * lax.rsqrt(jnp.mean(xf * xf, axis=-1, keepdims=True) + RMS_EPS)
    return (y * g.astype(jnp.float32)).astype(x.dtype)


def rwkv7_branch(z, mu, w0, w2, a0, a2, g2, k_k, k_a, r_k, ln_w, ln_b):
    B, S, _ = z.shape
    H, N = RW_HEADS, RW_HEAD_DIM
    f32 = jnp.float32
    z_prev = jnp.pad(z, ((0, 0), (1, 0), (0, 0)))[:, :-1]
    z = z + (z_prev - z) * mu
    r, k, v, xw, xa, xg = _split(z, RW_SIZES)
    w = -jax.nn.softplus(-(w0 + jnp.tanh(xw) @ w2).astype(f32)) - 0.5
    decay = jnp.exp(-jnp.exp(w))
    a = jax.nn.sigmoid(a0 + xa @ a2)
    g = jax.nn.sigmoid(xg) @ g2
    heads = lambda t: t.astype(f32).reshape(B, S, H, N)
    kk = heads(k * k_k)
    kk = kk / jnp.maximum(jnp.sqrt(jnp.sum(kk * kk, -1, keepdims=True)), 1e-12)
    k = k * (1.0 + (a - 1.0) * k_a)
    r_h, k_h, v_h, a_h = heads(r), heads(k), heads(v), heads(a)
    seq_major = lambda t: jnp.moveaxis(t, 1, 0)
    xs = (seq_major(r_h), seq_major(heads(decay)), seq_major(k_h),
          seq_major(v_h), seq_major(kk), seq_major(a_h))

    def step(state, inp):
        r_t, w_t, k_t, v_t, kk_t, a_t = inp
        sa = jnp.einsum('bhij,bhj->bhi', state, -kk_t)
        state = (state * w_t[:, :, None, :]
                 + sa[..., None] * (kk_t * a_t)[:, :, None, :]
                 + v_t[..., None] * k_t[:, :, None, :])
        return state, jnp.einsum('bhij,bhj->bhi', state, r_t)

    _, y = lax.scan(step, jnp.zeros((B, H, N, N), f32), xs)
    y = jnp.moveaxis(y, 0, 1)
    mean = jnp.mean(y, -1, keepdims=True)
    var = jnp.mean(jnp.square(y - mean), -1, keepdims=True)
    y = ((y - mean) * lax.rsqrt(var + RW_GN_EPS)).reshape(B, S, RW_WIDTH)
    y = y * ln_w.astype(f32) + ln_b.astype(f32)
    bonus = jnp.sum(r_h * k_h * r_k.astype(f32), -1, keepdims=True) * v_h
    y = y + bonus.reshape(B, S, RW_WIDTH)
    return (y * g.astype(f32)).astype(z.dtype)


def dsa_branch(z, kv_norm, w_uk, w_uv):
    B, S, _ = z.shape
    f32 = jnp.float32
    k_sel = min(IDX_TOPK_MAX, S // 4)
    q, c_kv, q_idx, k_idx, w_idx = _split(z, DSA_SIZES)
    q = q.reshape(B, S, DSA_HEADS, DSA_HEAD_DIM)
    c_kv = rmsnorm(c_kv, kv_norm)
    q_lat = jnp.einsum('bshd,rhd->bshr', q, w_uk) * (DSA_HEAD_DIM ** -0.5)
    q_idx = q_idx.reshape(B, S, IDX_HEADS, IDX_DIM)
    w_idx = w_idx * ((IDX_HEADS * IDX_DIM) ** -0.5)
    nb = S // Q_BLOCK
    to_blocks = lambda t: jnp.moveaxis(t.reshape(B, nb, Q_BLOCK, *t.shape[2:]), 1, 0)
    key_pos = jnp.arange(S)

    def block(args):
        b, ql, qi, wi = args
        t_pos = b * Q_BLOCK + jnp.arange(Q_BLOCK)
        rel = jax.nn.relu(jnp.einsum('bqhd,bsd->bqhs', qi, k_idx).astype(f32))
        iscore = jnp.einsum('bqh,bqhs->bqs', wi.astype(f32), rel)
        causal = key_pos[None, :] <= t_pos[:, None]
        iscore = jnp.where(causal[None], iscore, -jnp.inf)
        _, idx = lax.top_k(iscore, k_sel)
        valid = idx <= t_pos[None, :, None]
        c_sel = jax.vmap(lambda c, i: c[i])(c_kv, idx)
        s = jnp.einsum('bqhr,bqkr->bhqk', ql, c_sel).astype(f32)
        s = jnp.where(valid[:, None], s, -jnp.inf)
        p = jax.nn.softmax(s, axis=-1).astype(c_sel.dtype)
        o_lat = jnp.einsum('bhqk,bqkr->bqhr', p, c_sel)
        return jnp.einsum('bqhr,rhd->bqhd', o_lat, w_uv)

    o = lax.map(block, (jnp.arange(nb), to_blocks(q_lat), to_blocks(q_idx), to_blocks(w_idx)))
    return jnp.moveaxis(o, 0, 1).reshape(B, S, DSA_WIDTH)


def cross_attention(hn, mem_n, w_cq, w_ckv, w_co):
    B, S, _ = hn.shape
    M = mem_n.shape[1]
    q = (hn @ w_cq).reshape(B, S, X_HEADS, X_HEAD_DIM)
    k, v = jnp.split((mem_n @ w_ckv).reshape(B, M, 2, X_HEADS, X_HEAD_DIM), 2, axis=2)
    k, v = k[:, :, 0], v[:, :, 0]
    s = jnp.einsum('bshd,bmhd->bhsm', q, k).astype(jnp.float32) * (X_HEAD_DIM ** -0.5)
    p = jax.nn.softmax(s, axis=-1).astype(v.dtype)
    o = jnp.einsum('bhsm,bmhd->bshd', p, v).reshape(B, S, X_WIDTH)
    return o @ w_co


def hier_moe(hn, w_rg, b_rg, w_re, b_re, w_gate, w_up, w_down):
    B, S, D = hn.shape
    T = B * S
    xt = hn.reshape(T, D)
    g_prob = jax.nn.softmax((xt @ w_rg + b_rg).astype(jnp.float32), axis=-1)
    p_grp, grp = lax.top_k(g_prob, 1)
    e_logits = (xt @ w_re + b_re).astype(jnp.float32).reshape(T, N_GROUPS, EXPERTS_PER_GROUP)
    e_logits = jnp.take_along_axis(e_logits, grp[:, :, None], axis=1)[:, 0]
    p_e, e_loc = lax.top_k(jax.nn.softmax(e_logits, axis=-1), TOP_K_INNER)
    gate = p_grp * p_e / jnp.sum(p_e, -1, keepdims=True)
    expert = grp * EXPERTS_PER_GROUP + e_loc
    A = T * TOP_K_INNER
    e_flat = expert.reshape(A)
    tok_flat = jnp.repeat(jnp.arange(T, dtype=jnp.int32), TOP_K_INNER)
    g_flat = gate.reshape(A)
    order = jnp.argsort(e_flat)
    e_sorted = e_flat[order]
    counts = jnp.bincount(e_flat, length=N_EXPERTS)
    start = jnp.cumsum(counts) - counts
    padded = (counts + MOE_BLOCK - 1) // MOE_BLOCK * MOE_BLOCK
    pend = jnp.cumsum(padded)
    pstart = pend - padded
    dest = pstart[e_sorted] + (jnp.arange(A) - start[e_sorted])
    P = A + N_EXPERTS * MOE_BLOCK
    buf_tok = jnp.full((P,), T, jnp.int32).at[dest].set(tok_flat[order])
    buf_gate = jnp.zeros((P,), jnp.float32).at[dest].set(g_flat[order])
    n_blocks = P // MOE_BLOCK
    blk_expert = jnp.minimum(
        jnp.searchsorted(pend, jnp.arange(n_blocks) * MOE_BLOCK, side='right'), N_EXPERTS - 1)
    x_pad = jnp.concatenate([xt, jnp.zeros((1, D), xt.dtype)], axis=0)

    def run_block(args):
        e, toks, gts = args
        xb = x_pad[toks]
        hid = jax.nn.silu(xb @ w_gate[e]) * (xb @ w_up[e])
        return (hid @ w_down[e]) * gts[:, None].astype(xb.dtype)

    yb = lax.map(run_block, (blk_expert, buf_tok.reshape(n_blocks, MOE_BLOCK),
                             buf_gate.reshape(n_blocks, MOE_BLOCK)))
    y = jnp.zeros((T + 1, D), hn.dtype).at[buf_tok].add(yb.reshape(P, D))[:T]
    return y.reshape(B, S, D)


def hybrid_layer(h, mem, norm_mix, w_in, shift_mu, rw_w0, rw_w2, rw_a0, rw_a2, rw_g2,
                 rw_k_k, rw_k_a, rw_r_k, rw_ln_w, rw_ln_b, kv_norm, w_uk, w_uv,
                 w_proj_a, w_proj_b, b_gate, w_out, norm_cross, norm_mem, w_cq, w_ckv, w_co,
                 norm_ffn, w_router_g, b_router_g, w_router_e, b_router_e,
                 w_e_gate, w_e_up, w_e_down):
    z = rmsnorm(h, norm_mix) @ w_in
    z_rw, z_dsa, z_gate = _split(z, (RW_COLS, DSA_COLS, GATE_COLS))
    y_a = rwkv7_branch(z_rw, shift_mu, rw_w0, rw_w2, rw_a0, rw_a2, rw_g2,
                       rw_k_k, rw_k_a, rw_r_k, rw_ln_w, rw_ln_b)
    y_b = dsa_branch(z_dsa, kv_norm, w_uk, w_uv)
    g_a, g_b = jnp.split(jax.nn.sigmoid(z_gate + b_gate), 2, axis=-1)
    h = h + (g_a * (y_a @ w_proj_a) + g_b * (y_b @ w_proj_b)) @ w_out
    h = h + cross_attention(rmsnorm(h, norm_cross), rmsnorm(mem, norm_mem), w_cq, w_ckv, w_co)
    h = h + hier_moe(rmsnorm(h, norm_ffn), w_router_g, b_router_g, w_router_e, b_router_e,
                     w_e_gate, w_e_up, w_e_down)
    return h


def setup_inputs(seed: int = 0) -> dict:
    key = jax.random.key(seed)
    ks = iter(jax.random.split(key, 48))
    f32 = jnp.float32
    L = DEPTH

    def nrm(shape, scale):
        return jax.random.normal(next(ks), shape, f32) * scale

    def gain(shape):
        return 1.0 + nrm(shape, 0.02)

    return {
        'x': nrm((BATCH, SEQ, D_MODEL), 1.0),
        'mem': nrm((BATCH, N_MEM, D_MODEL), 1.0),
        'norm_mix': gain((L, D_MODEL)),
        'w_in': nrm((L, D_MODEL, IN_COLS), D_MODEL ** -0.5),
        'shift_mu': jax.random.uniform(next(ks), (L, RW_COLS), f32),
        'rw_w0': jax.random.uniform(next(ks), (L, RW_WIDTH), f32, -5.0, 1.0),
        'rw_w2': nrm((L, RW_DECAY_LORA, RW_WIDTH), 0.1 * RW_DECAY_LORA ** -0.5),
        'rw_a0': nrm((L, RW_WIDTH), 0.1),
        'rw_a2': nrm((L, RW_AAA_LORA, RW_WIDTH), 0.1 * RW_AAA_LORA ** -0.5),
        'rw_g2': nrm((L, RW_GATE_LORA, RW_WIDTH), RW_GATE_LORA ** -0.5),
        'rw_k_k': 0.85 + nrm((L, RW_WIDTH), 0.02),
        'rw_k_a': gain((L, RW_WIDTH)),
        'rw_r_k': nrm((L, RW_HEADS, RW_HEAD_DIM), 0.1),
        'rw_ln_w': gain((L, RW_WIDTH)),
        'rw_ln_b': nrm((L, RW_WIDTH), 0.01),
        'kv_norm': gain((L, DSA_KV_RANK)),
        'w_uk': nrm((L, DSA_KV_RANK, DSA_HEADS, DSA_HEAD_DIM), DSA_KV_RANK ** -0.5),
        'w_uv': nrm((L, DSA_KV_RANK, DSA_HEADS, DSA_HEAD_DIM), DSA_KV_RANK ** -0.5),
        'w_proj_a': nrm((L, RW_WIDTH, D_MODEL), RW_WIDTH ** -0.5),
        'w_proj_b': nrm((L, DSA_WIDTH, D_MODEL), DSA_WIDTH ** -0.5),
        'b_gate': nrm((L, GATE_COLS), 0.01),
        'w_out': nrm((L, D_MODEL, D_MODEL), D_MODEL ** -0.5),
        'norm_cross': gain((L, D_MODEL)),
        'norm_mem': gain((L, D_MODEL)),
        'w_cq': nrm((L, D_MODEL, X_WIDTH), D_MODEL ** -0.5),
        'w_ckv': nrm((L, D_MODEL, 2 * X_WIDTH), D_MODEL ** -0.5),
        'w_co': nrm((L, X_WIDTH, D_MODEL), X_WIDTH ** -0.5),
        'norm_ffn': gain((L, D_MODEL)),
        'w_router_g': nrm((L, D_MODEL, N_GROUPS), D_MODEL ** -0.5),
        'b_router_g': nrm((L, N_GROUPS), 0.01),
        'w_router_e': nrm((L, D_MODEL, N_EXPERTS), D_MODEL ** -0.5),
        'b_router_e': nrm((L, N_EXPERTS), 0.01),
        'w_e_gate': nrm((L, N_EXPERTS, D_MODEL, D_EXPERT), D_MODEL ** -0.5),
        'w_e_up': nrm((L, N_EXPERTS, D_MODEL, D_EXPERT), D_MODEL ** -0.5),
        'w_e_down': nrm((L, N_EXPERTS, D_EXPERT, D_MODEL), D_EXPERT ** -0.5),
        'norm_final': gain((D_MODEL,)),
    }


def reference(x, mem, norm_mix, w_in, shift_mu, rw_w0, rw_w2, rw_a0, rw_a2, rw_g2,
              rw_k_k, rw_k_a, rw_r_k, rw_ln_w, rw_ln_b, kv_norm, w_uk, w_uv,
              w_proj_a, w_proj_b, b_gate, w_out, norm_cross, norm_mem, w_cq, w_ckv, w_co,
              norm_ffn, w_router_g, b_router_g, w_router_e, b_router_e,
              w_e_gate, w_e_up, w_e_down, norm_final):
    h = x
    for l in range(DEPTH):
        h = hybrid_layer(h, mem, norm_mix[l], w_in[l], shift_mu[l], rw_w0[l], rw_w2[l],
                         rw_a0[l], rw_a2[l], rw_g2[l], rw_k_k[l], rw_k_a[l], rw_r_k[l],
                         rw_ln_w[l], rw_ln_b[l], kv_norm[l], w_uk[l], w_uv[l],
                         w_proj_a[l], w_proj_b[l], b_gate[l], w_out[l],
                         norm_cross[l], norm_mem[l], w_cq[l], w_ckv[l], w_co[l],
                         norm_ffn[l], w_router_g[l], b_router_g[l], w_router_e[l], b_router_e[l],
                         w_e_gate[l], w_e_up[l], w_e_down[l])
    return rmsnorm(h, norm_final)
```

```cpp
#include <hip/hip_runtime.h>
#include <hip/hip_cooperative_groups.h>
#include <cstdio>
#include <cstdint>
namespace cg = cooperative_groups;
#define RWKV_CHUNKED 1
#define PROBE_DUP 0u

#define GAS __attribute__((address_space(1)))
#define LAS __attribute__((address_space(3)))
typedef unsigned short bf16;
typedef unsigned v4u __attribute__((ext_vector_type(4)));
typedef unsigned v2u __attribute__((ext_vector_type(2)));
typedef float f32x4 __attribute__((ext_vector_type(4)));
typedef float f32x2 __attribute__((ext_vector_type(2)));
typedef short bf16x8 __attribute__((ext_vector_type(8)));
typedef short s16x4 __attribute__((ext_vector_type(4)));

constexpr int NB = 16, SEQ = 4096, T = NB * SEQ, D = 1024;
constexpr int NIN = 5376;
constexpr int NWAVES = 8, NTHREADS = 512;
constexpr int PSLOT = 2 * T + 32 * 256;

constexpr size_t MiB = 1u << 20;
constexpr size_t WS_CTL = 0, CTL_ZERO_BYTES = 1 * MiB;
constexpr size_t WS_WIN = 2 * MiB, WS_WA = 13 * MiB, WS_WB = 14 * MiB, WS_WOUT = 16 * MiB, WS_WCQ = 18 * MiB, WS_WCKV = 20 * MiB, WS_WCO = 24 * MiB;
constexpr size_t WS_BLORA = 26 * MiB, WS_WR = 27 * MiB, WS_WGU = 28 * MiB, WS_WD = 92 * MiB;
constexpr size_t WS_MEMN = 124 * MiB, WS_KMEM = 132 * MiB, WS_VT = 140 * MiB;
constexpr size_t WS_ZRKV = 150 * MiB, WS_ZLORA = 342 * MiB, WS_QLAT = 374 * MiB, WS_ZD = 502 * MiB, WS_G = 566 * MiB, WS_CKV = 822 * MiB, WS_IDX = 838 * MiB, WS_YA = 870 * MiB, WS_YC = 934 * MiB;
constexpr size_t WS_H1B = 694 * MiB  , WS_H2B = 218 * MiB  ;
constexpr size_t WS_U = WS_ZRKV, WS_HN = WS_G, WS_QC = WS_QLAT, WS_HN8 = WS_QLAT  , WS_LOGIT = 694 * MiB, WS_ROUTE = 710 * MiB, WS_HID = WS_ZRKV, WS_YS = 714 * MiB, WS_XO = WS_YA  , WS_XN8 = WS_YA  , WS_WG8 = 60 * MiB  , WS_WQ8 = 62 * MiB  , WS_END = 998 * MiB;
constexpr size_t DO_XN = 0, DO_ALORA = 0, DO_WAG = 32 * MiB, DO_SB = 224 * MiB;
constexpr int CW_BAR = 4096, CW_CNT = 1024, CW_FILL = 1088, CW_RK = 2048;

constexpr int RING_BYTES = 131072, MISC_OFF = 8 * 16 * 260 * 4 + 16384  , LDS_BYTES = MISC_OFF + 1024;

typedef __bf16 bf16x2_t __attribute__((ext_vector_type(2)));
__device__ __forceinline__ unsigned cvt_pk_bf16(float lo, float hi) { const f32x2 v = {lo, hi}; const bf16x2_t b = __builtin_convertvector(v, bf16x2_t); return __builtin_bit_cast(unsigned, b); }
typedef int v8i __attribute__((ext_vector_type(8)));
typedef int v4i __attribute__((ext_vector_type(4)));
typedef v8i v8i_a16 __attribute__((aligned(16)));
__device__ __forceinline__ unsigned pk4_fp8(float a, float b, float c, float d) { unsigned w = (unsigned)__builtin_amdgcn_cvt_pk_fp8_f32(a, b, 0, false); return (unsigned)__builtin_amdgcn_cvt_pk_fp8_f32(c, d, (int)w, true); }
__device__ __forceinline__ float bf2f(unsigned b) { return __uint_as_float(b << 16); }
__device__ __forceinline__ float bflo(unsigned w) { return __uint_as_float(w << 16); }
__device__ __forceinline__ float bfhi(unsigned w) { return __uint_as_float(w & 0xffff0000u); }
__device__ __forceinline__ float fsigmoid(float x) { return __builtin_amdgcn_rcpf(1.0f + __expf(-x)); }
__device__ __forceinline__ unsigned lds_add(LAS unsigned* p, unsigned v) { return __hip_atomic_fetch_add(p, v, __ATOMIC_RELAXED, __HIP_MEMORY_SCOPE_WORKGROUP); }
__device__ __forceinline__ float wave_sum(float v) {
#pragma unroll
    for (int o = 1; o < 64; o <<= 1) v += __shfl_xor(v, o);
    return v;
}
__device__ __forceinline__ float dpp_f(float v, const int ctrl_sel) {
    int x = __builtin_bit_cast(int, v), r;
    if (ctrl_sel == 0) r = __builtin_amdgcn_update_dpp(x, x, 0xB1, 0xF, 0xF, false);
    else if (ctrl_sel == 1) r = __builtin_amdgcn_update_dpp(x, x, 0x4E, 0xF, 0xF, false);
    else if (ctrl_sel == 2) r = __builtin_amdgcn_update_dpp(x, x, 0x141, 0xF, 0xF, false);
    else r = __builtin_amdgcn_update_dpp(x, x, 0x140, 0xF, 0xF, false);
    return __builtin_bit_cast(float, r);
}
__device__ __forceinline__ float sum8(float v) {
    v += dpp_f(v, 0); v += dpp_f(v, 1); v += dpp_f(v, 2); return v;
}

#define XB_TMO      128
#define XB_XCNT(j)  (256  + 64 * (j))
#define XB_XSUB(j)  (1280 + 64 * (j))
#define XB_XGEN(j)  (2304 + 64 * (j))
#define XB_TOP      3328
#define XB_TOPGEN   3392
#define XCD_BAR_WORDS 3456
#define XB_SPIN_CAP (1u << 20)
__device__ __forceinline__ unsigned xb_ld(unsigned* p)              { return __hip_atomic_load(p, __ATOMIC_RELAXED, __HIP_MEMORY_SCOPE_AGENT); }
__device__ __forceinline__ unsigned xb_add(unsigned* p, unsigned v) { return __hip_atomic_fetch_add(p, v, __ATOMIC_RELAXED, __HIP_MEMORY_SCOPE_AGENT); }
__device__ __forceinline__ unsigned xb_xcc_id() { return (unsigned)__builtin_amdgcn_s_getreg((3 << 11) | 20) & 0xFu; }
#define XB_SPIN(cond, bar) do { unsigned _sp = 0; while (cond) { __builtin_amdgcn_s_sleep(1); \
    if ((++_sp & 255u) == 0u) { if (xb_ld(&(bar)[XB_TMO])) break; if (_sp > XB_SPIN_CAP) { atomicAdd(&(bar)[XB_TMO], 1u); break; } } } } while (0)
struct XcdBarrier { unsigned* bar; unsigned x; volatile LAS unsigned* st; };
__device__ __forceinline__ XcdBarrier xcd_barrier_post(unsigned* bar, volatile LAS unsigned* st) {
    XcdBarrier b; b.bar = bar; b.x = xb_xcc_id(); b.st = st;
    if (threadIdx.x == 0) (void)xb_add(&bar[XB_XCNT(b.x)], 1u);
    return b;
}
__device__ __forceinline__ void xcd_barrier_complete(unsigned* bar, unsigned x, unsigned& nloc, unsigned& nx) {
    const unsigned G = gridDim.x * gridDim.y * gridDim.z;
    unsigned sum, cnt, mine, sp = 0u;
    for (;;) {
        sum = 0u; cnt = 0u; mine = 0u;
#pragma unroll
        for (unsigned j = 0; j < 16; ++j) { const unsigned c = xb_ld(&bar[XB_XCNT(j)]); sum += c; cnt += (c > 0u) ? 1u : 0u; mine = (j == x) ? c : mine; }
        if (sum == G) break;
        __builtin_amdgcn_s_sleep(1);
        if ((++sp & 255u) == 0u) { if (xb_ld(&bar[XB_TMO])) break; if (sp > XB_SPIN_CAP) { atomicAdd(&bar[XB_TMO], 1u); break; } }
    }
    nloc = mine > 0u ? mine : 1u; nx = cnt > 0u ? cnt : 1u;
}
__device__ __forceinline__ void xcd_barrier(const XcdBarrier& b) {
    asm volatile("s_waitcnt vmcnt(0)" ::: "memory");
    __syncthreads();
    if (threadIdx.x == 0) {
        unsigned* bar = b.bar;
        __builtin_amdgcn_s_waitcnt(0);
        unsigned nloc = b.st[0], nx = b.st[1];
        if (nloc == 0u) { xcd_barrier_complete(bar, b.x, nloc, nx); b.st[0] = nloc; b.st[1] = nx; }
        const unsigned old = xb_add(&bar[XB_XSUB(b.x)], 1u);
        const unsigned gen = old / nloc;
        if (old + 1u == (gen + 1u) * nloc) {
            __builtin_amdgcn_fence(__ATOMIC_RELEASE, "agent");
            asm volatile("s_waitcnt vmcnt(0)" ::: "memory");
            const unsigned og = xb_add(&bar[XB_TOP], 1u);
            const unsigned tg = og / nx;
            if (og + 1u == (tg + 1u) * nx) xb_add(&bar[XB_TOPGEN], 1u);
            else XB_SPIN(xb_ld(&bar[XB_TOPGEN]) == tg, bar);
            __builtin_amdgcn_fence(__ATOMIC_ACQUIRE, "agent");
            xb_add(&bar[XB_XGEN(b.x)], 1u);
            asm volatile("s_waitcnt vmcnt(0)" ::: "memory");
        } else {
            XB_SPIN(xb_ld(&bar[XB_XGEN(b.x)]) == gen, bar);
            __builtin_amdgcn_fence(__ATOMIC_ACQUIRE, "agent");
            asm volatile("s_waitcnt vmcnt(0)" ::: "memory");
        }
    }
    __syncthreads();
}

namespace pg8 {
constexpr int BM = 256, BK = 64, HALF = 128, HTB = HALF * BK * 2, NXCD = 8, WGM = 2;
__host__ __device__ __forceinline__ int lds_byte(int r, int c) { const int st = (r >> 4) * 2 + (c >> 5), rr = r & 15, cc = c & 31, ob = rr * 64 + cc * 2; return st * 1024 + (ob ^ (((ob >> 9) & 1) << 5)); }
__host__ __device__ __forceinline__ void stage_rc(int b, int& R, int& C) { const int st = b / 1024, sb = b % 1024, swz = sb ^ (((sb >> 9) & 1) << 5); R = (st >> 1) * 16 + swz / 64; C = (st & 1) * 32 + (swz % 64) / 2; }
__host__ __device__ __forceinline__ int perm32(int rho) { const int n = rho >> 4, i = rho & 15; return 8 * (i >> 2) + 4 * n + (i & 3); }

struct Unit { int pm, pn; const char* a; const char* b; const int* gidx; };

struct StaticOrder {
    const char* A; const char* Bt; int K; int nM, nN, nwg, G, c;
    __device__ void init(const void* A_, const void* Bt_, int M, int N, int K_, int G_, int c_) { A = (const char*)A_; Bt = (const char*)Bt_; K = K_; nM = M / BM; nN = N / BM; nwg = nM * nN; G = G_; c = c_; }
    __device__ bool next(int i, Unit& u) const {
        const long L = (long)i * G + c; if (L >= nwg) return false;
        int wgid = (int)L; { const int q = nwg / NXCD, r = nwg % NXCD, xcd = wgid % NXCD, off = wgid / NXCD; wgid = (xcd < r ? xcd * (q + 1) : r * (q + 1) + (xcd - r) * q) + off; }
        const int nig = WGM * nN, gid = wgid / nig, fm = gid * WGM, gsz = (nM - fm) < WGM ? (nM - fm) : WGM;
        u.pm = fm + ((wgid % nig) % gsz); u.pn = (wgid % nig) / gsz;
        u.a = A + (size_t)u.pm * 256 * K * 2; u.b = Bt + (size_t)u.pn * 256 * K * 2; u.gidx = nullptr; return true;
    }
};

template <class Epi, class Sched, bool GATHER, bool F8 = false>
__device__ __forceinline__ void gemm_phase(LAS unsigned char* lds, const int K_, const Sched& S, const Epi& E) {
    int K = K_; asm volatile("" : "+s"(K));
    int tid = threadIdx.x; asm volatile("" : "+v"(tid));
    const int wid = __builtin_amdgcn_readfirstlane(tid >> 6), lane = tid & 63, wr = wid >> 2, wc = wid & 3, fr = lane & 15, fq = lane >> 4;
    const int nt = K / BK;
    const size_t kstep = (size_t)(BK * 2);
    const size_t hstep = (size_t)HALF * K * 2;
    int stR[2], stC[2];
    unsigned voffB[2], cvo[2][2], nvo[2][2];
#pragma unroll
    for (int i = 0; i < 2; ++i) { int R, C; stage_rc(tid * 16 + i * 8192, R, C); stR[i] = R; stC[i] = C; const int Rb = Epi::PERM ? ((R & ~31) + perm32(R & 31)) : R;
        voffB[i] = (unsigned)(Rb * K + C) * 2u;
        cvo[0][i] = (unsigned)(R * K + C) * 2u; cvo[1][i] = cvo[0][i] + (unsigned)hstep; nvo[0][i] = cvo[0][i]; nvo[1][i] = cvo[1][i]; }
    const unsigned ldsw = (unsigned)wid * 1024u;
    const int aoff = F8 ? lds_byte(wr * 64 + fr, fq * 16) : lds_byte(wr * 64 + fr, fq * 8), boff = F8 ? lds_byte(wc * 32 + fr, fq * 16) : lds_byte(wc * 32 + fr, fq * 8);
#define PG8_SA(b, h) (((b) * 2 + (h)) * HTB)
#define PG8_SB(b, h) ((4 + (b) * 2 + (h)) * HTB)
#define PG8_STAGE(bufoff, gbase, voff) do { _Pragma("unroll") for (int _i = 0; _i < 2; ++_i) \
        __builtin_amdgcn_global_load_lds((const unsigned*)((const char*)(gbase) + (voff)[_i]), (LAS unsigned*)(lds + (bufoff) + ldsw + _i * 8192), 16, 0, 0); } while (0)
#define PG8_LDA(dst, b, h) do { if constexpr (F8) { _Pragma("unroll") for (int m = 0; m < 4; ++m) dst##8[m] = *(const LAS v8i_a16*)(lds + PG8_SA(b, h) + aoff + m * 2048); } \
    else { _Pragma("unroll") for (int m = 0; m < 4; ++m) _Pragma("unroll") for (int k = 0; k < 2; ++k) dst[m][k] = *(const LAS bf16x8*)(lds + PG8_SA(b, h) + aoff + m * 2048 + k * 1024); } } while (0)
#define PG8_LDB(dst, b, h) do { if constexpr (F8) { _Pragma("unroll") for (int n = 0; n < 2; ++n) dst##8[n] = *(const LAS v8i_a16*)(lds + PG8_SB(b, h) + boff + n * 2048); } \
    else { _Pragma("unroll") for (int n = 0; n < 2; ++n) _Pragma("unroll") for (int k = 0; k < 2; ++k) dst[n][k] = *(const LAS bf16x8*)(lds + PG8_SB(b, h) + boff + n * 2048 + k * 1024); } } while (0)
#define PG8_MMA(ai, bj, At, Bt) do { __builtin_amdgcn_s_setprio(1); if constexpr (F8) { _Pragma("unroll") for (int m = 0; m < 4; ++m) _Pragma("unroll") for (int n = 0; n < 2; ++n) { \
            asm volatile("v_mfma_scale_f32_16x16x128_f8f6f4 %0, %1, %2, %0, %3, %3 op_sel_hi:[0,0,0]" : "+v"(acc[ai][bj][m][n]) : "v"(Bt##8[n]), "v"(At##8[m]), "v"(f8one)); } } \
        else { _Pragma("unroll") for (int m = 0; m < 4; ++m) _Pragma("unroll") for (int n = 0; n < 2; ++n) _Pragma("unroll") for (int k = 0; k < 2; ++k) \
        acc[ai][bj][m][n] = __builtin_amdgcn_mfma_f32_16x16x32_bf16(Bt[n][k], At[m][k], acc[ai][bj][m][n], 0, 0, 0); } __builtin_amdgcn_s_setprio(0); } while (0)
#define PG8_WAIT_V(n) asm volatile("s_waitcnt vmcnt(" #n ")" ::: "memory")
#define PG8_WAIT_L(n) asm volatile("s_waitcnt lgkmcnt(" #n ")" ::: "memory")
#define PG8_BAR __builtin_amdgcn_s_barrier()
#define PG8_SCHED __builtin_amdgcn_sched_barrier(0)
    Unit cur, nxt; int ui = 0;
    if (!S.next(0, cur)) return;
    if constexpr (GATHER) {
#pragma unroll
        for (int h = 0; h < 2; ++h)
#pragma unroll
            for (int i = 0; i < 2; ++i) cvo[h][i] = (unsigned)(cur.gidx[h * HALF + stR[i]] * K + stC[i]) * 2u;
    }
    f32x4 acc[2][2][4][2];
#pragma unroll
    for (int a = 0; a < 2; ++a)
#pragma unroll
        for (int b = 0; b < 2; ++b)
#pragma unroll
            for (int m = 0; m < 4; ++m)
#pragma unroll
                for (int n = 0; n < 2; ++n) acc[a][b][m][n] = (f32x4){0.f, 0.f, 0.f, 0.f};
    bf16x8 At[4][2], B0[2][2], B1[2][2]; v8i At8[4], B08[2], B18[2];
    const int f8one = 0x7f7f7f7f;
    const char* cA = cur.a; const char* cB = cur.b;
    PG8_STAGE(PG8_SB(0, 0), cB, voffB); PG8_STAGE(PG8_SB(0, 1), cB + hstep, voffB); PG8_STAGE(PG8_SA(0, 0), cA, cvo[0]); PG8_STAGE(PG8_SA(0, 1), cA, cvo[1]);
    if (wr == 1) PG8_BAR;
    PG8_WAIT_V(2); PG8_BAR;
    PG8_STAGE(PG8_SB(1, 0), cB + kstep, voffB); PG8_STAGE(PG8_SA(1, 0), cA + kstep, cvo[0]); PG8_STAGE(PG8_SB(1, 1), cB + hstep + kstep, voffB);
    PG8_WAIT_V(6); PG8_BAR;
    for (;;) {
        const bool has_next = S.next(ui + 1, nxt);
        const char* nA = has_next ? nxt.a : cA; const char* nB = has_next ? nxt.b : cB;
        if constexpr (GATHER) {
            if (has_next) {
#pragma unroll
                for (int h = 0; h < 2; ++h)
#pragma unroll
                    for (int i = 0; i < 2; ++i) nvo[h][i] = (unsigned)(nxt.gidx[h * HALF + stR[i]] * K + stC[i]) * 2u;
            } else {
#pragma unroll
                for (int h = 0; h < 2; ++h)
#pragma unroll
                    for (int i = 0; i < 2; ++i) nvo[h][i] = cvo[h][i];
            }
        }
        for (int t = 0; t < nt; t += 2) {
            const bool last = (t == nt - 2);
            const char* a1 = cA + (size_t)(t + 1) * kstep;
            const char* a2 = last ? nA : cA + (size_t)(t + 2) * kstep; const char* b2 = last ? nB : cB + (size_t)(t + 2) * kstep;
            const char* a3 = a2 + kstep; const char* b3 = b2 + kstep;
            unsigned v2[2][2];
#pragma unroll
            for (int h = 0; h < 2; ++h)
#pragma unroll
                for (int i = 0; i < 2; ++i) v2[h][i] = (GATHER && last) ? nvo[h][i] : cvo[h][i];
            PG8_LDB(B0, 0, 0); PG8_LDB(B1, 0, 1); PG8_SCHED; PG8_LDA(At, 0, 0); PG8_STAGE(PG8_SA(1, 1), a1, cvo[1]);
            PG8_WAIT_V(8); PG8_WAIT_L(0); PG8_BAR; PG8_MMA(0, 0, At, B0); PG8_MMA(0, 1, At, B1); PG8_BAR; PG8_SCHED;
            PG8_LDA(At, 0, 1); PG8_STAGE(PG8_SB(0, 0), b2, voffB); PG8_STAGE(PG8_SB(0, 1), b2 + hstep, voffB); PG8_STAGE(PG8_SA(0, 0), a2, v2[0]);
            PG8_WAIT_V(8); PG8_WAIT_L(0); PG8_BAR; PG8_MMA(1, 0, At, B0); PG8_MMA(1, 1, At, B1); PG8_BAR; PG8_SCHED;
            PG8_LDB(B0, 1, 0); PG8_LDB(B1, 1, 1); PG8_SCHED; PG8_LDA(At, 1, 0); PG8_STAGE(PG8_SA(0, 1), a2, v2[1]);
            PG8_WAIT_V(8); PG8_WAIT_L(0); PG8_BAR; PG8_MMA(0, 0, At, B0); PG8_MMA(0, 1, At, B1); PG8_BAR; PG8_SCHED;
            PG8_LDA(At, 1, 1); PG8_STAGE(PG8_SB(1, 0), b3, voffB); PG8_STAGE(PG8_SB(1, 1), b3 + hstep, voffB); PG8_STAGE(PG8_SA(1, 0), a3, v2[0]);
            PG8_WAIT_V(8); PG8_WAIT_L(0); PG8_BAR; PG8_MMA(1, 0, At, B0); PG8_MMA(1, 1, At, B1); PG8_BAR; PG8_SCHED;
        }
        if (wr == 0) PG8_BAR;
        if constexpr (F8) asm volatile("s_nop 15\n\ts_nop 15" ::: "memory");
        E(acc, cur, wr, wc, fr, fq);
        if (!has_next) break;
#pragma unroll
        for (int a = 0; a < 2; ++a)
#pragma unroll
            for (int b = 0; b < 2; ++b)
#pragma unroll
                for (int m = 0; m < 4; ++m)
#pragma unroll
                    for (int n = 0; n < 2; ++n) acc[a][b][m][n] = (f32x4){0.f, 0.f, 0.f, 0.f};
        cur = nxt; cA = nA; cB = nB; ++ui;
        if constexpr (GATHER) {
#pragma unroll
            for (int h = 0; h < 2; ++h)
#pragma unroll
                for (int i = 0; i < 2; ++i) cvo[h][i] = nvo[h][i];
        }
        if (wr == 1) PG8_BAR;
    }
    PG8_WAIT_V(0);
    PG8_BAR;
#undef PG8_SA
#undef PG8_SB
#undef PG8_STAGE
#undef PG8_LDA
#undef PG8_LDB
#undef PG8_MMA
#undef PG8_WAIT_V
#undef PG8_WAIT_L
#undef PG8_BAR
#undef PG8_SCHED
}
}
using pg8::Unit;

struct Args { const float* in[36]; float* out; unsigned char* ws; };
struct Frame {
    LAS unsigned char* lds; volatile LAS unsigned* MISC; unsigned* ctl;
    int tid, lane, wave, vcu, G, gw, NGW;
    const float* const* in; float* out; unsigned char* ws;
};
#define WSP(T_, off) ((T_*)(F.ws + (off)))
#define DOP(T_, off) ((T_*)((unsigned char*)F.out + (off)))

struct XArg { const float* W; int ldw, col0; bf16* WT; int ldt, row_off, kdst, kb, nb; float f8scale; };
__device__ __forceinline__ void xpose_load(const XArg& x, int lane, f32x4 (&r)[8]) {
    const float* p = x.W + (size_t)(64 * x.kb + (lane >> 3)) * x.ldw + x.col0 + 32 * x.nb + 4 * (lane & 7);
#pragma unroll
    for (int i = 0; i < 8; ++i) r[i] = *(const f32x4*)(p + (size_t)(8 * i) * x.ldw);
    __builtin_amdgcn_sched_barrier(0);
}
__device__ __forceinline__ void xpose_store(const XArg& x, int lane, const f32x4 (&r)[8], LAS float* scr) {
    const int k0 = 64 * x.kb, n0 = 32 * x.nb;
#pragma unroll
    for (int i = 0; i < 8; ++i) { LAS float* d = scr + (8 * i + (lane >> 3)) * 33 + 4 * (lane & 7); d[0] = r[i].x; d[1] = r[i].y; d[2] = r[i].z; d[3] = r[i].w; }
    asm volatile("s_waitcnt lgkmcnt(0)" ::: "memory");
    const int c = lane & 7; const float f8scale = x.f8scale; bf16* WT = x.WT;
#pragma unroll
    for (int j = 0; j < 4; ++j) { const int n = (lane >> 3) + 8 * j; const LAS float* s = scr + (8 * c) * 33 + n;
        if (f8scale != 0.f) *(v2u*)((unsigned char*)WT + (size_t)(x.row_off + n0 + n) * x.ldt + x.kdst + k0 + 8 * c) = (v2u){pk4_fp8(s[0 * 33] * f8scale, s[1 * 33] * f8scale, s[2 * 33] * f8scale, s[3 * 33] * f8scale), pk4_fp8(s[4 * 33] * f8scale, s[5 * 33] * f8scale, s[6 * 33] * f8scale, s[7 * 33] * f8scale)};
        else { v4u o; o.x = cvt_pk_bf16(s[0 * 33], s[1 * 33]); o.y = cvt_pk_bf16(s[2 * 33], s[3 * 33]); o.z = cvt_pk_bf16(s[4 * 33], s[5 * 33]); o.w = cvt_pk_bf16(s[6 * 33], s[7 * 33]);
            *(v4u*)(WT + (size_t)(x.row_off + n0 + n) * x.ldt + x.kdst + k0 + 8 * c) = o; } }
    asm volatile("s_waitcnt lgkmcnt(0)" ::: "memory");
}
template <class GetArg>
__device__ __forceinline__ void xpose_pipe(Frame& F, int nit, GetArg getarg) {
    LAS float* scr = (LAS float*)(F.lds + F.wave * 16384);
    const int lane = F.lane, step = F.NGW; int it = F.gw;
    if (it >= nit) return;
    f32x4 A[8], B[8];
    XArg aA = getarg(it), aB = getarg(it + step < nit ? it + step : it);
    xpose_load(aA, lane, A); xpose_load(aB, lane, B);
#define XP_DO(S_, a_) { if (it < nit) { f32x4 c_[8]; _Pragma("unroll") for (int i = 0; i < 8; ++i) c_[i] = S_[i]; const XArg ca_ = a_; const int itn_ = it + 2 * step; \
        a_ = getarg(itn_ < nit ? itn_ : it); xpose_load(a_, lane, S_); xpose_store(ca_, lane, c_, scr); it += step; } }
    while (it < nit) { XP_DO(A, aA); XP_DO(B, aB); }
#undef XP_DO
}
__device__ __forceinline__ void xpose_job(Frame& F, const float* W, int ldw, int col0, int K, int N, bf16* WT, int ldt, int row_off, int kdst) {
    const int nblk = N / 32, nit = (K / 64) * nblk;
    xpose_pipe(F, nit, [&](int it) { return XArg{W, ldw, col0, WT, ldt, row_off, kdst, it / nblk, it % nblk, 0.f}; });
}
__device__ __forceinline__ void rms_row_to_bf16(const float* xrow, const float* g, bf16* orow, int lane, unsigned* o8row = nullptr) {
    const f32x4* xr = (const f32x4*)xrow + lane; const f32x4* gr = (const f32x4*)g + lane;
    f32x4 v[4]; float s = 0.f;
#pragma unroll
    for (int j = 0; j < 4; ++j) { v[j] = xr[64 * j]; s += (v[j].x * v[j].x + v[j].y * v[j].y) + (v[j].z * v[j].z + v[j].w * v[j].w); }
    const float rstd = rsqrtf(wave_sum(s) * (1.f / 1024.f) + 1e-6f);
    v2u* o8 = (v2u*)orow + lane;
#pragma unroll
    for (int j = 0; j < 4; ++j) { const f32x4 gg = gr[64 * j]; v2u o; o.x = cvt_pk_bf16(v[j].x * rstd * gg.x, v[j].y * rstd * gg.y); o.y = cvt_pk_bf16(v[j].z * rstd * gg.z, v[j].w * rstd * gg.w); o8[64 * j] = o;
        if (o8row) o8row[64 * j + lane] = pk4_fp8(v[j].x * rstd * gg.x, v[j].y * rstd * gg.y, v[j].z * rstd * gg.z, v[j].w * rstd * gg.w); }
}

__device__ __forceinline__ void p0_prologue(Frame& F) {
    const float* w_in = F.in[3];
    bf16* WinT = WSP(bf16, WS_WIN);
    {
        struct Job { const float* W; int ldw, col0; void* WT; int ldt, row_off, kdst, nblk, nit; float f8; };
        const Job jobs[13] = {
            {w_in, 4804, 0, WinT, 1024, 0, 0, 56, 16 * 56, 0.f},
            {w_in, 4804, 2304, WinT, 1024, 2816, 0, 4, 16 * 4, 0.f},
            {w_in, 4804, 2688, WinT, 1024, 2816 + 128, 0, 2, 16 * 2, 0.f},
            {w_in, 4804, 2432, WinT, 1024, 2816 + 256, 0, 8, 16 * 8, 0.f},
            {w_in, 4804, 2756, F.ws + WS_WG8, 1024, 0, 0, 64, 16 * 64, 16.f},
            {F.in[18], 1024, 0, F.ws + WS_WA, 512, 0, 0, 32, 8 * 32, 0.f},
            {F.in[21], 1024, 0, F.ws + WS_WOUT, 1024, 0, 0, 32, 16 * 32, 0.f},
            {F.in[24], 1024, 0, F.ws + WS_WCQ, 1024, 0, 0, 32, 16 * 32, 16.f},
            {F.in[25], 2048, 0, F.ws + WS_WCKV, 1024, 0, 0, 64, 16 * 64, 0.f},
            {F.in[26], 1024, 0, F.ws + WS_WCO, 1024, 0, 0, 32, 16 * 32, 16.f},
            {F.in[6], 512, 0, F.ws + WS_BLORA, 256, 0, 0, 16, 1 * 16, 0.f},
            {F.in[8], 512, 0, F.ws + WS_BLORA, 256, 512, 64, 16, 1 * 16, 0.f},
            {F.in[9], 512, 0, F.ws + WS_BLORA, 256, 1024, 128, 16, 2 * 16, 0.f}};
        constexpr int NGU = 32 * 2 * 16 * 16, NDN = 32 * 8 * 32;
        int nsmall = 0;
#pragma unroll
        for (int j = 0; j < 13; ++j) nsmall += jobs[j].nit;
        xpose_pipe(F, NGU + NDN + nsmall, [&](int it) {
            if (it < NGU) {
                const int nb = it & 15, kb = (it >> 4) & 15, which = (it >> 8) & 1, e = it >> 9;
                const float* W = (which ? F.in[33] : F.in[32]) + (size_t)e * 1024 * 512;
                const int n0 = 32 * nb, drow = 256 * (n0 >> 7) + (n0 & 127) + 128 * which;
                return XArg{W, 512, 0, (bf16*)(F.ws + WS_WGU + (size_t)e * 1024 * 1024), 1024, drow - n0, 0, kb, nb, 16.f}; }
            it -= NGU;
            if (it < NDN) {
                const int nb = it & 31, kb = (it >> 5) & 7, e = it >> 8;
                return XArg{F.in[34] + (size_t)e * 512 * 1024, 1024, 0, (bf16*)(F.ws + WS_WD + (size_t)e * 1024 * 512), 512, 0, 0, kb, nb, 16.f}; }
            it -= NDN;
            XArg r = XArg{jobs[12].W, jobs[12].ldw, jobs[12].col0, (bf16*)jobs[12].WT, jobs[12].ldt, jobs[12].row_off, jobs[12].kdst, 0, 0, jobs[12].f8}; int nblk = jobs[12].nblk, loc = it;
            int acc = 0; bool found = false;
#pragma unroll
            for (int j = 0; j < 13; ++j) { const bool here = !found && it < acc + jobs[j].nit;
                if (here) { r = XArg{jobs[j].W, jobs[j].ldw, jobs[j].col0, (bf16*)jobs[j].WT, jobs[j].ldt, jobs[j].row_off, jobs[j].kdst, 0, 0, jobs[j].f8}; nblk = jobs[j].nblk; loc = it - acc; found = true; }
                acc += jobs[j].nit; }
            r.kb = loc / nblk; r.nb = loc % nblk; return r; });
    }
    const int gt = F.vcu * NTHREADS + F.tid, NGT = F.G * NTHREADS;
    for (int i = gt; i < 64 * 1024; i += NGT) { const int n = i >> 10, k = i & 1023; WinT[(size_t)(2816 + 192 + n) * 1024 + k] = (n < 4) ? (bf16)(cvt_pk_bf16(w_in[(size_t)k * 4804 + 2752 + n], 0.f) & 0xffff) : (bf16)0; }
    { bf16* BL = WSP(bf16, WS_BLORA);
      for (int i = gt; i < 1536 * 256; i += NGT) { const int n = i >> 8, k = i & 255; const int seg = n >> 9; const bool diag = (seg == 0) ? (k < 64) : (seg == 1) ? (k >= 64 && k < 128) : (k >= 128); if (!diag) BL[i] = 0; } }
    { bf16* WR = WSP(bf16, WS_WR);
      for (int i = gt; i < 256 * 1024; i += NGT) { const int n = i >> 10, k = i & 1023; float v = 0.f; if (n < 4) v = F.in[28][k * 4 + n]; else if (n < 36) v = F.in[30][k * 32 + (n - 4)]; WR[i] = (bf16)(cvt_pk_bf16(v, 0.f) & 0xffff); } }
    for (int task = F.vcu; task < 256; task += F.G) {
        const bool isq = task < 128; const int h = (task >> 4) & 7, chunk = task & 15;
        LAS float* sw = (LAS float*)F.lds;
        const float* src = isq ? F.in[16] : F.in[17]; const float* wpb = F.in[19]; bf16* WbT = WSP(bf16, WS_WB);
        __syncthreads();
        for (int i = F.tid; i < 128 * 16; i += NTHREADS) { const int r = i >> 4, q = i & 15; *(LAS f32x4*)(sw + r * 64 + q * 4) = *(const f32x4*)(src + (size_t)r * 512 + h * 64 + q * 4); }
        __syncthreads();
        const int idx = chunk * 64 + F.lane;
        float a[64];
        if (isq) {
#pragma unroll
            for (int q = 0; q < 16; ++q) { const f32x4 t4 = *(const f32x4*)(w_in + (size_t)idx * 4804 + 1792 + h * 64 + 4 * q); a[4 * q] = t4[0]; a[4 * q + 1] = t4[1]; a[4 * q + 2] = t4[2]; a[4 * q + 3] = t4[3]; }
        } else {
            const float* p = wpb + (size_t)(h * 64) * 1024 + idx;
#pragma unroll
            for (int g4 = 0; g4 < 8; ++g4) {
#pragma unroll
                for (int d = 0; d < 8; ++d) a[8 * g4 + d] = p[(size_t)(8 * g4 + d) * 1024];
                __builtin_amdgcn_sched_barrier(0); }
        }
#pragma unroll 1
        for (int r0 = F.wave * 16; r0 < F.wave * 16 + 16; r0 += 2) { float o[2];
#pragma unroll
            for (int rr = 0; rr < 2; ++rr) { const LAS f32x4* b4 = (const LAS f32x4*)(sw + (r0 + rr) * 64); float s0 = 0.f, s1 = 0.f;
#pragma unroll
                for (int q = 0; q < 16; q += 2) { const f32x4 b0 = b4[q], b1 = b4[q + 1];
                    s0 += a[4 * q] * b0[0] + a[4 * q + 1] * b0[1] + a[4 * q + 2] * b0[2] + a[4 * q + 3] * b0[3]; s1 += a[4 * q + 4] * b1[0] + a[4 * q + 5] * b1[1] + a[4 * q + 6] * b1[2] + a[4 * q + 7] * b1[3]; }
                o[rr] = s0 + s1; __builtin_amdgcn_sched_barrier(0); }
            if (isq) {
#pragma unroll
                for (int rr = 0; rr < 2; ++rr) (F.ws + WS_WQ8)[(size_t)(h * 128 + r0 + rr) * 1024 + idx] = (unsigned char)(pk4_fp8(o[rr] * (0.125f * 256.f), 0.f, 0.f, 0.f) & 0xffu);
            } else *(unsigned*)(WbT + (size_t)idx * 1024 + h * 128 + r0) = cvt_pk_bf16(o[0], o[1]);
        }
    }
    __syncthreads();
    {
        const int lane = F.lane, step = F.NGW; const float* x = F.in[0]; bf16* xn = DOP(bf16, DO_XN);
        f32x4 gg[4], v0[4], v1[4];
#pragma unroll
        for (int j = 0; j < 4; ++j) gg[j] = *((const f32x4*)F.in[2] + lane + 64 * j);
        int m = F.gw;
#define XN_LD(v_, m_) { const int mm_ = (m_) < T ? (m_) : F.gw; _Pragma("unroll") for (int j = 0; j < 4; ++j) v_[j] = *((const f32x4*)(x + (size_t)mm_ * D) + lane + 64 * j); __builtin_amdgcn_sched_barrier(0); }
#define XN_DO(v_) { if (m < T) { f32x4 c_[4]; _Pragma("unroll") for (int j = 0; j < 4; ++j) c_[j] = v_[j]; XN_LD(v_, m + 2 * step); float s = 0.f; \
            _Pragma("unroll") for (int j = 0; j < 4; ++j) s += (c_[j].x * c_[j].x + c_[j].y * c_[j].y) + (c_[j].z * c_[j].z + c_[j].w * c_[j].w); \
            const float rstd = rsqrtf(wave_sum(s) * (1.f / 1024.f) + 1e-6f); v2u* o8 = (v2u*)(xn + (size_t)m * D) + lane; \
            unsigned* q8 = (unsigned*)(F.ws + WS_XN8 + (size_t)m * D) + lane; \
            _Pragma("unroll") for (int j = 0; j < 4; ++j) { const float y0 = c_[j].x * rstd * gg[j].x, y1 = c_[j].y * rstd * gg[j].y, y2 = c_[j].z * rstd * gg[j].z, y3 = c_[j].w * rstd * gg[j].w; \
                v2u o; o.x = cvt_pk_bf16(y0, y1); o.y = cvt_pk_bf16(y2, y3); o8[64 * j] = o; q8[64 * j] = pk4_fp8(y0, y1, y2, y3); } \
            m += step; } }
        if (m < T) {
            XN_LD(v0, m); XN_LD(v1, m + step);
            while (m < T) { XN_DO(v0); XN_DO(v1); }
        }
#undef XN_LD
#undef XN_DO
    }
    for (int m = F.gw; m < NB * 256; m += F.NGW) rms_row_to_bf16(F.in[1] + (size_t)m * D, F.in[23], WSP(bf16, WS_MEMN) + (size_t)m * D, F.lane);
}

#define EPI_LOOP_PERM(...) \
    _Pragma("unroll") for (int ai = 0; ai < 2; ++ai) _Pragma("unroll") for (int m = 0; m < 4; ++m) { const int row = u.pm * 256 + ai * 128 + wr * 64 + m * 16 + fr; \
        _Pragma("unroll") for (int bj = 0; bj < 2; ++bj) { const int ct = bj * 128 + wc * 32 + 8 * fq;   f32x4 v0 = acc[ai][bj][m][0], v1 = acc[ai][bj][m][1]; __VA_ARGS__ } }
#define PACK8(v0, v1) ((v4u){cvt_pk_bf16((v0)[0], (v0)[1]), cvt_pk_bf16((v0)[2], (v0)[3]), cvt_pk_bf16((v1)[0], (v1)[1]), cvt_pk_bf16((v1)[2], (v1)[3])})

struct EpiMain {
    static constexpr bool PERM = true;
    bf16 *Zrkv, *Zlora, *QLAT, *Zd, *G; const float* b_gate; int pn_off = 0;
    __device__ __forceinline__ void operator()(const f32x4 (&acc)[2][2][4][2], const Unit& u, int wr, int wc, int fr, int fq) const {
        const int pn = u.pn + pn_off; bf16* base; int ldc, c0; bool act = false;
        if (pn < 6) { base = Zrkv; ldc = 1536; c0 = pn * 256; }
        else if (pn == 6) { base = Zlora; ldc = 256; c0 = 0; }
        else if (pn < 11) { base = QLAT; ldc = 1024; c0 = (pn - 7) * 256; }
        else if (pn < 13) { base = Zd; ldc = 512; c0 = (pn - 11) * 256; }
        else { base = G; ldc = 2048; c0 = (pn - 13) * 256; act = true; }
        if (act) {
            f32x4 bg[2][2];
#pragma unroll
            for (int bj = 0; bj < 2; ++bj) { const int ct = bj * 128 + wc * 32 + 8 * fq; bg[bj][0] = *(const f32x4*)(b_gate + c0 + ct); bg[bj][1] = *(const f32x4*)(b_gate + c0 + ct + 4); }
            EPI_LOOP_PERM(
_Pragma("unroll")
                for (int e = 0; e < 4; ++e) { v0[e] = fsigmoid(v0[e] + bg[bj][0][e]); v1[e] = fsigmoid(v1[e] + bg[bj][1][e]); }
                *(v4u*)(base + (size_t)row * ldc + c0 + ct) = PACK8(v0, v1);
            )
        } else {
            EPI_LOOP_PERM(
                *(v4u*)(base + (size_t)row * ldc + c0 + ct) = PACK8(v0, v1);
            )
        }
    }
};
struct EpiGate8 {
    static constexpr bool PERM = true;
    bf16* G; const float* b_gate;
    __device__ __forceinline__ void operator()(const f32x4 (&acc)[2][2][4][2], const Unit& u, int wr, int wc, int fr, int fq) const {
        const int c0 = u.pn * 256;
        f32x4 bg[2][2];
#pragma unroll
        for (int bj = 0; bj < 2; ++bj) { const int ct = bj * 128 + wc * 32 + 8 * fq; bg[bj][0] = *(const f32x4*)(b_gate + c0 + ct); bg[bj][1] = *(const f32x4*)(b_gate + c0 + ct + 4); }
        EPI_LOOP_PERM(
_Pragma("unroll")
            for (int e = 0; e < 4; ++e) { v0[e] = fsigmoid(0.0625f * v0[e] + bg[bj][0][e]); v1[e] = fsigmoid(0.0625f * v1[e] + bg[bj][1][e]); }
            *(v4u*)(G + (size_t)row * 2048 + c0 + ct) = PACK8(v0, v1);
        )
    }
};
struct EpiBf16 {
    static constexpr bool PERM = true;
    bf16* O; int ldc; int colmul; size_t pn_stride; float scale;
    __device__ __forceinline__ void operator()(const f32x4 (&acc)[2][2][4][2], const Unit& u, int wr, int wc, int fr, int fq) const {
        bf16* base = O + (size_t)u.pn * pn_stride + (size_t)u.pn * 256 * colmul;
        EPI_LOOP_PERM( v0 = v0 * scale; v1 = v1 * scale; *(v4u*)(base + (size_t)row * ldc + ct) = PACK8(v0, v1); )
    }
};
struct EpiLora {
    static constexpr bool PERM = true;
    bf16* WAG; const float* w0; const float* a0;
    __device__ __forceinline__ void operator()(const f32x4 (&acc)[2][2][4][2], const Unit& u, int wr, int wc, int fr, int fq) const {
        const int seg = u.pn >> 1; const int cc0 = (u.pn & 1) * 256; const float* bias = seg == 0 ? w0 : a0;
        if (seg < 2) {
            const float mul = seg == 0 ? 0.6065306597126334f : 1.0f;
            f32x4 bg[2][2];
#pragma unroll
            for (int bj = 0; bj < 2; ++bj) { const int ct = bj * 128 + wc * 32 + 8 * fq; bg[bj][0] = *(const f32x4*)(bias + cc0 + ct); bg[bj][1] = *(const f32x4*)(bias + cc0 + ct + 4); }
            EPI_LOOP_PERM(
_Pragma("unroll")
                for (int e = 0; e < 4; ++e) { v0[e] = mul * fsigmoid(v0[e] + bg[bj][0][e]); v1[e] = mul * fsigmoid(v1[e] + bg[bj][1][e]); }
                *(v4u*)(WAG + (size_t)row * 1536 + u.pn * 256 + ct) = PACK8(v0, v1);
            )
        } else {
            EPI_LOOP_PERM(
                *(v4u*)(WAG + (size_t)row * 1536 + u.pn * 256 + ct) = PACK8(v0, v1);
            )
        }
    }
};
struct EpiMix {
    static constexpr bool PERM = true;
    bf16* U; const bf16* G; int second;
    __device__ __forceinline__ void operator()(const f32x4 (&acc)[2][2][4][2], const Unit& u, int wr, int wc, int fr, int fq) const {
#pragma unroll
        for (int ai = 0; ai < 2; ++ai) {
            v4u gw[4][2], ow[4][2];
#pragma unroll
            for (int m = 0; m < 4; ++m)
#pragma unroll
                for (int bj = 0; bj < 2; ++bj) { const int row = u.pm * 256 + ai * 128 + wr * 64 + m * 16 + fr, col = u.pn * 256 + bj * 128 + wc * 32 + 8 * fq;
                    gw[m][bj] = *(const v4u*)(G + (size_t)row * 2048 + second * 1024 + col);
                    ow[m][bj] = second ? *(const v4u*)(U + (size_t)row * 1024 + col) : (v4u){0, 0, 0, 0}; }
#pragma unroll
            for (int m = 0; m < 4; ++m)
#pragma unroll
                for (int bj = 0; bj < 2; ++bj) { const int row = u.pm * 256 + ai * 128 + wr * 64 + m * 16 + fr, col = u.pn * 256 + bj * 128 + wc * 32 + 8 * fq;
                    f32x4 v0 = acc[ai][bj][m][0], v1 = acc[ai][bj][m][1]; const v4u g4 = gw[m][bj], o = ow[m][bj];
                    v0[0] = v0[0] * bflo(g4.x) + bflo(o.x); v0[1] = v0[1] * bfhi(g4.x) + bfhi(o.x); v0[2] = v0[2] * bflo(g4.y) + bflo(o.y); v0[3] = v0[3] * bfhi(g4.y) + bfhi(o.y);
                    v1[0] = v1[0] * bflo(g4.z) + bflo(o.z); v1[1] = v1[1] * bfhi(g4.z) + bfhi(o.z); v1[2] = v1[2] * bflo(g4.w) + bflo(o.w); v1[3] = v1[3] * bfhi(g4.w) + bfhi(o.w);
                    *(v4u*)(U + (size_t)row * 1024 + col) = PACK8(v0, v1); }
        }
    }
};
struct EpiRes {
    static constexpr bool PERM = false;
    const float* res; float* out;
    __device__ __forceinline__ void operator()(const f32x4 (&acc)[2][2][4][2], const Unit& u, int wr, int wc, int fr, int fq) const {
#pragma unroll
        for (int ai = 0; ai < 2; ++ai) {
            f32x4 r[4][2][2];
#pragma unroll
            for (int m = 0; m < 4; ++m)
#pragma unroll
                for (int bj = 0; bj < 2; ++bj)
#pragma unroll
                    for (int n = 0; n < 2; ++n) { const int row = u.pm * 256 + ai * 128 + wr * 64 + m * 16 + fr, col = u.pn * 256 + bj * 128 + wc * 32 + 16 * n + 4 * fq; r[m][bj][n] = *(const f32x4*)(res + (size_t)row * 1024 + col); }
#pragma unroll
            for (int m = 0; m < 4; ++m)
#pragma unroll
                for (int bj = 0; bj < 2; ++bj)
#pragma unroll
                    for (int n = 0; n < 2; ++n) { const int row = u.pm * 256 + ai * 128 + wr * 64 + m * 16 + fr, col = u.pn * 256 + bj * 128 + wc * 32 + 16 * n + 4 * fq; *(f32x4*)(out + (size_t)row * 1024 + col) = r[m][bj][n] + acc[ai][bj][m][n]; }
        }
    }
};
struct EpiResB {
    static constexpr bool PERM = true;
    const float* res32; const bf16* res16; bf16* out; float ascale = 1.f;
    __device__ __forceinline__ void operator()(const f32x4 (&acc)[2][2][4][2], const Unit& u, int wr, int wc, int fr, int fq) const {
#pragma unroll
        for (int ai = 0; ai < 2; ++ai) {
            f32x4 r[4][2][2];
#pragma unroll
            for (int m = 0; m < 4; ++m)
#pragma unroll
                for (int bj = 0; bj < 2; ++bj) { const int row = u.pm * 256 + ai * 128 + wr * 64 + m * 16 + fr, col = u.pn * 256 + bj * 128 + wc * 32 + 8 * fq; const size_t o = (size_t)row * 1024 + col;
                    if (res32) { r[m][bj][0] = *(const f32x4*)(res32 + o); r[m][bj][1] = *(const f32x4*)(res32 + o + 4); }
                    else { const v4u w = *(const v4u*)(res16 + o); r[m][bj][0] = (f32x4){bflo(w.x), bfhi(w.x), bflo(w.y), bfhi(w.y)}; r[m][bj][1] = (f32x4){bflo(w.z), bfhi(w.z), bflo(w.w), bfhi(w.w)}; } }
#pragma unroll
            for (int m = 0; m < 4; ++m)
#pragma unroll
                for (int bj = 0; bj < 2; ++bj) { const int row = u.pm * 256 + ai * 128 + wr * 64 + m * 16 + fr, col = u.pn * 256 + bj * 128 + wc * 32 + 8 * fq;
                    const f32x4 v0 = r[m][bj][0] + acc[ai][bj][m][0] * ascale, v1 = r[m][bj][1] + acc[ai][bj][m][1] * ascale;
                    *(v4u*)(out + (size_t)row * 1024 + col) = PACK8(v0, v1); }
        }
    }
};
struct EpiLogit {
    static constexpr bool PERM = false;
    float* L;
    __device__ __forceinline__ void operator()(const f32x4 (&acc)[2][2][4][2], const Unit& u, int wr, int wc, int fr, int fq) const {
        if (wc >= 2) return;
#pragma unroll
        for (int ai = 0; ai < 2; ++ai)
#pragma unroll
            for (int m = 0; m < 4; ++m) { const int row = u.pm * 256 + ai * 128 + wr * 64 + m * 16 + fr;
#pragma unroll
                for (int n = 0; n < 2; ++n) { const int col = wc * 32 + 16 * n + 4 * fq; *(f32x4*)(L + (size_t)row * 64 + col) = acc[ai][0][m][n]; } }
    }
};
struct EpiMoe1 {
    static constexpr bool PERM = true;
    unsigned char* HID;
    __device__ __forceinline__ void operator()(const f32x4 (&acc)[2][2][4][2], const Unit& u, int wr, int wc, int fr, int fq) const {
#pragma unroll
        for (int ai = 0; ai < 2; ++ai)
#pragma unroll
            for (int m = 0; m < 4; ++m) { const int row = u.pm * 256 + ai * 128 + wr * 64 + m * 16 + fr; f32x4 h0, h1;
#pragma unroll
                for (int e = 0; e < 4; ++e) { const float g0 = 0.0625f * acc[ai][0][m][0][e], g1 = 0.0625f * acc[ai][0][m][1][e]; h0[e] = g0 * fsigmoid(g0) * (0.0625f * acc[ai][1][m][0][e]); h1[e] = g1 * fsigmoid(g1) * (0.0625f * acc[ai][1][m][1][e]); }
                *(v2u*)(HID + (size_t)row * 512 + u.pn * 128 + wc * 32 + 8 * fq) = (v2u){pk4_fp8(h0[0], h0[1], h0[2], h0[3]), pk4_fp8(h1[0], h1[1], h1[2], h1[3])}; }
    }
};
struct EpiMoe2 {
    static constexpr bool PERM = true;
    bf16* YS; const float* sgate;
    __device__ __forceinline__ void operator()(const f32x4 (&acc)[2][2][4][2], const Unit& u, int wr, int wc, int fr, int fq) const {
        float gts[2][4];
#pragma unroll
        for (int ai = 0; ai < 2; ++ai)
#pragma unroll
            for (int m = 0; m < 4; ++m) gts[ai][m] = sgate[u.pm * 256 + ai * 128 + wr * 64 + m * 16 + fr];
        EPI_LOOP_PERM( const float gt = 0.0625f * gts[ai][m]; v0 = v0 * gt; v1 = v1 * gt; *(v4u*)(YS + (size_t)row * 1024 + u.pn * 256 + ct) = PACK8(v0, v1); )
    }
};
struct MoeOrder {
    const char* A; const char* Bt; size_t bstride  ; int K; int NPN; const int* stok; volatile LAS int* tstart; int G, c; bool gather;
    __device__ bool next(int i, Unit& u) const {
        const int ntile = tstart[32]; const long L = (long)i * G + c; if (L >= (long)ntile * NPN) return false;
        const int tile = (int)(L / NPN); u.pn = (int)(L % NPN); u.pm = tile;
        int e = 0;
#pragma unroll 1
        for (int j = 1; j < 32; ++j) e += (tstart[j] <= tile) ? 1 : 0;
        u.b = Bt + (size_t)e * bstride + (size_t)u.pn * 256 * K * 2;
        if (gather) { u.a = A; u.gidx = stok + (size_t)tile * 256; } else { u.a = A + (size_t)tile * 256 * K * 2; u.gidx = nullptr; }
        return true;
    }
};

__device__ __forceinline__ void p2_lora_prep(Frame& F) {
    const bf16* Zlora = WSP(bf16, WS_ZLORA); const bf16* Zd = WSP(bf16, WS_ZD); bf16* AL = DOP(bf16, DO_ALORA); bf16* CKV = WSP(bf16, WS_CKV);
    const float* mu = F.in[4] + 1536; const float* kvn = F.in[15];
    const int c = 4 * F.lane;
    const f32x4 m4 = *(const f32x4*)(mu + c);
    const f32x2 kn = *(const f32x2*)(kvn + 2 * F.lane);
    constexpr int NB4 = 4;
    for (int t0 = F.gw; t0 < T; t0 += NB4 * F.NGW) {
        v2u z[NB4], zp[NB4]; unsigned cw[NB4];
#pragma unroll
        for (int u = 0; u < NB4; ++u) { const int t1 = t0 + u * F.NGW, t = t1 < T ? t1 : t0;
            z[u] = *(const v2u*)(Zlora + (size_t)t * 256 + c);
            const int tp = (t & (SEQ - 1)) != 0 ? t - 1 : t;
            zp[u] = *(const v2u*)(Zlora + (size_t)tp * 256 + c);
            cw[u] = *(const unsigned*)(Zd + (size_t)t * 512 + 2 * F.lane); }
#pragma unroll
        for (int u = 0; u < NB4; ++u) { const int t = t0 + u * F.NGW;
            if (t < T) {
                if ((t & (SEQ - 1)) == 0) zp[u] = (v2u){0u, 0u};
                float v[4] = {bflo(z[u].x), bfhi(z[u].x), bflo(z[u].y), bfhi(z[u].y)}; const float p[4] = {bflo(zp[u].x), bfhi(zp[u].x), bflo(zp[u].y), bfhi(zp[u].y)};
#pragma unroll
                for (int e = 0; e < 4; ++e) { float s = v[e] + (p[e] - v[e]) * m4[e];
                    if (c < 64) { const float ex = __expf(2.f * s); s = 1.f - 2.f * __builtin_amdgcn_rcpf(ex + 1.f); }
                    else if (c >= 128) s = fsigmoid(s);
                    v[e] = s; }
                *(v2u*)(AL + (size_t)t * 256 + c) = (v2u){cvt_pk_bf16(v[0], v[1]), cvt_pk_bf16(v[2], v[3])};
                const float c0 = bflo(cw[u]), c1 = bfhi(cw[u]);
                const float rstd = rsqrtf(wave_sum(c0 * c0 + c1 * c1) * (1.f / 128.f) + 1e-6f);
                *(unsigned*)(CKV + (size_t)t * 128 + 2 * F.lane) = cvt_pk_bf16(c0 * rstd * kn.x, c1 * rstd * kn.y);
            }
        }
    }
}

struct ScanRows { v4u zr, zk, zv, pr, pk, pv, ew4, a4, g4; };
__device__ __forceinline__ void scan_load_rows(ScanRows& L, const bf16* Zrkv, const bf16* WAG, size_t tok, int pos, int j0) {
    L.zr = *(const v4u*)(Zrkv + tok * 1536 + j0); L.zk = *(const v4u*)(Zrkv + tok * 1536 + 512 + j0); L.zv = *(const v4u*)(Zrkv + tok * 1536 + 1024 + j0);
    L.pr = (v4u){0, 0, 0, 0}; L.pk = L.pr; L.pv = L.pr;
    if (pos != 0) { L.pr = *(const v4u*)(Zrkv + (tok - 1) * 1536 + j0); L.pk = *(const v4u*)(Zrkv + (tok - 1) * 1536 + 512 + j0); L.pv = *(const v4u*)(Zrkv + (tok - 1) * 1536 + 1024 + j0); }
    L.ew4 = *(const v4u*)(WAG + tok * 1536 + j0); L.a4 = *(const v4u*)(WAG + tok * 1536 + 512 + j0); L.g4 = *(const v4u*)(WAG + tok * 1536 + 1024 + j0);
}
__device__ __forceinline__ void p4_scan(Frame& F) {
    const int bh = F.vcu >> 1, half = F.vcu & 1, b = bh >> 3, h = bh & 7;
    const bf16* Zrkv = WSP(bf16, WS_ZRKV); const bf16* WAG = DOP(bf16, DO_WAG); bf16* YA = WSP(bf16, WS_YA); bf16* YC = WSP(bf16, WS_YC);
    LAS float* sR = (LAS float*)F.lds; LAS float* sDEC = sR + 4096; LAS float* sKK = sR + 8192; LAS float* sBB = sR + 12288; LAS float* sKP = sR + 16384; LAS float* sV = sR + 20480; LAS float* sY = sR + 24576; LAS float* sBR = sR + 28672;
    const int tt = F.tid >> 3, jg = F.tid & 7, j0 = h * 64 + jg * 8;
    const int il = F.lane >> 3, irow = half * 32 + (F.wave & 3) * 8 + il;
    float mu_r[8], mu_k[8], mu_v[8], kkw[8], kaw[8], rkw[8], lnw[8], lnb[8];
#pragma unroll
    for (int e = 0; e < 8; ++e) { mu_r[e] = F.in[4][j0 + e]; mu_k[e] = F.in[4][512 + j0 + e]; mu_v[e] = F.in[4][1024 + j0 + e]; kkw[e] = F.in[10][j0 + e]; kaw[e] = F.in[11][j0 + e]; rkw[e] = F.in[12][j0 + e]; lnw[e] = F.in[13][j0 + e]; lnb[e] = F.in[14][j0 + e]; }
    float S[8];
#pragma unroll
    for (int e = 0; e < 8; ++e) S[e] = 0.f;
    ScanRows L; scan_load_rows(L, Zrkv, WAG, (size_t)b * SEQ + tt, tt, j0);
    for (int tile = 0; tile < SEQ / 64; ++tile) {
        const int pos = tile * 64 + tt; const size_t tok = (size_t)b * SEQ + pos;
        const v4u g4 = L.g4;
        {
            float r[8], k[8], v[8], a[8], ew[8], kk[8];
#pragma unroll
            for (int q = 0; q < 4; ++q) {
                const float zr0 = bflo(L.zr[q]), zr1 = bfhi(L.zr[q]), zk0 = bflo(L.zk[q]), zk1 = bfhi(L.zk[q]), zv0 = bflo(L.zv[q]), zv1 = bfhi(L.zv[q]);
                r[2 * q] = zr0 + (bflo(L.pr[q]) - zr0) * mu_r[2 * q]; r[2 * q + 1] = zr1 + (bfhi(L.pr[q]) - zr1) * mu_r[2 * q + 1];
                k[2 * q] = zk0 + (bflo(L.pk[q]) - zk0) * mu_k[2 * q]; k[2 * q + 1] = zk1 + (bfhi(L.pk[q]) - zk1) * mu_k[2 * q + 1];
                v[2 * q] = zv0 + (bflo(L.pv[q]) - zv0) * mu_v[2 * q]; v[2 * q + 1] = zv1 + (bfhi(L.pv[q]) - zv1) * mu_v[2 * q + 1];
                a[2 * q] = bflo(L.a4[q]); a[2 * q + 1] = bfhi(L.a4[q]); ew[2 * q] = bflo(L.ew4[q]); ew[2 * q + 1] = bfhi(L.ew4[q]);
            }
            float ss = 0.f;
#pragma unroll
            for (int e = 0; e < 8; ++e) { kk[e] = k[e] * kkw[e]; ss += kk[e] * kk[e]; }
            ss = sum8(ss);
            const float inv = 1.0f / fmaxf(sqrtf(ss), 1e-12f);
            float br = 0.f;
#pragma unroll
            for (int e = 0; e < 8; ++e) { kk[e] *= inv; br += kk[e] * a[e] * r[e]; }
            br = sum8(br);
            f32x4 o0, o1;
#define ST8(dst, expr) { _Pragma("unroll") for (int e = 0; e < 4; ++e) { { const int E = e; o0[e] = (expr); } { const int E = e + 4; o1[e] = (expr); } } *(LAS f32x4*)(dst + tt * 64 + jg * 8) = o0; *(LAS f32x4*)(dst + tt * 64 + jg * 8 + 4) = o1; }
            ST8(sR, r[E]);
            ST8(sDEC, __expf(-ew[E]));
            ST8(sKK, kk[E]);
            ST8(sBB, kk[E] * a[E]);
            ST8(sKP, k[E] * (1.f + (a[E] - 1.f) * kaw[E]));
            ST8(sV, v[E]);
#undef ST8
            if (jg == 0) sBR[tt] = br;
        }
        __syncthreads();
        if (tile + 1 < SEQ / 64) scan_load_rows(L, Zrkv, WAG, tok + 64, pos + 64, j0);
        if (F.wave < 4) {
            const LAS float* base = sR + jg * 8;
            f32x4 cr0 = *(const LAS f32x4*)(base), cr1 = *(const LAS f32x4*)(base + 4), cd0 = *(const LAS f32x4*)(base + 4096), cd1 = *(const LAS f32x4*)(base + 4100);
            f32x4 cq0 = *(const LAS f32x4*)(base + 8192), cq1 = *(const LAS f32x4*)(base + 8196), cb0 = *(const LAS f32x4*)(base + 12288), cb1 = *(const LAS f32x4*)(base + 12292);
            f32x4 cp0 = *(const LAS f32x4*)(base + 16384), cp1 = *(const LAS f32x4*)(base + 16388);
            float cvi = sV[irow], cbr = sBR[0];
#pragma unroll 2
            for (int s = 0; s < 64; ++s) {
                const int sn = (s + 1) & 63; const LAS float* nb = base + sn * 64;
                const f32x4 nr0 = *(const LAS f32x4*)(nb), nr1 = *(const LAS f32x4*)(nb + 4), nd0 = *(const LAS f32x4*)(nb + 4096), nd1 = *(const LAS f32x4*)(nb + 4100);
                const f32x4 nq0 = *(const LAS f32x4*)(nb + 8192), nq1 = *(const LAS f32x4*)(nb + 8196), nb0 = *(const LAS f32x4*)(nb + 12288), nb1 = *(const LAS f32x4*)(nb + 12292);
                const f32x4 np0 = *(const LAS f32x4*)(nb + 16384), np1 = *(const LAS f32x4*)(nb + 16388);
                const float nvi = sV[sn * 64 + irow], nbr = sBR[sn];
                float t[8], sa0 = 0.f, sa1 = 0.f, ty0 = 0.f, ty1 = 0.f;
#pragma unroll
                for (int e = 0; e < 4; ++e) {
                    sa0 += S[e] * cq0[e]; sa1 += S[4 + e] * cq1[e];
                    t[e] = S[e] * cd0[e] + cvi * cp0[e]; t[4 + e] = S[4 + e] * cd1[e] + cvi * cp1[e];
                    ty0 += t[e] * cr0[e]; ty1 += t[4 + e] * cr1[e];
                }
                float sa = sa0 + sa1, ty = ty0 + ty1;
                sa += dpp_f(sa, 0); ty += dpp_f(ty, 0); sa += dpp_f(sa, 1); ty += dpp_f(ty, 1); sa += dpp_f(sa, 2); ty += dpp_f(ty, 2);
                sa = -sa;
#pragma unroll
                for (int e = 0; e < 4; ++e) { S[e] = t[e] + sa * cb0[e]; S[4 + e] = t[4 + e] + sa * cb1[e]; }
                if (jg == 0) sY[s * 64 + irow] = ty + sa * cbr;
                cr0 = nr0; cr1 = nr1; cd0 = nd0; cd1 = nd1; cq0 = nq0; cq1 = nq1; cb0 = nb0; cb1 = nb1; cp0 = np0; cp1 = np1; cvi = nvi; cbr = nbr;
            }
        }
        __syncthreads();
        {
            const LAS float* rb = sR + tt * 64 + jg * 8; const LAS float* kb = sKP + tt * 64 + jg * 8; const LAS float* vb = sV + tt * 64 + jg * 8;
            float dot = 0.f;
#pragma unroll
            for (int e = 0; e < 8; ++e) dot += rb[e] * kb[e] * rkw[e];
            dot = sum8(dot);
            if ((jg >> 2) == half) {
                const LAS float* yb = sY + tt * 64 + jg * 8;
                const f32x4 ya = *(const LAS f32x4*)yb, yc = *(const LAS f32x4*)(yb + 4);
                float c[8];
#pragma unroll
                for (int q = 0; q < 4; ++q) { c[2 * q] = (lnb[2 * q] + dot * vb[2 * q]) * bflo(g4[q]); c[2 * q + 1] = (lnb[2 * q + 1] + dot * vb[2 * q + 1]) * bfhi(g4[q]); }
                *(v4u*)(YA + tok * 512 + j0) = (v4u){cvt_pk_bf16(ya[0], ya[1]), cvt_pk_bf16(ya[2], ya[3]), cvt_pk_bf16(yc[0], yc[1]), cvt_pk_bf16(yc[2], yc[3])};
                *(v4u*)(YC + tok * 512 + j0) = (v4u){cvt_pk_bf16(c[0], c[1]), cvt_pk_bf16(c[2], c[3]), cvt_pk_bf16(c[4], c[5]), cvt_pk_bf16(c[6], c[7])};
            }
        }
        __syncthreads();
    }
}

namespace rk {
constexpr int RSB = 144, SLOT = 64 * RSB;
__device__ __forceinline__ int off(int row, int elem) { return row * RSB + ((((elem) >> 3) ^ ((row >> 3) & 7)) << 4) + ((elem) & 7) * 2; }
struct Acc2 { f32x4 a[2]; };
template <bool TWO>
__device__ __forceinline__ Acc2 mm_mul(const LAS unsigned char* lds, int X, int Y, int X2, int Y2, int wave, int lane) {
    const int g = lane >> 4, c15 = lane & 15; Acc2 r;
#pragma unroll
    for (int jj = 0; jj < 2; ++jj) {
        const int job = wave + 8 * jj, yt = job >> 2, xt = job & 3;
        f32x4 acc = (f32x4){0.f, 0.f, 0.f, 0.f};
#pragma unroll
        for (int ks = 0; ks < 2; ++ks) {
            const bf16x8 a = *(const LAS bf16x8*)(lds + X * SLOT + off(16 * xt + c15, ks * 32 + 8 * g)), b = *(const LAS bf16x8*)(lds + Y * SLOT + off(16 * yt + c15, ks * 32 + 8 * g));
            acc = __builtin_amdgcn_mfma_f32_16x16x32_bf16(a, b, acc, 0, 0, 0);
        }
        if (TWO) {
#pragma unroll
            for (int ks = 0; ks < 2; ++ks) {
                const bf16x8 a = *(const LAS bf16x8*)(lds + X2 * SLOT + off(16 * xt + c15, ks * 32 + 8 * g)), b = *(const LAS bf16x8*)(lds + Y2 * SLOT + off(16 * yt + c15, ks * 32 + 8 * g));
                acc = __builtin_amdgcn_mfma_f32_16x16x32_bf16(a, b, acc, 0, 0, 0);
            }
        }
        r.a[jj] = acc;
    }
    return r;
}
template <int EPI>
__device__ __forceinline__ void mm_put(LAS unsigned char* lds, Acc2 r, int Z, int C, const LAS float* gam, int wave, int lane) {
    const int g = lane >> 4, c15 = lane & 15;
#pragma unroll
    for (int jj = 0; jj < 2; ++jj) {
        const int job = wave + 8 * jj, yt = job >> 2, xt = job & 3;
        f32x4 acc = r.a[jj];
        const int y = 16 * yt + c15, x0 = 16 * xt + 4 * g;
        if (EPI == 4) { const v2u cw = *(const LAS v2u*)(lds + C * SLOT + off(y, x0)); acc[0] += bflo(cw.x); acc[1] += bfhi(cw.x); acc[2] += bflo(cw.y); acc[3] += bfhi(cw.y); }
#pragma unroll
        for (int e = 0; e < 4; ++e) { const int x = x0 + e;
            if (EPI == 1) acc[e] = (x < y) ? acc[e] : 0.f;
            if (EPI == 2) acc[e] = (x > y) ? acc[e] : 0.f;
            if (EPI == 3) acc[e] = (x <= y) ? acc[e] : 0.f;
            if (EPI == 5) acc[e] += (x == y) ? gam[x] : 0.f; }
        *(LAS v2u*)(lds + Z * SLOT + off(y, x0)) = (v2u){cvt_pk_bf16(acc[0], acc[1]), cvt_pk_bf16(acc[2], acc[3])};
        if (EPI == 1) { float t[4];
#pragma unroll
            for (int e = 0; e < 4; ++e) t[e] = acc[e] + ((x0 + e == y) ? 1.f : 0.f);
            *(LAS v2u*)(lds + C * SLOT + off(y, x0)) = (v2u){cvt_pk_bf16(t[0], t[1]), cvt_pk_bf16(t[2], t[3])}; }
    }
}
}
__device__ __forceinline__ void p4_rwkv_chunked(Frame& F) {
    using namespace rk;
    const int bh = F.vcu >> 1, par = F.vcu & 1, b = bh >> 3, h = bh & 7;
    bf16* SB = (bf16*)((unsigned char*)F.out + DO_SB) + (size_t)bh * 2 * 4096; unsigned* flag = F.ctl + CW_RK + bh;
    const bf16* Zrkv = WSP(bf16, WS_ZRKV); const bf16* WAG = DOP(bf16, DO_WAG); bf16* YA = WSP(bf16, WS_YA);
    LAS unsigned char* lds = F.lds;
    LAS float* sL = (LAS float*)(lds + 14 * SLOT);
    LAS float* sY = (LAS float*)(lds + 3 * SLOT);
    LAS float* sG = (LAS float*)(lds + 16 * SLOT);
    const int tt = F.tid >> 3, jg = F.tid & 7, j0 = h * 64 + jg * 8, wave = F.wave, lane = F.lane;
    ScanRows L; scan_load_rows(L, Zrkv, WAG, (size_t)b * SEQ + par * 64 + tt, par * 64 + tt, j0);
    for (int ch = par; ch < SEQ / 64; ch += 2) {
        const int pos = ch * 64 + tt; const size_t tok = (size_t)b * SEQ + pos;
        const v4u g4 = L.g4;
        float r[8], kp[8], v[8], a[8], ew[8], kk[8];
        float dot = 0.f;
        {
            float k[8];
            float mu_r[8], mu_k[8], mu_v[8], kkw[8], kaw[8], rkw[8];
#pragma unroll
            for (int e = 0; e < 8; ++e) { mu_r[e] = F.in[4][j0 + e]; mu_k[e] = F.in[4][512 + j0 + e]; mu_v[e] = F.in[4][1024 + j0 + e]; kkw[e] = F.in[10][j0 + e]; kaw[e] = F.in[11][j0 + e]; rkw[e] = F.in[12][j0 + e]; }
#pragma unroll
            for (int q = 0; q < 4; ++q) {
                const float zr0 = bflo(L.zr[q]), zr1 = bfhi(L.zr[q]), zk0 = bflo(L.zk[q]), zk1 = bfhi(L.zk[q]), zv0 = bflo(L.zv[q]), zv1 = bfhi(L.zv[q]);
                r[2 * q] = zr0 + (bflo(L.pr[q]) - zr0) * mu_r[2 * q]; r[2 * q + 1] = zr1 + (bfhi(L.pr[q]) - zr1) * mu_r[2 * q + 1];
                k[2 * q] = zk0 + (bflo(L.pk[q]) - zk0) * mu_k[2 * q]; k[2 * q + 1] = zk1 + (bfhi(L.pk[q]) - zk1) * mu_k[2 * q + 1];
                v[2 * q] = zv0 + (bflo(L.pv[q]) - zv0) * mu_v[2 * q]; v[2 * q + 1] = zv1 + (bfhi(L.pv[q]) - zv1) * mu_v[2 * q + 1];
                a[2 * q] = bflo(L.a4[q]); a[2 * q + 1] = bfhi(L.a4[q]); ew[2 * q] = bflo(L.ew4[q]); ew[2 * q + 1] = bfhi(L.ew4[q]);
            }
            float ss = 0.f;
#pragma unroll
            for (int e = 0; e < 8; ++e) { kk[e] = k[e] * kkw[e]; ss += kk[e] * kk[e]; }
            ss = sum8(ss);
            const float inv = fminf(__builtin_amdgcn_rsqf(ss), 1e12f);
#pragma unroll
            for (int e = 0; e < 8; ++e) { kk[e] *= inv; kp[e] = k[e] * (1.f + (a[e] - 1.f) * kaw[e]); }
#pragma unroll
            for (int e = 0; e < 8; ++e) dot += r[e] * kp[e] * rkw[e];
            dot = sum8(dot);
        }
        __syncthreads();
        {
#pragma unroll
            for (int e = 0; e < 8; ++e) *(LAS unsigned short*)(lds + 11 * SLOT + off(jg * 8 + e, tt)) = (unsigned short)(cvt_pk_bf16(ew[e], 0.f) & 0xffffu);
            unsigned tw[4];
#pragma unroll
            for (int q = 0; q < 4; ++q) tw[q] = ((jg * 8 + 2 * q <= tt) ? 0x3f80u : 0u) | ((jg * 8 + 2 * q + 1 <= tt) ? 0x3f800000u : 0u);
            *(LAS v4u*)(lds + 10 * SLOT + off(tt, jg * 8)) = (v4u){tw[0], tw[1], tw[2], tw[3]};
        }
        __syncthreads();
        { const Acc2 q0 = mm_mul<false>(lds, 11, 10, 0, 0, wave, lane); const int g = lane >> 4, c15 = lane & 15;
#pragma unroll
          for (int jj = 0; jj < 2; ++jj) { const int job = wave + 8 * jj, yt = job >> 2, xt = job & 3; *(LAS f32x4*)(sL + (16 * yt + c15) * 64 + 16 * xt + 4 * g) = -q0.a[jj]; } }
        __syncthreads();
        if (F.tid < 64) sG[F.tid] = __expf(sL[63 * 64 + F.tid]);
        if (ch + 2 < SEQ / 64) scan_load_rows(L, Zrkv, WAG, tok + 128, pos + 128, j0);
        {
            const f32x4 l0 = *(const LAS f32x4*)(sL + tt * 64 + jg * 8), l1 = *(const LAS f32x4*)(sL + tt * 64 + jg * 8 + 4);
            const f32x4 c0 = *(const LAS f32x4*)(sL + 63 * 64 + jg * 8), c1 = *(const LAS f32x4*)(sL + 63 * 64 + jg * 8 + 4);
            float At[8], Bt[8], Kt[8], Rt[8], Bh[8], Kh[8];
#pragma unroll
            for (int e = 0; e < 8; ++e) { const float Lt = e < 4 ? l0[e] : l1[e - 4], LC = e < 4 ? c0[e] : c1[e - 4];
                const float eL = __expf(Lt), eLm1 = __expf(Lt + ew[e]), einv = __builtin_amdgcn_rcpf(eL), eC = __expf(LC) * einv, ba = kk[e] * a[e];
                At[e] = -kk[e] * eLm1; Bt[e] = ba * einv; Kt[e] = kp[e] * einv; Rt[e] = r[e] * eL; Bh[e] = ba * eC; Kh[e] = kp[e] * eC; }
#define RK_ROW(slot, arr) *(LAS v4u*)(lds + (slot) * SLOT + off(tt, jg * 8)) = (v4u){cvt_pk_bf16(arr[0], arr[1]), cvt_pk_bf16(arr[2], arr[3]), cvt_pk_bf16(arr[4], arr[5]), cvt_pk_bf16(arr[6], arr[7])}
#define RK_COL(slot, arr) { _Pragma("unroll") for (int e = 0; e < 8; ++e) *(LAS unsigned short*)(lds + (slot) * SLOT + off(jg * 8 + e, tt)) = (unsigned short)(cvt_pk_bf16(arr[e], 0.f) & 0xffffu); }
            RK_ROW(0, At); RK_COL(1, At); RK_ROW(2, Bt); RK_ROW(3, Kt); RK_ROW(4, Rt); RK_COL(5, Bh); RK_COL(6, Kh); RK_COL(7, v);
#undef RK_ROW
#undef RK_COL
        }
        __syncthreads();
#define MUL1(X_, Y_) mm_mul<false>(lds, X_, Y_, 0, 0, wave, lane)
#define MUL2(X_, Y_, X2_, Y2_) mm_mul<true>(lds, X_, Y_, X2_, Y2_, wave, lane)
#define PUT(E_, R_, Z_, C_) mm_put<E_>(lds, R_, Z_, C_, sG, wave, lane)
        { const Acc2 q0 = MUL1(2, 0), q1 = MUL1(0, 2), q2 = MUL1(3, 0), q3 = MUL1(2, 4), q4 = MUL1(3, 4);
          PUT(1, q0, 8, 13); PUT(2, q1, 14, 0); PUT(1, q2, 10, 15); PUT(3, q3, 11, 0); PUT(3, q4, 12, 0); }
        __syncthreads();
        { const Acc2 q0 = MUL1(14, 8), q1 = MUL1(8, 14); PUT(0, q0, 0, 0); PUT(0, q1, 2, 0); }
        __syncthreads();
        { const Acc2 q0 = MUL1(2, 13), q1 = MUL1(2, 0), q2 = MUL1(0, 2); PUT(4, q0, 3, 13); PUT(0, q1, 8, 0); PUT(0, q2, 14, 0); }
        __syncthreads();
        { const Acc2 q0 = MUL1(14, 3), q1 = MUL1(14, 8), q2 = MUL1(8, 14); PUT(4, q0, 13, 3); PUT(0, q1, 0, 0); PUT(0, q2, 2, 0); }
        __syncthreads();
        { const Acc2 q0 = MUL1(2, 13), q1 = MUL1(2, 0), q2 = MUL1(0, 2); PUT(4, q0, 3, 13); PUT(0, q1, 8, 0); PUT(0, q2, 14, 0); }
        __syncthreads();
        { const Acc2 q0 = MUL1(14, 3), q1 = MUL1(8, 14); PUT(4, q0, 13, 3); PUT(0, q1, 0, 0); }
        __syncthreads();
        { const Acc2 q0 = MUL1(0, 13); PUT(4, q0, 3, 13); }
        __syncthreads();
        { const Acc2 q0 = MUL1(3, 1), q1 = MUL1(10, 7); PUT(0, q0, 8, 0); PUT(0, q1, 0, 0); }
        __syncthreads();
        { const Acc2 q0 = MUL1(3, 0); PUT(0, q0, 13, 0); }
        __syncthreads();
        { const Acc2 q0 = MUL1(8, 5), q1 = MUL2(5, 13, 6, 7), q2 = MUL1(8, 11), q3 = MUL2(11, 13, 12, 7);
          PUT(5, q0, 2, 0); PUT(0, q1, 14, 0); PUT(4, q2, 15, 4); PUT(0, q3, 0, 0); }
        __syncthreads();
#undef MUL1
#undef MUL2
#undef PUT
        if (ch == 0) { for (int i = F.tid; i < SLOT / 4; i += NTHREADS) ((LAS unsigned*)(lds + 9 * SLOT))[i] = 0u; }
        else {
            if (F.tid == 0) { unsigned sp = 0; while (__hip_atomic_load(flag, __ATOMIC_RELAXED, __HIP_MEMORY_SCOPE_AGENT) < (unsigned)ch && ++sp < (1u << 22)) __builtin_amdgcn_s_sleep(1); }
            __syncthreads();
            const unsigned long long* sp8 = (const unsigned long long*)(SB + (size_t)(ch & 1) * 4096 + F.tid * 8);
            const unsigned long long w0 = __hip_atomic_load(sp8, __ATOMIC_RELAXED, __HIP_MEMORY_SCOPE_AGENT), w1 = __hip_atomic_load(sp8 + 1, __ATOMIC_RELAXED, __HIP_MEMORY_SCOPE_AGENT);
            *(LAS v4u*)(lds + 9 * SLOT + off(F.tid >> 3, (F.tid & 7) * 8)) = (v4u){(unsigned)w0, (unsigned)(w0 >> 32), (unsigned)w1, (unsigned)(w1 >> 32)};
        }
        __syncthreads();
        v2u snew[2];
        {
            const int g = lane >> 4, c15 = lane & 15;
#pragma unroll
            for (int jj = 0; jj < 2; ++jj) {
                const int job = wave + 8 * jj, yt = job >> 2, xt = job & 3;
                f32x4 ya = (f32x4){0.f, 0.f, 0.f, 0.f}, sa2 = (f32x4){0.f, 0.f, 0.f, 0.f};
#pragma unroll
                for (int ks = 0; ks < 2; ++ks) {
                    const bf16x8 sf = *(const LAS bf16x8*)(lds + 9 * SLOT + off(16 * yt + c15, ks * 32 + 8 * g));
                    const bf16x8 rf = *(const LAS bf16x8*)(lds + 15 * SLOT + off(16 * xt + c15, ks * 32 + 8 * g)), mf = *(const LAS bf16x8*)(lds + 2 * SLOT + off(16 * xt + c15, ks * 32 + 8 * g));
                    ya = __builtin_amdgcn_mfma_f32_16x16x32_bf16(rf, sf, ya, 0, 0, 0); sa2 = __builtin_amdgcn_mfma_f32_16x16x32_bf16(mf, sf, sa2, 0, 0, 0);
                }
                const int yy = 16 * yt + c15, x0 = 16 * xt + 4 * g;
                const v2u y0w = *(const LAS v2u*)(lds + 0 * SLOT + off(yy, x0)), nw = *(const LAS v2u*)(lds + 14 * SLOT + off(yy, x0));
                ya[0] += bflo(y0w.x); ya[1] += bfhi(y0w.x); ya[2] += bflo(y0w.y); ya[3] += bfhi(y0w.y);
                sa2[0] += bflo(nw.x); sa2[1] += bfhi(nw.x); sa2[2] += bflo(nw.y); sa2[3] += bfhi(nw.y);
#pragma unroll
                for (int e = 0; e < 4; ++e) sY[(x0 + e) * 64 + yy] = ya[e];
                snew[jj] = (v2u){cvt_pk_bf16(sa2[0], sa2[1]), cvt_pk_bf16(sa2[2], sa2[3])};
            }
        }
        {
            const int g = lane >> 4, c15 = lane & 15;
#pragma unroll
            for (int jj = 0; jj < 2; ++jj) { const int job = wave + 8 * jj, yt = job >> 2, xt = job & 3;
                __hip_atomic_store((unsigned long long*)(SB + (size_t)((ch + 1) & 1) * 4096 + (16 * yt + c15) * 64 + 16 * xt + 4 * g), (unsigned long long)snew[jj].x | ((unsigned long long)snew[jj].y << 32), __ATOMIC_RELAXED, __HIP_MEMORY_SCOPE_AGENT); }
            asm volatile("s_waitcnt vmcnt(0)" ::: "memory");
            __syncthreads();
            if (F.tid == 0) __hip_atomic_store(flag, (unsigned)(ch + 1), __ATOMIC_RELAXED, __HIP_MEMORY_SCOPE_AGENT);
        }
        {
            const LAS float* yb = sY + tt * 64 + jg * 8;
            const f32x4 ya = *(const LAS f32x4*)yb, yc = *(const LAS f32x4*)(yb + 4);
            float y[8] = {ya[0], ya[1], ya[2], ya[3], yc[0], yc[1], yc[2], yc[3]};
            float sm = 0.f;
#pragma unroll
            for (int e = 0; e < 8; ++e) sm += y[e];
            const float mean = sum8(sm) * (1.f / 64.f);
            float sv = 0.f;
#pragma unroll
            for (int e = 0; e < 8; ++e) { y[e] -= mean; sv += y[e] * y[e]; }
            const float rstd = rsqrtf(sum8(sv) * (1.f / 64.f) + 64e-5f);
            float lnw[8], lnb[8];
#pragma unroll
            for (int e = 0; e < 8; ++e) { lnw[e] = F.in[13][j0 + e]; lnb[e] = F.in[14][j0 + e]; }
            float o[8];
#pragma unroll
            for (int q = 0; q < 4; ++q) {
                o[2 * q] = (y[2 * q] * rstd * lnw[2 * q] + lnb[2 * q] + dot * v[2 * q]) * bflo(g4[q]);
                o[2 * q + 1] = (y[2 * q + 1] * rstd * lnw[2 * q + 1] + lnb[2 * q + 1] + dot * v[2 * q + 1]) * bfhi(g4[q]);
            }
            *(v4u*)(YA + tok * 512 + j0) = (v4u){cvt_pk_bf16(o[0], o[1]), cvt_pk_bf16(o[2], o[3]), cvt_pk_bf16(o[4], o[5]), cvt_pk_bf16(o[6], o[7])};
        }
    }
    __syncthreads();
}

__device__ __forceinline__ void p5_post(Frame& F) {
    bf16* YA = WSP(bf16, WS_YA); const bf16* YC = WSP(bf16, WS_YC); const bf16* WAG = DOP(bf16, DO_WAG);
    const int gt = F.vcu * NTHREADS + F.tid, NGT = F.G * NTHREADS;
    for (int it = gt; it < T * 64; it += NGT) {
        const size_t tok = (size_t)(it >> 6); const int c0 = (it & 63) * 8;
        const v4u yw = *(const v4u*)(YA + tok * 512 + c0), cw = *(const v4u*)(YC + tok * 512 + c0), gw = *(const v4u*)(WAG + tok * 1536 + 1024 + c0);
        float y[8], sm = 0.f;
#pragma unroll
        for (int q = 0; q < 4; ++q) { y[2 * q] = bflo(yw[q]); y[2 * q + 1] = bfhi(yw[q]); sm += y[2 * q] + y[2 * q + 1]; }
        const float mean = sum8(sm) * (1.f / 64.f); float sv = 0.f;
#pragma unroll
        for (int e = 0; e < 8; ++e) { y[e] -= mean; sv += y[e] * y[e]; }
        const float rstd = rsqrtf(sum8(sv) * (1.f / 64.f) + 64e-5f);
        const f32x4 l0 = *(const f32x4*)(F.in[13] + c0), l1 = *(const f32x4*)(F.in[13] + c0 + 4);
        const float lw[8] = {l0[0], l0[1], l0[2], l0[3], l1[0], l1[1], l1[2], l1[3]};
        float o[8];
#pragma unroll
        for (int q = 0; q < 4; ++q) { o[2 * q] = y[2 * q] * rstd * lw[2 * q] * bflo(gw[q]) + bflo(cw[q]); o[2 * q + 1] = y[2 * q + 1] * rstd * lw[2 * q + 1] * bfhi(gw[q]) + bfhi(cw[q]); }
        *(v4u*)(YA + tok * 512 + c0) = (v4u){cvt_pk_bf16(o[0], o[1]), cvt_pk_bf16(o[2], o[3]), cvt_pk_bf16(o[4], o[5]), cvt_pk_bf16(o[6], o[7])};
    }
}

__device__ __forceinline__ unsigned score_key(float s) {
    s = s + 0.0f;
    const _Float16 hv = (_Float16)s; const unsigned u = (unsigned)__builtin_bit_cast(unsigned short, hv);
    return (u & 0x8000u) ? (~u & 0xffffu) : (u | 0x8000u);
}
__device__ __forceinline__ void find_bin(const LAS unsigned* hist, unsigned need, int lane, unsigned& bsel, unsigned& above) {
    const v4u c = *(const LAS v4u*)(hist + 4 * lane);
    const unsigned sl = c.x + c.y + c.z + c.w;
    unsigned suf = sl;
#pragma unroll
    for (int d = 1; d < 64; d <<= 1) { const unsigned o = (unsigned)__shfl_down((int)suf, d); suf += (lane + d < 64) ? o : 0u; }
    const unsigned long long bal = __ballot(suf >= need);
    const int L = 63 - __builtin_clzll(bal | 1ull);
    unsigned run = suf - sl;
    unsigned bb, ab;
    if (run + c.w >= need) { bb = 3; ab = run; }
    else if (run + c.w + c.z >= need) { bb = 2; ab = run + c.w; }
    else if (run + c.w + c.z + c.y >= need) { bb = 1; ab = run + c.w + c.z; }
    else { bb = 0; ab = run + c.w + c.z + c.y; }
    bsel = (unsigned)__shfl((int)(4 * lane + bb), L); above = (unsigned)__shfl((int)ab, L);
}
constexpr int HP = 260;
constexpr int HIST_WAVE_BYTES = 16 * HP * 4, KBUF_OFF = NWAVES * HIST_WAVE_BYTES;
template <int PASS>
__device__ __forceinline__ void idx_tile(const bf16x8 K0, const bf16x8 K1, const int kt, const bool diag, const bf16x8 (&Q)[4][2], const float (&w)[4], LAS unsigned* hrow, const int g, const int c15,
                                         const unsigned b1, const unsigned thr, const unsigned rr, unsigned& cnt, unsigned& ties, unsigned short* idxrow, unsigned short* sink) {
    float sc[4] = {0.f, 0.f, 0.f, 0.f};
#pragma unroll
    for (int hh = 0; hh < 4; ++hh) {
        f32x4 acc = (f32x4){0.f, 0.f, 0.f, 0.f};
        acc = __builtin_amdgcn_mfma_f32_16x16x32_bf16(K0, Q[hh][0], acc, 0, 0, 0);
        acc = __builtin_amdgcn_mfma_f32_16x16x32_bf16(K1, Q[hh][1], acc, 0, 0, 0);
#pragma unroll
        for (int i = 0; i < 4; ++i) sc[i] += w[hh] * __builtin_amdgcn_fmed3f(acc[i], 0.f, __builtin_inff());
    }
    unsigned key[4]; bool valid[4];
#pragma unroll
    for (int i = 0; i < 4; ++i) { valid[i] = !diag || (4 * g + i <= c15); key[i] = score_key(sc[i]); }
    if (PASS == 0) {
#pragma unroll
        for (int i = 0; i < 4; ++i) lds_add(hrow + (key[i] >> 8), valid[i] ? 1u : 0u);
    } else if (PASS == 1) {
#pragma unroll
        for (int i = 0; i < 4; ++i) if (valid[i] && (key[i] >> 8) == b1) lds_add(hrow + (key[i] & 255u), 1u);
    } else {
        const unsigned long long qmask = 0x0001000100010001ull << c15, lowerG = qmask & ((1ull << (16 * g)) - 1ull);
        bool tie[4]; unsigned tlow = 0;
#pragma unroll
        for (int i = 0; i < 4; ++i) tie[i] = valid[i] && key[i] == thr;
        unsigned tb[4];
#pragma unroll
        for (int i = 0; i < 4; ++i) { const unsigned long long bl = __ballot(tie[i]); tb[i] = (unsigned)__popcll(bl & qmask); tlow += (unsigned)__popcll(bl & lowerG); }
        bool sel[4]; unsigned trun = ties + tlow;
#pragma unroll
        for (int i = 0; i < 4; ++i) { const bool tacc = tie[i] && trun < rr; sel[i] = (valid[i] && key[i] > thr) || tacc; trun += tie[i] ? 1u : 0u; }
        unsigned slow = 0, stot = 0;
#pragma unroll
        for (int i = 0; i < 4; ++i) { const unsigned long long bl = __ballot(sel[i]); stot += (unsigned)__popcll(bl & qmask); slow += (unsigned)__popcll(bl & lowerG); }
        unsigned pos = cnt + slow;
#pragma unroll
        for (int i = 0; i < 4; ++i) { if (sel[i] && pos < 256u) ((LAS unsigned short*)hrow)[pos] = (unsigned short)(kt * 16 + 4 * g + i); pos += sel[i] ? 1u : 0u; }
        cnt += stot; ties += tb[0] + tb[1] + tb[2] + tb[3];
    }
}
template <int PASS>
__device__ __forceinline__ void idx_pass(Frame& F, const bf16* kb_batch  , const int p, const int pmax, const bf16x8 (&Q)[4][2], const float (&w)[4], LAS unsigned* hrow,
                                         const unsigned b1, const unsigned thr, const unsigned rr, unsigned& cnt, unsigned& ties, unsigned short* idxrow, unsigned short* sink) {
    const int g = F.lane >> 4, c15 = F.lane & 15;
    LAS unsigned char* kbuf = F.lds + KBUF_OFF;
    const int skey = F.tid >> 3, sd8 = F.tid & 7;
    const unsigned sdst = (unsigned)((skey >> 4) * 2048 + (sd8 >> 2) * 1024 + (sd8 & 3) * 256 + (skey & 15) * 16);
    const bf16* ssrc = kb_batch + (size_t)skey * 512 + sd8 * 8;
    const int nchunk = (pmax >> 2) + 1;
    v4u st = *(const v4u*)ssrc;
    __syncthreads();
    *(LAS v4u*)(kbuf + sdst) = st;
    for (int c = 0; c < nchunk; ++c) {
        if (c + 1 < nchunk) st = *(const v4u*)(ssrc + (size_t)(c + 1) * 64 * 512);
        __syncthreads();
        const LAS unsigned char* kb = kbuf + (c & 1) * 8192 + g * 256 + c15 * 16;
        if (c * 4 + 3 < p) {
            bf16x8 K0[4], K1[4];
#pragma unroll
            for (int u = 0; u < 4; ++u) { K0[u] = *(const LAS bf16x8*)(kb + u * 2048); K1[u] = *(const LAS bf16x8*)(kb + u * 2048 + 1024); }
#pragma unroll
            for (int u = 0; u < 4; ++u) idx_tile<PASS>(K0[u], K1[u], c * 4 + u, false, Q, w, hrow, g, c15, b1, thr, rr, cnt, ties, idxrow, sink);
        } else {
#pragma unroll
            for (int u = 0; u < 4; ++u) {
                const int kt = c * 4 + u;
                if (kt <= p) {
                    const bf16x8 K0 = *(const LAS bf16x8*)(kb + u * 2048), K1 = *(const LAS bf16x8*)(kb + u * 2048 + 1024);
                    idx_tile<PASS>(K0, K1, kt, kt == p, Q, w, hrow, g, c15, b1, thr, rr, cnt, ties, idxrow, sink);
                }
            }
        }
        if (c + 1 < nchunk) *(LAS v4u*)(kbuf + ((c + 1) & 1) * 8192 + sdst) = st;
    }
}
namespace ix3 {
constexpr int KP = 8208, KEYS_B = 16 * KP, HIST_OFF = KEYS_B, CNT_OFF = HIST_OFF + 16 * HP * 4, QI_OFF = CNT_OFF + 8 * 16 * 2 * 4, END_OFF = QI_OFF + 16 * 4 * 4;
static_assert(END_OFF <= MISC_OFF, "indexer LDS map");
}
__device__ __forceinline__ void p4_indexer(Frame& F) {
    using namespace ix3;
    const bf16* Zd = WSP(bf16, WS_ZD); unsigned short* IDX = WSP(unsigned short, WS_IDX);
    LAS unsigned char* lds = F.lds;
    LAS unsigned* hist = (LAS unsigned*)(lds + HIST_OFF); LAS unsigned* cntt = (LAS unsigned*)(lds + CNT_OFF); LAS unsigned* qi = (LAS unsigned*)(lds + QI_OFF);
    const int lane = F.lane, wave = F.wave, g = lane >> 4, c15 = lane & 15;
    const int b = F.vcu >> 4, vb = F.vcu & 15;
    if (b >= NB) return;
    LAS unsigned* hrow = hist + c15 * HP;
    LAS unsigned char* krow = lds + c15 * KP;
    const unsigned long long qmask = 0x0001000100010001ull << c15, lowerG = qmask & ((1ull << (16 * g)) - 1ull);
    for (int ti = 0; ti < 16; ++ti) {
        const int pr = vb * 8 + (ti & 7), p = (ti & 8) ? 255 - pr : pr;
        const int q0 = p * 16; const size_t tok0 = (size_t)b * SEQ + q0;
        if (p < 16) {
            for (int i = F.tid; i < 16 * 256; i += NTHREADS) { const int r = i >> 8, jx = i & 255; IDX[(tok0 + r) * 256 + jx] = (unsigned short)(jx <= q0 + r ? jx : 0); }
            continue;
        }
        const int np = p + 1, K8 = (np + 7) >> 3, lo = wave * K8, hi = (lo + K8 < np) ? lo + K8 : np;
        for (int z = F.tid; z < 16 * HP; z += NTHREADS) hist[z] = 0u;
        bf16x8 Q[4][2];
#pragma unroll
        for (int hh = 0; hh < 4; ++hh)
#pragma unroll
            for (int ks = 0; ks < 2; ++ks) Q[hh][ks] = *(const bf16x8*)(Zd + (tok0 + c15) * 512 + 256 + hh * 64 + ks * 32 + 8 * g);
        float w[4];
        { const v2u ww = *(const v2u*)(Zd + (tok0 + c15) * 512 + 192); w[0] = bflo(ww.x) * 0.0625f; w[1] = bfhi(ww.x) * 0.0625f; w[2] = bflo(ww.y) * 0.0625f; w[3] = bfhi(ww.y) * 0.0625f; }
        __syncthreads();
        if (lo < hi) {
            const bf16* kbase = Zd + ((size_t)b * SEQ + c15) * 512 + 128 + 8 * g;
            constexpr int NPF = 2;
            bf16x8 R[NPF][2];
#pragma unroll
            for (int u = 0; u < NPF; ++u) { const int kl = lo + u < hi ? lo + u : hi - 1; R[u][0] = *(const bf16x8*)(kbase + (size_t)kl * 8192); R[u][1] = *(const bf16x8*)(kbase + (size_t)kl * 8192 + 32);
                __builtin_amdgcn_sched_barrier(0); }
            auto keys2 = [&](const float s0, const float s1) __attribute__((always_inline)) -> unsigned {
                typedef _Float16 h2_t __attribute__((ext_vector_type(2))); typedef short s2_t __attribute__((ext_vector_type(2)));
                h2_t hv = __builtin_convertvector((f32x2){s0, s1}, h2_t); hv = hv + (h2_t){(_Float16)0.0f, (_Float16)0.0f};
                const s2_t hs = __builtin_bit_cast(s2_t, hv); const s2_t sg = hs >> (s2_t){15, 15};
                return __builtin_bit_cast(unsigned, hs) ^ (__builtin_bit_cast(unsigned, sg) | 0x80008000u);
            };
            for (int kt0 = lo; kt0 < hi; kt0 += NPF) {
#pragma unroll
                for (int u = 0; u < NPF; ++u) {
                    const int kt = kt0 + u;
                    f32x4 acc[4];
#pragma unroll
                    for (int hh = 0; hh < 4; ++hh) {
                        acc[hh] = __builtin_amdgcn_mfma_f32_16x16x32_bf16(R[u][0], Q[hh][0], (f32x4){0.f, 0.f, 0.f, 0.f}, 0, 0, 0);
                        acc[hh] = __builtin_amdgcn_mfma_f32_16x16x32_bf16(R[u][1], Q[hh][1], acc[hh], 0, 0, 0);
                    }
                    { const int kn = kt + NPF, kl = kn < hi ? kn : hi - 1; R[u][0] = *(const bf16x8*)(kbase + (size_t)kl * 8192); R[u][1] = *(const bf16x8*)(kbase + (size_t)kl * 8192 + 32); }
                    float sc[4] = {0.f, 0.f, 0.f, 0.f};
#pragma unroll
                    for (int hh = 0; hh < 4; ++hh)
#pragma unroll
                        for (int i = 0; i < 4; ++i) { const float av = acc[hh][i]; const int ai = __builtin_bit_cast(int, av); const int ar = ai > 0 ? ai : 0; sc[i] += w[hh] * __builtin_bit_cast(float, ar); }
                    if (kt < hi) {
                        const unsigned k01 = keys2(sc[0], sc[1]), k23 = keys2(sc[2], sc[3]);
                        const unsigned bin[4] = {(k01 >> 8) & 255u, k01 >> 24, (k23 >> 8) & 255u, k23 >> 24};
                        if (kt == p) {
                            asm volatile("" ::: "memory");
#pragma unroll
                            for (int i = 0; i < 4; ++i) lds_add(hrow + bin[i], (4 * g + i <= c15) ? 1u : 0u);
                        } else {
#pragma unroll
                            for (int i = 0; i < 4; ++i) lds_add(hrow + bin[i], 1u);
                        }
                        *(LAS v2u*)(krow + (kt * 16 + 4 * g) * 2) = (v2u){k01, k23};
                    }
                }
            }
        }
        __syncthreads();
        {
            LAS unsigned* hq[2]; const LAS unsigned char* kq[2]; unsigned qpos[2], b1[2], ab1[2], thr[2], rr[2];
            const int nsteps = (np * 16 + 255) >> 8;
#pragma unroll
            for (int qq = 0; qq < 2; ++qq) { const int q = 2 * wave + qq; hq[qq] = hist + q * HP; kq[qq] = lds + q * KP; qpos[qq] = (unsigned)(q0 + q); }
#pragma unroll
            for (int qq = 0; qq < 2; ++qq) find_bin(hq[qq], 256u, lane, b1[qq], ab1[qq]);
#pragma unroll
            for (int qq = 0; qq < 2; ++qq) for (int z = lane; z < HP; z += 64) hq[qq][z] = 0u;
            {
                auto step = [&](const int s, const bool mk) __attribute__((always_inline)) {
                    const unsigned k0 = (unsigned)(s * 256 + 4 * lane);
                    v2u kw[2];
#pragma unroll
                    for (int qq = 0; qq < 2; ++qq) kw[qq] = *(const LAS v2u*)(kq[qq] + k0 * 2);
#pragma unroll
                    for (int qq = 0; qq < 2; ++qq) { const unsigned key[4] = {kw[qq].x & 0xffffu, kw[qq].x >> 16, kw[qq].y & 0xffffu, kw[qq].y >> 16};
#pragma unroll
                        for (int i = 0; i < 4; ++i) if ((!mk || k0 + i <= qpos[qq]) && (key[i] >> 8) == b1[qq]) lds_add(hq[qq] + (key[i] & 255u), 1u); }
                };
                for (int s = 0; s < nsteps - 1; ++s) step(s, false);
                step(nsteps - 1, true);
            }
#pragma unroll
            for (int qq = 0; qq < 2; ++qq) { unsigned bs, ab; find_bin(hq[qq], 256u - ab1[qq], lane, bs, ab); thr[qq] = (b1[qq] << 8) | bs; rr[qq] = 256u - (ab1[qq] + ab); }
            unsigned cnt[2] = {0u, 0u}, ties[2] = {0u, 0u};
            {
                auto step = [&](const int s, const bool mk) __attribute__((always_inline)) {
                    const unsigned k0 = (unsigned)(s * 256 + 4 * lane);
                    v2u kw[2];
#pragma unroll
                    for (int qq = 0; qq < 2; ++qq) kw[qq] = *(const LAS v2u*)(kq[qq] + k0 * 2);
                    bool tie[2][4], sel[2][4]; bool anyt = false;
#pragma unroll
                    for (int qq = 0; qq < 2; ++qq) { const unsigned key[4] = {kw[qq].x & 0xffffu, kw[qq].x >> 16, kw[qq].y & 0xffffu, kw[qq].y >> 16};
#pragma unroll
                        for (int i = 0; i < 4; ++i) { const bool valid = !mk || k0 + i <= qpos[qq]; tie[qq][i] = valid && key[i] == thr[qq]; sel[qq][i] = valid && key[i] > thr[qq]; anyt = anyt || tie[qq][i]; } }
                    if (__ballot(anyt) != 0ull) {
                        asm volatile("" ::: "memory");
#pragma unroll
                        for (int qq = 0; qq < 2; ++qq) { unsigned tlow = 0, tall = 0;
#pragma unroll
                            for (int i = 0; i < 4; ++i) { const unsigned long long bm = __ballot(tie[qq][i]); tlow = __builtin_amdgcn_mbcnt_hi((unsigned)(bm >> 32), __builtin_amdgcn_mbcnt_lo((unsigned)bm, tlow)); tall += (unsigned)__popcll(bm); }
                            unsigned trun = ties[qq] + tlow;
#pragma unroll
                            for (int i = 0; i < 4; ++i) { sel[qq][i] = sel[qq][i] || (tie[qq][i] && trun < rr[qq]); trun += tie[qq][i] ? 1u : 0u; }
                            ties[qq] += tall; }
                    }
#pragma unroll
                    for (int qq = 0; qq < 2; ++qq) { LAS unsigned short* list = (LAS unsigned short*)hq[qq];
                        unsigned slow = 0, sall = 0;
#pragma unroll
                        for (int i = 0; i < 4; ++i) { const unsigned long long bm = __ballot(sel[qq][i]); slow = __builtin_amdgcn_mbcnt_hi((unsigned)(bm >> 32), __builtin_amdgcn_mbcnt_lo((unsigned)bm, slow)); sall += (unsigned)__popcll(bm); }
                        unsigned pos = cnt[qq] + slow;
#pragma unroll
                        for (int i = 0; i < 4; ++i) { const unsigned wpos = (sel[qq][i] && pos < 256u) ? pos : 256u + (unsigned)lane; list[wpos] = (unsigned short)(k0 + i); pos += sel[qq][i] ? 1u : 0u; }
                        cnt[qq] += sall; }
                };
                for (int s = 0; s < nsteps - 1; ++s) step(s, false);
                step(nsteps - 1, true);
            }
        }
        __syncthreads();
        { const int q = F.tid >> 5, ch = F.tid & 31; const v4u v = *(const LAS v4u*)((const LAS unsigned char*)(hist + q * HP) + ch * 16); *(v4u*)((unsigned char*)(IDX + (tok0 + q) * 256) + ch * 16) = v; }
        __syncthreads();
    }
}

__device__ __forceinline__ unsigned off_b(unsigned row, unsigned ch) { return 256u * row + 16u * (ch ^ (((row & 3) << 2) | ((row >> 2) & 3))); }
__device__ __forceinline__ void p4_sparse_attn(Frame& F) {
    const bf16* CKV = WSP(bf16, WS_CKV); const unsigned short* IDX = WSP(unsigned short, WS_IDX); bf16* QL = WSP(bf16, WS_QLAT);
    LAS unsigned char* img0 = F.lds + F.wave * 16384;
    const int lane = F.lane, g = lane >> 4, c15 = lane & 15, qq = c15 >> 2, pp = lane & 3;
    const int t0 = F.gw * 32; constexpr int NF = 256;
    v4u ixw; v4u rw[8];
    const unsigned goff = 16u * g, coff = 16u * c15;
#define SA_LOAD_IDX(f_) { const int f2 = (f_) < NF ? (f_) : NF - 1; ixw = *(const v4u*)((const unsigned char*)(IDX + (size_t)(t0 + (f2 >> 3)) * 256 + (f2 & 7) * 32) + goff); }
#define SA_IX(c_) (((c_) & 1) ? (ixw[(c_) >> 1] >> 16) : (ixw[(c_) >> 1] & 0xffffu))
#define SA_LOAD_ROWS(f_) { const int f2 = (f_) < NF ? (f_) : NF - 1; const unsigned char* rbp = (const unsigned char*)(CKV + (size_t)((t0 + (f2 >> 3)) >> 12) * SEQ * 128); \
        _Pragma("unroll") for (int c = 0; c < 8; ++c) rw[c] = *(const v4u*)(rbp + ((SA_IX(c) << 8) + coff)); }
    SA_LOAD_IDX(0); SA_LOAD_ROWS(0); SA_LOAD_IDX(1);
    bf16x8 Bq[4], Bqn[4];
#pragma unroll
    for (int ks = 0; ks < 4; ++ks) { Bqn[ks] = (bf16x8){0, 0, 0, 0, 0, 0, 0, 0}; if (c15 < 8) Bqn[ks] = *(const bf16x8*)(QL + (size_t)t0 * 1024 + c15 * 128 + ks * 32 + 8 * g); Bq[ks] = Bqn[ks]; }
    float mrun = -1e30f, lsum = 0.f;
    f32x4 O[8];
#pragma unroll
    for (int c = 0; c < 8; ++c) O[c] = (f32x4){0.f, 0.f, 0.f, 0.f};
    for (int f = 0; f < NF; ++f) {
        const int t = t0 + (f >> 3), im = f & 7; const int pos = t & (SEQ - 1); const int nsel = pos + 1 < 256 ? pos + 1 : 256;
        LAS unsigned char* img = img0 + (f & 1) * 8192;
#pragma unroll
        for (int c = 0; c < 8; ++c) *(LAS v4u*)(img + off_b(8 * g + c, c15)) = rw[c];
        SA_LOAD_ROWS(f + 1);
        SA_LOAD_IDX(f + 2);
        if (im == 0) {
#pragma unroll
            for (int ks = 0; ks < 4; ++ks) Bq[ks] = Bqn[ks];
            mrun = -1e30f; lsum = 0.f;
#pragma unroll
            for (int c = 0; c < 8; ++c) O[c] = (f32x4){0.f, 0.f, 0.f, 0.f};
        }
        if (im == 2) { const int tn = (t + 1 < t0 + 32) ? t + 1 : t;
#pragma unroll
            for (int ks = 0; ks < 4; ++ks) if (c15 < 8) Bqn[ks] = *(const bf16x8*)(QL + (size_t)tn * 1024 + c15 * 128 + ks * 32 + 8 * g); }
        f32x4 sacc[2];
#pragma unroll
        for (int rb = 0; rb < 2; ++rb) { sacc[rb] = (f32x4){0.f, 0.f, 0.f, 0.f};
#pragma unroll
            for (int ks = 0; ks < 4; ++ks) { const bf16x8 a = *(const LAS bf16x8*)(img + off_b(c15 + 16 * rb, 4 * ks + g)); sacc[rb] = __builtin_amdgcn_mfma_f32_16x16x32_bf16(a, Bq[ks], sacc[rb], 0, 0, 0); } }
        if (nsel < 256) {
            asm volatile("" ::: "memory");
#pragma unroll
            for (int rb = 0; rb < 2; ++rb)
#pragma unroll
                for (int i = 0; i < 4; ++i) { const int j = im * 32 + 16 * rb + 4 * g + i; if (j >= nsel) sacc[rb][i] = -1e30f; }
        }
        float mx = -1e30f;
#pragma unroll
        for (int rb = 0; rb < 2; ++rb)
#pragma unroll
            for (int i = 0; i < 4; ++i) mx = fmaxf(mx, sacc[rb][i]);
        mx = fmaxf(mx, __shfl_xor(mx, 16)); mx = fmaxf(mx, __shfl_xor(mx, 32));
        const float mnew = fmaxf(mrun, mx), alpha = __expf(mrun - mnew), mneg = -1.4426950408889634f * mnew;
        float ps = 0.f; float pv[8];
#pragma unroll
        for (int rb = 0; rb < 2; ++rb)
#pragma unroll
            for (int i = 0; i < 4; ++i) { const float pe = __builtin_amdgcn_exp2f(__builtin_fmaf(sacc[rb][i], 1.4426950408889634f, mneg)); pv[4 * rb + i] = pe; ps += pe; }
        ps += __shfl_xor(ps, 16); ps += __shfl_xor(ps, 32);
        lsum = lsum * alpha + ps; mrun = mnew;
        const v4u pw = (v4u){cvt_pk_bf16(pv[0], pv[1]), cvt_pk_bf16(pv[2], pv[3]), cvt_pk_bf16(pv[4], pv[5]), cvt_pk_bf16(pv[6], pv[7])};
        const bf16x8 pa = __builtin_bit_cast(bf16x8, pw);
        float al[4];
#pragma unroll
        for (int i = 0; i < 4; ++i) al[i] = __shfl(alpha, (4 * g + i) & 15);
#pragma unroll
        for (int c = 0; c < 8; ++c) {
#pragma unroll
            for (int i = 0; i < 4; ++i) O[c][i] *= al[i];
            const s16x4 lo = __builtin_bit_cast(s16x4, __builtin_amdgcn_ds_read_tr16_b64_v4i16((LAS s16x4*)(img + off_b(4 * g + qq, 2 * c + (pp >> 1)) + 8 * (pp & 1))));
            const s16x4 hi = __builtin_bit_cast(s16x4, __builtin_amdgcn_ds_read_tr16_b64_v4i16((LAS s16x4*)(img + off_b(16 + 4 * g + qq, 2 * c + (pp >> 1)) + 8 * (pp & 1))));
            const bf16x8 bv = (bf16x8){lo[0], lo[1], lo[2], lo[3], hi[0], hi[1], hi[2], hi[3]};
            O[c] = __builtin_amdgcn_mfma_f32_16x16x32_bf16(pa, bv, O[c], 0, 0, 0);
        }
        if (im == 7) {
            float inv[4];
#pragma unroll
            for (int i = 0; i < 4; ++i) inv[i] = __builtin_amdgcn_rcpf(__shfl(lsum, (4 * g + i) & 15));
            if (g < 2) {
#pragma unroll
                for (int c = 0; c < 8; ++c)
#pragma unroll
                    for (int i = 0; i < 4; ++i) *(LAS unsigned short*)(img + ((4 * g + i) * 128 + 16 * c + c15) * 2) = (unsigned short)(cvt_pk_bf16(O[c][i] * inv[i], 0.f) & 0xffffu);
            }
            const v4u o0 = *(const LAS v4u*)(img + lane * 32), o1 = *(const LAS v4u*)(img + lane * 32 + 16);
            *(v4u*)(QL + (size_t)t * 1024 + lane * 16) = o0; *(v4u*)(QL + (size_t)t * 1024 + lane * 16 + 8) = o1;
        }
    }
#undef SA_LOAD_IDX
#undef SA_IX
#undef SA_LOAD_ROWS
}

__device__ __forceinline__ void p10_cross_attn(Frame& F) {
    const bf16* QC = WSP(bf16, WS_QC); bf16* XO = WSP(bf16, WS_XO); const bf16* Km = WSP(bf16, WS_KMEM); const bf16* Vt = WSP(bf16, WS_VT);
    const int lane = F.lane, g = lane >> 4, c15 = lane & 15;
    constexpr int RS = 528, BUFB = 64 * RS, NU = NB * 4 * 16;
    const int srow = F.tid >> 5, spc = F.tid & 31;
#define X_SRC(u_, c_) ((c_) < 4 ? (const unsigned char*)(Km + ((size_t)((u_) >> 6) * 256 + (c_) * 64 + srow) * 1024 + (((u_) >> 4) & 3) * 256) + spc * 16 \
                               : (const unsigned char*)(Vt + ((size_t)((u_) >> 4) * 256 + ((c_) - 4) * 64 + srow) * 256) + spc * 16)
#define X_LOAD(st_, u_, c_) { const unsigned char* s_ = X_SRC(u_, c_); _Pragma("unroll") for (int j = 0; j < 4; ++j) st_[j] = *(const v4u*)(s_ + (size_t)j * 16 * ((c_) < 4 ? 2048 : 512)); }
#define X_PUT(st_, bi_) { _Pragma("unroll") for (int j = 0; j < 4; ++j) *(LAS v4u*)(F.lds + (bi_) * BUFB + (srow + 16 * j) * RS + spc * 16) = st_[j]; }
#define X_QROW(u_, t_) (QC + ((size_t)((u_) >> 6) * SEQ + ((u_) & 15) * 256 + F.wave * 32 + (t_) * 16 + c15) * 1024 + (((u_) >> 4) & 3) * 256)
    if (F.vcu >= NU) return;
    v4u st0[4], st1[4];
    bf16x8 Bq[2][8];
    {
        const int u = F.vcu;
        X_LOAD(st0, u, 0); X_LOAD(st1, u, 1);
#pragma unroll
        for (int t = 0; t < 2; ++t) { const bf16* qrow = X_QROW(u, t);
#pragma unroll
            for (int ks = 0; ks < 8; ++ks) Bq[t][ks] = *(const bf16x8*)(qrow + ks * 32 + 8 * g); }
        X_PUT(st0, 0);
    }
    for (int u = F.vcu; u < NU; u += F.G) {
        const int un = (u + F.G < NU) ? u + F.G : u;
        bf16x8 pb[2][8]; float mc[2][4], Ls[2] = {0.f, 0.f}, inv[2] = {0.f, 0.f};
#pragma unroll
        for (int cs = 0; cs < 8; ++cs) {
            if (cs & 1) { if (cs + 2 < 8) { X_LOAD(st1, u, cs + 2); } else { X_LOAD(st1, un, cs + 2 - 8); } }
            else        { if (cs + 2 < 8) { X_LOAD(st0, u, cs + 2); } else { X_LOAD(st0, un, cs + 2 - 8); } }
            __syncthreads();
            const LAS unsigned char* buf = F.lds + (cs & 1) * BUFB;
            if (cs < 4) {
                f32x4 acc[2][4];
                bf16x8 Af[2][4];
                const LAS unsigned char* kb = buf + c15 * RS + 16 * g;
#define X_LDK(gi_) { _Pragma("unroll") for (int q = 0; q < 4; ++q) Af[(gi_) & 1][q] = *(const LAS bf16x8*)(kb + ((gi_) >> 1) * 16 * RS + (((gi_) & 1) * 4 + q) * 64); }
                X_LDK(0);
                f32x4 a0 = (f32x4){0.f, 0.f, 0.f, 0.f}, a1 = a0;
#pragma unroll
                for (int gi = 0; gi < 8; ++gi) {
                    if (gi + 1 < 8) X_LDK(gi + 1);
                    __builtin_amdgcn_sched_barrier(0);
                    if (!(gi & 1)) { a0 = (f32x4){0.f, 0.f, 0.f, 0.f}; a1 = a0; }
#pragma unroll
                    for (int q = 0; q < 4; ++q) { a0 = __builtin_amdgcn_mfma_f32_16x16x32_bf16(Af[gi & 1][q], Bq[0][(gi & 1) * 4 + q], a0, 0, 0, 0); a1 = __builtin_amdgcn_mfma_f32_16x16x32_bf16(Af[gi & 1][q], Bq[1][(gi & 1) * 4 + q], a1, 0, 0, 0); }
                    if (gi & 1) { acc[0][gi >> 1] = a0; acc[1][gi >> 1] = a1; }
                    __builtin_amdgcn_sched_barrier(0);
                }
#undef X_LDK
#pragma unroll
                for (int t = 0; t < 2; ++t) {
                    float mx = -1e30f;
#pragma unroll
                    for (int m4 = 0; m4 < 4; ++m4)
#pragma unroll
                        for (int i = 0; i < 4; ++i) mx = fmaxf(mx, acc[t][m4][i]);
                    mx = fmaxf(mx, __shfl_xor(mx, 16)); mx = fmaxf(mx, __shfl_xor(mx, 32));
                    if (cs > 0) mx = fmaxf(mx, mc[t][cs > 0 ? cs - 1 : 0]);
                    float ps = (cs > 0) ? Ls[t] * __expf(mc[t][cs > 0 ? cs - 1 : 0] - mx) : 0.f;
#pragma unroll
                    for (int s2 = 0; s2 < 2; ++s2) { float e[8];
#pragma unroll
                        for (int i = 0; i < 4; ++i) { e[i] = __expf(acc[t][2 * s2][i] - mx); e[4 + i] = __expf(acc[t][2 * s2 + 1][i] - mx); ps += e[i] + e[4 + i]; }
                        const v4u w = (v4u){cvt_pk_bf16(e[0], e[1]), cvt_pk_bf16(e[2], e[3]), cvt_pk_bf16(e[4], e[5]), cvt_pk_bf16(e[6], e[7])}; pb[t][cs * 2 + s2] = __builtin_bit_cast(bf16x8, w); }
                    mc[t][cs] = mx; Ls[t] = ps;
                }
                if (cs == 3) {
#pragma unroll
                    for (int t = 0; t < 2; ++t) {
                        const float M = mc[t][3];
                        float L = Ls[t];
#pragma unroll
                        for (int c = 0; c < 3; ++c) { const float f = __expf(mc[t][c] - M);
#pragma unroll
                            for (int s2 = 0; s2 < 2; ++s2) { const v4u w = __builtin_bit_cast(v4u, pb[t][c * 2 + s2]);
                                const v4u r = (v4u){cvt_pk_bf16(bflo(w.x) * f, bfhi(w.x) * f), cvt_pk_bf16(bflo(w.y) * f, bfhi(w.y) * f), cvt_pk_bf16(bflo(w.z) * f, bfhi(w.z) * f), cvt_pk_bf16(bflo(w.w) * f, bfhi(w.w) * f)};
                                pb[t][c * 2 + s2] = __builtin_bit_cast(bf16x8, r); } }
                        L += __shfl_xor(L, 16); L += __shfl_xor(L, 32);
                        inv[t] = 1.0f / L;
                    }
#pragma unroll
                    for (int t = 0; t < 2; ++t) { const bf16* qn = X_QROW(un, t);
#pragma unroll
                        for (int ks = 0; ks < 8; ++ks) Bq[t][ks] = *(const bf16x8*)(qn + ks * 32 + 8 * g); }
                }
            } else {
                unsigned char* q0 = (unsigned char*)XO + (X_QROW(u, 0) - QC); unsigned char* q1 = (unsigned char*)XO + (X_QROW(u, 1) - QC);
                v4u Vf[2][4];
                const LAS unsigned char* vb = buf + c15 * RS + 8 * g;
#define X_LDV(gi_) { _Pragma("unroll") for (int q = 0; q < 4; ++q) { const LAS unsigned char* p_ = vb + ((gi_) >> 1) * 16 * RS + (((gi_) & 1) * 4 + q) * 64; \
                        const v2u lo = *(const LAS v2u*)p_, hi = *(const LAS v2u*)(p_ + 32); Vf[(gi_) & 1][q] = (v4u){lo.x, lo.y, hi.x, hi.y}; } }
                X_LDV(0);
                f32x4 o0 = (f32x4){0.f, 0.f, 0.f, 0.f}, o1 = o0;
#pragma unroll
                for (int gi = 0; gi < 8; ++gi) {
                    if (gi + 1 < 8) X_LDV(gi + 1);
                    __builtin_amdgcn_sched_barrier(0);
                    if (!(gi & 1)) { o0 = (f32x4){0.f, 0.f, 0.f, 0.f}; o1 = o0; }
#pragma unroll
                    for (int q = 0; q < 4; ++q) { const bf16x8 av = __builtin_bit_cast(bf16x8, Vf[gi & 1][q]);
                        o0 = __builtin_amdgcn_mfma_f32_16x16x32_bf16(av, pb[0][(gi & 1) * 4 + q], o0, 0, 0, 0); o1 = __builtin_amdgcn_mfma_f32_16x16x32_bf16(av, pb[1][(gi & 1) * 4 + q], o1, 0, 0, 0); }
                    if (gi & 1) { const int d4 = gi >> 1;
                        *(unsigned*)(q0 + ((cs - 4) * 4 + d4) * 16 + 4 * g) = pk4_fp8(o0[0] * inv[0], o0[1] * inv[0], o0[2] * inv[0], o0[3] * inv[0]);
                        *(unsigned*)(q1 + ((cs - 4) * 4 + d4) * 16 + 4 * g) = pk4_fp8(o1[0] * inv[1], o1[1] * inv[1], o1[2] * inv[1], o1[3] * inv[1]); }
                    __builtin_amdgcn_sched_barrier(0);
                }
#undef X_LDV
            }
            if (cs & 1) { X_PUT(st0, 0); } else { X_PUT(st1, 1); }
        }
    }
    __syncthreads();
#undef X_SRC
#undef X_LOAD
#undef X_PUT
#undef X_QROW
}

__device__ __forceinline__ void rms_row16(const bf16* xrow, const float* g, bf16* orow, int lane, unsigned char* o8row) {
    const v4u a = *((const v4u*)xrow + 2 * lane), b = *((const v4u*)xrow + 2 * lane + 1);
    float v[16] = {bflo(a.x), bfhi(a.x), bflo(a.y), bfhi(a.y), bflo(a.z), bfhi(a.z), bflo(a.w), bfhi(a.w), bflo(b.x), bfhi(b.x), bflo(b.y), bfhi(b.y), bflo(b.z), bfhi(b.z), bflo(b.w), bfhi(b.w)};
    float s = 0.f;
#pragma unroll
    for (int e = 0; e < 16; ++e) s += v[e] * v[e];
    const float rstd = rsqrtf(wave_sum(s) * (1.f / 1024.f) + 1e-6f);
    const f32x4* gr = (const f32x4*)g + 4 * lane;
#pragma unroll
    for (int q = 0; q < 4; ++q) { const f32x4 gg = gr[q]; v[4 * q] *= rstd * gg[0]; v[4 * q + 1] *= rstd * gg[1]; v[4 * q + 2] *= rstd * gg[2]; v[4 * q + 3] *= rstd * gg[3]; }
    *((v4u*)orow + 2 * lane) = (v4u){cvt_pk_bf16(v[0], v[1]), cvt_pk_bf16(v[2], v[3]), cvt_pk_bf16(v[4], v[5]), cvt_pk_bf16(v[6], v[7])};
    *((v4u*)orow + 2 * lane + 1) = (v4u){cvt_pk_bf16(v[8], v[9]), cvt_pk_bf16(v[10], v[11]), cvt_pk_bf16(v[12], v[13]), cvt_pk_bf16(v[14], v[15])};
    if (o8row) *((v4u*)o8row + lane) = (v4u){pk4_fp8(v[0], v[1], v[2], v[3]), pk4_fp8(v[4], v[5], v[6], v[7]), pk4_fp8(v[8], v[9], v[10], v[11]), pk4_fp8(v[12], v[13], v[14], v[15])};
}
__device__ __forceinline__ void rms_row16_do(const v4u a, const v4u b, const f32x4 (&gv)[4], bf16* orow, int lane, unsigned char* o8row) {
    float v[16] = {bflo(a.x), bfhi(a.x), bflo(a.y), bfhi(a.y), bflo(a.z), bfhi(a.z), bflo(a.w), bfhi(a.w), bflo(b.x), bfhi(b.x), bflo(b.y), bfhi(b.y), bflo(b.z), bfhi(b.z), bflo(b.w), bfhi(b.w)};
    float s = 0.f;
#pragma unroll
    for (int e = 0; e < 16; ++e) s += v[e] * v[e];
    const float rstd = rsqrtf(wave_sum(s) * (1.f / 1024.f) + 1e-6f);
#pragma unroll
    for (int q = 0; q < 4; ++q) { const f32x4 gg = gv[q]; v[4 * q] *= rstd * gg[0]; v[4 * q + 1] *= rstd * gg[1]; v[4 * q + 2] *= rstd * gg[2]; v[4 * q + 3] *= rstd * gg[3]; }
    if (orow) {
        *((v4u*)orow + 2 * lane) = (v4u){cvt_pk_bf16(v[0], v[1]), cvt_pk_bf16(v[2], v[3]), cvt_pk_bf16(v[4], v[5]), cvt_pk_bf16(v[6], v[7])};
        *((v4u*)orow + 2 * lane + 1) = (v4u){cvt_pk_bf16(v[8], v[9]), cvt_pk_bf16(v[10], v[11]), cvt_pk_bf16(v[12], v[13]), cvt_pk_bf16(v[14], v[15])}; }
    if (o8row) *((v4u*)o8row + lane) = (v4u){pk4_fp8(v[0], v[1], v[2], v[3]), pk4_fp8(v[4], v[5], v[6], v[7]), pk4_fp8(v[8], v[9], v[10], v[11]), pk4_fp8(v[12], v[13], v[14], v[15])};
}
__device__ __forceinline__ void p_norm_rows16(Frame& F, const bf16* src, const float* g, bf16* dst, unsigned char* dst8) {
    const int lane = F.lane, step = F.NGW; int m = F.gw;
    if (m >= T) return;
    f32x4 gv[4];
#pragma unroll
    for (int q = 0; q < 4; ++q) gv[q] = *((const f32x4*)g + 4 * lane + q);
#define NR_LD(a_, b_, m_) { const int mm_ = (m_) < T ? (m_) : m; a_ = *((const v4u*)(src + (size_t)mm_ * D) + 2 * lane); b_ = *((const v4u*)(src + (size_t)mm_ * D) + 2 * lane + 1); __builtin_amdgcn_sched_barrier(0); }
#define NR_DO(a_, b_) { if (m < T) { const v4u ca_ = a_, cb_ = b_; NR_LD(a_, b_, m + 3 * step); rms_row16_do(ca_, cb_, gv, dst ? dst + (size_t)m * D : nullptr, lane, dst8 ? dst8 + (size_t)m * D : nullptr); m += step; } }
    v4u a0, b0, a1, b1, a2, b2;
    NR_LD(a0, b0, m); NR_LD(a1, b1, m + step); NR_LD(a2, b2, m + 2 * step);
    while (m < T) { NR_DO(a0, b0); NR_DO(a1, b1); NR_DO(a2, b2); }
#undef NR_LD
#undef NR_DO
}
__device__ __forceinline__ void p_norm_rows(Frame& F, const float* g, bf16* dst, unsigned char* dst8 = nullptr) {
    for (int m = F.gw; m < T; m += F.NGW) rms_row_to_bf16(F.out + (size_t)m * D, g, dst + (size_t)m * D, F.lane, dst8 ? (unsigned*)(dst8 + (size_t)m * D) : nullptr);
}

struct TokInfo { int e0, e1; float g0, g1; };
__device__ __forceinline__ void p14a_route(Frame& F) {
    const float* L = WSP(float, WS_LOGIT); TokInfo* TI = WSP(TokInfo, WS_ROUTE); const float* bg = F.in[29]; const float* be = F.in[31];
    volatile LAS unsigned* lh = (volatile LAS unsigned*)F.lds;
    if (F.tid < 32) lh[F.tid] = 0u;
    __syncthreads();
    const int t = F.vcu * 256 + F.tid;
    if (F.tid < 256) {
        const float* l = L + (size_t)t * 64;
        float gl[4]; int grp = 0; float gm = -1e30f;
#pragma unroll
        for (int i = 0; i < 4; ++i) { gl[i] = l[i] + bg[i]; if (gl[i] > gm) { gm = gl[i]; grp = i; } }
        float gs = 0.f;
#pragma unroll
        for (int i = 0; i < 4; ++i) gs += __expf(gl[i] - gm);
        const float pgrp = 1.0f / gs;
        float el[8];
#pragma unroll
        for (int i = 0; i < 8; ++i) el[i] = l[4 + grp * 8 + i] + be[grp * 8 + i];
        int i0 = 0; float m0 = -1e30f;
#pragma unroll
        for (int i = 0; i < 8; ++i) if (el[i] > m0) { m0 = el[i]; i0 = i; }
        int i1 = 0; float m1 = -1e30f;
#pragma unroll
        for (int i = 0; i < 8; ++i) if (i != i0 && el[i] > m1) { m1 = el[i]; i1 = i; }
        const float p1 = __expf(m1 - m0);
        TokInfo ti; ti.e0 = grp * 8 + i0; ti.e1 = grp * 8 + i1; ti.g0 = pgrp / (1.f + p1); ti.g1 = pgrp * p1 / (1.f + p1);
        TI[t] = ti;
        lds_add((LAS unsigned*)&lh[ti.e0], 1u); lds_add((LAS unsigned*)&lh[ti.e1], 1u);
    }
    __syncthreads();
    if (F.tid < 32 && lh[F.tid]) atomicAdd(F.ctl + CW_CNT + F.tid, lh[F.tid]);
}
__device__ __forceinline__ void moe_tstart(Frame& F, volatile LAS int* tstart) {
    if (F.tid == 0) { int acc = 0; for (int e = 0; e < 32; ++e) { tstart[e] = acc; acc += (int)((__hip_atomic_load(F.ctl + CW_CNT + e, __ATOMIC_RELAXED, __HIP_MEMORY_SCOPE_AGENT) + 255u) >> 8); } tstart[32] = acc; }
    __syncthreads();
}
__device__ __forceinline__ void p14b_slots(Frame& F) {
    const TokInfo* TI = WSP(TokInfo, WS_ROUTE); int* TS = (int*)(F.ws + WS_ROUTE + 1 * MiB); int* stok = (int*)(F.ws + WS_ROUTE + 2 * MiB); float* sgate = (float*)(F.ws + WS_ROUTE + 3 * MiB);
    volatile LAS int* tstart = (volatile LAS int*)(F.lds + MISC_OFF + 256);
    volatile LAS unsigned* lh = (volatile LAS unsigned*)F.lds; volatile LAS unsigned* lbase = lh + 32;
    if (F.tid < 32) lh[F.tid] = 0u;
    moe_tstart(F, tstart);
    const int t = F.vcu * 256 + F.tid; TokInfo ti; unsigned r0 = 0, r1 = 0;
    if (F.tid < 256) { ti = TI[t]; r0 = lds_add((LAS unsigned*)&lh[ti.e0], 1u); r1 = lds_add((LAS unsigned*)&lh[ti.e1], 1u); }
    __syncthreads();
    if (F.tid < 32) lbase[F.tid] = lh[F.tid] ? atomicAdd(F.ctl + CW_FILL + F.tid, lh[F.tid]) : 0u;
    __syncthreads();
    if (F.tid < 256) {
        const int s0 = tstart[ti.e0] * 256 + (int)(lbase[ti.e0] + r0), s1 = tstart[ti.e1] * 256 + (int)(lbase[ti.e1] + r1);
        stok[s0] = t; sgate[s0] = ti.g0; stok[s1] = t; sgate[s1] = ti.g1; TS[2 * t] = s0; TS[2 * t + 1] = s1;
    }
    if (F.vcu < 32) {
        const int e = F.vcu; const int cnt = (int)__hip_atomic_load(F.ctl + CW_CNT + e, __ATOMIC_RELAXED, __HIP_MEMORY_SCOPE_AGENT); const int base = tstart[e] * 256, end = tstart[e + 1] * 256;
        for (int s = base + cnt + F.tid; s < end; s += NTHREADS) { stok[s] = 0; sgate[s] = 0.f; }
    }
}

__device__ __forceinline__ void p17_final(Frame& F) {
    const int* TS = (const int*)(F.ws + WS_ROUTE + 1 * MiB); const bf16* YS = WSP(bf16, WS_YS); const bf16* H2 = WSP(bf16, WS_H2B); const float* gn = F.in[35];
    const int lane = F.lane, step = F.NGW; int m = F.gw;
    if (m >= T) return;
    f32x4 gg[4];
#pragma unroll
    for (int j = 0; j < 4; ++j) gg[j] = *((const f32x4*)gn + lane + 64 * j);
    struct Row { v2u h[4], a[4], c[4]; };
#define FN_IDX(i_, m_) { const int mm_ = (m_) < T ? (m_) : F.gw; i_ = *(const int2*)(TS + 2 * mm_); }
#define FN_LD(r_, i_, m_) { const int mm_ = (m_) < T ? (m_) : F.gw; const v2u* hr = (const v2u*)(H2 + (size_t)mm_ * D) + lane; const v2u* y0 = (const v2u*)(YS + (size_t)i_.x * 1024) + lane; \
        const v2u* y1 = (const v2u*)(YS + (size_t)i_.y * 1024) + lane; _Pragma("unroll") for (int j = 0; j < 4; ++j) { r_.h[j] = hr[64 * j]; r_.a[j] = y0[64 * j]; r_.c[j] = y1[64 * j]; } __builtin_amdgcn_sched_barrier(0); }
    Row r0, r1; int2 i0, i1, j0, j1;
    FN_IDX(i0, m); FN_IDX(i1, m + step);
    FN_LD(r0, i0, m); FN_LD(r1, i1, m + step);
    FN_IDX(j0, m + 2 * step); FN_IDX(j1, m + 3 * step);
#define FN_DO(r_, jn_) { if (m < T) { const Row q_ = r_; const int2 in_ = jn_; FN_LD(r_, in_, m + 2 * step); FN_IDX(jn_, m + 4 * step); \
        f32x4 v[4]; float s = 0.f; \
        _Pragma("unroll") for (int j = 0; j < 4; ++j) { v[j] = (f32x4){bflo(q_.h[j].x), bfhi(q_.h[j].x), bflo(q_.h[j].y), bfhi(q_.h[j].y)}; \
            v[j].x += bflo(q_.a[j].x) + bflo(q_.c[j].x); v[j].y += bfhi(q_.a[j].x) + bfhi(q_.c[j].x); v[j].z += bflo(q_.a[j].y) + bflo(q_.c[j].y); v[j].w += bfhi(q_.a[j].y) + bfhi(q_.c[j].y); \
            s += (v[j].x * v[j].x + v[j].y * v[j].y) + (v[j].z * v[j].z + v[j].w * v[j].w); } \
        const float rstd = rsqrtf(wave_sum(s) * (1.f / 1024.f) + 1e-6f); f32x4* xr = (f32x4*)(F.out + (size_t)m * D) + lane; \
        _Pragma("unroll") for (int j = 0; j < 4; ++j) xr[64 * j] = (f32x4){v[j].x * rstd * gg[j].x, v[j].y * rstd * gg[j].y, v[j].z * rstd * gg[j].z, v[j].w * rstd * gg[j].w}; \
        m += step; } }
    while (m < T) { FN_DO(r0, j0); FN_DO(r1, j1); }
#undef FN_IDX
#undef FN_LD
#undef FN_DO
}

__global__ void __launch_bounds__(NTHREADS, 2) hybrid_fwd(Args args) {
    extern __shared__ __attribute__((aligned(16))) unsigned char lds_raw[];
    cg::grid_group grid = cg::this_grid();
    Frame F;
    F.lds = (LAS unsigned char*)lds_raw; F.MISC = (volatile LAS unsigned*)(F.lds + MISC_OFF);
    F.tid = threadIdx.x; F.lane = F.tid & 63; F.wave = __builtin_amdgcn_readfirstlane(F.tid >> 6);
    F.G = gridDim.x; { const int bx = blockIdx.x; F.vcu = (F.G % 8 == 0) ? (bx % 8) * (F.G / 8) + bx / 8 : bx; }
    F.gw = F.vcu * NWAVES + F.wave; F.NGW = F.G * NWAVES;
    F.in = args.in; F.out = args.out; F.ws = args.ws; F.ctl = (unsigned*)(args.ws + WS_CTL);
    for (int u = F.tid; u < (LDS_BYTES - MISC_OFF) / 4; u += NTHREADS) ((LAS unsigned*)(F.lds + MISC_OFF))[u] = 0u;
    __syncthreads();
    XcdBarrier bar = xcd_barrier_post(F.ctl + CW_BAR, F.MISC + 8);
#ifdef USE_CG_BAR
#define GRID_BAR() grid.sync()
#else
#define GRID_BAR() do { xcd_barrier(bar); asm volatile("" : "+v"(F.tid), "+v"(F.lane)); } while (0)
#endif
    const int c = (int)blockIdx.x;

#ifndef PHASE_MASK
#define PHASE_MASK 0xffffffffu
#endif
#ifndef PROBE_DUP
#define PROBE_DUP 0u
#endif
#define PH(n) for (int _rep = 0; _rep < (((PROBE_DUP) >> (n)) & 1u) + 1; ++_rep) if (PHASE_MASK & (1u << (n)))
#ifdef DIAG_FILL
    {
        const size_t n16 = (WS_END - 2 * MiB) / 16; v4u* p = (v4u*)(F.ws + 2 * MiB);
        for (size_t i = (size_t)F.vcu * NTHREADS + F.tid; i < n16; i += (size_t)F.G * NTHREADS) p[i] = (v4u){0, 0, 0, 0};
        const size_t m16 = ((size_t)T * D * 4) / 16; v4u* q = (v4u*)F.out;
        for (size_t i = (size_t)F.vcu * NTHREADS + F.tid; i < m16; i += (size_t)F.G * NTHREADS) q[i] = (v4u){0, 0, 0, 0};
        grid.sync();
    }
#endif
    PH(0) p0_prologue(F);
    grid.sync();
    asm volatile("" : "+v"(F.tid), "+v"(F.lane));
    PH(1) { pg8::StaticOrder S; S.init(DOP(bf16, DO_XN), WSP(bf16, WS_WIN), T, 1792, 1024, F.G, c);
      EpiMain E{WSP(bf16, WS_ZRKV), WSP(bf16, WS_ZLORA), WSP(bf16, WS_QLAT), WSP(bf16, WS_ZD), WSP(bf16, WS_G), F.in[20]};
      pg8::gemm_phase<EpiMain, pg8::StaticOrder, false>(F.lds, 1024, S, E); }
    PH(1) { pg8::StaticOrder S; S.init(DOP(bf16, DO_XN), WSP(bf16, WS_WIN) + (size_t)2816 * 1024, T, 512, 1024, F.G, c);
      EpiMain E{WSP(bf16, WS_ZRKV), WSP(bf16, WS_ZLORA), WSP(bf16, WS_QLAT), WSP(bf16, WS_ZD), WSP(bf16, WS_G), F.in[20], 11};
      pg8::gemm_phase<EpiMain, pg8::StaticOrder, false>(F.lds, 1024, S, E); }
    PH(1) { pg8::StaticOrder S; S.init(F.ws + WS_XN8, F.ws + WS_WQ8, T, 1024, 512, F.G, c);
      EpiBf16 E{WSP(bf16, WS_QLAT), 1024, 1, 0, 1.0f / 256.f};
      pg8::gemm_phase<EpiBf16, pg8::StaticOrder, false, true>(F.lds, 512, S, E); }
    PH(1) { pg8::StaticOrder S; S.init(F.ws + WS_XN8, F.ws + WS_WG8, T, 2048, 512, F.G, c);
      EpiGate8 E{WSP(bf16, WS_G), F.in[20]};
      pg8::gemm_phase<EpiGate8, pg8::StaticOrder, false, true>(F.lds, 512, S, E); }
    PH(2) { pg8::StaticOrder S; S.init(WSP(bf16, WS_MEMN), WSP(bf16, WS_WCKV), NB * 256, 1024, 1024, F.G, c);
      EpiBf16 E{WSP(bf16, WS_KMEM), 1024, 1, 0, 1.0f};
      pg8::gemm_phase<EpiBf16, pg8::StaticOrder, false>(F.lds, 1024, S, E); }
    PH(21) { pg8::StaticOrder S; S.init(WSP(bf16, WS_WCKV) + (size_t)1024 * 1024, WSP(bf16, WS_MEMN), 1024, NB * 256, 1024, F.G, c);
      EpiBf16 E{WSP(bf16, WS_VT), 256, 0, (size_t)1024 * 256, 1.0f};
      pg8::gemm_phase<EpiBf16, pg8::StaticOrder, false>(F.lds, 1024, S, E); }
    GRID_BAR();
    PH(3) p2_lora_prep(F);
    GRID_BAR();
    PH(4) { pg8::StaticOrder S; S.init(DOP(bf16, DO_ALORA), WSP(bf16, WS_BLORA), T, 1536, 256, F.G, c);
      EpiLora E{DOP(bf16, DO_WAG), F.in[5], F.in[7]};
      pg8::gemm_phase<EpiLora, pg8::StaticOrder, false>(F.lds, 256, S, E); }
    PH(5) p4_indexer(F);
    GRID_BAR();
#ifdef RWKV_CHUNKED
    PH(6) p4_rwkv_chunked(F);
    PH(7) p4_sparse_attn(F);
    GRID_BAR();
#else
    PH(6) p4_scan(F);
    PH(7) p4_sparse_attn(F);
    GRID_BAR();
    PH(22) p5_post(F);
    GRID_BAR();
#endif
    PH(8) { pg8::StaticOrder S; S.init(WSP(bf16, WS_YA), WSP(bf16, WS_WA), T, 1024, 512, F.G, c);
      EpiMix E{WSP(bf16, WS_U), WSP(bf16, WS_G), 0};
      pg8::gemm_phase<EpiMix, pg8::StaticOrder, false>(F.lds, 512, S, E); }
    PH(8) { pg8::StaticOrder S; S.init(WSP(bf16, WS_QLAT), WSP(bf16, WS_WB), T, 1024, 1024, F.G, c);
      EpiMix E{WSP(bf16, WS_U), WSP(bf16, WS_G), 1};
      pg8::gemm_phase<EpiMix, pg8::StaticOrder, false>(F.lds, 1024, S, E); }
    GRID_BAR();
    PH(9) { pg8::StaticOrder S; S.init(WSP(bf16, WS_U), WSP(bf16, WS_WOUT), T, 1024, 1024, F.G, c);
      EpiResB E{F.in[0], nullptr, WSP(bf16, WS_H1B)};
      pg8::gemm_phase<EpiResB, pg8::StaticOrder, false>(F.lds, 1024, S, E); }
    GRID_BAR();
    PH(10) p_norm_rows16(F, WSP(bf16, WS_H1B), F.in[22], nullptr, F.ws + WS_XO);
    GRID_BAR();
    PH(11) { pg8::StaticOrder S; S.init(F.ws + WS_XO, F.ws + WS_WCQ, T, 1024, 512, F.G, c);
      EpiBf16 E{WSP(bf16, WS_QC), 1024, 1, 0, 0.0625f * 0.0625f};
      pg8::gemm_phase<EpiBf16, pg8::StaticOrder, false, true>(F.lds, 512, S, E); }
    GRID_BAR();
    PH(12) p10_cross_attn(F);
    GRID_BAR();
    PH(13) { pg8::StaticOrder S; S.init(F.ws + WS_XO, F.ws + WS_WCO, T, 1024, 512, F.G, c);
      EpiResB E{nullptr, WSP(bf16, WS_H1B), WSP(bf16, WS_H2B), 0.0625f};
      pg8::gemm_phase<EpiResB, pg8::StaticOrder, false, true>(F.lds, 512, S, E); }
    GRID_BAR();
    PH(14) p_norm_rows16(F, WSP(bf16, WS_H2B), F.in[27], WSP(bf16, WS_HN), F.ws + WS_HN8);
    GRID_BAR();
    PH(15) { pg8::StaticOrder S; S.init(WSP(bf16, WS_HN), WSP(bf16, WS_WR), T, 256, 1024, F.G, c);
      EpiLogit E{WSP(float, WS_LOGIT)};
      pg8::gemm_phase<EpiLogit, pg8::StaticOrder, false>(F.lds, 1024, S, E); }
    GRID_BAR();
    PH(16) p14a_route(F);
    GRID_BAR();
    PH(17) p14b_slots(F);
    GRID_BAR();
    { volatile LAS int* tstart = (volatile LAS int*)(F.lds + MISC_OFF + 256);
      const int* stok = (const int*)(F.ws + WS_ROUTE + 2 * MiB); const float* sgate = (const float*)(F.ws + WS_ROUTE + 3 * MiB);
      PH(18) { MoeOrder S{(const char*)(F.ws + WS_HN8), (const char*)(F.ws + WS_WGU), (size_t)1024 * 1024, 512, 4, stok, tstart, F.G, c, true};
        EpiMoe1 E{F.ws + WS_HID};
        pg8::gemm_phase<EpiMoe1, MoeOrder, true, true>(F.lds, 512, S, E); }
      GRID_BAR();
      PH(19) { MoeOrder S{(const char*)(F.ws + WS_HID), (const char*)(F.ws + WS_WD), (size_t)1024 * 512, 256, 4, stok, tstart, F.G, c, false};
        EpiMoe2 E{WSP(bf16, WS_YS), sgate};
        pg8::gemm_phase<EpiMoe2, MoeOrder, false, true>(F.lds, 256, S, E); }
    }
    GRID_BAR();
    PH(20) p17_final(F);
}

extern "C" void kernel_launch(void* const* d_in, const int* in_sizes, int n_in, void* d_out, int out_size, void* d_ws, size_t ws_size, hipStream_t stream) {
    static int grid = 0;
    if (grid == 0) {
        if (n_in != 36 || out_size != T * D || ws_size < WS_END) { fprintf(stderr, "kernel_launch: unexpected shapes (n_in %d out %d ws %zu)\n", n_in, out_size, ws_size); grid = -1; return; }
        int dev = 0, cus = 0, per_cu = 0;
        hipGetDevice(&dev); hipDeviceGetAttribute(&cus, hipDeviceAttributeMultiprocessorCount, dev);
        hipFuncSetAttribute((const void*)hybrid_fwd, hipFuncAttributeMaxDynamicSharedMemorySize, LDS_BYTES);
        hipOccupancyMaxActiveBlocksPerMultiprocessor(&per_cu, (const void*)hybrid_fwd, NTHREADS, LDS_BYTES);
        (void)hipGetLastError();
        if (per_cu < 1) { fprintf(stderr, "kernel_launch: occupancy query says %d blocks per CU\n", per_cu); grid = -1; return; }
        grid = cus;
    }
    if (grid < 0) return;
    hipMemsetAsync((char*)d_ws + WS_CTL, 0, CTL_ZERO_BYTES, stream);
    Args a{};
    for (int i = 0; i < 36; ++i) a.in[i] = (const float*)d_in[i];
    a.out = (float*)d_out; a.ws = (unsigned char*)d_ws;
    void* params[] = {&a};
    hipError_t e = hipLaunchCooperativeKernel((const void*)hybrid_fwd, dim3(grid), dim3(NTHREADS), params, LDS_BYTES, stream);
    if (e != hipSuccess) fprintf(stderr, "kernel_launch: cooperative launch failed: %s (grid %d)\n", hipGetErrorString(e), grid);
}
```

```cpp
#include <hip/hip_runtime.h>
#include <hip/hip_cooperative_groups.h>
#include <cstdio>
#include <cstdint>
namespace cg = cooperative_groups;
#define RWKV_CHUNKED 1
#define PROBE_DUP 0u

#define GAS __attribute__((address_space(1)))
#define LAS __attribute__((address_space(3)))
typedef unsigned short bf16;
typedef unsigned v4u __attribute__((ext_vector_type(4)));
typedef unsigned v2u __attribute__((ext_vector_type(2)));
typedef float f32x4 __attribute__((ext_vector_type(4)));
typedef float f32x2 __attribute__((ext_vector_type(2)));
typedef short bf16x8 __attribute__((ext_vector_type(8)));
typedef short s16x4 __attribute__((ext_vector_type(4)));

constexpr int NB = 16, SEQ = 4096, T = NB * SEQ, D = 1024;
constexpr int NIN = 5376;
constexpr int NWAVES = 8, NTHREADS = 512;
constexpr int PSLOT = 2 * T + 32 * 256;

constexpr size_t MiB = 1u << 20;
constexpr size_t WS_CTL = 0, CTL_ZERO_BYTES = 1 * MiB;
constexpr size_t WS_WIN = 2 * MiB, WS_WA = 13 * MiB, WS_WB = 14 * MiB, WS_WOUT = 16 * MiB, WS_WCQ = 18 * MiB, WS_WCKV = 20 * MiB, WS_WCO = 24 * MiB;
constexpr size_t WS_BLORA = 26 * MiB, WS_WR = 27 * MiB, WS_WGU = 28 * MiB, WS_WD = 92 * MiB;
constexpr size_t WS_MEMN = 124 * MiB, WS_KMEM = 132 * MiB, WS_VT = 140 * MiB;
constexpr size_t WS_ZRKV = 150 * MiB, WS_ZLORA = 342 * MiB, WS_QLAT = 374 * MiB, WS_ZD = 502 * MiB, WS_G = 566 * MiB, WS_CKV = 822 * MiB, WS_IDX = 838 * MiB, WS_YA = 870 * MiB, WS_YC = 934 * MiB;
constexpr size_t WS_H1B = 694 * MiB  , WS_H2B = 218 * MiB  ;
constexpr size_t WS_U = WS_ZRKV, WS_HN = WS_G, WS_QC = WS_QLAT, WS_HN8 = WS_QLAT  , WS_LOGIT = 694 * MiB, WS_ROUTE = 710 * MiB, WS_HID = WS_ZRKV, WS_YS = 714 * MiB, WS_XO = WS_YA  , WS_XN8 = WS_YA  , WS_WG8 = 60 * MiB  , WS_WQ8 = 62 * MiB  , WS_END = 998 * MiB;
constexpr size_t DO_XN = 0, DO_ALORA = 0, DO_WAG = 32 * MiB, DO_SB = 224 * MiB;
constexpr int CW_BAR = 4096, CW_CNT = 1024, CW_FILL = 1088, CW_RK = 2048;

constexpr int RING_BYTES = 131072, MISC_OFF = 8 * 16 * 260 * 4 + 16384  , LDS_BYTES = MISC_OFF + 1024;

typedef __bf16 bf16x2_t __attribute__((ext_vector_type(2)));
__device__ __forceinline__ unsigned cvt_pk_bf16(float lo, float hi) { const f32x2 v = {lo, hi}; const bf16x2_t b = __builtin_convertvector(v, bf16x2_t); return __builtin_bit_cast(unsigned, b); }
typedef int v8i __attribute__((ext_vector_type(8)));
typedef int v4i __attribute__((ext_vector_type(4)));
typedef v8i v8i_a16 __attribute__((aligned(16)));
__device__ __forceinline__ unsigned pk4_fp8(float a, float b, float c, float d) { unsigned w = (unsigned)__builtin_amdgcn_cvt_pk_fp8_f32(a, b, 0, false); return (unsigned)__builtin_amdgcn_cvt_pk_fp8_f32(c, d, (int)w, true); }
__device__ __forceinline__ float bf2f(unsigned b) { return __uint_as_float(b << 16); }
__device__ __forceinline__ float bflo(unsigned w) { return __uint_as_float(w << 16); }
__device__ __forceinline__ float bfhi(unsigned w) { return __uint_as_float(w & 0xffff0000u); }
__device__ __forceinline__ float fsigmoid(float x) { return __builtin_amdgcn_rcpf(1.0f + __expf(-x)); }
__device__ __forceinline__ unsigned lds_add(LAS unsigned* p, unsigned v) { return __hip_atomic_fetch_add(p, v, __ATOMIC_RELAXED, __HIP_MEMORY_SCOPE_WORKGROUP); }
__device__ __forceinline__ float wave_sum(float v) {
#pragma unroll
    for (int o = 1; o < 64; o <<= 1) v += __shfl_xor(v, o);
    return v;
}
__device__ __forceinline__ float dpp_f(float v, const int ctrl_sel) {
    int x = __builtin_bit_cast(int, v), r;
    if (ctrl_sel == 0) r = __builtin_amdgcn_update_dpp(x, x, 0xB1, 0xF, 0xF, false);
    else if (ctrl_sel == 1) r = __builtin_amdgcn_update_dpp(x, x, 0x4E, 0xF, 0xF, false);
    else if (ctrl_sel == 2) r = __builtin_amdgcn_update_dpp(x, x, 0x141, 0xF, 0xF, false);
    else r = __builtin_amdgcn_update_dpp(x, x, 0x140, 0xF, 0xF, false);
    return __builtin_bit_cast(float, r);
}
__device__ __forceinline__ float sum8(float v) {
    v += dpp_f(v, 0); v += dpp_f(v, 1); v += dpp_f(v, 2); return v;
}

#define XB_TMO      128
#define XB_XCNT(j)  (256  + 64 * (j))
#define XB_XSUB(j)  (1280 + 64 * (j))
#define XB_XGEN(j)  (2304 + 64 * (j))
#define XB_TOP      3328
#define XB_TOPGEN   3392
#define XCD_BAR_WORDS 3456
#define XB_SPIN_CAP (1u << 20)
__device__ __forceinline__ unsigned xb_ld(unsigned* p)              { return __hip_atomic_load(p, __ATOMIC_RELAXED, __HIP_MEMORY_SCOPE_AGENT); }
__device__ __forceinline__ unsigned xb_add(unsigned* p, unsigned v) { return __hip_atomic_fetch_add(p, v, __ATOMIC_RELAXED, __HIP_MEMORY_SCOPE_AGENT); }
__device__ __forceinline__ unsigned xb_xcc_id() { return (unsigned)__builtin_amdgcn_s_getreg((3 << 11) | 20) & 0xFu; }
#define XB_SPIN(cond, bar) do { unsigned _sp = 0; while (cond) { __builtin_amdgcn_s_sleep(1); \
    if ((++_sp & 255u) == 0u) { if (xb_ld(&(bar)[XB_TMO])) break; if (_sp > XB_SPIN_CAP) { atomicAdd(&(bar)[XB_TMO], 1u); break; } } } } while (0)
struct XcdBarrier { unsigned* bar; unsigned x; volatile LAS unsigned* st; };
__device__ __forceinline__ XcdBarrier xcd_barrier_post(unsigned* bar, volatile LAS unsigned* st) {
    XcdBarrier b; b.bar = bar; b.x = xb_xcc_id(); b.st = st;
    if (threadIdx.x == 0) (void)xb_add(&bar[XB_XCNT(b.x)], 1u);
    return b;
}
__device__ __forceinline__ void xcd_barrier_complete(unsigned* bar, unsigned x, unsigned& nloc, unsigned& nx) {
    const unsigned G = gridDim.x * gridDim.y * gridDim.z;
    unsigned sum, cnt, mine, sp = 0u;
    for (;;) {
        sum = 0u; cnt = 0u; mine = 0u;
#pragma unroll
        for (unsigned j = 0; j < 16; ++j) { const unsigned c = xb_ld(&bar[XB_XCNT(j)]); sum += c; cnt += (c > 0u) ? 1u : 0u; mine = (j == x) ? c : mine; }
        if (sum == G) break;
        __builtin_amdgcn_s_sleep(1);
        if ((++sp & 255u) == 0u) { if (xb_ld(&bar[XB_TMO])) break; if (sp > XB_SPIN_CAP) { atomicAdd(&bar[XB_TMO], 1u); break; } }
    }
    nloc = mine > 0u ? mine : 1u; nx = cnt > 0u ? cnt : 1u;
}
__device__ __forceinline__ void xcd_barrier(const XcdBarrier& b) {
    asm volatile("s_waitcnt vmcnt(0)" ::: "memory");
    __syncthreads();
    if (threadIdx.x == 0) {
        unsigned* bar = b.bar;
        __builtin_amdgcn_s_waitcnt(0);
        unsigned nloc = b.st[0], nx = b.st[1];
        if (nloc == 0u) { xcd_barrier_complete(bar, b.x, nloc, nx); b.st[0] = nloc; b.st[1] = nx; }
        const unsigned old = xb_add(&bar[XB_XSUB(b.x)], 1u);
        const unsigned gen = old / nloc;
        if (old + 1u == (gen + 1u) * nloc) {
            __builtin_amdgcn_fence(__ATOMIC_RELEASE, "agent");
            asm volatile("s_waitcnt vmcnt(0)" ::: "memory");
            const unsigned og = xb_add(&bar[XB_TOP], 1u);
            const unsigned tg = og / nx;
            if (og + 1u == (tg + 1u) * nx) xb_add(&bar[XB_TOPGEN], 1u);
            else XB_SPIN(xb_ld(&bar[XB_TOPGEN]) == tg, bar);
            __builtin_amdgcn_fence(__ATOMIC_ACQUIRE, "agent");
            xb_add(&bar[XB_XGEN(b.x)], 1u);
            asm volatile("s_waitcnt vmcnt(0)" ::: "memory");
        } else {
            XB_SPIN(xb_ld(&bar[XB_XGEN(b.x)]) == gen, bar);
            __builtin_amdgcn_fence(__ATOMIC_ACQUIRE, "agent");
            asm volatile("s_waitcnt vmcnt(0)" ::: "memory");
        }
    }
    __syncthreads();
}

namespace pg8 {
constexpr int BM = 256, BK = 64, HALF = 128, HTB = HALF * BK * 2, NXCD = 8, WGM = 2;
__host__ __device__ __forceinline__ int lds_byte(int r, int c) { const int st = (r >> 4) * 2 + (c >> 5), rr = r & 15, cc = c & 31, ob = rr * 64 + cc * 2; return st * 1024 + (ob ^ (((ob >> 9) & 1) << 5)); }
__host__ __device__ __forceinline__ void stage_rc(int b, int& R, int& C) { const int st = b / 1024, sb = b % 1024, swz = sb ^ (((sb >> 9) & 1) << 5); R = (st >> 1) * 16 + swz / 64; C = (st & 1) * 32 + (swz % 64) / 2; }
__host__ __device__ __forceinline__ int perm32(int rho) { const int n = rho >> 4, i = rho & 15; return 8 * (i >> 2) + 4 * n + (i & 3); }

struct Unit { int pm, pn; const char* a; const char* b; const int* gidx; };

struct StaticOrder {
    const char* A; const char* Bt; int K; int nM, nN, nwg, G, c;
    __device__ void init(const void* A_, const void* Bt_, int M, int N, int K_, int G_, int c_) { A = (const char*)A_; Bt = (const char*)Bt_; K = K_; nM = M / BM; nN = N / BM; nwg = nM * nN; G = G_; c = c_; }
    __device__ bool next(int i, Unit& u) const { return nextL((long)i * G + c, u); }
    __device__ bool nextL(const long L, Unit& u) const {
        if (L >= nwg) return false;
        int wgid = (int)L; { const int q = nwg / NXCD, r = nwg % NXCD, xcd = wgid % NXCD, off = wgid / NXCD; wgid = (xcd < r ? xcd * (q + 1) : r * (q + 1) + (xcd - r) * q) + off; }
        const int nig = WGM * nN, gid = wgid / nig, fm = gid * WGM, gsz = (nM - fm) < WGM ? (nM - fm) : WGM;
        u.pm = fm + ((wgid % nig) % gsz); u.pn = (wgid % nig) / gsz;
        u.a = A + (size_t)u.pm * 256 * K * 2; u.b = Bt + (size_t)u.pn * 256 * K * 2; u.gidx = nullptr; return true;
    }
};

struct SkewOrder {
    StaticOrder S; int per, nlow;
    __device__ bool next(int i, Unit& u) const {
        const int c = S.c, G = S.G;
        if (i < per - 1) return S.nextL((long)i * G + c, u);
        if (c < nlow) return false;
        if (i == per - 1) return S.nextL((long)(per - 1) * G + c, u);
        if (i == per && c < 2 * nlow) return S.nextL((long)(per - 1) * G + (c - nlow), u);
        return false;
    }
};

template <class Epi, class Sched, bool GATHER, bool F8 = false>
__device__ __forceinline__ void gemm_phase(LAS unsigned char* lds, const int K_, const Sched& S, const Epi& E) {
    int K = K_; asm volatile("" : "+s"(K));
    int tid = threadIdx.x; asm volatile("" : "+v"(tid));
    const int wid = __builtin_amdgcn_readfirstlane(tid >> 6), lane = tid & 63, wr = wid >> 2, wc = wid & 3, fr = lane & 15, fq = lane >> 4;
    const int nt = K / BK;
    const size_t kstep = (size_t)(BK * 2);
    const size_t hstep = (size_t)HALF * K * 2;
    int stR[2], stC[2];
    unsigned voffB[2], cvo[2][2], nvo[2][2];
#pragma unroll
    for (int i = 0; i < 2; ++i) { int R, C; stage_rc(tid * 16 + i * 8192, R, C); stR[i] = R; stC[i] = C; const int Rb = Epi::PERM ? ((R & ~31) + perm32(R & 31)) : R;
        voffB[i] = (unsigned)(Rb * K + C) * 2u;
        cvo[0][i] = (unsigned)(R * K + C) * 2u; cvo[1][i] = cvo[0][i] + (unsigned)hstep; nvo[0][i] = cvo[0][i]; nvo[1][i] = cvo[1][i]; }
    const unsigned ldsw = (unsigned)wid * 1024u;
    const int aoff = F8 ? lds_byte(wr * 64 + fr, fq * 16) : lds_byte(wr * 64 + fr, fq * 8), boff = F8 ? lds_byte(wc * 32 + fr, fq * 16) : lds_byte(wc * 32 + fr, fq * 8);
#define PG8_SA(b, h) (((b) * 2 + (h)) * HTB)
#define PG8_SB(b, h) ((4 + (b) * 2 + (h)) * HTB)
#define PG8_STAGE(bufoff, gbase, voff) do { _Pragma("unroll") for (int _i = 0; _i < 2; ++_i) \
        __builtin_amdgcn_global_load_lds((const unsigned*)((const char*)(gbase) + (voff)[_i]), (LAS unsigned*)(lds + (bufoff) + ldsw + _i * 8192), 16, 0, 0); } while (0)
#define PG8_LDA(dst, b, h) do { if constexpr (F8) { _Pragma("unroll") for (int m = 0; m < 4; ++m) dst##8[m] = *(const LAS v8i_a16*)(lds + PG8_SA(b, h) + aoff + m * 2048); } \
    else { _Pragma("unroll") for (int m = 0; m < 4; ++m) _Pragma("unroll") for (int k = 0; k < 2; ++k) dst[m][k] = *(const LAS bf16x8*)(lds + PG8_SA(b, h) + aoff + m * 2048 + k * 1024); } } while (0)
#define PG8_LDB(dst, b, h) do { if constexpr (F8) { _Pragma("unroll") for (int n = 0; n < 2; ++n) dst##8[n] = *(const LAS v8i_a16*)(lds + PG8_SB(b, h) + boff + n * 2048); } \
    else { _Pragma("unroll") for (int n = 0; n < 2; ++n) _Pragma("unroll") for (int k = 0; k < 2; ++k) dst[n][k] = *(const LAS bf16x8*)(lds + PG8_SB(b, h) + boff + n * 2048 + k * 1024); } } while (0)
#define PG8_MMA(ai, bj, At, Bt) do { __builtin_amdgcn_s_setprio(1); if constexpr (F8) { _Pragma("unroll") for (int m = 0; m < 4; ++m) _Pragma("unroll") for (int n = 0; n < 2; ++n) { \
            asm volatile("v_mfma_scale_f32_16x16x128_f8f6f4 %0, %1, %2, %0, %3, %3 op_sel_hi:[0,0,0]" : "+v"(acc[ai][bj][m][n]) : "v"(Bt##8[n]), "v"(At##8[m]), "v"(f8one)); } } \
        else { _Pragma("unroll") for (int m = 0; m < 4; ++m) _Pragma("unroll") for (int n = 0; n < 2; ++n) _Pragma("unroll") for (int k = 0; k < 2; ++k) \
        acc[ai][bj][m][n] = __builtin_amdgcn_mfma_f32_16x16x32_bf16(Bt[n][k], At[m][k], acc[ai][bj][m][n], 0, 0, 0); } __builtin_amdgcn_s_setprio(0); } while (0)
#define PG8_WAIT_V(n) asm volatile("s_waitcnt vmcnt(" #n ")" ::: "memory")
#define PG8_WAIT_L(n) asm volatile("s_waitcnt lgkmcnt(" #n ")" ::: "memory")
#define PG8_BAR __builtin_amdgcn_s_barrier()
#define PG8_SCHED __builtin_amdgcn_sched_barrier(0)
    Unit cur, nxt; int ui = 0;
    if (!S.next(0, cur)) return;
    if constexpr (GATHER) {
#pragma unroll
        for (int h = 0; h < 2; ++h)
#pragma unroll
            for (int i = 0; i < 2; ++i) cvo[h][i] = (unsigned)(cur.gidx[h * HALF + stR[i]] * K + stC[i]) * 2u;
    }
    f32x4 acc[2][2][4][2];
#pragma unroll
    for (int a = 0; a < 2; ++a)
#pragma unroll
        for (int b = 0; b < 2; ++b)
#pragma unroll
            for (int m = 0; m < 4; ++m)
#pragma unroll
                for (int n = 0; n < 2; ++n) acc[a][b][m][n] = (f32x4){0.f, 0.f, 0.f, 0.f};
    bf16x8 At[4][2], B0[2][2], B1[2][2]; v8i At8[4], B08[2], B18[2];
    const int f8one = 0x7f7f7f7f;
    const char* cA = cur.a; const char* cB = cur.b;
    PG8_STAGE(PG8_SB(0, 0), cB, voffB); PG8_STAGE(PG8_SB(0, 1), cB + hstep, voffB); PG8_STAGE(PG8_SA(0, 0), cA, cvo[0]); PG8_STAGE(PG8_SA(0, 1), cA, cvo[1]);
    if (wr == 1) PG8_BAR;
    PG8_WAIT_V(2); PG8_BAR;
    PG8_STAGE(PG8_SB(1, 0), cB + kstep, voffB); PG8_STAGE(PG8_SA(1, 0), cA + kstep, cvo[0]); PG8_STAGE(PG8_SB(1, 1), cB + hstep + kstep, voffB);
    PG8_WAIT_V(6); PG8_BAR;
    for (;;) {
        const bool has_next = S.next(ui + 1, nxt);
        const char* nA = has_next ? nxt.a : cA; const char* nB = has_next ? nxt.b : cB;
        if constexpr (GATHER) {
            if (has_next) {
#pragma unroll
                for (int h = 0; h < 2; ++h)
#pragma unroll
                    for (int i = 0; i < 2; ++i) nvo[h][i] = (unsigned)(nxt.gidx[h * HALF + stR[i]] * K + stC[i]) * 2u;
            } else {
#pragma unroll
                for (int h = 0; h < 2; ++h)
#pragma unroll
                    for (int i = 0; i < 2; ++i) nvo[h][i] = cvo[h][i];
            }
        }
        for (int t = 0; t < nt; t += 2) {
            const bool last = (t == nt - 2);
            const char* a1 = cA + (size_t)(t + 1) * kstep;
            const char* a2 = last ? nA : cA + (size_t)(t + 2) * kstep; const char* b2 = last ? nB : cB + (size_t)(t + 2) * kstep;
            const char* a3 = a2 + kstep; const char* b3 = b2 + kstep;
            unsigned v2[2][2];
#pragma unroll
            for (int h = 0; h < 2; ++h)
#pragma unroll
                for (int i = 0; i < 2; ++i) v2[h][i] = (GATHER && last) ? nvo[h][i] : cvo[h][i];
            PG8_LDB(B0, 0, 0); PG8_LDB(B1, 0, 1); PG8_SCHED; PG8_LDA(At, 0, 0); PG8_STAGE(PG8_SA(1, 1), a1, cvo[1]);
            PG8_WAIT_V(8); PG8_WAIT_L(0); PG8_BAR; PG8_MMA(0, 0, At, B0); PG8_MMA(0, 1, At, B1); PG8_BAR; PG8_SCHED;
            PG8_LDA(At, 0, 1); PG8_STAGE(PG8_SB(0, 0), b2, voffB); PG8_STAGE(PG8_SB(0, 1), b2 + hstep, voffB); PG8_STAGE(PG8_SA(0, 0), a2, v2[0]);
            PG8_WAIT_V(8); PG8_WAIT_L(0); PG8_BAR; PG8_MMA(1, 0, At, B0); PG8_MMA(1, 1, At, B1); PG8_BAR; PG8_SCHED;
            PG8_LDB(B0, 1, 0); PG8_LDB(B1, 1, 1); PG8_SCHED; PG8_LDA(At, 1, 0); PG8_STAGE(PG8_SA(0, 1), a2, v2[1]);
            PG8_WAIT_V(8); PG8_WAIT_L(0); PG8_BAR; PG8_MMA(0, 0, At, B0); PG8_MMA(0, 1, At, B1); PG8_BAR; PG8_SCHED;
            PG8_LDA(At, 1, 1); PG8_STAGE(PG8_SB(1, 0), b3, voffB); PG8_STAGE(PG8_SB(1, 1), b3 + hstep, voffB); PG8_STAGE(PG8_SA(1, 0), a3, v2[0]);
            PG8_WAIT_V(8); PG8_WAIT_L(0); PG8_BAR; PG8_MMA(1, 0, At, B0); PG8_MMA(1, 1, At, B1); PG8_BAR; PG8_SCHED;
        }
        if (wr == 0) PG8_BAR;
        if constexpr (F8) asm volatile("s_nop 15\n\ts_nop 15" ::: "memory");
        E(acc, cur, wr, wc, fr, fq);
        if (!has_next) break;
#pragma unroll
        for (int a = 0; a < 2; ++a)
#pragma unroll
            for (int b = 0; b < 2; ++b)
#pragma unroll
                for (int m = 0; m < 4; ++m)
#pragma unroll
                    for (int n = 0; n < 2; ++n) acc[a][b][m][n] = (f32x4){0.f, 0.f, 0.f, 0.f};
        cur = nxt; cA = nA; cB = nB; ++ui;
        if constexpr (GATHER) {
#pragma unroll
            for (int h = 0; h < 2; ++h)
#pragma unroll
                for (int i = 0; i < 2; ++i) cvo[h][i] = nvo[h][i];
        }
        if (wr == 1) PG8_BAR;
    }
    PG8_WAIT_V(0);
    PG8_BAR;
#undef PG8_SA
#undef PG8_SB
#undef PG8_STAGE
#undef PG8_LDA
#undef PG8_LDB
#undef PG8_MMA
#undef PG8_WAIT_V
#undef PG8_WAIT_L
#undef PG8_BAR
#undef PG8_SCHED
}
}
using pg8::Unit;

struct Args { const float* in[36]; float* out; unsigned char* ws; };
struct Frame {
    LAS unsigned char* lds; volatile LAS unsigned* MISC; unsigned* ctl;
    int tid, lane, wave, vcu, G, gw, NGW;
    const float* const* in; float* out; unsigned char* ws;
};
#define WSP(T_, off) ((T_*)(F.ws + (off)))
#define DOP(T_, off) ((T_*)((unsigned char*)F.out + (off)))

struct XArg { const float* W; int ldw, col0; bf16* WT; int ldt, row_off, kdst, kb, nb; float f8scale; };
__device__ __forceinline__ void xpose_load(const XArg& x, int lane, f32x4 (&r)[8]) {
    const float* p = x.W + (size_t)(64 * x.kb + (lane >> 3)) * x.ldw + x.col0 + 32 * x.nb + 4 * (lane & 7);
#pragma unroll
    for (int i = 0; i < 8; ++i) r[i] = *(const f32x4*)(p + (size_t)(8 * i) * x.ldw);
    __builtin_amdgcn_sched_barrier(0);
}
__device__ __forceinline__ void xpose_store(const XArg& x, int lane, const f32x4 (&r)[8], LAS float* scr) {
    const int k0 = 64 * x.kb, n0 = 32 * x.nb;
#pragma unroll
    for (int i = 0; i < 8; ++i) { LAS float* d = scr + (8 * i + (lane >> 3)) * 33 + 4 * (lane & 7); d[0] = r[i].x; d[1] = r[i].y; d[2] = r[i].z; d[3] = r[i].w; }
    asm volatile("s_waitcnt lgkmcnt(0)" ::: "memory");
    const int c = lane & 7; const float f8scale = x.f8scale; bf16* WT = x.WT;
#pragma unroll
    for (int j = 0; j < 4; ++j) { const int n = (lane >> 3) + 8 * j; const LAS float* s = scr + (8 * c) * 33 + n;
        if (f8scale != 0.f) *(v2u*)((unsigned char*)WT + (size_t)(x.row_off + n0 + n) * x.ldt + x.kdst + k0 + 8 * c) = (v2u){pk4_fp8(s[0 * 33] * f8scale, s[1 * 33] * f8scale, s[2 * 33] * f8scale, s[3 * 33] * f8scale), pk4_fp8(s[4 * 33] * f8scale, s[5 * 33] * f8scale, s[6 * 33] * f8scale, s[7 * 33] * f8scale)};
        else { v4u o; o.x = cvt_pk_bf16(s[0 * 33], s[1 * 33]); o.y = cvt_pk_bf16(s[2 * 33], s[3 * 33]); o.z = cvt_pk_bf16(s[4 * 33], s[5 * 33]); o.w = cvt_pk_bf16(s[6 * 33], s[7 * 33]);
            *(v4u*)(WT + (size_t)(x.row_off + n0 + n) * x.ldt + x.kdst + k0 + 8 * c) = o; } }
    asm volatile("s_waitcnt lgkmcnt(0)" ::: "memory");
}
template <class GetArg>
__device__ __forceinline__ void xpose_pipe(Frame& F, int nit, GetArg getarg) {
    LAS float* scr = (LAS float*)(F.lds + F.wave * 16384);
    const int lane = F.lane, step = F.NGW; int it = F.gw;
    if (it >= nit) return;
    f32x4 A[8], B[8];
    XArg aA = getarg(it), aB = getarg(it + step < nit ? it + step : it);
    xpose_load(aA, lane, A); xpose_load(aB, lane, B);
#define XP_DO(S_, a_) { if (it < nit) { f32x4 c_[8]; _Pragma("unroll") for (int i = 0; i < 8; ++i) c_[i] = S_[i]; const XArg ca_ = a_; const int itn_ = it + 2 * step; \
        a_ = getarg(itn_ < nit ? itn_ : it); xpose_load(a_, lane, S_); xpose_store(ca_, lane, c_, scr); it += step; } }
    while (it < nit) { XP_DO(A, aA); XP_DO(B, aB); }
#undef XP_DO
}
__device__ __forceinline__ void xpose_job(Frame& F, const float* W, int ldw, int col0, int K, int N, bf16* WT, int ldt, int row_off, int kdst) {
    const int nblk = N / 32, nit = (K / 64) * nblk;
    xpose_pipe(F, nit, [&](int it) { return XArg{W, ldw, col0, WT, ldt, row_off, kdst, it / nblk, it % nblk, 0.f}; });
}
__device__ __forceinline__ void rms_row_to_bf16(const float* xrow, const float* g, bf16* orow, int lane, unsigned* o8row = nullptr) {
    const f32x4* xr = (const f32x4*)xrow + lane; const f32x4* gr = (const f32x4*)g + lane;
    f32x4 v[4]; float s = 0.f;
#pragma unroll
    for (int j = 0; j < 4; ++j) { v[j] = xr[64 * j]; s += (v[j].x * v[j].x + v[j].y * v[j].y) + (v[j].z * v[j].z + v[j].w * v[j].w); }
    const float rstd = rsqrtf(wave_sum(s) * (1.f / 1024.f) + 1e-6f);
    v2u* o8 = (v2u*)orow + lane;
#pragma unroll
    for (int j = 0; j < 4; ++j) { const f32x4 gg = gr[64 * j]; v2u o; o.x = cvt_pk_bf16(v[j].x * rstd * gg.x, v[j].y * rstd * gg.y); o.y = cvt_pk_bf16(v[j].z * rstd * gg.z, v[j].w * rstd * gg.w); o8[64 * j] = o;
        if (o8row) o8row[64 * j + lane] = pk4_fp8(v[j].x * rstd * gg.x, v[j].y * rstd * gg.y, v[j].z * rstd * gg.z, v[j].w * rstd * gg.w); }
}

__device__ __forceinline__ void p0_prologue(Frame& F) {
    const float* w_in = F.in[3];
    bf16* WinT = WSP(bf16, WS_WIN);
    {
        struct Job { const float* W; int ldw, col0; void* WT; int ldt, row_off, kdst, nblk, nit; float f8; };
        const Job jobs[13] = {
            {w_in, 4804, 0, WinT, 1024, 0, 0, 56, 16 * 56, 0.f},
            {w_in, 4804, 2304, WinT, 1024, 2816, 0, 4, 16 * 4, 0.f},
            {w_in, 4804, 2688, WinT, 1024, 2816 + 128, 0, 2, 16 * 2, 0.f},
            {w_in, 4804, 2432, WinT, 1024, 2816 + 256, 0, 8, 16 * 8, 0.f},
            {w_in, 4804, 2756, F.ws + WS_WG8, 1024, 0, 0, 64, 16 * 64, 16.f},
            {F.in[18], 1024, 0, F.ws + WS_WA, 512, 0, 0, 32, 8 * 32, 0.f},
            {F.in[21], 1024, 0, F.ws + WS_WOUT, 1024, 0, 0, 32, 16 * 32, 0.f},
            {F.in[24], 1024, 0, F.ws + WS_WCQ, 1024, 0, 0, 32, 16 * 32, 16.f},
            {F.in[25], 2048, 0, F.ws + WS_WCKV, 1024, 0, 0, 64, 16 * 64, 0.f},
            {F.in[26], 1024, 0, F.ws + WS_WCO, 1024, 0, 0, 32, 16 * 32, 16.f},
            {F.in[6], 512, 0, F.ws + WS_BLORA, 256, 0, 0, 16, 1 * 16, 0.f},
            {F.in[8], 512, 0, F.ws + WS_BLORA, 256, 512, 64, 16, 1 * 16, 0.f},
            {F.in[9], 512, 0, F.ws + WS_BLORA, 256, 1024, 128, 16, 2 * 16, 0.f}};
        constexpr int NGU = 32 * 2 * 16 * 16, NDN = 32 * 8 * 32;
        int nsmall = 0;
#pragma unroll
        for (int j = 0; j < 13; ++j) nsmall += jobs[j].nit;
        xpose_pipe(F, NGU + NDN + nsmall, [&](int it) {
            if (it < NGU) {
                const int nb = it & 15, kb = (it >> 4) & 15, which = (it >> 8) & 1, e = it >> 9;
                const float* W = (which ? F.in[33] : F.in[32]) + (size_t)e * 1024 * 512;
                const int n0 = 32 * nb, drow = 256 * (n0 >> 7) + (n0 & 127) + 128 * which;
                return XArg{W, 512, 0, (bf16*)(F.ws + WS_WGU + (size_t)e * 1024 * 1024), 1024, drow - n0, 0, kb, nb, 16.f}; }
            it -= NGU;
            if (it < NDN) {
                const int nb = it & 31, kb = (it >> 5) & 7, e = it >> 8;
                return XArg{F.in[34] + (size_t)e * 512 * 1024, 1024, 0, (bf16*)(F.ws + WS_WD + (size_t)e * 1024 * 512), 512, 0, 0, kb, nb, 16.f}; }
            it -= NDN;
            XArg r = XArg{jobs[12].W, jobs[12].ldw, jobs[12].col0, (bf16*)jobs[12].WT, jobs[12].ldt, jobs[12].row_off, jobs[12].kdst, 0, 0, jobs[12].f8}; int nblk = jobs[12].nblk, loc = it;
            int acc = 0; bool found = false;
#pragma unroll
            for (int j = 0; j < 13; ++j) { const bool here = !found && it < acc + jobs[j].nit;
                if (here) { r = XArg{jobs[j].W, jobs[j].ldw, jobs[j].col0, (bf16*)jobs[j].WT, jobs[j].ldt, jobs[j].row_off, jobs[j].kdst, 0, 0, jobs[j].f8}; nblk = jobs[j].nblk; loc = it - acc; found = true; }
                acc += jobs[j].nit; }
            r.kb = loc / nblk; r.nb = loc % nblk; return r; });
    }
    const int gt = F.vcu * NTHREADS + F.tid, NGT = F.G * NTHREADS;
    for (int i = gt; i < 64 * 1024; i += NGT) { const int n = i >> 10, k = i & 1023; WinT[(size_t)(2816 + 192 + n) * 1024 + k] = (n < 4) ? (bf16)(cvt_pk_bf16(w_in[(size_t)k * 4804 + 2752 + n], 0.f) & 0xffff) : (bf16)0; }
    { bf16* BL = WSP(bf16, WS_BLORA);
      for (int i = gt; i < 1536 * 256; i += NGT) { const int n = i >> 8, k = i & 255; const int seg = n >> 9; const bool diag = (seg == 0) ? (k < 64) : (seg == 1) ? (k >= 64 && k < 128) : (k >= 128); if (!diag) BL[i] = 0; } }
    { bf16* WR = WSP(bf16, WS_WR);
      for (int i = gt; i < 256 * 1024; i += NGT) { const int n = i >> 10, k = i & 1023; float v = 0.f; if (n < 4) v = F.in[28][k * 4 + n]; else if (n < 36) v = F.in[30][k * 32 + (n - 4)]; WR[i] = (bf16)(cvt_pk_bf16(v, 0.f) & 0xffff); } }
    for (int task = F.vcu; task < 256; task += F.G) {
        const bool isq = task < 128; const int h = (task >> 4) & 7, chunk = task & 15;
        LAS float* sw = (LAS float*)F.lds;
        const float* src = isq ? F.in[16] : F.in[17]; const float* wpb = F.in[19]; bf16* WbT = WSP(bf16, WS_WB);
        __syncthreads();
        for (int i = F.tid; i < 128 * 16; i += NTHREADS) { const int r = i >> 4, q = i & 15; *(LAS f32x4*)(sw + r * 64 + q * 4) = *(const f32x4*)(src + (size_t)r * 512 + h * 64 + q * 4); }
        __syncthreads();
        const int idx = chunk * 64 + F.lane;
        float a[64];
        if (isq) {
#pragma unroll
            for (int q = 0; q < 16; ++q) { const f32x4 t4 = *(const f32x4*)(w_in + (size_t)idx * 4804 + 1792 + h * 64 + 4 * q); a[4 * q] = t4[0]; a[4 * q + 1] = t4[1]; a[4 * q + 2] = t4[2]; a[4 * q + 3] = t4[3]; }
        } else {
            const float* p = wpb + (size_t)(h * 64) * 1024 + idx;
#pragma unroll
            for (int g4 = 0; g4 < 8; ++g4) {
#pragma unroll
                for (int d = 0; d < 8; ++d) a[8 * g4 + d] = p[(size_t)(8 * g4 + d) * 1024];
                __builtin_amdgcn_sched_barrier(0); }
        }
#pragma unroll 1
        for (int r0 = F.wave * 16; r0 < F.wave * 16 + 16; r0 += 2) { float o[2];
#pragma unroll
            for (int rr = 0; rr < 2; ++rr) { const LAS f32x4* b4 = (const LAS f32x4*)(sw + (r0 + rr) * 64); float s0 = 0.f, s1 = 0.f;
#pragma unroll
                for (int q = 0; q < 16; q += 2) { const f32x4 b0 = b4[q], b1 = b4[q + 1];
                    s0 += a[4 * q] * b0[0] + a[4 * q + 1] * b0[1] + a[4 * q + 2] * b0[2] + a[4 * q + 3] * b0[3]; s1 += a[4 * q + 4] * b1[0] + a[4 * q + 5] * b1[1] + a[4 * q + 6] * b1[2] + a[4 * q + 7] * b1[3]; }
                o[rr] = s0 + s1; __builtin_amdgcn_sched_barrier(0); }
            if (isq) {
#pragma unroll
                for (int rr = 0; rr < 2; ++rr) (F.ws + WS_WQ8)[(size_t)(h * 128 + r0 + rr) * 1024 + idx] = (unsigned char)(pk4_fp8(o[rr] * (0.125f * 256.f), 0.f, 0.f, 0.f) & 0xffu);
            } else *(unsigned*)(WbT + (size_t)idx * 1024 + h * 128 + r0) = cvt_pk_bf16(o[0], o[1]);
        }
    }
    __syncthreads();
    {
        const int lane = F.lane, step = F.NGW; const float* x = F.in[0]; bf16* xn = DOP(bf16, DO_XN);
        f32x4 gg[4], v0[4], v1[4];
#pragma unroll
        for (int j = 0; j < 4; ++j) gg[j] = *((const f32x4*)F.in[2] + lane + 64 * j);
        int m = F.gw;
#define XN_LD(v_, m_) { const int mm_ = (m_) < T ? (m_) : F.gw; _Pragma("unroll") for (int j = 0; j < 4; ++j) v_[j] = *((const f32x4*)(x + (size_t)mm_ * D) + lane + 64 * j); __builtin_amdgcn_sched_barrier(0); }
#define XN_DO(v_) { if (m < T) { f32x4 c_[4]; _Pragma("unroll") for (int j = 0; j < 4; ++j) c_[j] = v_[j]; XN_LD(v_, m + 2 * step); float s = 0.f; \
            _Pragma("unroll") for (int j = 0; j < 4; ++j) s += (c_[j].x * c_[j].x + c_[j].y * c_[j].y) + (c_[j].z * c_[j].z + c_[j].w * c_[j].w); \
            const float rstd = rsqrtf(wave_sum(s) * (1.f / 1024.f) + 1e-6f); v2u* o8 = (v2u*)(xn + (size_t)m * D) + lane; \
            unsigned* q8 = (unsigned*)(F.ws + WS_XN8 + (size_t)m * D) + lane; \
            _Pragma("unroll") for (int j = 0; j < 4; ++j) { const float y0 = c_[j].x * rstd * gg[j].x, y1 = c_[j].y * rstd * gg[j].y, y2 = c_[j].z * rstd * gg[j].z, y3 = c_[j].w * rstd * gg[j].w; \
                v2u o; o.x = cvt_pk_bf16(y0, y1); o.y = cvt_pk_bf16(y2, y3); o8[64 * j] = o; q8[64 * j] = pk4_fp8(y0, y1, y2, y3); } \
            m += step; } }
        if (m < T) {
            XN_LD(v0, m); XN_LD(v1, m + step);
            while (m < T) { XN_DO(v0); XN_DO(v1); }
        }
#undef XN_LD
#undef XN_DO
    }
    for (int m = F.gw; m < NB * 256; m += F.NGW) rms_row_to_bf16(F.in[1] + (size_t)m * D, F.in[23], WSP(bf16, WS_MEMN) + (size_t)m * D, F.lane);
}

#define EPI_LOOP_PERM(...) \
    _Pragma("unroll") for (int ai = 0; ai < 2; ++ai) _Pragma("unroll") for (int m = 0; m < 4; ++m) { const int row = u.pm * 256 + ai * 128 + wr * 64 + m * 16 + fr; \
        _Pragma("unroll") for (int bj = 0; bj < 2; ++bj) { const int ct = bj * 128 + wc * 32 + 8 * fq;   f32x4 v0 = acc[ai][bj][m][0], v1 = acc[ai][bj][m][1]; __VA_ARGS__ } }
#define PACK8(v0, v1) ((v4u){cvt_pk_bf16((v0)[0], (v0)[1]), cvt_pk_bf16((v0)[2], (v0)[3]), cvt_pk_bf16((v1)[0], (v1)[1]), cvt_pk_bf16((v1)[2], (v1)[3])})

struct EpiMain {
    static constexpr bool PERM = true;
    bf16 *Zrkv, *Zlora, *QLAT, *Zd, *G; const float* b_gate; int pn_off = 0;
    __device__ __forceinline__ void operator()(const f32x4 (&acc)[2][2][4][2], const Unit& u, int wr, int wc, int fr, int fq) const {
        const int pn = u.pn + pn_off; bf16* base; int ldc, c0; bool act = false;
        if (pn < 6) { base = Zrkv; ldc = 1536; c0 = pn * 256; }
        else if (pn == 6) { base = Zlora; ldc = 256; c0 = 0; }
        else if (pn < 11) { base = QLAT; ldc = 1024; c0 = (pn - 7) * 256; }
        else if (pn < 13) { base = Zd; ldc = 512; c0 = (pn - 11) * 256; }
        else { base = G; ldc = 2048; c0 = (pn - 13) * 256; act = true; }
        if (act) {
            f32x4 bg[2][2];
#pragma unroll
            for (int bj = 0; bj < 2; ++bj) { const int ct = bj * 128 + wc * 32 + 8 * fq; bg[bj][0] = *(const f32x4*)(b_gate + c0 + ct); bg[bj][1] = *(const f32x4*)(b_gate + c0 + ct + 4); }
            EPI_LOOP_PERM(
_Pragma("unroll")
                for (int e = 0; e < 4; ++e) { v0[e] = fsigmoid(v0[e] + bg[bj][0][e]); v1[e] = fsigmoid(v1[e] + bg[bj][1][e]); }
                *(v4u*)(base + (size_t)row * ldc + c0 + ct) = PACK8(v0, v1);
            )
        } else {
            EPI_LOOP_PERM(
                *(v4u*)(base + (size_t)row * ldc + c0 + ct) = PACK8(v0, v1);
            )
        }
    }
};
struct EpiGate8 {
    static constexpr bool PERM = true;
    bf16* G; const float* b_gate;
    __device__ __forceinline__ void operator()(const f32x4 (&acc)[2][2][4][2], const Unit& u, int wr, int wc, int fr, int fq) const {
        const int c0 = u.pn * 256;
        f32x4 bg[2][2];
#pragma unroll
        for (int bj = 0; bj < 2; ++bj) { const int ct = bj * 128 + wc * 32 + 8 * fq; bg[bj][0] = *(const f32x4*)(b_gate + c0 + ct); bg[bj][1] = *(const f32x4*)(b_gate + c0 + ct + 4); }
        EPI_LOOP_PERM(
_Pragma("unroll")
            for (int e = 0; e < 4; ++e) { v0[e] = fsigmoid(0.0625f * v0[e] + bg[bj][0][e]); v1[e] = fsigmoid(0.0625f * v1[e] + bg[bj][1][e]); }
            *(v4u*)(G + (size_t)row * 2048 + c0 + ct) = PACK8(v0, v1);
        )
    }
};
struct EpiBf16 {
    static constexpr bool PERM = true;
    bf16* O; int ldc; int colmul; size_t pn_stride; float scale;
    __device__ __forceinline__ void operator()(const f32x4 (&acc)[2][2][4][2], const Unit& u, int wr, int wc, int fr, int fq) const {
        bf16* base = O + (size_t)u.pn * pn_stride + (size_t)u.pn * 256 * colmul;
        EPI_LOOP_PERM( v0 = v0 * scale; v1 = v1 * scale; *(v4u*)(base + (size_t)row * ldc + ct) = PACK8(v0, v1); )
    }
};
struct EpiLora {
    static constexpr bool PERM = true;
    bf16* WAG; const float* w0; const float* a0;
    __device__ __forceinline__ void operator()(const f32x4 (&acc)[2][2][4][2], const Unit& u, int wr, int wc, int fr, int fq) const {
        const int seg = u.pn >> 1; const int cc0 = (u.pn & 1) * 256; const float* bias = seg == 0 ? w0 : a0;
        if (seg < 2) {
            const float mul = seg == 0 ? 0.6065306597126334f : 1.0f;
            f32x4 bg[2][2];
#pragma unroll
            for (int bj = 0; bj < 2; ++bj) { const int ct = bj * 128 + wc * 32 + 8 * fq; bg[bj][0] = *(const f32x4*)(bias + cc0 + ct); bg[bj][1] = *(const f32x4*)(bias + cc0 + ct + 4); }
            EPI_LOOP_PERM(
_Pragma("unroll")
                for (int e = 0; e < 4; ++e) { v0[e] = mul * fsigmoid(v0[e] + bg[bj][0][e]); v1[e] = mul * fsigmoid(v1[e] + bg[bj][1][e]); }
                *(v4u*)(WAG + (size_t)row * 1536 + u.pn * 256 + ct) = PACK8(v0, v1);
            )
        } else {
            EPI_LOOP_PERM(
                *(v4u*)(WAG + (size_t)row * 1536 + u.pn * 256 + ct) = PACK8(v0, v1);
            )
        }
    }
};
struct EpiMix {
    static constexpr bool PERM = true;
    bf16* U; const bf16* G; int second;
    __device__ __forceinline__ void operator()(const f32x4 (&acc)[2][2][4][2], const Unit& u, int wr, int wc, int fr, int fq) const {
#pragma unroll
        for (int ai = 0; ai < 2; ++ai) {
            v4u gw[4][2], ow[4][2];
#pragma unroll
            for (int m = 0; m < 4; ++m)
#pragma unroll
                for (int bj = 0; bj < 2; ++bj) { const int row = u.pm * 256 + ai * 128 + wr * 64 + m * 16 + fr, col = u.pn * 256 + bj * 128 + wc * 32 + 8 * fq;
                    gw[m][bj] = *(const v4u*)(G + (size_t)row * 2048 + second * 1024 + col);
                    ow[m][bj] = second ? *(const v4u*)(U + (size_t)row * 1024 + col) : (v4u){0, 0, 0, 0}; }
#pragma unroll
            for (int m = 0; m < 4; ++m)
#pragma unroll
                for (int bj = 0; bj < 2; ++bj) { const int row = u.pm * 256 + ai * 128 + wr * 64 + m * 16 + fr, col = u.pn * 256 + bj * 128 + wc * 32 + 8 * fq;
                    f32x4 v0 = acc[ai][bj][m][0], v1 = acc[ai][bj][m][1]; const v4u g4 = gw[m][bj], o = ow[m][bj];
                    v0[0] = v0[0] * bflo(g4.x) + bflo(o.x); v0[1] = v0[1] * bfhi(g4.x) + bfhi(o.x); v0[2] = v0[2] * bflo(g4.y) + bflo(o.y); v0[3] = v0[3] * bfhi(g4.y) + bfhi(o.y);
                    v1[0] = v1[0] * bflo(g4.z) + bflo(o.z); v1[1] = v1[1] * bfhi(g4.z) + bfhi(o.z); v1[2] = v1[2] * bflo(g4.w) + bflo(o.w); v1[3] = v1[3] * bfhi(g4.w) + bfhi(o.w);
                    *(v4u*)(U + (size_t)row * 1024 + col) = PACK8(v0, v1); }
        }
    }
};
struct EpiRes {
    static constexpr bool PERM = false;
    const float* res; float* out;
    __device__ __forceinline__ void operator()(const f32x4 (&acc)[2][2][4][2], const Unit& u, int wr, int wc, int fr, int fq) const {
#pragma unroll
        for (int ai = 0; ai < 2; ++ai) {
            f32x4 r[4][2][2];
#pragma unroll
            for (int m = 0; m < 4; ++m)
#pragma unroll
                for (int bj = 0; bj < 2; ++bj)
#pragma unroll
                    for (int n = 0; n < 2; ++n) { const int row = u.pm * 256 + ai * 128 + wr * 64 + m * 16 + fr, col = u.pn * 256 + bj * 128 + wc * 32 + 16 * n + 4 * fq; r[m][bj][n] = *(const f32x4*)(res + (size_t)row * 1024 + col); }
#pragma unroll
            for (int m = 0; m < 4; ++m)
#pragma unroll
                for (int bj = 0; bj < 2; ++bj)
#pragma unroll
                    for (int n = 0; n < 2; ++n) { const int row = u.pm * 256 + ai * 128 + wr * 64 + m * 16 + fr, col = u.pn * 256 + bj * 128 + wc * 32 + 16 * n + 4 * fq; *(f32x4*)(out + (size_t)row * 1024 + col) = r[m][bj][n] + acc[ai][bj][m][n]; }
        }
    }
};
struct EpiResB {
    static constexpr bool PERM = true;
    const float* res32; const bf16* res16; bf16* out; float ascale = 1.f;
    __device__ __forceinline__ void operator()(const f32x4 (&acc)[2][2][4][2], const Unit& u, int wr, int wc, int fr, int fq) const {
#pragma unroll
        for (int ai = 0; ai < 2; ++ai) {
            f32x4 r[4][2][2];
#pragma unroll
            for (int m = 0; m < 4; ++m)
#pragma unroll
                for (int bj = 0; bj < 2; ++bj) { const int row = u.pm * 256 + ai * 128 + wr * 64 + m * 16 + fr, col = u.pn * 256 + bj * 128 + wc * 32 + 8 * fq; const size_t o = (size_t)row * 1024 + col;
                    if (res32) { r[m][bj][0] = *(const f32x4*)(res32 + o); r[m][bj][1] = *(const f32x4*)(res32 + o + 4); }
                    else { const v4u w = *(const v4u*)(res16 + o); r[m][bj][0] = (f32x4){bflo(w.x), bfhi(w.x), bflo(w.y), bfhi(w.y)}; r[m][bj][1] = (f32x4){bflo(w.z), bfhi(w.z), bflo(w.w), bfhi(w.w)}; } }
#pragma unroll
            for (int m = 0; m < 4; ++m)
#pragma unroll
                for (int bj = 0; bj < 2; ++bj) { const int row = u.pm * 256 + ai * 128 + wr * 64 + m * 16 + fr, col = u.pn * 256 + bj * 128 + wc * 32 + 8 * fq;
                    const f32x4 v0 = r[m][bj][0] + acc[ai][bj][m][0] * ascale, v1 = r[m][bj][1] + acc[ai][bj][m][1] * ascale;
                    *(v4u*)(out + (size_t)row * 1024 + col) = PACK8(v0, v1); }
        }
    }
};
struct EpiLogit {
    static constexpr bool PERM = false;
    float* L;
    __device__ __forceinline__ void operator()(const f32x4 (&acc)[2][2][4][2], const Unit& u, int wr, int wc, int fr, int fq) const {
        if (wc >= 2) return;
#pragma unroll
        for (int ai = 0; ai < 2; ++ai)
#pragma unroll
            for (int m = 0; m < 4; ++m) { const int row = u.pm * 256 + ai * 128 + wr * 64 + m * 16 + fr;
#pragma unroll
                for (int n = 0; n < 2; ++n) { const int col = wc * 32 + 16 * n + 4 * fq; *(f32x4*)(L + (size_t)row * 64 + col) = acc[ai][0][m][n]; } }
    }
};
struct EpiMoe1 {
    static constexpr bool PERM = true;
    unsigned char* HID;
    __device__ __forceinline__ void operator()(const f32x4 (&acc)[2][2][4][2], const Unit& u, int wr, int wc, int fr, int fq) const {
#pragma unroll
        for (int ai = 0; ai < 2; ++ai)
#pragma unroll
            for (int m = 0; m < 4; ++m) { const int row = u.pm * 256 + ai * 128 + wr * 64 + m * 16 + fr; f32x4 h0, h1;
#pragma unroll
                for (int e = 0; e < 4; ++e) { const float g0 = 0.0625f * acc[ai][0][m][0][e], g1 = 0.0625f * acc[ai][0][m][1][e]; h0[e] = g0 * fsigmoid(g0) * (0.0625f * acc[ai][1][m][0][e]); h1[e] = g1 * fsigmoid(g1) * (0.0625f * acc[ai][1][m][1][e]); }
                *(v2u*)(HID + (size_t)row * 512 + u.pn * 128 + wc * 32 + 8 * fq) = (v2u){pk4_fp8(h0[0], h0[1], h0[2], h0[3]), pk4_fp8(h1[0], h1[1], h1[2], h1[3])}; }
    }
};
struct EpiMoe2 {
    static constexpr bool PERM = true;
    bf16* YS; const float* sgate;
    __device__ __forceinline__ void operator()(const f32x4 (&acc)[2][2][4][2], const Unit& u, int wr, int wc, int fr, int fq) const {
        float gts[2][4];
#pragma unroll
        for (int ai = 0; ai < 2; ++ai)
#pragma unroll
            for (int m = 0; m < 4; ++m) gts[ai][m] = sgate[u.pm * 256 + ai * 128 + wr * 64 + m * 16 + fr];
        EPI_LOOP_PERM( const float gt = 0.0625f * gts[ai][m]; v0 = v0 * gt; v1 = v1 * gt; *(v4u*)(YS + (size_t)row * 1024 + u.pn * 256 + ct) = PACK8(v0, v1); )
    }
};
struct MoeOrder {
    const char* A; const char* Bt; size_t bstride  ; int K; int NPN; const int* stok; volatile LAS int* tstart; int G, c; bool gather;
    __device__ bool next(int i, Unit& u) const {
        const int ntile = tstart[32]; const long L = (long)i * G + c; if (L >= (long)ntile * NPN) return false;
        const int tile = (int)(L / NPN); u.pn = (int)(L % NPN); u.pm = tile;
        int e = 0;
#pragma unroll 1
        for (int j = 1; j < 32; ++j) e += (tstart[j] <= tile) ? 1 : 0;
        u.b = Bt + (size_t)e * bstride + (size_t)u.pn * 256 * K * 2;
        if (gather) { u.a = A; u.gidx = stok + (size_t)tile * 256; } else { u.a = A + (size_t)tile * 256 * K * 2; u.gidx = nullptr; }
        return true;
    }
};

__device__ __forceinline__ void p2_lora_prep(Frame& F) {
    const bf16* Zlora = WSP(bf16, WS_ZLORA); const bf16* Zd = WSP(bf16, WS_ZD); bf16* AL = DOP(bf16, DO_ALORA); bf16* CKV = WSP(bf16, WS_CKV);
    const float* mu = F.in[4] + 1536; const float* kvn = F.in[15];
    const int c = 4 * F.lane;
    const f32x4 m4 = *(const f32x4*)(mu + c);
    const f32x2 kn = *(const f32x2*)(kvn + 2 * F.lane);
    constexpr int NB4 = 4;
    for (int t0 = F.gw; t0 < T; t0 += NB4 * F.NGW) {
        v2u z[NB4], zp[NB4]; unsigned cw[NB4];
#pragma unroll
        for (int u = 0; u < NB4; ++u) { const int t1 = t0 + u * F.NGW, t = t1 < T ? t1 : t0;
            z[u] = *(const v2u*)(Zlora + (size_t)t * 256 + c);
            const int tp = (t & (SEQ - 1)) != 0 ? t - 1 : t;
            zp[u] = *(const v2u*)(Zlora + (size_t)tp * 256 + c);
            cw[u] = *(const unsigned*)(Zd + (size_t)t * 512 + 2 * F.lane); }
#pragma unroll
        for (int u = 0; u < NB4; ++u) { const int t = t0 + u * F.NGW;
            if (t < T) {
                if ((t & (SEQ - 1)) == 0) zp[u] = (v2u){0u, 0u};
                float v[4] = {bflo(z[u].x), bfhi(z[u].x), bflo(z[u].y), bfhi(z[u].y)}; const float p[4] = {bflo(zp[u].x), bfhi(zp[u].x), bflo(zp[u].y), bfhi(zp[u].y)};
#pragma unroll
                for (int e = 0; e < 4; ++e) { float s = v[e] + (p[e] - v[e]) * m4[e];
                    if (c < 64) { const float ex = __expf(2.f * s); s = 1.f - 2.f * __builtin_amdgcn_rcpf(ex + 1.f); }
                    else if (c >= 128) s = fsigmoid(s);
                    v[e] = s; }
                *(v2u*)(AL + (size_t)t * 256 + c) = (v2u){cvt_pk_bf16(v[0], v[1]), cvt_pk_bf16(v[2], v[3])};
                const float c0 = bflo(cw[u]), c1 = bfhi(cw[u]);
                const float rstd = rsqrtf(wave_sum(c0 * c0 + c1 * c1) * (1.f / 128.f) + 1e-6f);
                *(unsigned*)(CKV + (size_t)t * 128 + 2 * F.lane) = cvt_pk_bf16(c0 * rstd * kn.x, c1 * rstd * kn.y);
            }
        }
    }
}

struct ScanRows { v4u zr, zk, zv, pr, pk, pv, ew4, a4, g4; };
__device__ __forceinline__ void scan_load_rows(ScanRows& L, const bf16* Zrkv, const bf16* WAG, size_t tok, int pos, int j0) {
    L.zr = *(const v4u*)(Zrkv + tok * 1536 + j0); L.zk = *(const v4u*)(Zrkv + tok * 1536 + 512 + j0); L.zv = *(const v4u*)(Zrkv + tok * 1536 + 1024 + j0);
    L.pr = (v4u){0, 0, 0, 0}; L.pk = L.pr; L.pv = L.pr;
    if (pos != 0) { L.pr = *(const v4u*)(Zrkv + (tok - 1) * 1536 + j0); L.pk = *(const v4u*)(Zrkv + (tok - 1) * 1536 + 512 + j0); L.pv = *(const v4u*)(Zrkv + (tok - 1) * 1536 + 1024 + j0); }
    L.ew4 = *(const v4u*)(WAG + tok * 1536 + j0); L.a4 = *(const v4u*)(WAG + tok * 1536 + 512 + j0); L.g4 = *(const v4u*)(WAG + tok * 1536 + 1024 + j0);
}
__device__ __forceinline__ void p4_scan(Frame& F) {
    const int bh = F.vcu >> 1, half = F.vcu & 1, b = bh >> 3, h = bh & 7;
    const bf16* Zrkv = WSP(bf16, WS_ZRKV); const bf16* WAG = DOP(bf16, DO_WAG); bf16* YA = WSP(bf16, WS_YA); bf16* YC = WSP(bf16, WS_YC);
    LAS float* sR = (LAS float*)F.lds; LAS float* sDEC = sR + 4096; LAS float* sKK = sR + 8192; LAS float* sBB = sR + 12288; LAS float* sKP = sR + 16384; LAS float* sV = sR + 20480; LAS float* sY = sR + 24576; LAS float* sBR = sR + 28672;
    const int tt = F.tid >> 3, jg = F.tid & 7, j0 = h * 64 + jg * 8;
    const int il = F.lane >> 3, irow = half * 32 + (F.wave & 3) * 8 + il;
    float mu_r[8], mu_k[8], mu_v[8], kkw[8], kaw[8], rkw[8], lnw[8], lnb[8];
#pragma unroll
    for (int e = 0; e < 8; ++e) { mu_r[e] = F.in[4][j0 + e]; mu_k[e] = F.in[4][512 + j0 + e]; mu_v[e] = F.in[4][1024 + j0 + e]; kkw[e] = F.in[10][j0 + e]; kaw[e] = F.in[11][j0 + e]; rkw[e] = F.in[12][j0 + e]; lnw[e] = F.in[13][j0 + e]; lnb[e] = F.in[14][j0 + e]; }
    float S[8];
#pragma unroll
    for (int e = 0; e < 8; ++e) S[e] = 0.f;
    ScanRows L; scan_load_rows(L, Zrkv, WAG, (size_t)b * SEQ + tt, tt, j0);
    for (int tile = 0; tile < SEQ / 64; ++tile) {
        const int pos = tile * 64 + tt; const size_t tok = (size_t)b * SEQ + pos;
        const v4u g4 = L.g4;
        {
            float r[8], k[8], v[8], a[8], ew[8], kk[8];
#pragma unroll
            for (int q = 0; q < 4; ++q) {
                const float zr0 = bflo(L.zr[q]), zr1 = bfhi(L.zr[q]), zk0 = bflo(L.zk[q]), zk1 = bfhi(L.zk[q]), zv0 = bflo(L.zv[q]), zv1 = bfhi(L.zv[q]);
                r[2 * q] = zr0 + (bflo(L.pr[q]) - zr0) * mu_r[2 * q]; r[2 * q + 1] = zr1 + (bfhi(L.pr[q]) - zr1) * mu_r[2 * q + 1];
                k[2 * q] = zk0 + (bflo(L.pk[q]) - zk0) * mu_k[2 * q]; k[2 * q + 1] = zk1 + (bfhi(L.pk[q]) - zk1) * mu_k[2 * q + 1];
                v[2 * q] = zv0 + (bflo(L.pv[q]) - zv0) * mu_v[2 * q]; v[2 * q + 1] = zv1 + (bfhi(L.pv[q]) - zv1) * mu_v[2 * q + 1];
                a[2 * q] = bflo(L.a4[q]); a[2 * q + 1] = bfhi(L.a4[q]); ew[2 * q] = bflo(L.ew4[q]); ew[2 * q + 1] = bfhi(L.ew4[q]);
            }
            float ss = 0.f;
#pragma unroll
            for (int e = 0; e < 8; ++e) { kk[e] = k[e] * kkw[e]; ss += kk[e] * kk[e]; }
            ss = sum8(ss);
            const float inv = 1.0f / fmaxf(sqrtf(ss), 1e-12f);
            float br = 0.f;
#pragma unroll
            for (int e = 0; e < 8; ++e) { kk[e] *= inv; br += kk[e] * a[e] * r[e]; }
            br = sum8(br);
            f32x4 o0, o1;
#define ST8(dst, expr) { _Pragma("unroll") for (int e = 0; e < 4; ++e) { { const int E = e; o0[e] = (expr); } { const int E = e + 4; o1[e] = (expr); } } *(LAS f32x4*)(dst + tt * 64 + jg * 8) = o0; *(LAS f32x4*)(dst + tt * 64 + jg * 8 + 4) = o1; }
            ST8(sR, r[E]);
            ST8(sDEC, __expf(-ew[E]));
            ST8(sKK, kk[E]);
            ST8(sBB, kk[E] * a[E]);
            ST8(sKP, k[E] * (1.f + (a[E] - 1.f) * kaw[E]));
            ST8(sV, v[E]);
#undef ST8
            if (jg == 0) sBR[tt] = br;
        }
        __syncthreads();
        if (tile + 1 < SEQ / 64) scan_load_rows(L, Zrkv, WAG, tok + 64, pos + 64, j0);
        if (F.wave < 4) {
            const LAS float* base = sR + jg * 8;
            f32x4 cr0 = *(const LAS f32x4*)(base), cr1 = *(const LAS f32x4*)(base + 4), cd0 = *(const LAS f32x4*)(base + 4096), cd1 = *(const LAS f32x4*)(base + 4100);
            f32x4 cq0 = *(const LAS f32x4*)(base + 8192), cq1 = *(const LAS f32x4*)(base + 8196), cb0 = *(const LAS f32x4*)(base + 12288), cb1 = *(const LAS f32x4*)(base + 12292);
            f32x4 cp0 = *(const LAS f32x4*)(base + 16384), cp1 = *(const LAS f32x4*)(base + 16388);
            float cvi = sV[irow], cbr = sBR[0];
#pragma unroll 2
            for (int s = 0; s < 64; ++s) {
                const int sn = (s + 1) & 63; const LAS float* nb = base + sn * 64;
                const f32x4 nr0 = *(const LAS f32x4*)(nb), nr1 = *(const LAS f32x4*)(nb + 4), nd0 = *(const LAS f32x4*)(nb + 4096), nd1 = *(const LAS f32x4*)(nb + 4100);
                const f32x4 nq0 = *(const LAS f32x4*)(nb + 8192), nq1 = *(const LAS f32x4*)(nb + 8196), nb0 = *(const LAS f32x4*)(nb + 12288), nb1 = *(const LAS f32x4*)(nb + 12292);
                const f32x4 np0 = *(const LAS f32x4*)(nb + 16384), np1 = *(const LAS f32x4*)(nb + 16388);
                const float nvi = sV[sn * 64 + irow], nbr = sBR[sn];
                float t[8], sa0 = 0.f, sa1 = 0.f, ty0 = 0.f, ty1 = 0.f;
#pragma unroll
                for (int e = 0; e < 4; ++e) {
                    sa0 += S[e] * cq0[e]; sa1 += S[4 + e] * cq1[e];
                    t[e] = S[e] * cd0[e] + cvi * cp0[e]; t[4 + e] = S[4 + e] * cd1[e] + cvi * cp1[e];
                    ty0 += t[e] * cr0[e]; ty1 += t[4 + e] * cr1[e];
                }
                float sa = sa0 + sa1, ty = ty0 + ty1;
                sa += dpp_f(sa, 0); ty += dpp_f(ty, 0); sa += dpp_f(sa, 1); ty += dpp_f(ty, 1); sa += dpp_f(sa, 2); ty += dpp_f(ty, 2);
                sa = -sa;
#pragma unroll
                for (int e = 0; e < 4; ++e) { S[e] = t[e] + sa * cb0[e]; S[4 + e] = t[4 + e] + sa * cb1[e]; }
                if (jg == 0) sY[s * 64 + irow] = ty + sa * cbr;
                cr0 = nr0; cr1 = nr1; cd0 = nd0; cd1 = nd1; cq0 = nq0; cq1 = nq1; cb0 = nb0; cb1 = nb1; cp0 = np0; cp1 = np1; cvi = nvi; cbr = nbr;
            }
        }
        __syncthreads();
        {
            const LAS float* rb = sR + tt * 64 + jg * 8; const LAS float* kb = sKP + tt * 64 + jg * 8; const LAS float* vb = sV + tt * 64 + jg * 8;
            float dot = 0.f;
#pragma unroll
            for (int e = 0; e < 8; ++e) dot += rb[e] * kb[e] * rkw[e];
            dot = sum8(dot);
            if ((jg >> 2) == half) {
                const LAS float* yb = sY + tt * 64 + jg * 8;
                const f32x4 ya = *(const LAS f32x4*)yb, yc = *(const LAS f32x4*)(yb + 4);
                float c[8];
#pragma unroll
                for (int q = 0; q < 4; ++q) { c[2 * q] = (lnb[2 * q] + dot * vb[2 * q]) * bflo(g4[q]); c[2 * q + 1] = (lnb[2 * q + 1] + dot * vb[2 * q + 1]) * bfhi(g4[q]); }
                *(v4u*)(YA + tok * 512 + j0) = (v4u){cvt_pk_bf16(ya[0], ya[1]), cvt_pk_bf16(ya[2], ya[3]), cvt_pk_bf16(yc[0], yc[1]), cvt_pk_bf16(yc[2], yc[3])};
                *(v4u*)(YC + tok * 512 + j0) = (v4u){cvt_pk_bf16(c[0], c[1]), cvt_pk_bf16(c[2], c[3]), cvt_pk_bf16(c[4], c[5]), cvt_pk_bf16(c[6], c[7])};
            }
        }
        __syncthreads();
    }
}

namespace rk {
constexpr int RSB = 144, SLOT = 64 * RSB;
__device__ __forceinline__ int off(int row, int elem) { return row * RSB + ((((elem) >> 3) ^ ((row >> 3) & 7)) << 4) + ((elem) & 7) * 2; }
struct Acc2 { f32x4 a[2]; };
template <bool TWO>
__device__ __forceinline__ Acc2 mm_mul(const LAS unsigned char* lds, int X, int Y, int X2, int Y2, int wave, int lane) {
    const int g = lane >> 4, c15 = lane & 15; Acc2 r;
#pragma unroll
    for (int jj = 0; jj < 2; ++jj) {
        const int job = wave + 8 * jj, yt = job >> 2, xt = job & 3;
        f32x4 acc = (f32x4){0.f, 0.f, 0.f, 0.f};
#pragma unroll
        for (int ks = 0; ks < 2; ++ks) {
            const bf16x8 a = *(const LAS bf16x8*)(lds + X * SLOT + off(16 * xt + c15, ks * 32 + 8 * g)), b = *(const LAS bf16x8*)(lds + Y * SLOT + off(16 * yt + c15, ks * 32 + 8 * g));
            acc = __builtin_amdgcn_mfma_f32_16x16x32_bf16(a, b, acc, 0, 0, 0);
        }
        if (TWO) {
#pragma unroll
            for (int ks = 0; ks < 2; ++ks) {
                const bf16x8 a = *(const LAS bf16x8*)(lds + X2 * SLOT + off(16 * xt + c15, ks * 32 + 8 * g)), b = *(const LAS bf16x8*)(lds + Y2 * SLOT + off(16 * yt + c15, ks * 32 + 8 * g));
                acc = __builtin_amdgcn_mfma_f32_16x16x32_bf16(a, b, acc, 0, 0, 0);
            }
        }
        r.a[jj] = acc;
    }
    return r;
}
template <int EPI>
__device__ __forceinline__ void mm_put(LAS unsigned char* lds, Acc2 r, int Z, int C, const LAS float* gam, int wave, int lane) {
    const int g = lane >> 4, c15 = lane & 15;
#pragma unroll
    for (int jj = 0; jj < 2; ++jj) {
        const int job = wave + 8 * jj, yt = job >> 2, xt = job & 3;
        f32x4 acc = r.a[jj];
        const int y = 16 * yt + c15, x0 = 16 * xt + 4 * g;
        if (EPI == 4) { const v2u cw = *(const LAS v2u*)(lds + C * SLOT + off(y, x0)); acc[0] += bflo(cw.x); acc[1] += bfhi(cw.x); acc[2] += bflo(cw.y); acc[3] += bfhi(cw.y); }
#pragma unroll
        for (int e = 0; e < 4; ++e) { const int x = x0 + e;
            if (EPI == 1) acc[e] = (x < y) ? acc[e] : 0.f;
            if (EPI == 2) acc[e] = (x > y) ? acc[e] : 0.f;
            if (EPI == 3) acc[e] = (x <= y) ? acc[e] : 0.f;
            if (EPI == 5) acc[e] += (x == y) ? gam[x] : 0.f; }
        *(LAS v2u*)(lds + Z * SLOT + off(y, x0)) = (v2u){cvt_pk_bf16(acc[0], acc[1]), cvt_pk_bf16(acc[2], acc[3])};
        if (EPI == 1) { float t[4];
#pragma unroll
            for (int e = 0; e < 4; ++e) t[e] = acc[e] + ((x0 + e == y) ? 1.f : 0.f);
            *(LAS v2u*)(lds + C * SLOT + off(y, x0)) = (v2u){cvt_pk_bf16(t[0], t[1]), cvt_pk_bf16(t[2], t[3])}; }
    }
}
}
__device__ __forceinline__ void p4_rwkv_chunked(Frame& F) {
    using namespace rk;
    const int bh = F.vcu >> 1, par = F.vcu & 1, b = bh >> 3, h = bh & 7;
    bf16* SB = (bf16*)((unsigned char*)F.out + DO_SB) + (size_t)bh * 2 * 4096; unsigned* flag = F.ctl + CW_RK + bh;
    const bf16* Zrkv = WSP(bf16, WS_ZRKV); const bf16* WAG = DOP(bf16, DO_WAG); bf16* YA = WSP(bf16, WS_YA);
    LAS unsigned char* lds = F.lds;
    LAS float* sL = (LAS float*)(lds + 14 * SLOT);
    LAS float* sY = (LAS float*)(lds + 3 * SLOT);
    LAS float* sG = (LAS float*)(lds + 16 * SLOT);
    const int tt = F.tid >> 3, jg = F.tid & 7, j0 = h * 64 + jg * 8, wave = F.wave, lane = F.lane;
    ScanRows L; scan_load_rows(L, Zrkv, WAG, (size_t)b * SEQ + par * 64 + tt, par * 64 + tt, j0);
    for (int ch = par; ch < SEQ / 64; ch += 2) {
        const int pos = ch * 64 + tt; const size_t tok = (size_t)b * SEQ + pos;
        const v4u g4 = L.g4;
        float r[8], kp[8], v[8], a[8], ew[8], kk[8];
        float dot = 0.f;
        {
            float k[8];
            float mu_r[8], mu_k[8], mu_v[8], kkw[8], kaw[8], rkw[8];
#pragma unroll
            for (int e = 0; e < 8; ++e) { mu_r[e] = F.in[4][j0 + e]; mu_k[e] = F.in[4][512 + j0 + e]; mu_v[e] = F.in[4][1024 + j0 + e]; kkw[e] = F.in[10][j0 + e]; kaw[e] = F.in[11][j0 + e]; rkw[e] = F.in[12][j0 + e]; }
#pragma unroll
            for (int q = 0; q < 4; ++q) {
                const float zr0 = bflo(L.zr[q]), zr1 = bfhi(L.zr[q]), zk0 = bflo(L.zk[q]), zk1 = bfhi(L.zk[q]), zv0 = bflo(L.zv[q]), zv1 = bfhi(L.zv[q]);
                r[2 * q] = zr0 + (bflo(L.pr[q]) - zr0) * mu_r[2 * q]; r[2 * q + 1] = zr1 + (bfhi(L.pr[q]) - zr1) * mu_r[2 * q + 1];
                k[2 * q] = zk0 + (bflo(L.pk[q]) - zk0) * mu_k[2 * q]; k[2 * q + 1] = zk1 + (bfhi(L.pk[q]) - zk1) * mu_k[2 * q + 1];
                v[2 * q] = zv0 + (bflo(L.pv[q]) - zv0) * mu_v[2 * q]; v[2 * q + 1] = zv1 + (bfhi(L.pv[q]) - zv1) * mu_v[2 * q + 1];
                a[2 * q] = bflo(L.a4[q]); a[2 * q + 1] = bfhi(L.a4[q]); ew[2 * q] = bflo(L.ew4[q]); ew[2 * q + 1] = bfhi(L.ew4[q]);
            }
            float ss = 0.f;
#pragma unroll
            for (int e = 0; e < 8; ++e) { kk[e] = k[e] * kkw[e]; ss += kk[e] * kk[e]; }
            ss = sum8(ss);
            const float inv = fminf(__builtin_amdgcn_rsqf(ss), 1e12f);
#pragma unroll
            for (int e = 0; e < 8; ++e) { kk[e] *= inv; kp[e] = k[e] * (1.f + (a[e] - 1.f) * kaw[e]); }
#pragma unroll
            for (int e = 0; e < 8; ++e) dot += r[e] * kp[e] * rkw[e];
            dot = sum8(dot);
        }
        __syncthreads();
        {
#pragma unroll
            for (int e = 0; e < 8; ++e) *(LAS unsigned short*)(lds + 11 * SLOT + off(jg * 8 + e, tt)) = (unsigned short)(cvt_pk_bf16(ew[e], 0.f) & 0xffffu);
            unsigned tw[4];
#pragma unroll
            for (int q = 0; q < 4; ++q) tw[q] = ((jg * 8 + 2 * q <= tt) ? 0x3f80u : 0u) | ((jg * 8 + 2 * q + 1 <= tt) ? 0x3f800000u : 0u);
            *(LAS v4u*)(lds + 10 * SLOT + off(tt, jg * 8)) = (v4u){tw[0], tw[1], tw[2], tw[3]};
        }
        __syncthreads();
        { const Acc2 q0 = mm_mul<false>(lds, 11, 10, 0, 0, wave, lane); const int g = lane >> 4, c15 = lane & 15;
#pragma unroll
          for (int jj = 0; jj < 2; ++jj) { const int job = wave + 8 * jj, yt = job >> 2, xt = job & 3; *(LAS f32x4*)(sL + (16 * yt + c15) * 64 + 16 * xt + 4 * g) = -q0.a[jj]; } }
        __syncthreads();
        if (F.tid < 64) sG[F.tid] = __expf(sL[63 * 64 + F.tid]);
        if (ch + 2 < SEQ / 64) scan_load_rows(L, Zrkv, WAG, tok + 128, pos + 128, j0);
        {
            const f32x4 l0 = *(const LAS f32x4*)(sL + tt * 64 + jg * 8), l1 = *(const LAS f32x4*)(sL + tt * 64 + jg * 8 + 4);
            const f32x4 c0 = *(const LAS f32x4*)(sL + 63 * 64 + jg * 8), c1 = *(const LAS f32x4*)(sL + 63 * 64 + jg * 8 + 4);
            float At[8], Bt[8], Kt[8], Rt[8], Bh[8], Kh[8];
#pragma unroll
            for (int e = 0; e < 8; ++e) { const float Lt = e < 4 ? l0[e] : l1[e - 4], LC = e < 4 ? c0[e] : c1[e - 4];
                const float eL = __expf(Lt), eLm1 = __expf(Lt + ew[e]), einv = __builtin_amdgcn_rcpf(eL), eC = __expf(LC) * einv, ba = kk[e] * a[e];
                At[e] = -kk[e] * eLm1; Bt[e] = ba * einv; Kt[e] = kp[e] * einv; Rt[e] = r[e] * eL; Bh[e] = ba * eC; Kh[e] = kp[e] * eC; }
#define RK_ROW(slot, arr) *(LAS v4u*)(lds + (slot) * SLOT + off(tt, jg * 8)) = (v4u){cvt_pk_bf16(arr[0], arr[1]), cvt_pk_bf16(arr[2], arr[3]), cvt_pk_bf16(arr[4], arr[5]), cvt_pk_bf16(arr[6], arr[7])}
#define RK_COL(slot, arr) { _Pragma("unroll") for (int e = 0; e < 8; ++e) *(LAS unsigned short*)(lds + (slot) * SLOT + off(jg * 8 + e, tt)) = (unsigned short)(cvt_pk_bf16(arr[e], 0.f) & 0xffffu); }
            RK_ROW(0, At); RK_COL(1, At); RK_ROW(2, Bt); RK_ROW(3, Kt); RK_ROW(4, Rt); RK_COL(5, Bh); RK_COL(6, Kh); RK_COL(7, v);
#undef RK_ROW
#undef RK_COL
        }
        __syncthreads();
#define MUL1(X_, Y_) mm_mul<false>(lds, X_, Y_, 0, 0, wave, lane)
#define MUL2(X_, Y_, X2_, Y2_) mm_mul<true>(lds, X_, Y_, X2_, Y2_, wave, lane)
#define PUT(E_, R_, Z_, C_) mm_put<E_>(lds, R_, Z_, C_, sG, wave, lane)
        { const Acc2 q0 = MUL1(2, 0), q1 = MUL1(0, 2), q2 = MUL1(3, 0), q3 = MUL1(2, 4), q4 = MUL1(3, 4);
          PUT(1, q0, 8, 13); PUT(2, q1, 14, 0); PUT(1, q2, 10, 15); PUT(3, q3, 11, 0); PUT(3, q4, 12, 0); }
        __syncthreads();
        { const Acc2 q0 = MUL1(14, 8), q1 = MUL1(8, 14); PUT(0, q0, 0, 0); PUT(0, q1, 2, 0); }
        __syncthreads();
        { const Acc2 q0 = MUL1(2, 13), q1 = MUL1(2, 0), q2 = MUL1(0, 2); PUT(4, q0, 3, 13); PUT(0, q1, 8, 0); PUT(0, q2, 14, 0); }
        __syncthreads();
        { const Acc2 q0 = MUL1(14, 3), q1 = MUL1(14, 8), q2 = MUL1(8, 14); PUT(4, q0, 13, 3); PUT(0, q1, 0, 0); PUT(0, q2, 2, 0); }
        __syncthreads();
        { const Acc2 q0 = MUL1(2, 13), q1 = MUL1(2, 0), q2 = MUL1(0, 2); PUT(4, q0, 3, 13); PUT(0, q1, 8, 0); PUT(0, q2, 14, 0); }
        __syncthreads();
        { const Acc2 q0 = MUL1(14, 3), q1 = MUL1(8, 14); PUT(4, q0, 13, 3); PUT(0, q1, 0, 0); }
        __syncthreads();
        { const Acc2 q0 = MUL1(0, 13); PUT(4, q0, 3, 13); }
        __syncthreads();
        { const Acc2 q0 = MUL1(3, 1), q1 = MUL1(10, 7); PUT(0, q0, 8, 0); PUT(0, q1, 0, 0); }
        __syncthreads();
        { const Acc2 q0 = MUL1(3, 0); PUT(0, q0, 13, 0); }
        __syncthreads();
        { const Acc2 q0 = MUL1(8, 5), q1 = MUL2(5, 13, 6, 7), q2 = MUL1(8, 11), q3 = MUL2(11, 13, 12, 7);
          PUT(5, q0, 2, 0); PUT(0, q1, 14, 0); PUT(4, q2, 15, 4); PUT(0, q3, 0, 0); }
        __syncthreads();
#undef MUL1
#undef MUL2
#undef PUT
        if (ch == 0) { for (int i = F.tid; i < SLOT / 4; i += NTHREADS) ((LAS unsigned*)(lds + 9 * SLOT))[i] = 0u; }
        else {
            if (F.tid == 0) { unsigned sp = 0; while (__hip_atomic_load(flag, __ATOMIC_RELAXED, __HIP_MEMORY_SCOPE_AGENT) < (unsigned)ch && ++sp < (1u << 22)) __builtin_amdgcn_s_sleep(1); }
            __syncthreads();
            const unsigned long long* sp8 = (const unsigned long long*)(SB + (size_t)(ch & 1) * 4096 + F.tid * 8);
            const unsigned long long w0 = __hip_atomic_load(sp8, __ATOMIC_RELAXED, __HIP_MEMORY_SCOPE_AGENT), w1 = __hip_atomic_load(sp8 + 1, __ATOMIC_RELAXED, __HIP_MEMORY_SCOPE_AGENT);
            *(LAS v4u*)(lds + 9 * SLOT + off(F.tid >> 3, (F.tid & 7) * 8)) = (v4u){(unsigned)w0, (unsigned)(w0 >> 32), (unsigned)w1, (unsigned)(w1 >> 32)};
        }
        __syncthreads();
        v2u snew[2];
        {
            const int g = lane >> 4, c15 = lane & 15;
#pragma unroll
            for (int jj = 0; jj < 2; ++jj) {
                const int job = wave + 8 * jj, yt = job >> 2, xt = job & 3;
                f32x4 ya = (f32x4){0.f, 0.f, 0.f, 0.f}, sa2 = (f32x4){0.f, 0.f, 0.f, 0.f};
#pragma unroll
                for (int ks = 0; ks < 2; ++ks) {
                    const bf16x8 sf = *(const LAS bf16x8*)(lds + 9 * SLOT + off(16 * yt + c15, ks * 32 + 8 * g));
                    const bf16x8 rf = *(const LAS bf16x8*)(lds + 15 * SLOT + off(16 * xt + c15, ks * 32 + 8 * g)), mf = *(const LAS bf16x8*)(lds + 2 * SLOT + off(16 * xt + c15, ks * 32 + 8 * g));
                    ya = __builtin_amdgcn_mfma_f32_16x16x32_bf16(rf, sf, ya, 0, 0, 0); sa2 = __builtin_amdgcn_mfma_f32_16x16x32_bf16(mf, sf, sa2, 0, 0, 0);
                }
                const int yy = 16 * yt + c15, x0 = 16 * xt + 4 * g;
                const v2u y0w = *(const LAS v2u*)(lds + 0 * SLOT + off(yy, x0)), nw = *(const LAS v2u*)(lds + 14 * SLOT + off(yy, x0));
                ya[0] += bflo(y0w.x); ya[1] += bfhi(y0w.x); ya[2] += bflo(y0w.y); ya[3] += bfhi(y0w.y);
                sa2[0] += bflo(nw.x); sa2[1] += bfhi(nw.x); sa2[2] += bflo(nw.y); sa2[3] += bfhi(nw.y);
#pragma unroll
                for (int e = 0; e < 4; ++e) sY[(x0 + e) * 64 + yy] = ya[e];
                snew[jj] = (v2u){cvt_pk_bf16(sa2[0], sa2[1]), cvt_pk_bf16(sa2[2], sa2[3])};
            }
        }
        {
            const int g = lane >> 4, c15 = lane & 15;
#pragma unroll
            for (int jj = 0; jj < 2; ++jj) { const int job = wave + 8 * jj, yt = job >> 2, xt = job & 3;
                __hip_atomic_store((unsigned long long*)(SB + (size_t)((ch + 1) & 1) * 4096 + (16 * yt + c15) * 64 + 16 * xt + 4 * g), (unsigned long long)snew[jj].x | ((unsigned long long)snew[jj].y << 32), __ATOMIC_RELAXED, __HIP_MEMORY_SCOPE_AGENT); }
            asm volatile("s_waitcnt vmcnt(0)" ::: "memory");
            __syncthreads();
            if (F.tid == 0) __hip_atomic_store(flag, (unsigned)(ch + 1), __ATOMIC_RELAXED, __HIP_MEMORY_SCOPE_AGENT);
        }
        {
            const LAS float* yb = sY + tt * 64 + jg * 8;
            const f32x4 ya = *(const LAS f32x4*)yb, yc = *(const LAS f32x4*)(yb + 4);
            float y[8] = {ya[0], ya[1], ya[2], ya[3], yc[0], yc[1], yc[2], yc[3]};
            float sm = 0.f;
#pragma unroll
            for (int e = 0; e < 8; ++e) sm += y[e];
            const float mean = sum8(sm) * (1.f / 64.f);
            float sv = 0.f;
#pragma unroll
            for (int e = 0; e < 8; ++e) { y[e] -= mean; sv += y[e] * y[e]; }
            const float rstd = rsqrtf(sum8(sv) * (1.f / 64.f) + 64e-5f);
            float lnw[8], lnb[8];
#pragma unroll
            for (int e = 0; e < 8; ++e) { lnw[e] = F.in[13][j0 + e]; lnb[e] = F.in[14][j0 + e]; }
            float o[8];
#pragma unroll
            for (int q = 0; q < 4; ++q) {
                o[2 * q] = (y[2 * q] * rstd * lnw[2 * q] + lnb[2 * q] + dot * v[2 * q]) * bflo(g4[q]);
                o[2 * q + 1] = (y[2 * q + 1] * rstd * lnw[2 * q + 1] + lnb[2 * q + 1] + dot * v[2 * q + 1]) * bfhi(g4[q]);
            }
            *(v4u*)(YA + tok * 512 + j0) = (v4u){cvt_pk_bf16(o[0], o[1]), cvt_pk_bf16(o[2], o[3]), cvt_pk_bf16(o[4], o[5]), cvt_pk_bf16(o[6], o[7])};
        }
    }
    __syncthreads();
}

__device__ __forceinline__ void p5_post(Frame& F) {
    bf16* YA = WSP(bf16, WS_YA); const bf16* YC = WSP(bf16, WS_YC); const bf16* WAG = DOP(bf16, DO_WAG);
    const int gt = F.vcu * NTHREADS + F.tid, NGT = F.G * NTHREADS;
    for (int it = gt; it < T * 64; it += NGT) {
        const size_t tok = (size_t)(it >> 6); const int c0 = (it & 63) * 8;
        const v4u yw = *(const v4u*)(YA + tok * 512 + c0), cw = *(const v4u*)(YC + tok * 512 + c0), gw = *(const v4u*)(WAG + tok * 1536 + 1024 + c0);
        float y[8], sm = 0.f;
#pragma unroll
        for (int q = 0; q < 4; ++q) { y[2 * q] = bflo(yw[q]); y[2 * q + 1] = bfhi(yw[q]); sm += y[2 * q] + y[2 * q + 1]; }
        const float mean = sum8(sm) * (1.f / 64.f); float sv = 0.f;
#pragma unroll
        for (int e = 0; e < 8; ++e) { y[e] -= mean; sv += y[e] * y[e]; }
        const float rstd = rsqrtf(sum8(sv) * (1.f / 64.f) + 64e-5f);
        const f32x4 l0 = *(const f32x4*)(F.in[13] + c0), l1 = *(const f32x4*)(F.in[13] + c0 + 4);
        const float lw[8] = {l0[0], l0[1], l0[2], l0[3], l1[0], l1[1], l1[2], l1[3]};
        float o[8];
#pragma unroll
        for (int q = 0; q < 4; ++q) { o[2 * q] = y[2 * q] * rstd * lw[2 * q] * bflo(gw[q]) + bflo(cw[q]); o[2 * q + 1] = y[2 * q + 1] * rstd * lw[2 * q + 1] * bfhi(gw[q]) + bfhi(cw[q]); }
        *(v4u*)(YA + tok * 512 + c0) = (v4u){cvt_pk_bf16(o[0], o[1]), cvt_pk_bf16(o[2], o[3]), cvt_pk_bf16(o[4], o[5]), cvt_pk_bf16(o[6], o[7])};
    }
}

__device__ __forceinline__ unsigned score_key(float s) {
    s = s + 0.0f;
    const _Float16 hv = (_Float16)s; const unsigned u = (unsigned)__builtin_bit_cast(unsigned short, hv);
    return (u & 0x8000u) ? (~u & 0xffffu) : (u | 0x8000u);
}
__device__ __forceinline__ void find_bin(const LAS unsigned* hist, unsigned need, int lane, unsigned& bsel, unsigned& above) {
    const v4u c = *(const LAS v4u*)(hist + 4 * lane);
    const unsigned sl = c.x + c.y + c.z + c.w;
    unsigned suf = sl;
#pragma unroll
    for (int d = 1; d < 64; d <<= 1) { const unsigned o = (unsigned)__shfl_down((int)suf, d); suf += (lane + d < 64) ? o : 0u; }
    const unsigned long long bal = __ballot(suf >= need);
    const int L = 63 - __builtin_clzll(bal | 1ull);
    unsigned run = suf - sl;
    unsigned bb, ab;
    if (run + c.w >= need) { bb = 3; ab = run; }
    else if (run + c.w + c.z >= need) { bb = 2; ab = run + c.w; }
    else if (run + c.w + c.z + c.y >= need) { bb = 1; ab = run + c.w + c.z; }
    else { bb = 0; ab = run + c.w + c.z + c.y; }
    bsel = (unsigned)__shfl((int)(4 * lane + bb), L); above = (unsigned)__shfl((int)ab, L);
}
constexpr int HP = 260;
constexpr int HIST_WAVE_BYTES = 16 * HP * 4, KBUF_OFF = NWAVES * HIST_WAVE_BYTES;
template <int PASS>
__device__ __forceinline__ void idx_tile(const bf16x8 K0, const bf16x8 K1, const int kt, const bool diag, const bf16x8 (&Q)[4][2], const float (&w)[4], LAS unsigned* hrow, const int g, const int c15,
                                         const unsigned b1, const unsigned thr, const unsigned rr, unsigned& cnt, unsigned& ties, unsigned short* idxrow, unsigned short* sink) {
    float sc[4] = {0.f, 0.f, 0.f, 0.f};
#pragma unroll
    for (int hh = 0; hh < 4; ++hh) {
        f32x4 acc = (f32x4){0.f, 0.f, 0.f, 0.f};
        acc = __builtin_amdgcn_mfma_f32_16x16x32_bf16(K0, Q[hh][0], acc, 0, 0, 0);
        acc = __builtin_amdgcn_mfma_f32_16x16x32_bf16(K1, Q[hh][1], acc, 0, 0, 0);
#pragma unroll
        for (int i = 0; i < 4; ++i) sc[i] += w[hh] * __builtin_amdgcn_fmed3f(acc[i], 0.f, __builtin_inff());
    }
    unsigned key[4]; bool valid[4];
#pragma unroll
    for (int i = 0; i < 4; ++i) { valid[i] = !diag || (4 * g + i <= c15); key[i] = score_key(sc[i]); }
    if (PASS == 0) {
#pragma unroll
        for (int i = 0; i < 4; ++i) lds_add(hrow + (key[i] >> 8), valid[i] ? 1u : 0u);
    } else if (PASS == 1) {
#pragma unroll
        for (int i = 0; i < 4; ++i) if (valid[i] && (key[i] >> 8) == b1) lds_add(hrow + (key[i] & 255u), 1u);
    } else {
        const unsigned long long qmask = 0x0001000100010001ull << c15, lowerG = qmask & ((1ull << (16 * g)) - 1ull);
        bool tie[4]; unsigned tlow = 0;
#pragma unroll
        for (int i = 0; i < 4; ++i) tie[i] = valid[i] && key[i] == thr;
        unsigned tb[4];
#pragma unroll
        for (int i = 0; i < 4; ++i) { const unsigned long long bl = __ballot(tie[i]); tb[i] = (unsigned)__popcll(bl & qmask); tlow += (unsigned)__popcll(bl & lowerG); }
        bool sel[4]; unsigned trun = ties + tlow;
#pragma unroll
        for (int i = 0; i < 4; ++i) { const bool tacc = tie[i] && trun < rr; sel[i] = (valid[i] && key[i] > thr) || tacc; trun += tie[i] ? 1u : 0u; }
        unsigned slow = 0, stot = 0;
#pragma unroll
        for (int i = 0; i < 4; ++i) { const unsigned long long bl = __ballot(sel[i]); stot += (unsigned)__popcll(bl & qmask); slow += (unsigned)__popcll(bl & lowerG); }
        unsigned pos = cnt + slow;
#pragma unroll
        for (int i = 0; i < 4; ++i) { if (sel[i] && pos < 256u) ((LAS unsigned short*)hrow)[pos] = (unsigned short)(kt * 16 + 4 * g + i); pos += sel[i] ? 1u : 0u; }
        cnt += stot; ties += tb[0] + tb[1] + tb[2] + tb[3];
    }
}
template <int PASS>
__device__ __forceinline__ void idx_pass(Frame& F, const bf16* kb_batch  , const int p, const int pmax, const bf16x8 (&Q)[4][2], const float (&w)[4], LAS unsigned* hrow,
                                         const unsigned b1, const unsigned thr, const unsigned rr, unsigned& cnt, unsigned& ties, unsigned short* idxrow, unsigned short* sink) {
    const int g = F.lane >> 4, c15 = F.lane & 15;
    LAS unsigned char* kbuf = F.lds + KBUF_OFF;
    const int skey = F.tid >> 3, sd8 = F.tid & 7;
    const unsigned sdst = (unsigned)((skey >> 4) * 2048 + (sd8 >> 2) * 1024 + (sd8 & 3) * 256 + (skey & 15) * 16);
    const bf16* ssrc = kb_batch + (size_t)skey * 512 + sd8 * 8;
    const int nchunk = (pmax >> 2) + 1;
    v4u st = *(const v4u*)ssrc;
    __syncthreads();
    *(LAS v4u*)(kbuf + sdst) = st;
    for (int c = 0; c < nchunk; ++c) {
        if (c + 1 < nchunk) st = *(const v4u*)(ssrc + (size_t)(c + 1) * 64 * 512);
        __syncthreads();
        const LAS unsigned char* kb = kbuf + (c & 1) * 8192 + g * 256 + c15 * 16;
        if (c * 4 + 3 < p) {
            bf16x8 K0[4], K1[4];
#pragma unroll
            for (int u = 0; u < 4; ++u) { K0[u] = *(const LAS bf16x8*)(kb + u * 2048); K1[u] = *(const LAS bf16x8*)(kb + u * 2048 + 1024); }
#pragma unroll
            for (int u = 0; u < 4; ++u) idx_tile<PASS>(K0[u], K1[u], c * 4 + u, false, Q, w, hrow, g, c15, b1, thr, rr, cnt, ties, idxrow, sink);
        } else {
#pragma unroll
            for (int u = 0; u < 4; ++u) {
                const int kt = c * 4 + u;
                if (kt <= p) {
                    const bf16x8 K0 = *(const LAS bf16x8*)(kb + u * 2048), K1 = *(const LAS bf16x8*)(kb + u * 2048 + 1024);
                    idx_tile<PASS>(K0, K1, kt, kt == p, Q, w, hrow, g, c15, b1, thr, rr, cnt, ties, idxrow, sink);
                }
            }
        }
        if (c + 1 < nchunk) *(LAS v4u*)(kbuf + ((c + 1) & 1) * 8192 + sdst) = st;
    }
}
namespace ix3 {
constexpr int KP = 8208, KEYS_B = 16 * KP, HIST_OFF = KEYS_B, CNT_OFF = HIST_OFF + 16 * HP * 4, QI_OFF = CNT_OFF + 8 * 16 * 2 * 4, END_OFF = QI_OFF + 16 * 4 * 4;
static_assert(END_OFF <= MISC_OFF, "indexer LDS map");
}
__device__ __forceinline__ void p4_indexer(Frame& F) {
    using namespace ix3;
    const bf16* Zd = WSP(bf16, WS_ZD); unsigned short* IDX = WSP(unsigned short, WS_IDX);
    LAS unsigned char* lds = F.lds;
    LAS unsigned* hist = (LAS unsigned*)(lds + HIST_OFF); LAS unsigned* cntt = (LAS unsigned*)(lds + CNT_OFF); LAS unsigned* qi = (LAS unsigned*)(lds + QI_OFF);
    const int lane = F.lane, wave = F.wave, g = lane >> 4, c15 = lane & 15;
    const int b = F.vcu >> 4, vb = F.vcu & 15;
    if (b >= NB) return;
    LAS unsigned* hrow = hist + c15 * HP;
    LAS unsigned char* krow = lds + c15 * KP;
    const unsigned long long qmask = 0x0001000100010001ull << c15, lowerG = qmask & ((1ull << (16 * g)) - 1ull);
    for (int ti = 0; ti < 16; ++ti) {
        const int pr = vb * 8 + (ti & 7), p = (ti & 8) ? 255 - pr : pr;
        const int q0 = p * 16; const size_t tok0 = (size_t)b * SEQ + q0;
        if (p < 16) {
            for (int i = F.tid; i < 16 * 256; i += NTHREADS) { const int r = i >> 8, jx = i & 255; IDX[(tok0 + r) * 256 + jx] = (unsigned short)(jx <= q0 + r ? jx : 0); }
            continue;
        }
        const int np = p + 1, K8 = (np + 7) >> 3, lo = wave * K8, hi = (lo + K8 < np) ? lo + K8 : np;
        for (int z = F.tid; z < 16 * HP; z += NTHREADS) hist[z] = 0u;
        bf16x8 Q[4][2];
#pragma unroll
        for (int hh = 0; hh < 4; ++hh)
#pragma unroll
            for (int ks = 0; ks < 2; ++ks) Q[hh][ks] = *(const bf16x8*)(Zd + (tok0 + c15) * 512 + 256 + hh * 64 + ks * 32 + 8 * g);
        float w[4];
        { const v2u ww = *(const v2u*)(Zd + (tok0 + c15) * 512 + 192); w[0] = bflo(ww.x) * 0.0625f; w[1] = bfhi(ww.x) * 0.0625f; w[2] = bflo(ww.y) * 0.0625f; w[3] = bfhi(ww.y) * 0.0625f; }
        __syncthreads();
        if (lo < hi) {
            const bf16* kbase = Zd + ((size_t)b * SEQ + c15) * 512 + 128 + 8 * g;
            constexpr int NPF = 2;
            bf16x8 R[NPF][2];
#pragma unroll
            for (int u = 0; u < NPF; ++u) { const int kl = lo + u < hi ? lo + u : hi - 1; R[u][0] = *(const bf16x8*)(kbase + (size_t)kl * 8192); R[u][1] = *(const bf16x8*)(kbase + (size_t)kl * 8192 + 32);
                __builtin_amdgcn_sched_barrier(0); }
            auto keys2 = [&](const float s0, const float s1) __attribute__((always_inline)) -> unsigned {
                typedef _Float16 h2_t __attribute__((ext_vector_type(2))); typedef short s2_t __attribute__((ext_vector_type(2)));
                h2_t hv = __builtin_convertvector((f32x2){s0, s1}, h2_t); hv = hv + (h2_t){(_Float16)0.0f, (_Float16)0.0f};
                const s2_t hs = __builtin_bit_cast(s2_t, hv); const s2_t sg = hs >> (s2_t){15, 15};
                return __builtin_bit_cast(unsigned, hs) ^ (__builtin_bit_cast(unsigned, sg) | 0x80008000u);
            };
            for (int kt0 = lo; kt0 < hi; kt0 += NPF) {
#pragma unroll
                for (int u = 0; u < NPF; ++u) {
                    const int kt = kt0 + u;
                    f32x4 acc[4];
#pragma unroll
                    for (int hh = 0; hh < 4; ++hh) {
                        acc[hh] = __builtin_amdgcn_mfma_f32_16x16x32_bf16(R[u][0], Q[hh][0], (f32x4){0.f, 0.f, 0.f, 0.f}, 0, 0, 0);
                        acc[hh] = __builtin_amdgcn_mfma_f32_16x16x32_bf16(R[u][1], Q[hh][1], acc[hh], 0, 0, 0);
                    }
                    { const int kn = kt + NPF, kl = kn < hi ? kn : hi - 1; R[u][0] = *(const bf16x8*)(kbase + (size_t)kl * 8192); R[u][1] = *(const bf16x8*)(kbase + (size_t)kl * 8192 + 32); }
                    float sc[4] = {0.f, 0.f, 0.f, 0.f};
#pragma unroll
                    for (int hh = 0; hh < 4; ++hh)
#pragma unroll
                        for (int i = 0; i < 4; ++i) { const float av = acc[hh][i]; const int ai = __builtin_bit_cast(int, av); const int ar = ai > 0 ? ai : 0; sc[i] += w[hh] * __builtin_bit_cast(float, ar); }
                    if (kt < hi) {
                        const unsigned k01 = keys2(sc[0], sc[1]), k23 = keys2(sc[2], sc[3]);
                        const unsigned bin[4] = {(k01 >> 8) & 255u, k01 >> 24, (k23 >> 8) & 255u, k23 >> 24};
                        if (kt == p) {
                            asm volatile("" ::: "memory");
#pragma unroll
                            for (int i = 0; i < 4; ++i) lds_add(hrow + bin[i], (4 * g + i <= c15) ? 1u : 0u);
                        } else {
#pragma unroll
                            for (int i = 0; i < 4; ++i) lds_add(hrow + bin[i], 1u);
                        }
                        *(LAS v2u*)(krow + (kt * 16 + 4 * g) * 2) = (v2u){k01, k23};
                    }
                }
            }
        }
        __syncthreads();
        {
            LAS unsigned* hq[2]; const LAS unsigned char* kq[2]; unsigned qpos[2], b1[2], ab1[2], thr[2], rr[2];
            const int nsteps = (np * 16 + 255) >> 8;
#pragma unroll
            for (int qq = 0; qq < 2; ++qq) { const int q = 2 * wave + qq; hq[qq] = hist + q * HP; kq[qq] = lds + q * KP; qpos[qq] = (unsigned)(q0 + q); }
#pragma unroll
            for (int qq = 0; qq < 2; ++qq) find_bin(hq[qq], 256u, lane, b1[qq], ab1[qq]);
#pragma unroll
            for (int qq = 0; qq < 2; ++qq) for (int z = lane; z < HP; z += 64) hq[qq][z] = 0u;
            {
                auto step = [&](const int s, const bool mk) __attribute__((always_inline)) {
                    const unsigned k0 = (unsigned)(s * 256 + 4 * lane);
                    v2u kw[2];
#pragma unroll
                    for (int qq = 0; qq < 2; ++qq) kw[qq] = *(const LAS v2u*)(kq[qq] + k0 * 2);
#pragma unroll
                    for (int qq = 0; qq < 2; ++qq) { const unsigned key[4] = {kw[qq].x & 0xffffu, kw[qq].x >> 16, kw[qq].y & 0xffffu, kw[qq].y >> 16};
#pragma unroll
                        for (int i = 0; i < 4; ++i) if ((!mk || k0 + i <= qpos[qq]) && (key[i] >> 8) == b1[qq]) lds_add(hq[qq] + (key[i] & 255u), 1u); }
                };
                for (int s = 0; s < nsteps - 1; ++s) step(s, false);
                step(nsteps - 1, true);
            }
#pragma unroll
            for (int qq = 0; qq < 2; ++qq) { unsigned bs, ab; find_bin(hq[qq], 256u - ab1[qq], lane, bs, ab); thr[qq] = (b1[qq] << 8) | bs; rr[qq] = 256u - (ab1[qq] + ab); }
            unsigned cnt[2] = {0u, 0u}, ties[2] = {0u, 0u};
            {
                auto step = [&](const int s, const bool mk) __attribute__((always_inline)) {
                    const unsigned k0 = (unsigned)(s * 256 + 4 * lane);
                    v2u kw[2];
#pragma unroll
                    for (int qq = 0; qq < 2; ++qq) kw[qq] = *(const LAS v2u*)(kq[qq] + k0 * 2);
                    bool tie[2][4], sel[2][4]; bool anyt = false;
#pragma unroll
                    for (int qq = 0; qq < 2; ++qq) { const unsigned key[4] = {kw[qq].x & 0xffffu, kw[qq].x >> 16, kw[qq].y & 0xffffu, kw[qq].y >> 16};
#pragma unroll
                        for (int i = 0; i < 4; ++i) { const bool valid = !mk || k0 + i <= qpos[qq]; tie[qq][i] = valid && key[i] == thr[qq]; sel[qq][i] = valid && key[i] > thr[qq]; anyt = anyt || tie[qq][i]; } }
                    if (__ballot(anyt) != 0ull) {
                        asm volatile("" ::: "memory");
#pragma unroll
                        for (int qq = 0; qq < 2; ++qq) { unsigned tlow = 0, tall = 0;
#pragma unroll
                            for (int i = 0; i < 4; ++i) { const unsigned long long bm = __ballot(tie[qq][i]); tlow = __builtin_amdgcn_mbcnt_hi((unsigned)(bm >> 32), __builtin_amdgcn_mbcnt_lo((unsigned)bm, tlow)); tall += (unsigned)__popcll(bm); }
                            unsigned trun = ties[qq] + tlow;
#pragma unroll
                            for (int i = 0; i < 4; ++i) { sel[qq][i] = sel[qq][i] || (tie[qq][i] && trun < rr[qq]); trun += tie[qq][i] ? 1u : 0u; }
                            ties[qq] += tall; }
                    }
#pragma unroll
                    for (int qq = 0; qq < 2; ++qq) { LAS unsigned short* list = (LAS unsigned short*)hq[qq];
                        unsigned slow = 0, sall = 0;
#pragma unroll
                        for (int i = 0; i < 4; ++i) { const unsigned long long bm = __ballot(sel[qq][i]); slow = __builtin_amdgcn_mbcnt_hi((unsigned)(bm >> 32), __builtin_amdgcn_mbcnt_lo((unsigned)bm, slow)); sall += (unsigned)__popcll(bm); }
                        unsigned pos = cnt[qq] + slow;
#pragma unroll
                        for (int i = 0; i < 4; ++i) { const unsigned wpos = (sel[qq][i] && pos < 256u) ? pos : 256u + (unsigned)lane; list[wpos] = (unsigned short)(k0 + i); pos += sel[qq][i] ? 1u : 0u; }
                        cnt[qq] += sall; }
                };
                for (int s = 0; s < nsteps - 1; ++s) step(s, false);
                step(nsteps - 1, true);
            }
        }
        __syncthreads();
        { const int q = F.tid >> 5, ch = F.tid & 31; const v4u v = *(const LAS v4u*)((const LAS unsigned char*)(hist + q * HP) + ch * 16); *(v4u*)((unsigned char*)(IDX + (tok0 + q) * 256) + ch * 16) = v; }
        __syncthreads();
    }
}

__device__ __forceinline__ unsigned off_b(unsigned row, unsigned ch) { return 256u * row + 16u * (ch ^ (((row & 3) << 2) | ((row >> 2) & 3))); }
__device__ __forceinline__ void p4_sparse_attn(Frame& F) {
    const bf16* CKV = WSP(bf16, WS_CKV); const unsigned short* IDX = WSP(unsigned short, WS_IDX); bf16* QL = WSP(bf16, WS_QLAT);
    LAS unsigned char* img0 = F.lds + F.wave * 16384;
    const int lane = F.lane, g = lane >> 4, c15 = lane & 15, qq = c15 >> 2, pp = lane & 3;
    const int t0 = F.gw * 32; constexpr int NF = 256;
    v4u ixw; v4u rw[8];
    const unsigned goff = 16u * g, coff = 16u * c15;
#define SA_LOAD_IDX(f_) { const int f2 = (f_) < NF ? (f_) : NF - 1; ixw = *(const v4u*)((const unsigned char*)(IDX + (size_t)(t0 + (f2 >> 3)) * 256 + (f2 & 7) * 32) + goff); }
#define SA_IX(c_) (((c_) & 1) ? (ixw[(c_) >> 1] >> 16) : (ixw[(c_) >> 1] & 0xffffu))
#define SA_LOAD_ROWS(f_) { const int f2 = (f_) < NF ? (f_) : NF - 1; const unsigned char* rbp = (const unsigned char*)(CKV + (size_t)((t0 + (f2 >> 3)) >> 12) * SEQ * 128); \
        _Pragma("unroll") for (int c = 0; c < 8; ++c) rw[c] = *(const v4u*)(rbp + ((SA_IX(c) << 8) + coff)); }
    SA_LOAD_IDX(0); SA_LOAD_ROWS(0); SA_LOAD_IDX(1);
    bf16x8 Bq[4], Bqn[4];
#pragma unroll
    for (int ks = 0; ks < 4; ++ks) { Bqn[ks] = (bf16x8){0, 0, 0, 0, 0, 0, 0, 0}; if (c15 < 8) Bqn[ks] = *(const bf16x8*)(QL + (size_t)t0 * 1024 + c15 * 128 + ks * 32 + 8 * g); Bq[ks] = Bqn[ks]; }
    float mrun = -1e30f, lsum = 0.f;
    f32x4 O[8];
#pragma unroll
    for (int c = 0; c < 8; ++c) O[c] = (f32x4){0.f, 0.f, 0.f, 0.f};
    for (int f = 0; f < NF; ++f) {
        const int t = t0 + (f >> 3), im = f & 7; const int pos = t & (SEQ - 1); const int nsel = pos + 1 < 256 ? pos + 1 : 256;
        LAS unsigned char* img = img0 + (f & 1) * 8192;
#pragma unroll
        for (int c = 0; c < 8; ++c) *(LAS v4u*)(img + off_b(8 * g + c, c15)) = rw[c];
        SA_LOAD_ROWS(f + 1);
        SA_LOAD_IDX(f + 2);
        if (im == 0) {
#pragma unroll
            for (int ks = 0; ks < 4; ++ks) Bq[ks] = Bqn[ks];
            mrun = -1e30f; lsum = 0.f;
#pragma unroll
            for (int c = 0; c < 8; ++c) O[c] = (f32x4){0.f, 0.f, 0.f, 0.f};
        }
        if (im == 2) { const int tn = (t + 1 < t0 + 32) ? t + 1 : t;
#pragma unroll
            for (int ks = 0; ks < 4; ++ks) if (c15 < 8) Bqn[ks] = *(const bf16x8*)(QL + (size_t)tn * 1024 + c15 * 128 + ks * 32 + 8 * g); }
        f32x4 sacc[2];
#pragma unroll
        for (int rb = 0; rb < 2; ++rb) { sacc[rb] = (f32x4){0.f, 0.f, 0.f, 0.f};
#pragma unroll
            for (int ks = 0; ks < 4; ++ks) { const bf16x8 a = *(const LAS bf16x8*)(img + off_b(c15 + 16 * rb, 4 * ks + g)); sacc[rb] = __builtin_amdgcn_mfma_f32_16x16x32_bf16(a, Bq[ks], sacc[rb], 0, 0, 0); } }
        if (nsel < 256) {
            asm volatile("" ::: "memory");
#pragma unroll
            for (int rb = 0; rb < 2; ++rb)
#pragma unroll
                for (int i = 0; i < 4; ++i) { const int j = im * 32 + 16 * rb + 4 * g + i; if (j >= nsel) sacc[rb][i] = -1e30f; }
        }
        float mx = -1e30f;
#pragma unroll
        for (int rb = 0; rb < 2; ++rb)
#pragma unroll
            for (int i = 0; i < 4; ++i) mx = fmaxf(mx, sacc[rb][i]);
        mx = fmaxf(mx, __shfl_xor(mx, 16)); mx = fmaxf(mx, __shfl_xor(mx, 32));
        const float mnew = fmaxf(mrun, mx), alpha = __expf(mrun - mnew), mneg = -1.4426950408889634f * mnew;
        float ps = 0.f; float pv[8];
#pragma unroll
        for (int rb = 0; rb < 2; ++rb)
#pragma unroll
            for (int i = 0; i < 4; ++i) { const float pe = __builtin_amdgcn_exp2f(__builtin_fmaf(sacc[rb][i], 1.4426950408889634f, mneg)); pv[4 * rb + i] = pe; ps += pe; }
        ps += __shfl_xor(ps, 16); ps += __shfl_xor(ps, 32);
        lsum = lsum * alpha + ps; mrun = mnew;
        const v4u pw = (v4u){cvt_pk_bf16(pv[0], pv[1]), cvt_pk_bf16(pv[2], pv[3]), cvt_pk_bf16(pv[4], pv[5]), cvt_pk_bf16(pv[6], pv[7])};
        const bf16x8 pa = __builtin_bit_cast(bf16x8, pw);
        float al[4];
#pragma unroll
        for (int i = 0; i < 4; ++i) al[i] = __shfl(alpha, (4 * g + i) & 15);
#pragma unroll
        for (int c = 0; c < 8; ++c) {
#pragma unroll
            for (int i = 0; i < 4; ++i) O[c][i] *= al[i];
            const s16x4 lo = __builtin_bit_cast(s16x4, __builtin_amdgcn_ds_read_tr16_b64_v4i16((LAS s16x4*)(img + off_b(4 * g + qq, 2 * c + (pp >> 1)) + 8 * (pp & 1))));
            const s16x4 hi = __builtin_bit_cast(s16x4, __builtin_amdgcn_ds_read_tr16_b64_v4i16((LAS s16x4*)(img + off_b(16 + 4 * g + qq, 2 * c + (pp >> 1)) + 8 * (pp & 1))));
            const bf16x8 bv = (bf16x8){lo[0], lo[1], lo[2], lo[3], hi[0], hi[1], hi[2], hi[3]};
            O[c] = __builtin_amdgcn_mfma_f32_16x16x32_bf16(pa, bv, O[c], 0, 0, 0);
        }
        if (im == 7) {
            float inv[4];
#pragma unroll
            for (int i = 0; i < 4; ++i) inv[i] = __builtin_amdgcn_rcpf(__shfl(lsum, (4 * g + i) & 15));
            if (g < 2) {
#pragma unroll
                for (int c = 0; c < 8; ++c)
#pragma unroll
                    for (int i = 0; i < 4; ++i) *(LAS unsigned short*)(img + ((4 * g + i) * 128 + 16 * c + c15) * 2) = (unsigned short)(cvt_pk_bf16(O[c][i] * inv[i], 0.f) & 0xffffu);
            }
            const v4u o0 = *(const LAS v4u*)(img + lane * 32), o1 = *(const LAS v4u*)(img + lane * 32 + 16);
            *(v4u*)(QL + (size_t)t * 1024 + lane * 16) = o0; *(v4u*)(QL + (size_t)t * 1024 + lane * 16 + 8) = o1;
        }
    }
#undef SA_LOAD_IDX
#undef SA_IX
#undef SA_LOAD_ROWS
}

__device__ __forceinline__ void p10_cross_attn(Frame& F) {
    const bf16* QC = WSP(bf16, WS_QC); bf16* XO = WSP(bf16, WS_XO); const bf16* Km = WSP(bf16, WS_KMEM); const bf16* Vt = WSP(bf16, WS_VT);
    const int lane = F.lane, g = lane >> 4, c15 = lane & 15;
    constexpr int RS = 528, BUFB = 64 * RS, NU = NB * 4 * 16;
    const int srow = F.tid >> 5, spc = F.tid & 31;
#define X_SRC(u_, c_) ((c_) < 4 ? (const unsigned char*)(Km + ((size_t)((u_) >> 6) * 256 + (c_) * 64 + srow) * 1024 + (((u_) >> 4) & 3) * 256) + spc * 16 \
                               : (const unsigned char*)(Vt + ((size_t)((u_) >> 4) * 256 + ((c_) - 4) * 64 + srow) * 256) + spc * 16)
#define X_LOAD(st_, u_, c_) { const unsigned char* s_ = X_SRC(u_, c_); _Pragma("unroll") for (int j = 0; j < 4; ++j) st_[j] = *(const v4u*)(s_ + (size_t)j * 16 * ((c_) < 4 ? 2048 : 512)); }
#define X_PUT(st_, bi_) { _Pragma("unroll") for (int j = 0; j < 4; ++j) *(LAS v4u*)(F.lds + (bi_) * BUFB + (srow + 16 * j) * RS + spc * 16) = st_[j]; }
#define X_QROW(u_, t_) (QC + ((size_t)((u_) >> 6) * SEQ + ((u_) & 15) * 256 + F.wave * 32 + (t_) * 16 + c15) * 1024 + (((u_) >> 4) & 3) * 256)
    if (F.vcu >= NU) return;
    v4u st0[4], st1[4];
    bf16x8 Bq[2][8];
    {
        const int u = F.vcu;
        X_LOAD(st0, u, 0); X_LOAD(st1, u, 1);
#pragma unroll
        for (int t = 0; t < 2; ++t) { const bf16* qrow = X_QROW(u, t);
#pragma unroll
            for (int ks = 0; ks < 8; ++ks) Bq[t][ks] = *(const bf16x8*)(qrow + ks * 32 + 8 * g); }
        X_PUT(st0, 0);
    }
    for (int u = F.vcu; u < NU; u += F.G) {
        const int un = (u + F.G < NU) ? u + F.G : u;
        bf16x8 pb[2][8]; float mc[2][4], Ls[2] = {0.f, 0.f}, inv[2] = {0.f, 0.f};
#pragma unroll
        for (int cs = 0; cs < 8; ++cs) {
            if (cs & 1) { if (cs + 2 < 8) { X_LOAD(st1, u, cs + 2); } else { X_LOAD(st1, un, cs + 2 - 8); } }
            else        { if (cs + 2 < 8) { X_LOAD(st0, u, cs + 2); } else { X_LOAD(st0, un, cs + 2 - 8); } }
            __syncthreads();
            const LAS unsigned char* buf = F.lds + (cs & 1) * BUFB;
            if (cs < 4) {
                f32x4 acc[2][4];
                bf16x8 Af[2][4];
                const LAS unsigned char* kb = buf + c15 * RS + 16 * g;
#define X_LDK(gi_) { _Pragma("unroll") for (int q = 0; q < 4; ++q) Af[(gi_) & 1][q] = *(const LAS bf16x8*)(kb + ((gi_) >> 1) * 16 * RS + (((gi_) & 1) * 4 + q) * 64); }
                X_LDK(0);
                f32x4 a0 = (f32x4){0.f, 0.f, 0.f, 0.f}, a1 = a0;
#pragma unroll
                for (int gi = 0; gi < 8; ++gi) {
                    if (gi + 1 < 8) X_LDK(gi + 1);
                    __builtin_amdgcn_sched_barrier(0);
                    if (!(gi & 1)) { a0 = (f32x4){0.f, 0.f, 0.f, 0.f}; a1 = a0; }
#pragma unroll
                    for (int q = 0; q < 4; ++q) { a0 = __builtin_amdgcn_mfma_f32_16x16x32_bf16(Af[gi & 1][q], Bq[0][(gi & 1) * 4 + q], a0, 0, 0, 0); a1 = __builtin_amdgcn_mfma_f32_16x16x32_bf16(Af[gi & 1][q], Bq[1][(gi & 1) * 4 + q], a1, 0, 0, 0); }
                    if (gi & 1) { acc[0][gi >> 1] = a0; acc[1][gi >> 1] = a1; }
                    __builtin_amdgcn_sched_barrier(0);
                }
#undef X_LDK
#pragma unroll
                for (int t = 0; t < 2; ++t) {
                    float mx = -1e30f;
#pragma unroll
                    for (int m4 = 0; m4 < 4; ++m4)
#pragma unroll
                        for (int i = 0; i < 4; ++i) mx = fmaxf(mx, acc[t][m4][i]);
                    mx = fmaxf(mx, __shfl_xor(mx, 16)); mx = fmaxf(mx, __shfl_xor(mx, 32));
                    if (cs > 0) mx = fmaxf(mx, mc[t][cs > 0 ? cs - 1 : 0]);
                    float ps = (cs > 0) ? Ls[t] * __expf(mc[t][cs > 0 ? cs - 1 : 0] - mx) : 0.f;
#pragma unroll
                    for (int s2 = 0; s2 < 2; ++s2) { float e[8];
#pragma unroll
                        for (int i = 0; i < 4; ++i) { e[i] = __expf(acc[t][2 * s2][i] - mx); e[4 + i] = __expf(acc[t][2 * s2 + 1][i] - mx); ps += e[i] + e[4 + i]; }
                        const v4u w = (v4u){cvt_pk_bf16(e[0], e[1]), cvt_pk_bf16(e[2], e[3]), cvt_pk_bf16(e[4], e[5]), cvt_pk_bf16(e[6], e[7])}; pb[t][cs * 2 + s2] = __builtin_bit_cast(bf16x8, w); }
                    mc[t][cs] = mx; Ls[t] = ps;
                }
                if (cs == 3) {
#pragma unroll
                    for (int t = 0; t < 2; ++t) {
                        const float M = mc[t][3];
                        float L = Ls[t];
#pragma unroll
                        for (int c = 0; c < 3; ++c) { const float f = __expf(mc[t][c] - M);
#pragma unroll
                            for (int s2 = 0; s2 < 2; ++s2) { const v4u w = __builtin_bit_cast(v4u, pb[t][c * 2 + s2]);
                                const v4u r = (v4u){cvt_pk_bf16(bflo(w.x) * f, bfhi(w.x) * f), cvt_pk_bf16(bflo(w.y) * f, bfhi(w.y) * f), cvt_pk_bf16(bflo(w.z) * f, bfhi(w.z) * f), cvt_pk_bf16(bflo(w.w) * f, bfhi(w.w) * f)};
                                pb[t][c * 2 + s2] = __builtin_bit_cast(bf16x8, r); } }
                        L += __shfl_xor(L, 16); L += __shfl_xor(L, 32);
                        inv[t] = 1.0f / L;
                    }
#pragma unroll
                    for (int t = 0; t < 2; ++t) { const bf16* qn = X_QROW(un, t);
#pragma unroll
                        for (int ks = 0; ks < 8; ++ks) Bq[t][ks] = *(const bf16x8*)(qn + ks * 32 + 8 * g); }
                }
            } else {
                unsigned char* q0 = (unsigned char*)XO + (X_QROW(u, 0) - QC); unsigned char* q1 = (unsigned char*)XO + (X_QROW(u, 1) - QC);
                v4u Vf[2][4];
                const LAS unsigned char* vb = buf + c15 * RS + 8 * g;
#define X_LDV(gi_) { _Pragma("unroll") for (int q = 0; q < 4; ++q) { const LAS unsigned char* p_ = vb + ((gi_) >> 1) * 16 * RS + (((gi_) & 1) * 4 + q) * 64; \
                        const v2u lo = *(const LAS v2u*)p_, hi = *(const LAS v2u*)(p_ + 32); Vf[(gi_) & 1][q] = (v4u){lo.x, lo.y, hi.x, hi.y}; } }
                X_LDV(0);
                f32x4 o0 = (f32x4){0.f, 0.f, 0.f, 0.f}, o1 = o0;
#pragma unroll
                for (int gi = 0; gi < 8; ++gi) {
                    if (gi + 1 < 8) X_LDV(gi + 1);
                    __builtin_amdgcn_sched_barrier(0);
                    if (!(gi & 1)) { o0 = (f32x4){0.f, 0.f, 0.f, 0.f}; o1 = o0; }
#pragma unroll
                    for (int q = 0; q < 4; ++q) { const bf16x8 av = __builtin_bit_cast(bf16x8, Vf[gi & 1][q]);
                        o0 = __builtin_amdgcn_mfma_f32_16x16x32_bf16(av, pb[0][(gi & 1) * 4 + q], o0, 0, 0, 0); o1 = __builtin_amdgcn_mfma_f32_16x16x32_bf16(av, pb[1][(gi & 1) * 4 + q], o1, 0, 0, 0); }
                    if (gi & 1) { const int d4 = gi >> 1;
                        *(unsigned*)(q0 + ((cs - 4) * 4 + d4) * 16 + 4 * g) = pk4_fp8(o0[0] * inv[0], o0[1] * inv[0], o0[2] * inv[0], o0[3] * inv[0]);
                        *(unsigned*)(q1 + ((cs - 4) * 4 + d4) * 16 + 4 * g) = pk4_fp8(o1[0] * inv[1], o1[1] * inv[1], o1[2] * inv[1], o1[3] * inv[1]); }
                    __builtin_amdgcn_sched_barrier(0);
                }
#undef X_LDV
            }
            if (cs & 1) { X_PUT(st0, 0); } else { X_PUT(st1, 1); }
        }
    }
    __syncthreads();
#undef X_SRC
#undef X_LOAD
#undef X_PUT
#undef X_QROW
}

__device__ __forceinline__ void rms_row16(const bf16* xrow, const float* g, bf16* orow, int lane, unsigned char* o8row) {
    const v4u a = *((const v4u*)xrow + 2 * lane), b = *((const v4u*)xrow + 2 * lane + 1);
    float v[16] = {bflo(a.x), bfhi(a.x), bflo(a.y), bfhi(a.y), bflo(a.z), bfhi(a.z), bflo(a.w), bfhi(a.w), bflo(b.x), bfhi(b.x), bflo(b.y), bfhi(b.y), bflo(b.z), bfhi(b.z), bflo(b.w), bfhi(b.w)};
    float s = 0.f;
#pragma unroll
    for (int e = 0; e < 16; ++e) s += v[e] * v[e];
    const float rstd = rsqrtf(wave_sum(s) * (1.f / 1024.f) + 1e-6f);
    const f32x4* gr = (const f32x4*)g + 4 * lane;
#pragma unroll
    for (int q = 0; q < 4; ++q) { const f32x4 gg = gr[q]; v[4 * q] *= rstd * gg[0]; v[4 * q + 1] *= rstd * gg[1]; v[4 * q + 2] *= rstd * gg[2]; v[4 * q + 3] *= rstd * gg[3]; }
    *((v4u*)orow + 2 * lane) = (v4u){cvt_pk_bf16(v[0], v[1]), cvt_pk_bf16(v[2], v[3]), cvt_pk_bf16(v[4], v[5]), cvt_pk_bf16(v[6], v[7])};
    *((v4u*)orow + 2 * lane + 1) = (v4u){cvt_pk_bf16(v[8], v[9]), cvt_pk_bf16(v[10], v[11]), cvt_pk_bf16(v[12], v[13]), cvt_pk_bf16(v[14], v[15])};
    if (o8row) *((v4u*)o8row + lane) = (v4u){pk4_fp8(v[0], v[1], v[2], v[3]), pk4_fp8(v[4], v[5], v[6], v[7]), pk4_fp8(v[8], v[9], v[10], v[11]), pk4_fp8(v[12], v[13], v[14], v[15])};
}
__device__ __forceinline__ void rms_row16_do(const v4u a, const v4u b, const f32x4 (&gv)[4], bf16* orow, int lane, unsigned char* o8row) {
    float v[16] = {bflo(a.x), bfhi(a.x), bflo(a.y), bfhi(a.y), bflo(a.z), bfhi(a.z), bflo(a.w), bfhi(a.w), bflo(b.x), bfhi(b.x), bflo(b.y), bfhi(b.y), bflo(b.z), bfhi(b.z), bflo(b.w), bfhi(b.w)};
    float s = 0.f;
#pragma unroll
    for (int e = 0; e < 16; ++e) s += v[e] * v[e];
    const float rstd = rsqrtf(wave_sum(s) * (1.f / 1024.f) + 1e-6f);
#pragma unroll
    for (int q = 0; q < 4; ++q) { const f32x4 gg = gv[q]; v[4 * q] *= rstd * gg[0]; v[4 * q + 1] *= rstd * gg[1]; v[4 * q + 2] *= rstd * gg[2]; v[4 * q + 3] *= rstd * gg[3]; }
    if (orow) {
        *((v4u*)orow + 2 * lane) = (v4u){cvt_pk_bf16(v[0], v[1]), cvt_pk_bf16(v[2], v[3]), cvt_pk_bf16(v[4], v[5]), cvt_pk_bf16(v[6], v[7])};
        *((v4u*)orow + 2 * lane + 1) = (v4u){cvt_pk_bf16(v[8], v[9]), cvt_pk_bf16(v[10], v[11]), cvt_pk_bf16(v[12], v[13]), cvt_pk_bf16(v[14], v[15])}; }
    if (o8row) *((v4u*)o8row + lane) = (v4u){pk4_fp8(v[0], v[1], v[2], v[3]), pk4_fp8(v[4], v[5], v[6], v[7]), pk4_fp8(v[8], v[9], v[10], v[11]), pk4_fp8(v[12], v[13], v[14], v[15])};
}
__device__ __forceinline__ void p_norm_rows16(Frame& F, const bf16* src, const float* g, bf16* dst, unsigned char* dst8) {
    const int lane = F.lane, step = F.NGW; int m = F.gw;
    if (m >= T) return;
    f32x4 gv[4];
#pragma unroll
    for (int q = 0; q < 4; ++q) gv[q] = *((const f32x4*)g + 4 * lane + q);
#define NR_LD(a_, b_, m_) { const int mm_ = (m_) < T ? (m_) : m; a_ = *((const v4u*)(src + (size_t)mm_ * D) + 2 * lane); b_ = *((const v4u*)(src + (size_t)mm_ * D) + 2 * lane + 1); __builtin_amdgcn_sched_barrier(0); }
#define NR_DO(a_, b_) { if (m < T) { const v4u ca_ = a_, cb_ = b_; NR_LD(a_, b_, m + 3 * step); rms_row16_do(ca_, cb_, gv, dst ? dst + (size_t)m * D : nullptr, lane, dst8 ? dst8 + (size_t)m * D : nullptr); m += step; } }
    v4u a0, b0, a1, b1, a2, b2;
    NR_LD(a0, b0, m); NR_LD(a1, b1, m + step); NR_LD(a2, b2, m + 2 * step);
    while (m < T) { NR_DO(a0, b0); NR_DO(a1, b1); NR_DO(a2, b2); }
#undef NR_LD
#undef NR_DO
}
__device__ __forceinline__ void p_norm_rows(Frame& F, const float* g, bf16* dst, unsigned char* dst8 = nullptr) {
    for (int m = F.gw; m < T; m += F.NGW) rms_row_to_bf16(F.out + (size_t)m * D, g, dst + (size_t)m * D, F.lane, dst8 ? (unsigned*)(dst8 + (size_t)m * D) : nullptr);
}

struct TokInfo { int e0, e1; float g0, g1; };
__device__ __forceinline__ void p14a_route(Frame& F) {
    const float* L = WSP(float, WS_LOGIT); TokInfo* TI = WSP(TokInfo, WS_ROUTE); const float* bg = F.in[29]; const float* be = F.in[31];
    volatile LAS unsigned* lh = (volatile LAS unsigned*)F.lds;
    if (F.tid < 32) lh[F.tid] = 0u;
    __syncthreads();
    const int t = F.vcu * 256 + F.tid;
    if (F.tid < 256) {
        const float* l = L + (size_t)t * 64;
        float gl[4]; int grp = 0; float gm = -1e30f;
#pragma unroll
        for (int i = 0; i < 4; ++i) { gl[i] = l[i] + bg[i]; if (gl[i] > gm) { gm = gl[i]; grp = i; } }
        float gs = 0.f;
#pragma unroll
        for (int i = 0; i < 4; ++i) gs += __expf(gl[i] - gm);
        const float pgrp = 1.0f / gs;
        float el[8];
#pragma unroll
        for (int i = 0; i < 8; ++i) el[i] = l[4 + grp * 8 + i] + be[grp * 8 + i];
        int i0 = 0; float m0 = -1e30f;
#pragma unroll
        for (int i = 0; i < 8; ++i) if (el[i] > m0) { m0 = el[i]; i0 = i; }
        int i1 = 0; float m1 = -1e30f;
#pragma unroll
        for (int i = 0; i < 8; ++i) if (i != i0 && el[i] > m1) { m1 = el[i]; i1 = i; }
        const float p1 = __expf(m1 - m0);
        TokInfo ti; ti.e0 = grp * 8 + i0; ti.e1 = grp * 8 + i1; ti.g0 = pgrp / (1.f + p1); ti.g1 = pgrp * p1 / (1.f + p1);
        TI[t] = ti;
        lds_add((LAS unsigned*)&lh[ti.e0], 1u); lds_add((LAS unsigned*)&lh[ti.e1], 1u);
    }
    __syncthreads();
    if (F.tid < 32 && lh[F.tid]) atomicAdd(F.ctl + CW_CNT + F.tid, lh[F.tid]);
}
__device__ __forceinline__ void moe_tstart(Frame& F, volatile LAS int* tstart) {
    if (F.tid == 0) { int acc = 0; for (int e = 0; e < 32; ++e) { tstart[e] = acc; acc += (int)((__hip_atomic_load(F.ctl + CW_CNT + e, __ATOMIC_RELAXED, __HIP_MEMORY_SCOPE_AGENT) + 255u) >> 8); } tstart[32] = acc; }
    __syncthreads();
}
__device__ __forceinline__ void p14b_slots(Frame& F) {
    const TokInfo* TI = WSP(TokInfo, WS_ROUTE); int* TS = (int*)(F.ws + WS_ROUTE + 1 * MiB); int* stok = (int*)(F.ws + WS_ROUTE + 2 * MiB); float* sgate = (float*)(F.ws + WS_ROUTE + 3 * MiB);
    volatile LAS int* tstart = (volatile LAS int*)(F.lds + MISC_OFF + 256);
    volatile LAS unsigned* lh = (volatile LAS unsigned*)F.lds; volatile LAS unsigned* lbase = lh + 32;
    if (F.tid < 32) lh[F.tid] = 0u;
    moe_tstart(F, tstart);
    const int t = F.vcu * 256 + F.tid; TokInfo ti; unsigned r0 = 0, r1 = 0;
    if (F.tid < 256) { ti = TI[t]; r0 = lds_add((LAS unsigned*)&lh[ti.e0], 1u); r1 = lds_add((LAS unsigned*)&lh[ti.e1], 1u); }
    __syncthreads();
    if (F.tid < 32) lbase[F.tid] = lh[F.tid] ? atomicAdd(F.ctl + CW_FILL + F.tid, lh[F.tid]) : 0u;
    __syncthreads();
    if (F.tid < 256) {
        const int s0 = tstart[ti.e0] * 256 + (int)(lbase[ti.e0] + r0), s1 = tstart[ti.e1] * 256 + (int)(lbase[ti.e1] + r1);
        stok[s0] = t; sgate[s0] = ti.g0; stok[s1] = t; sgate[s1] = ti.g1; TS[2 * t] = s0; TS[2 * t + 1] = s1;
    }
    if (F.vcu < 32) {
        const int e = F.vcu; const int cnt = (int)__hip_atomic_load(F.ctl + CW_CNT + e, __ATOMIC_RELAXED, __HIP_MEMORY_SCOPE_AGENT); const int base = tstart[e] * 256, end = tstart[e + 1] * 256;
        for (int s = base + cnt + F.tid; s < end; s += NTHREADS) { stok[s] = 0; sgate[s] = 0.f; }
    }
}

__device__ __forceinline__ void p17_final(Frame& F) {
    const int* TS = (const int*)(F.ws + WS_ROUTE + 1 * MiB); const bf16* YS = WSP(bf16, WS_YS); const bf16* H2 = WSP(bf16, WS_H2B); const float* gn = F.in[35];
    const int lane = F.lane, step = F.NGW; int m = F.gw;
    if (m >= T) return;
    f32x4 gg[4];
#pragma unroll
    for (int j = 0; j < 4; ++j) gg[j] = *((const f32x4*)gn + lane + 64 * j);
    struct Row { v2u h[4], a[4], c[4]; };
#define FN_IDX(i_, m_) { const int mm_ = (m_) < T ? (m_) : F.gw; i_ = *(const int2*)(TS + 2 * mm_); }
#define FN_LD(r_, i_, m_) { const int mm_ = (m_) < T ? (m_) : F.gw; const v2u* hr = (const v2u*)(H2 + (size_t)mm_ * D) + lane; const v2u* y0 = (const v2u*)(YS + (size_t)i_.x * 1024) + lane; \
        const v2u* y1 = (const v2u*)(YS + (size_t)i_.y * 1024) + lane; _Pragma("unroll") for (int j = 0; j < 4; ++j) { r_.h[j] = hr[64 * j]; r_.a[j] = y0[64 * j]; r_.c[j] = y1[64 * j]; } __builtin_amdgcn_sched_barrier(0); }
    Row r0, r1; int2 i0, i1, j0, j1;
    FN_IDX(i0, m); FN_IDX(i1, m + step);
    FN_LD(r0, i0, m); FN_LD(r1, i1, m + step);
    FN_IDX(j0, m + 2 * step); FN_IDX(j1, m + 3 * step);
#define FN_DO(r_, jn_) { if (m < T) { const Row q_ = r_; const int2 in_ = jn_; FN_LD(r_, in_, m + 2 * step); FN_IDX(jn_, m + 4 * step); \
        f32x4 v[4]; float s = 0.f; \
        _Pragma("unroll") for (int j = 0; j < 4; ++j) { v[j] = (f32x4){bflo(q_.h[j].x), bfhi(q_.h[j].x), bflo(q_.h[j].y), bfhi(q_.h[j].y)}; \
            v[j].x += bflo(q_.a[j].x) + bflo(q_.c[j].x); v[j].y += bfhi(q_.a[j].x) + bfhi(q_.c[j].x); v[j].z += bflo(q_.a[j].y) + bflo(q_.c[j].y); v[j].w += bfhi(q_.a[j].y) + bfhi(q_.c[j].y); \
            s += (v[j].x * v[j].x + v[j].y * v[j].y) + (v[j].z * v[j].z + v[j].w * v[j].w); } \
        const float rstd = rsqrtf(wave_sum(s) * (1.f / 1024.f) + 1e-6f); f32x4* xr = (f32x4*)(F.out + (size_t)m * D) + lane; \
        _Pragma("unroll") for (int j = 0; j < 4; ++j) xr[64 * j] = (f32x4){v[j].x * rstd * gg[j].x, v[j].y * rstd * gg[j].y, v[j].z * rstd * gg[j].z, v[j].w * rstd * gg[j].w}; \
        m += step; } }
    while (m < T) { FN_DO(r0, j0); FN_DO(r1, j1); }
#undef FN_IDX
#undef FN_LD
#undef FN_DO
}

__global__ void __launch_bounds__(NTHREADS, 2) hybrid_fwd(Args args) {
    extern __shared__ __attribute__((aligned(16))) unsigned char lds_raw[];
    cg::grid_group grid = cg::this_grid();
    Frame F;
    F.lds = (LAS unsigned char*)lds_raw; F.MISC = (volatile LAS unsigned*)(F.lds + MISC_OFF);
    F.tid = threadIdx.x; F.lane = F.tid & 63; F.wave = __builtin_amdgcn_readfirstlane(F.tid >> 6);
    F.G = gridDim.x; { const int bx = blockIdx.x; F.vcu = (F.G % 8 == 0) ? (bx % 8) * (F.G / 8) + bx / 8 : bx; }
    F.gw = F.vcu * NWAVES + F.wave; F.NGW = F.G * NWAVES;
    F.in = args.in; F.out = args.out; F.ws = args.ws; F.ctl = (unsigned*)(args.ws + WS_CTL);
    for (int u = F.tid; u < (LDS_BYTES - MISC_OFF) / 4; u += NTHREADS) ((LAS unsigned*)(F.lds + MISC_OFF))[u] = 0u;
    __syncthreads();
    XcdBarrier bar = xcd_barrier_post(F.ctl + CW_BAR, F.MISC + 8);
#ifdef USE_CG_BAR
#define GRID_BAR() grid.sync()
#else
#define GRID_BAR() do { xcd_barrier(bar); asm volatile("" : "+v"(F.tid), "+v"(F.lane)); } while (0)
#endif
    const int c = (int)blockIdx.x;

#ifndef PHASE_MASK
#define PHASE_MASK 0xffffffffu
#endif
#ifndef PROBE_DUP
#define PROBE_DUP 0u
#endif
#define PH(n) for (int _rep = 0; _rep < (((PROBE_DUP) >> (n)) & 1u) + 1; ++_rep) if (PHASE_MASK & (1u << (n)))
#ifdef DIAG_FILL
    {
        const size_t n16 = (WS_END - 2 * MiB) / 16; v4u* p = (v4u*)(F.ws + 2 * MiB);
        for (size_t i = (size_t)F.vcu * NTHREADS + F.tid; i < n16; i += (size_t)F.G * NTHREADS) p[i] = (v4u){0, 0, 0, 0};
        const size_t m16 = ((size_t)T * D * 4) / 16; v4u* q = (v4u*)F.out;
        for (size_t i = (size_t)F.vcu * NTHREADS + F.tid; i < m16; i += (size_t)F.G * NTHREADS) q[i] = (v4u){0, 0, 0, 0};
        grid.sync();
    }
#endif
    PH(0) p0_prologue(F);
    grid.sync();
    asm volatile("" : "+v"(F.tid), "+v"(F.lane));
    PH(1) { pg8::StaticOrder S; S.init(DOP(bf16, DO_XN), WSP(bf16, WS_WIN), T, 1792, 1024, F.G, c);
      EpiMain E{WSP(bf16, WS_ZRKV), WSP(bf16, WS_ZLORA), WSP(bf16, WS_QLAT), WSP(bf16, WS_ZD), WSP(bf16, WS_G), F.in[20]};
      pg8::gemm_phase<EpiMain, pg8::StaticOrder, false>(F.lds, 1024, S, E); }
    PH(1) { pg8::StaticOrder S; S.init(DOP(bf16, DO_XN), WSP(bf16, WS_WIN) + (size_t)2816 * 1024, T, 512, 1024, F.G, c);
      EpiMain E{WSP(bf16, WS_ZRKV), WSP(bf16, WS_ZLORA), WSP(bf16, WS_QLAT), WSP(bf16, WS_ZD), WSP(bf16, WS_G), F.in[20], 11};
      pg8::gemm_phase<EpiMain, pg8::StaticOrder, false>(F.lds, 1024, S, E); }
    PH(1) { pg8::StaticOrder S; S.init(F.ws + WS_XN8, F.ws + WS_WQ8, T, 1024, 512, F.G, c);
      EpiBf16 E{WSP(bf16, WS_QLAT), 1024, 1, 0, 1.0f / 256.f};
      pg8::gemm_phase<EpiBf16, pg8::StaticOrder, false, true>(F.lds, 512, S, E); }
    PH(1) { pg8::SkewOrder S; S.S.init(F.ws + WS_XN8, F.ws + WS_WG8, T, 2048, 512, F.G, c); S.per = 8; S.nlow = (F.G == 256) ? 128 : 0;
      EpiGate8 E{WSP(bf16, WS_G), F.in[20]};
      pg8::gemm_phase<EpiGate8, pg8::SkewOrder, false, true>(F.lds, 512, S, E); }
    PH(2) { pg8::StaticOrder S; S.init(WSP(bf16, WS_MEMN), WSP(bf16, WS_WCKV), NB * 256, 1024, 1024, F.G, c);
      EpiBf16 E{WSP(bf16, WS_KMEM), 1024, 1, 0, 1.0f};
      pg8::gemm_phase<EpiBf16, pg8::StaticOrder, false>(F.lds, 1024, S, E); }
    PH(21) { pg8::StaticOrder S; S.init(WSP(bf16, WS_WCKV) + (size_t)1024 * 1024, WSP(bf16, WS_MEMN), 1024, NB * 256, 1024, F.G, (F.G == 256) ? ((c + 192) & 255) : c);
      EpiBf16 E{WSP(bf16, WS_VT), 256, 0, (size_t)1024 * 256, 1.0f};
      pg8::gemm_phase<EpiBf16, pg8::StaticOrder, false>(F.lds, 1024, S, E); }
    GRID_BAR();
    PH(3) p2_lora_prep(F);
    GRID_BAR();
    PH(4) { pg8::StaticOrder S; S.init(DOP(bf16, DO_ALORA), WSP(bf16, WS_BLORA), T, 1536, 256, F.G, c);
      EpiLora E{DOP(bf16, DO_WAG), F.in[5], F.in[7]};
      pg8::gemm_phase<EpiLora, pg8::StaticOrder, false>(F.lds, 256, S, E); }
    PH(5) p4_indexer(F);
    GRID_BAR();
#ifdef RWKV_CHUNKED
    PH(6) p4_rwkv_chunked(F);
    PH(7) p4_sparse_attn(F);
    GRID_BAR();
#else
    PH(6) p4_scan(F);
    PH(7) p4_sparse_attn(F);
    GRID_BAR();
    PH(22) p5_post(F);
    GRID_BAR();
#endif
    PH(8) { pg8::StaticOrder S; S.init(WSP(bf16, WS_YA), WSP(bf16, WS_WA), T, 1024, 512, F.G, c);
      EpiMix E{WSP(bf16, WS_U), WSP(bf16, WS_G), 0};
      pg8::gemm_phase<EpiMix, pg8::StaticOrder, false>(F.lds, 512, S, E); }
    PH(8) { pg8::StaticOrder S; S.init(WSP(bf16, WS_QLAT), WSP(bf16, WS_WB), T, 1024, 1024, F.G, c);
      EpiMix E{WSP(bf16, WS_U), WSP(bf16, WS_G), 1};
      pg8::gemm_phase<EpiMix, pg8::StaticOrder, false>(F.lds, 1024, S, E); }
    GRID_BAR();
    PH(9) { pg8::StaticOrder S; S.init(WSP(bf16, WS_U), WSP(bf16, WS_WOUT), T, 1024, 1024, F.G, c);
      EpiResB E{F.in[0], nullptr, WSP(bf16, WS_H1B)};
      pg8::gemm_phase<EpiResB, pg8::StaticOrder, false>(F.lds, 1024, S, E); }
    GRID_BAR();
    PH(10) p_norm_rows16(F, WSP(bf16, WS_H1B), F.in[22], nullptr, F.ws + WS_XO);
    GRID_BAR();
    PH(11) { pg8::StaticOrder S; S.init(F.ws + WS_XO, F.ws + WS_WCQ, T, 1024, 512, F.G, c);
      EpiBf16 E{WSP(bf16, WS_QC), 1024, 1, 0, 0.0625f * 0.0625f};
      pg8::gemm_phase<EpiBf16, pg8::StaticOrder, false, true>(F.lds, 512, S, E); }
    GRID_BAR();
    PH(12) p10_cross_attn(F);
    GRID_BAR();
    PH(13) { pg8::StaticOrder S; S.init(F.ws + WS_XO, F.ws + WS_WCO, T, 1024, 512, F.G, c);
      EpiResB E{nullptr, WSP(bf16, WS_H1B), WSP(bf16, WS_H2B), 0.0625f};
      pg8::gemm_phase<EpiResB, pg8::StaticOrder, false, true>(F.lds, 512, S, E); }
    GRID_BAR();
    PH(14) p_norm_rows16(F, WSP(bf16, WS_H2B), F.in[27], WSP(bf16, WS_HN), F.ws + WS_HN8);
    GRID_BAR();
    PH(15) { pg8::StaticOrder S; S.init(WSP(bf16, WS_HN), WSP(bf16, WS_WR), T, 256, 1024, F.G, c);
      EpiLogit E{WSP(float, WS_LOGIT)};
      pg8::gemm_phase<EpiLogit, pg8::StaticOrder, false>(F.lds, 1024, S, E); }
    GRID_BAR();
    PH(16) p14a_route(F);
    GRID_BAR();
    PH(17) p14b_slots(F);
    GRID_BAR();
    { volatile LAS int* tstart = (volatile LAS int*)(F.lds + MISC_OFF + 256);
      const int* stok = (const int*)(F.ws + WS_ROUTE + 2 * MiB); const float* sgate = (const float*)(F.ws + WS_ROUTE + 3 * MiB);
      PH(18) { MoeOrder S{(const char*)(F.ws + WS_HN8), (const char*)(F.ws + WS_WGU), (size_t)1024 * 1024, 512, 4, stok, tstart, F.G, c, true};
        EpiMoe1 E{F.ws + WS_HID};
        pg8::gemm_phase<EpiMoe1, MoeOrder, true, true>(F.lds, 512, S, E); }
      GRID_BAR();
      PH(19) { MoeOrder S{(const char*)(F.ws + WS_HID), (const char*)(F.ws + WS_WD), (size_t)1024 * 512, 256, 4, stok, tstart, F.G, c, false};
        EpiMoe2 E{WSP(bf16, WS_YS), sgate};
        pg8::gemm_phase<EpiMoe2, MoeOrder, false, true>(F.lds, 256, S, E); }
    }
    GRID_BAR();
    PH(20) p17_final(F);
}

extern "C" void kernel_launch(void* const* d_in, const int* in_sizes, int n_in, void* d_out, int out_size, void* d_ws, size_t ws_size, hipStream_t stream) {
    static int grid = 0;
    if (grid == 0) {
        if (n_in != 36 || out_size != T * D || ws_size < WS_END) { fprintf(stderr, "kernel_launch: unexpected shapes (n_in %d out %d ws %zu)\n", n_in, out_size, ws_size); grid = -1; return; }
        int dev = 0, cus = 0, per_cu = 0;
        hipGetDevice(&dev); hipDeviceGetAttribute(&cus, hipDeviceAttributeMultiprocessorCount, dev);
        hipFuncSetAttribute((const void*)hybrid_fwd, hipFuncAttributeMaxDynamicSharedMemorySize, LDS_BYTES);
        hipOccupancyMaxActiveBlocksPerMultiprocessor(&per_cu, (const void*)hybrid_fwd, NTHREADS, LDS_BYTES);
        (void)hipGetLastError();
        if (per_cu < 1) { fprintf(stderr, "kernel_launch: occupancy query says %d blocks per CU\n", per_cu); grid = -1; return; }
        grid = cus;
    }
    if (grid < 0) return;
    hipMemsetAsync((char*)d_ws + WS_CTL, 0, CTL_ZERO_BYTES, stream);
    Args a{};
    for (int i = 0; i < 36; ++i) a.in[i] = (const float*)d_in[i];
    a.out = (float*)d_out; a.ws = (unsigned char*)d_ws;
    void* params[] = {&a};
    hipError_t e = hipLaunchCooperativeKernel((const void*)hybrid_fwd, dim3(grid), dim3(NTHREADS), params, LDS_BYTES, stream);
    if (e != hipSuccess) fprintf(stderr, "kernel_launch: cooperative launch failed: %s (grid %d)\n", hipGetErrorString(e), grid);
}
```

```cpp
#include <hip/hip_runtime.h>
#include <hip/hip_cooperative_groups.h>
#include <cstdio>
#include <cstdint>
namespace cg = cooperative_groups;
#define RWKV_CHUNKED 1
#define PROBE_DUP 0u

#define GAS __attribute__((address_space(1)))
#define LAS __attribute__((address_space(3)))
typedef unsigned short bf16;
typedef unsigned v4u __attribute__((ext_vector_type(4)));
typedef unsigned v2u __attribute__((ext_vector_type(2)));
typedef float f32x4 __attribute__((ext_vector_type(4)));
typedef float f32x2 __attribute__((ext_vector_type(2)));
typedef short bf16x8 __attribute__((ext_vector_type(8)));
typedef short s16x4 __attribute__((ext_vector_type(4)));

constexpr int NB = 16, SEQ = 4096, T = NB * SEQ, D = 1024;
constexpr int NIN = 5376;
constexpr int NWAVES = 8, NTHREADS = 512;
constexpr int PSLOT = 2 * T + 32 * 256;

constexpr size_t MiB = 1u << 20;
constexpr size_t WS_CTL = 0, CTL_ZERO_BYTES = 1 * MiB;
constexpr size_t WS_WIN = 2 * MiB, WS_WA = 13 * MiB, WS_WB = 14 * MiB, WS_WOUT = 16 * MiB, WS_WCQ = 18 * MiB, WS_WCKV = 20 * MiB, WS_WCO = 24 * MiB;
constexpr size_t WS_BLORA = 26 * MiB, WS_WR = 27 * MiB, WS_WGU = 28 * MiB, WS_WD = 92 * MiB;
constexpr size_t WS_MEMN = 124 * MiB, WS_KMEM = 132 * MiB, WS_VT = 140 * MiB;
constexpr size_t WS_ZRKV = 150 * MiB, WS_ZLORA = 342 * MiB, WS_QLAT = 374 * MiB, WS_ZD = 502 * MiB, WS_G = 566 * MiB, WS_CKV = 822 * MiB, WS_IDX = 838 * MiB, WS_YA = 870 * MiB, WS_YC = 934 * MiB;
constexpr size_t WS_H1B = 694 * MiB  , WS_H2B = 218 * MiB  ;
constexpr size_t WS_U = WS_ZRKV, WS_HN = WS_G, WS_QC = WS_QLAT, WS_HN8 = WS_QLAT  , WS_LOGIT = 694 * MiB, WS_ROUTE = 710 * MiB, WS_HID = WS_ZRKV, WS_YS = 714 * MiB, WS_XO = WS_YA  , WS_XN8 = WS_YA  , WS_WG8 = 60 * MiB  , WS_WQ8 = 62 * MiB  , WS_END = 998 * MiB;
constexpr size_t DO_XN = 0, DO_ALORA = 0, DO_WAG = 32 * MiB, DO_SB = 224 * MiB;
constexpr int CW_BAR = 4096, CW_CNT = 1024, CW_FILL = 1088, CW_RK = 2048;

constexpr int RING_BYTES = 131072, MISC_OFF = 8 * 16 * 260 * 4 + 16384  , LDS_BYTES = MISC_OFF + 1024;

typedef __bf16 bf16x2_t __attribute__((ext_vector_type(2)));
__device__ __forceinline__ unsigned cvt_pk_bf16(float lo, float hi) { const f32x2 v = {lo, hi}; const bf16x2_t b = __builtin_convertvector(v, bf16x2_t); return __builtin_bit_cast(unsigned, b); }
typedef int v8i __attribute__((ext_vector_type(8)));
typedef int v4i __attribute__((ext_vector_type(4)));
typedef v8i v8i_a16 __attribute__((aligned(16)));
__device__ __forceinline__ unsigned pk4_fp8(float a, float b, float c, float d) { unsigned w = (unsigned)__builtin_amdgcn_cvt_pk_fp8_f32(a, b, 0, false); return (unsigned)__builtin_amdgcn_cvt_pk_fp8_f32(c, d, (int)w, true); }
__device__ __forceinline__ float bf2f(unsigned b) { return __uint_as_float(b << 16); }
__device__ __forceinline__ float bflo(unsigned w) { return __uint_as_float(w << 16); }
__device__ __forceinline__ float bfhi(unsigned w) { return __uint_as_float(w & 0xffff0000u); }
__device__ __forceinline__ float fsigmoid(float x) { return __builtin_amdgcn_rcpf(1.0f + __expf(-x)); }
__device__ __forceinline__ unsigned lds_add(LAS unsigned* p, unsigned v) { return __hip_atomic_fetch_add(p, v, __ATOMIC_RELAXED, __HIP_MEMORY_SCOPE_WORKGROUP); }
__device__ __forceinline__ float wave_sum(float v) {
#pragma unroll
    for (int o = 1; o < 64; o <<= 1) v += __shfl_xor(v, o);
    return v;
}
__device__ __forceinline__ float dpp_f(float v, const int ctrl_sel) {
    int x = __builtin_bit_cast(int, v), r;
    if (ctrl_sel == 0) r = __builtin_amdgcn_update_dpp(x, x, 0xB1, 0xF, 0xF, false);
    else if (ctrl_sel == 1) r = __builtin_amdgcn_update_dpp(x, x, 0x4E, 0xF, 0xF, false);
    else if (ctrl_sel == 2) r = __builtin_amdgcn_update_dpp(x, x, 0x141, 0xF, 0xF, false);
    else r = __builtin_amdgcn_update_dpp(x, x, 0x140, 0xF, 0xF, false);
    return __builtin_bit_cast(float, r);
}
__device__ __forceinline__ float sum8(float v) {
    v += dpp_f(v, 0); v += dpp_f(v, 1); v += dpp_f(v, 2); return v;
}

#define XB_TMO      128
#define XB_XCNT(j)  (256  + 64 * (j))
#define XB_XSUB(j)  (1280 + 64 * (j))
#define XB_XGEN(j)  (2304 + 64 * (j))
#define XB_TOP      3328
#define XB_TOPGEN   3392
#define XCD_BAR_WORDS 3456
#define XB_SPIN_CAP (1u << 20)
__device__ __forceinline__ unsigned xb_ld(unsigned* p)              { return __hip_atomic_load(p, __ATOMIC_RELAXED, __HIP_MEMORY_SCOPE_AGENT); }
__device__ __forceinline__ unsigned xb_add(unsigned* p, unsigned v) { return __hip_atomic_fetch_add(p, v, __ATOMIC_RELAXED, __HIP_MEMORY_SCOPE_AGENT); }
__device__ __forceinline__ unsigned xb_xcc_id() { return (unsigned)__builtin_amdgcn_s_getreg((3 << 11) | 20) & 0xFu; }
#define XB_SPIN(cond, bar) do { unsigned _sp = 0; while (cond) { __builtin_amdgcn_s_sleep(1); \
    if ((++_sp & 255u) == 0u) { if (xb_ld(&(bar)[XB_TMO])) break; if (_sp > XB_SPIN_CAP) { atomicAdd(&(bar)[XB_TMO], 1u); break; } } } } while (0)
struct XcdBarrier { unsigned* bar; unsigned x; volatile LAS unsigned* st; };
__device__ __forceinline__ XcdBarrier xcd_barrier_post(unsigned* bar, volatile LAS unsigned* st) {
    XcdBarrier b; b.bar = bar; b.x = xb_xcc_id(); b.st = st;
    if (threadIdx.x == 0) (void)xb_add(&bar[XB_XCNT(b.x)], 1u);
    return b;
}
__device__ __forceinline__ void xcd_barrier_complete(unsigned* bar, unsigned x, unsigned& nloc, unsigned& nx) {
    const unsigned G = gridDim.x * gridDim.y * gridDim.z;
    unsigned sum, cnt, mine, sp = 0u;
    for (;;) {
        sum = 0u; cnt = 0u; mine = 0u;
#pragma unroll
        for (unsigned j = 0; j < 16; ++j) { const unsigned c = xb_ld(&bar[XB_XCNT(j)]); sum += c; cnt += (c > 0u) ? 1u : 0u; mine = (j == x) ? c : mine; }
        if (sum == G) break;
        __builtin_amdgcn_s_sleep(1);
        if ((++sp & 255u) == 0u) { if (xb_ld(&bar[XB_TMO])) break; if (sp > XB_SPIN_CAP) { atomicAdd(&bar[XB_TMO], 1u); break; } }
    }
    nloc = mine > 0u ? mine : 1u; nx = cnt > 0u ? cnt : 1u;
}
__device__ __forceinline__ void xcd_barrier(const XcdBarrier& b) {
    asm volatile("s_waitcnt vmcnt(0)" ::: "memory");
    __syncthreads();
    if (threadIdx.x == 0) {
        unsigned* bar = b.bar;
        __builtin_amdgcn_s_waitcnt(0);
        unsigned nloc = b.st[0], nx = b.st[1];
        if (nloc == 0u) { xcd_barrier_complete(bar, b.x, nloc, nx); b.st[0] = nloc; b.st[1] = nx; }
        const unsigned old = xb_add(&bar[XB_XSUB(b.x)], 1u);
        const unsigned gen = old / nloc;
        if (old + 1u == (gen + 1u) * nloc) {
            __builtin_amdgcn_fence(__ATOMIC_RELEASE, "agent");
            asm volatile("s_waitcnt vmcnt(0)" ::: "memory");
            const unsigned og = xb_add(&bar[XB_TOP], 1u);
            const unsigned tg = og / nx;
            if (og + 1u == (tg + 1u) * nx) xb_add(&bar[XB_TOPGEN], 1u);
            else XB_SPIN(xb_ld(&bar[XB_TOPGEN]) == tg, bar);
            __builtin_amdgcn_fence(__ATOMIC_ACQUIRE, "agent");
            xb_add(&bar[XB_XGEN(b.x)], 1u);
            asm volatile("s_waitcnt vmcnt(0)" ::: "memory");
        } else {
            XB_SPIN(xb_ld(&bar[XB_XGEN(b.x)]) == gen, bar);
            __builtin_amdgcn_fence(__ATOMIC_ACQUIRE, "agent");
            asm volatile("s_waitcnt vmcnt(0)" ::: "memory");
        }
    }
    __syncthreads();
}

namespace pg8 {
constexpr int BM = 256, BK = 64, HALF = 128, HTB = HALF * BK * 2, NXCD = 8, WGM = 2;
__host__ __device__ __forceinline__ int lds_byte(int r, int c) { const int st = (r >> 4) * 2 + (c >> 5), rr = r & 15, cc = c & 31, ob = rr * 64 + cc * 2; return st * 1024 + (ob ^ (((ob >> 9) & 1) << 5)); }
__host__ __device__ __forceinline__ void stage_rc(int b, int& R, int& C) { const int st = b / 1024, sb = b % 1024, swz = sb ^ (((sb >> 9) & 1) << 5); R = (st >> 1) * 16 + swz / 64; C = (st & 1) * 32 + (swz % 64) / 2; }
__host__ __device__ __forceinline__ int perm32(int rho) { const int n = rho >> 4, i = rho & 15; return 8 * (i >> 2) + 4 * n + (i & 3); }

struct Unit { int pm, pn; const char* a; const char* b; const int* gidx; };

struct StaticOrder {
    const char* A; const char* Bt; int K; int nM, nN, nwg, G, c;
    __device__ void init(const void* A_, const void* Bt_, int M, int N, int K_, int G_, int c_) { A = (const char*)A_; Bt = (const char*)Bt_; K = K_; nM = M / BM; nN = N / BM; nwg = nM * nN; G = G_; c = c_; }
    __device__ bool next(int i, Unit& u) const { return nextL((long)i * G + c, u); }
    __device__ bool nextL(const long L, Unit& u) const {
        if (L >= nwg) return false;
        int wgid = (int)L; { const int q = nwg / NXCD, r = nwg % NXCD, xcd = wgid % NXCD, off = wgid / NXCD; wgid = (xcd < r ? xcd * (q + 1) : r * (q + 1) + (xcd - r) * q) + off; }
        const int nig = WGM * nN, gid = wgid / nig, fm = gid * WGM, gsz = (nM - fm) < WGM ? (nM - fm) : WGM;
        u.pm = fm + ((wgid % nig) % gsz); u.pn = (wgid % nig) / gsz;
        u.a = A + (size_t)u.pm * 256 * K * 2; u.b = Bt + (size_t)u.pn * 256 * K * 2; u.gidx = nullptr; return true;
    }
};

struct SkewOrder {
    StaticOrder S; int per, nlow;
    __device__ bool next(int i, Unit& u) const {
        const int c = S.c, G = S.G;
        if (i < per - 1) return S.nextL((long)i * G + c, u);
        if (c < nlow) return false;
        if (i == per - 1) return S.nextL((long)(per - 1) * G + c, u);
        if (i == per && c < 2 * nlow) return S.nextL((long)(per - 1) * G + (c - nlow), u);
        return false;
    }
};

template <class Epi, class Sched, bool GATHER, bool F8 = false>
__device__ __forceinline__ void gemm_phase(LAS unsigned char* lds, const int K_, const Sched& S, const Epi& E) {
    int K = K_; asm volatile("" : "+s"(K));
    int tid = threadIdx.x; asm volatile("" : "+v"(tid));
    const int wid = __builtin_amdgcn_readfirstlane(tid >> 6), lane = tid & 63, wr = wid >> 2, wc = wid & 3, fr = lane & 15, fq = lane >> 4;
    const int nt = K / BK;
    const size_t kstep = (size_t)(BK * 2);
    const size_t hstep = (size_t)HALF * K * 2;
    int stR[2], stC[2];
    unsigned voffB[2], cvo[2][2], nvo[2][2];
#pragma unroll
    for (int i = 0; i < 2; ++i) { int R, C; stage_rc(tid * 16 + i * 8192, R, C); stR[i] = R; stC[i] = C; const int Rb = Epi::PERM ? ((R & ~31) + perm32(R & 31)) : R;
        voffB[i] = (unsigned)(Rb * K + C) * 2u;
        cvo[0][i] = (unsigned)(R * K + C) * 2u; cvo[1][i] = cvo[0][i] + (unsigned)hstep; nvo[0][i] = cvo[0][i]; nvo[1][i] = cvo[1][i]; }
    const unsigned ldsw = (unsigned)wid * 1024u;
    const int aoff = F8 ? lds_byte(wr * 64 + fr, fq * 16) : lds_byte(wr * 64 + fr, fq * 8), boff = F8 ? lds_byte(wc * 32 + fr, fq * 16) : lds_byte(wc * 32 + fr, fq * 8);
#define PG8_SA(b, h) (((b) * 2 + (h)) * HTB)
#define PG8_SB(b, h) ((4 + (b) * 2 + (h)) * HTB)
#define PG8_STAGE(bufoff, gbase, voff) do { _Pragma("unroll") for (int _i = 0; _i < 2; ++_i) \
        __builtin_amdgcn_global_load_lds((const unsigned*)((const char*)(gbase) + (voff)[_i]), (LAS unsigned*)(lds + (bufoff) + ldsw + _i * 8192), 16, 0, 0); } while (0)
#define PG8_LDA(dst, b, h) do { if constexpr (F8) { _Pragma("unroll") for (int m = 0; m < 4; ++m) dst##8[m] = *(const LAS v8i_a16*)(lds + PG8_SA(b, h) + aoff + m * 2048); } \
    else { _Pragma("unroll") for (int m = 0; m < 4; ++m) _Pragma("unroll") for (int k = 0; k < 2; ++k) dst[m][k] = *(const LAS bf16x8*)(lds + PG8_SA(b, h) + aoff + m * 2048 + k * 1024); } } while (0)
#define PG8_LDB(dst, b, h) do { if constexpr (F8) { _Pragma("unroll") for (int n = 0; n < 2; ++n) dst##8[n] = *(const LAS v8i_a16*)(lds + PG8_SB(b, h) + boff + n * 2048); } \
    else { _Pragma("unroll") for (int n = 0; n < 2; ++n) _Pragma("unroll") for (int k = 0; k < 2; ++k) dst[n][k] = *(const LAS bf16x8*)(lds + PG8_SB(b, h) + boff + n * 2048 + k * 1024); } } while (0)
#define PG8_MMA(ai, bj, At, Bt) do { __builtin_amdgcn_s_setprio(1); if constexpr (F8) { _Pragma("unroll") for (int m = 0; m < 4; ++m) _Pragma("unroll") for (int n = 0; n < 2; ++n) { \
            asm volatile("v_mfma_scale_f32_16x16x128_f8f6f4 %0, %1, %2, %0, %3, %3 op_sel_hi:[0,0,0]" : "+v"(acc[ai][bj][m][n]) : "v"(Bt##8[n]), "v"(At##8[m]), "v"(f8one)); } } \
        else { _Pragma("unroll") for (int m = 0; m < 4; ++m) _Pragma("unroll") for (int n = 0; n < 2; ++n) _Pragma("unroll") for (int k = 0; k < 2; ++k) \
        acc[ai][bj][m][n] = __builtin_amdgcn_mfma_f32_16x16x32_bf16(Bt[n][k], At[m][k], acc[ai][bj][m][n], 0, 0, 0); } __builtin_amdgcn_s_setprio(0); } while (0)
#define PG8_WAIT_V(n) asm volatile("s_waitcnt vmcnt(" #n ")" ::: "memory")
#define PG8_WAIT_L(n) asm volatile("s_waitcnt lgkmcnt(" #n ")" ::: "memory")
#define PG8_BAR __builtin_amdgcn_s_barrier()
#define PG8_SCHED __builtin_amdgcn_sched_barrier(0)
    Unit cur, nxt; int ui = 0;
    if (!S.next(0, cur)) return;
    if constexpr (GATHER) {
#pragma unroll
        for (int h = 0; h < 2; ++h)
#pragma unroll
            for (int i = 0; i < 2; ++i) cvo[h][i] = (unsigned)(cur.gidx[h * HALF + stR[i]] * K + stC[i]) * 2u;
    }
    f32x4 acc[2][2][4][2];
#pragma unroll
    for (int a = 0; a < 2; ++a)
#pragma unroll
        for (int b = 0; b < 2; ++b)
#pragma unroll
            for (int m = 0; m < 4; ++m)
#pragma unroll
                for (int n = 0; n < 2; ++n) acc[a][b][m][n] = (f32x4){0.f, 0.f, 0.f, 0.f};
    bf16x8 At[4][2], B0[2][2], B1[2][2]; v8i At8[4], B08[2], B18[2];
    const int f8one = 0x7f7f7f7f;
    const char* cA = cur.a; const char* cB = cur.b;
    PG8_STAGE(PG8_SB(0, 0), cB, voffB); PG8_STAGE(PG8_SB(0, 1), cB + hstep, voffB); PG8_STAGE(PG8_SA(0, 0), cA, cvo[0]); PG8_STAGE(PG8_SA(0, 1), cA, cvo[1]);
    if (wr == 1) PG8_BAR;
    PG8_WAIT_V(2); PG8_BAR;
    PG8_STAGE(PG8_SB(1, 0), cB + kstep, voffB); PG8_STAGE(PG8_SA(1, 0), cA + kstep, cvo[0]); PG8_STAGE(PG8_SB(1, 1), cB + hstep + kstep, voffB);
    PG8_WAIT_V(6); PG8_BAR;
    for (;;) {
        const bool has_next = S.next(ui + 1, nxt);
        const char* nA = has_next ? nxt.a : cA; const char* nB = has_next ? nxt.b : cB;
        if constexpr (GATHER) {
            if (has_next) {
#pragma unroll
                for (int h = 0; h < 2; ++h)
#pragma unroll
                    for (int i = 0; i < 2; ++i) nvo[h][i] = (unsigned)(nxt.gidx[h * HALF + stR[i]] * K + stC[i]) * 2u;
            } else {
#pragma unroll
                for (int h = 0; h < 2; ++h)
#pragma unroll
                    for (int i = 0; i < 2; ++i) nvo[h][i] = cvo[h][i];
            }
        }
        for (int t = 0; t < nt; t += 2) {
            const bool last = (t == nt - 2);
            const char* a1 = cA + (size_t)(t + 1) * kstep;
            const char* a2 = last ? nA : cA + (size_t)(t + 2) * kstep; const char* b2 = last ? nB : cB + (size_t)(t + 2) * kstep;
            const char* a3 = a2 + kstep; const char* b3 = b2 + kstep;
            unsigned v2[2][2];
#pragma unroll
            for (int h = 0; h < 2; ++h)
#pragma unroll
                for (int i = 0; i < 2; ++i) v2[h][i] = (GATHER && last) ? nvo[h][i] : cvo[h][i];
            PG8_LDB(B0, 0, 0); PG8_LDB(B1, 0, 1); PG8_SCHED; PG8_LDA(At, 0, 0); PG8_STAGE(PG8_SA(1, 1), a1, cvo[1]);
            PG8_WAIT_V(8); PG8_WAIT_L(0); PG8_BAR; PG8_MMA(0, 0, At, B0); PG8_MMA(0, 1, At, B1); PG8_BAR; PG8_SCHED;
            PG8_LDA(At, 0, 1); PG8_STAGE(PG8_SB(0, 0), b2, voffB); PG8_STAGE(PG8_SB(0, 1), b2 + hstep, voffB); PG8_STAGE(PG8_SA(0, 0), a2, v2[0]);
            PG8_WAIT_V(8); PG8_WAIT_L(0); PG8_BAR; PG8_MMA(1, 0, At, B0); PG8_MMA(1, 1, At, B1); PG8_BAR; PG8_SCHED;
            PG8_LDB(B0, 1, 0); PG8_LDB(B1, 1, 1); PG8_SCHED; PG8_LDA(At, 1, 0); PG8_STAGE(PG8_SA(0, 1), a2, v2[1]);
            PG8_WAIT_V(8); PG8_WAIT_L(0); PG8_BAR; PG8_MMA(0, 0, At, B0); PG8_MMA(0, 1, At, B1); PG8_BAR; PG8_SCHED;
            PG8_LDA(At, 1, 1); PG8_STAGE(PG8_SB(1, 0), b3, voffB); PG8_STAGE(PG8_SB(1, 1), b3 + hstep, voffB); PG8_STAGE(PG8_SA(1, 0), a3, v2[0]);
            PG8_WAIT_V(8); PG8_WAIT_L(0); PG8_BAR; PG8_MMA(1, 0, At, B0); PG8_MMA(1, 1, At, B1); PG8_BAR; PG8_SCHED;
        }
        if (wr == 0) PG8_BAR;
        if constexpr (F8) asm volatile("s_nop 15\n\ts_nop 15" ::: "memory");
        E(acc, cur, wr, wc, fr, fq);
        if (!has_next) break;
#pragma unroll
        for (int a = 0; a < 2; ++a)
#pragma unroll
            for (int b = 0; b < 2; ++b)
#pragma unroll
                for (int m = 0; m < 4; ++m)
#pragma unroll
                    for (int n = 0; n < 2; ++n) acc[a][b][m][n] = (f32x4){0.f, 0.f, 0.f, 0.f};
        cur = nxt; cA = nA; cB = nB; ++ui;
        if constexpr (GATHER) {
#pragma unroll
            for (int h = 0; h < 2; ++h)
#pragma unroll
                for (int i = 0; i < 2; ++i) cvo[h][i] = nvo[h][i];
        }
        if (wr == 1) PG8_BAR;
    }
    PG8_WAIT_V(0);
    PG8_BAR;
#undef PG8_SA
#undef PG8_SB
#undef PG8_STAGE
#undef PG8_LDA
#undef PG8_LDB
#undef PG8_MMA
#undef PG8_WAIT_V
#undef PG8_WAIT_L
#undef PG8_BAR
#undef PG8_SCHED
}
}
using pg8::Unit;

struct Args { const float* in[36]; float* out; unsigned char* ws; };
struct Frame {
    LAS unsigned char* lds; volatile LAS unsigned* MISC; unsigned* ctl;
    int tid, lane, wave, vcu, G, gw, NGW;
    const float* const* in; float* out; unsigned char* ws;
};
#define WSP(T_, off) ((T_*)(F.ws + (off)))
#define DOP(T_, off) ((T_*)((unsigned char*)F.out + (off)))

struct XArg { const float* W; int ldw, col0; bf16* WT; int ldt, row_off, kdst, kb, nb; float f8scale; };
__device__ __forceinline__ void xpose_load(const XArg& x, int lane, f32x4 (&r)[8]) {
    const float* p = x.W + (size_t)(64 * x.kb + (lane >> 3)) * x.ldw + x.col0 + 32 * x.nb + 4 * (lane & 7);
#pragma unroll
    for (int i = 0; i < 8; ++i) r[i] = *(const f32x4*)(p + (size_t)(8 * i) * x.ldw);
    __builtin_amdgcn_sched_barrier(0);
}
__device__ __forceinline__ void xpose_store(const XArg& x, int lane, const f32x4 (&r)[8], LAS float* scr) {
    const int k0 = 64 * x.kb, n0 = 32 * x.nb;
#pragma unroll
    for (int i = 0; i < 8; ++i) { LAS float* d = scr + (8 * i + (lane >> 3)) * 33 + 4 * (lane & 7); d[0] = r[i].x; d[1] = r[i].y; d[2] = r[i].z; d[3] = r[i].w; }
    asm volatile("s_waitcnt lgkmcnt(0)" ::: "memory");
    const int c = lane & 7; const float f8scale = x.f8scale; bf16* WT = x.WT;
#pragma unroll
    for (int j = 0; j < 4; ++j) { const int n = (lane >> 3) + 8 * j; const LAS float* s = scr + (8 * c) * 33 + n;
        if (f8scale != 0.f) *(v2u*)((unsigned char*)WT + (size_t)(x.row_off + n0 + n) * x.ldt + x.kdst + k0 + 8 * c) = (v2u){pk4_fp8(s[0 * 33] * f8scale, s[1 * 33] * f8scale, s[2 * 33] * f8scale, s[3 * 33] * f8scale), pk4_fp8(s[4 * 33] * f8scale, s[5 * 33] * f8scale, s[6 * 33] * f8scale, s[7 * 33] * f8scale)};
        else { v4u o; o.x = cvt_pk_bf16(s[0 * 33], s[1 * 33]); o.y = cvt_pk_bf16(s[2 * 33], s[3 * 33]); o.z = cvt_pk_bf16(s[4 * 33], s[5 * 33]); o.w = cvt_pk_bf16(s[6 * 33], s[7 * 33]);
            *(v4u*)(WT + (size_t)(x.row_off + n0 + n) * x.ldt + x.kdst + k0 + 8 * c) = o; } }
    asm volatile("s_waitcnt lgkmcnt(0)" ::: "memory");
}
template <class GetArg>
__device__ __forceinline__ void xpose_pipe(Frame& F, int nit, GetArg getarg) {
    LAS float* scr = (LAS float*)(F.lds + F.wave * 16384);
    const int lane = F.lane, step = F.NGW; int it = F.gw;
    if (it >= nit) return;
    f32x4 A[8], B[8];
    XArg aA = getarg(it), aB = getarg(it + step < nit ? it + step : it);
    xpose_load(aA, lane, A); xpose_load(aB, lane, B);
#define XP_DO(S_, a_) { if (it < nit) { f32x4 c_[8]; _Pragma("unroll") for (int i = 0; i < 8; ++i) c_[i] = S_[i]; const XArg ca_ = a_; const int itn_ = it + 2 * step; \
        a_ = getarg(itn_ < nit ? itn_ : it); xpose_load(a_, lane, S_); xpose_store(ca_, lane, c_, scr); it += step; } }
    while (it < nit) { XP_DO(A, aA); XP_DO(B, aB); }
#undef XP_DO
}
__device__ __forceinline__ void xpose_job(Frame& F, const float* W, int ldw, int col0, int K, int N, bf16* WT, int ldt, int row_off, int kdst) {
    const int nblk = N / 32, nit = (K / 64) * nblk;
    xpose_pipe(F, nit, [&](int it) { return XArg{W, ldw, col0, WT, ldt, row_off, kdst, it / nblk, it % nblk, 0.f}; });
}
__device__ __forceinline__ void rms_row_to_bf16(const float* xrow, const float* g, bf16* orow, int lane, unsigned* o8row = nullptr) {
    const f32x4* xr = (const f32x4*)xrow + lane; const f32x4* gr = (const f32x4*)g + lane;
    f32x4 v[4]; float s = 0.f;
#pragma unroll
    for (int j = 0; j < 4; ++j) { v[j] = xr[64 * j]; s += (v[j].x * v[j].x + v[j].y * v[j].y) + (v[j].z * v[j].z + v[j].w * v[j].w); }
    const float rstd = rsqrtf(wave_sum(s) * (1.f / 1024.f) + 1e-6f);
    v2u* o8 = (v2u*)orow + lane;
#pragma unroll
    for (int j = 0; j < 4; ++j) { const f32x4 gg = gr[64 * j]; v2u o; o.x = cvt_pk_bf16(v[j].x * rstd * gg.x, v[j].y * rstd * gg.y); o.y = cvt_pk_bf16(v[j].z * rstd * gg.z, v[j].w * rstd * gg.w); o8[64 * j] = o;
        if (o8row) o8row[64 * j + lane] = pk4_fp8(v[j].x * rstd * gg.x, v[j].y * rstd * gg.y, v[j].z * rstd * gg.z, v[j].w * rstd * gg.w); }
}

__device__ __forceinline__ void p0_prologue(Frame& F) {
    const float* w_in = F.in[3];
    bf16* WinT = WSP(bf16, WS_WIN);
    {
        struct Job { const float* W; int ldw, col0; void* WT; int ldt, row_off, kdst, nblk, nit; float f8; };
        const Job jobs[13] = {
            {w_in, 4804, 0, WinT, 1024, 0, 0, 56, 16 * 56, 0.f},
            {w_in, 4804, 2304, WinT, 1024, 2816, 0, 4, 16 * 4, 0.f},
            {w_in, 4804, 2688, WinT, 1024, 2816 + 128, 0, 2, 16 * 2, 0.f},
            {w_in, 4804, 2432, WinT, 1024, 2816 + 256, 0, 8, 16 * 8, 0.f},
            {w_in, 4804, 2756, F.ws + WS_WG8, 1024, 0, 0, 64, 16 * 64, 16.f},
            {F.in[18], 1024, 0, F.ws + WS_WA, 512, 0, 0, 32, 8 * 32, 0.f},
            {F.in[21], 1024, 0, F.ws + WS_WOUT, 1024, 0, 0, 32, 16 * 32, 0.f},
            {F.in[24], 1024, 0, F.ws + WS_WCQ, 1024, 0, 0, 32, 16 * 32, 16.f},
            {F.in[25], 2048, 0, F.ws + WS_WCKV, 1024, 0, 0, 64, 16 * 64, 0.f},
            {F.in[26], 1024, 0, F.ws + WS_WCO, 1024, 0, 0, 32, 16 * 32, 16.f},
            {F.in[6], 512, 0, F.ws + WS_BLORA, 256, 0, 0, 16, 1 * 16, 0.f},
            {F.in[8], 512, 0, F.ws + WS_BLORA, 256, 512, 64, 16, 1 * 16, 0.f},
            {F.in[9], 512, 0, F.ws + WS_BLORA, 256, 1024, 128, 16, 2 * 16, 0.f}};
        constexpr int NGU = 32 * 2 * 16 * 16, NDN = 32 * 8 * 32;
        int nsmall = 0;
#pragma unroll
        for (int j = 0; j < 13; ++j) nsmall += jobs[j].nit;
        xpose_pipe(F, NGU + NDN + nsmall, [&](int it) {
            if (it < NGU) {
                const int nb = it & 15, kb = (it >> 4) & 15, which = (it >> 8) & 1, e = it >> 9;
                const float* W = (which ? F.in[33] : F.in[32]) + (size_t)e * 1024 * 512;
                const int n0 = 32 * nb, drow = 256 * (n0 >> 7) + (n0 & 127) + 128 * which;
                return XArg{W, 512, 0, (bf16*)(F.ws + WS_WGU + (size_t)e * 1024 * 1024), 1024, drow - n0, 0, kb, nb, 16.f}; }
            it -= NGU;
            if (it < NDN) {
                const int nb = it & 31, kb = (it >> 5) & 7, e = it >> 8;
                return XArg{F.in[34] + (size_t)e * 512 * 1024, 1024, 0, (bf16*)(F.ws + WS_WD + (size_t)e * 1024 * 512), 512, 0, 0, kb, nb, 16.f}; }
            it -= NDN;
            XArg r = XArg{jobs[12].W, jobs[12].ldw, jobs[12].col0, (bf16*)jobs[12].WT, jobs[12].ldt, jobs[12].row_off, jobs[12].kdst, 0, 0, jobs[12].f8}; int nblk = jobs[12].nblk, loc = it;
            int acc = 0; bool found = false;
#pragma unroll
            for (int j = 0; j < 13; ++j) { const bool here = !found && it < acc + jobs[j].nit;
                if (here) { r = XArg{jobs[j].W, jobs[j].ldw, jobs[j].col0, (bf16*)jobs[j].WT, jobs[j].ldt, jobs[j].row_off, jobs[j].kdst, 0, 0, jobs[j].f8}; nblk = jobs[j].nblk; loc = it - acc; found = true; }
                acc += jobs[j].nit; }
            r.kb = loc / nblk; r.nb = loc % nblk; return r; });
    }
    const int gt = F.vcu * NTHREADS + F.tid, NGT = F.G * NTHREADS;
    for (int i = gt; i < 64 * 1024; i += NGT) { const int n = i >> 10, k = i & 1023; WinT[(size_t)(2816 + 192 + n) * 1024 + k] = (n < 4) ? (bf16)(cvt_pk_bf16(w_in[(size_t)k * 4804 + 2752 + n], 0.f) & 0xffff) : (bf16)0; }
    { bf16* BL = WSP(bf16, WS_BLORA);
      for (int i = gt; i < 1536 * 256; i += NGT) { const int n = i >> 8, k = i & 255; const int seg = n >> 9; const bool diag = (seg == 0) ? (k < 64) : (seg == 1) ? (k >= 64 && k < 128) : (k >= 128); if (!diag) BL[i] = 0; } }
    { bf16* WR = WSP(bf16, WS_WR);
      for (int i = gt; i < 256 * 1024; i += NGT) { const int n = i >> 10, k = i & 1023; float v = 0.f; if (n < 4) v = F.in[28][k * 4 + n]; else if (n < 36) v = F.in[30][k * 32 + (n - 4)]; WR[i] = (bf16)(cvt_pk_bf16(v, 0.f) & 0xffff); } }
    for (int task = F.vcu; task < 256; task += F.G) {
        const bool isq = task < 128; const int h = (task >> 4) & 7, chunk = task & 15;
        LAS float* sw = (LAS float*)F.lds;
        const float* src = isq ? F.in[16] : F.in[17]; const float* wpb = F.in[19]; bf16* WbT = WSP(bf16, WS_WB);
        __syncthreads();
        for (int i = F.tid; i < 128 * 16; i += NTHREADS) { const int r = i >> 4, q = i & 15; *(LAS f32x4*)(sw + r * 64 + q * 4) = *(const f32x4*)(src + (size_t)r * 512 + h * 64 + q * 4); }
        __syncthreads();
        const int idx = chunk * 64 + F.lane;
        float a[64];
        if (isq) {
#pragma unroll
            for (int q = 0; q < 16; ++q) { const f32x4 t4 = *(const f32x4*)(w_in + (size_t)idx * 4804 + 1792 + h * 64 + 4 * q); a[4 * q] = t4[0]; a[4 * q + 1] = t4[1]; a[4 * q + 2] = t4[2]; a[4 * q + 3] = t4[3]; }
        } else {
            const float* p = wpb + (size_t)(h * 64) * 1024 + idx;
#pragma unroll
            for (int g4 = 0; g4 < 8; ++g4) {
#pragma unroll
                for (int d = 0; d < 8; ++d) a[8 * g4 + d] = p[(size_t)(8 * g4 + d) * 1024];
                __builtin_amdgcn_sched_barrier(0); }
        }
#pragma unroll 1
        for (int r0 = F.wave * 16; r0 < F.wave * 16 + 16; r0 += 2) { float o[2];
#pragma unroll
            for (int rr = 0; rr < 2; ++rr) { const LAS f32x4* b4 = (const LAS f32x4*)(sw + (r0 + rr) * 64); float s0 = 0.f, s1 = 0.f;
#pragma unroll
                for (int q = 0; q < 16; q += 2) { const f32x4 b0 = b4[q], b1 = b4[q + 1];
                    s0 += a[4 * q] * b0[0] + a[4 * q + 1] * b0[1] + a[4 * q + 2] * b0[2] + a[4 * q + 3] * b0[3]; s1 += a[4 * q + 4] * b1[0] + a[4 * q + 5] * b1[1] + a[4 * q + 6] * b1[2] + a[4 * q + 7] * b1[3]; }
                o[rr] = s0 + s1; __builtin_amdgcn_sched_barrier(0); }
            if (isq) {
#pragma unroll
                for (int rr = 0; rr < 2; ++rr) (F.ws + WS_WQ8)[(size_t)(h * 128 + r0 + rr) * 1024 + idx] = (unsigned char)(pk4_fp8(o[rr] * (0.125f * 256.f), 0.f, 0.f, 0.f) & 0xffu);
            } else *(unsigned*)(WbT + (size_t)idx * 1024 + h * 128 + r0) = cvt_pk_bf16(o[0], o[1]);
        }
    }
    __syncthreads();
    {
        const int lane = F.lane, step = F.NGW; const float* x = F.in[0]; bf16* xn = DOP(bf16, DO_XN);
        f32x4 gg[4], v0[4], v1[4];
#pragma unroll
        for (int j = 0; j < 4; ++j) gg[j] = *((const f32x4*)F.in[2] + lane + 64 * j);
        int m = F.gw;
#define XN_LD(v_, m_) { const int mm_ = (m_) < T ? (m_) : F.gw; _Pragma("unroll") for (int j = 0; j < 4; ++j) v_[j] = *((const f32x4*)(x + (size_t)mm_ * D) + lane + 64 * j); __builtin_amdgcn_sched_barrier(0); }
#define XN_DO(v_) { if (m < T) { f32x4 c_[4]; _Pragma("unroll") for (int j = 0; j < 4; ++j) c_[j] = v_[j]; XN_LD(v_, m + 2 * step); float s = 0.f; \
            _Pragma("unroll") for (int j = 0; j < 4; ++j) s += (c_[j].x * c_[j].x + c_[j].y * c_[j].y) + (c_[j].z * c_[j].z + c_[j].w * c_[j].w); \
            const float rstd = rsqrtf(wave_sum(s) * (1.f / 1024.f) + 1e-6f); v2u* o8 = (v2u*)(xn + (size_t)m * D) + lane; \
            unsigned* q8 = (unsigned*)(F.ws + WS_XN8 + (size_t)m * D) + lane; \
            _Pragma("unroll") for (int j = 0; j < 4; ++j) { const float y0 = c_[j].x * rstd * gg[j].x, y1 = c_[j].y * rstd * gg[j].y, y2 = c_[j].z * rstd * gg[j].z, y3 = c_[j].w * rstd * gg[j].w; \
                v2u o; o.x = cvt_pk_bf16(y0, y1); o.y = cvt_pk_bf16(y2, y3); o8[64 * j] = o; q8[64 * j] = pk4_fp8(y0, y1, y2, y3); } \
            m += step; } }
        if (m < T) {
            XN_LD(v0, m); XN_LD(v1, m + step);
            while (m < T) { XN_DO(v0); XN_DO(v1); }
        }
#undef XN_LD
#undef XN_DO
    }
    for (int m = F.gw; m < NB * 256; m += F.NGW) rms_row_to_bf16(F.in[1] + (size_t)m * D, F.in[23], WSP(bf16, WS_MEMN) + (size_t)m * D, F.lane);
}

#define EPI_LOOP_PERM(...) \
    _Pragma("unroll") for (int ai = 0; ai < 2; ++ai) _Pragma("unroll") for (int m = 0; m < 4; ++m) { const int row = u.pm * 256 + ai * 128 + wr * 64 + m * 16 + fr; \
        _Pragma("unroll") for (int bj = 0; bj < 2; ++bj) { const int ct = bj * 128 + wc * 32 + 8 * fq;   f32x4 v0 = acc[ai][bj][m][0], v1 = acc[ai][bj][m][1]; __VA_ARGS__ } }
#define PACK8(v0, v1) ((v4u){cvt_pk_bf16((v0)[0], (v0)[1]), cvt_pk_bf16((v0)[2], (v0)[3]), cvt_pk_bf16((v1)[0], (v1)[1]), cvt_pk_bf16((v1)[2], (v1)[3])})

struct EpiMain {
    static constexpr bool PERM = true;
    bf16 *Zrkv, *Zlora, *QLAT, *Zd, *G; const float* b_gate; int pn_off = 0;
    __device__ __forceinline__ void operator()(const f32x4 (&acc)[2][2][4][2], const Unit& u, int wr, int wc, int fr, int fq) const {
        const int pn = u.pn + pn_off; bf16* base; int ldc, c0; bool act = false;
        if (pn < 6) { base = Zrkv; ldc = 1536; c0 = pn * 256; }
        else if (pn == 6) { base = Zlora; ldc = 256; c0 = 0; }
        else if (pn < 11) { base = QLAT; ldc = 1024; c0 = (pn - 7) * 256; }
        else if (pn < 13) { base = Zd; ldc = 512; c0 = (pn - 11) * 256; }
        else { base = G; ldc = 2048; c0 = (pn - 13) * 256; act = true; }
        if (act) {
            f32x4 bg[2][2];
#pragma unroll
            for (int bj = 0; bj < 2; ++bj) { const int ct = bj * 128 + wc * 32 + 8 * fq; bg[bj][0] = *(const f32x4*)(b_gate + c0 + ct); bg[bj][1] = *(const f32x4*)(b_gate + c0 + ct + 4); }
            EPI_LOOP_PERM(
_Pragma("unroll")
                for (int e = 0; e < 4; ++e) { v0[e] = fsigmoid(v0[e] + bg[bj][0][e]); v1[e] = fsigmoid(v1[e] + bg[bj][1][e]); }
                *(v4u*)(base + (size_t)row * ldc + c0 + ct) = PACK8(v0, v1);
            )
        } else {
            EPI_LOOP_PERM(
                *(v4u*)(base + (size_t)row * ldc + c0 + ct) = PACK8(v0, v1);
            )
        }
    }
};
struct EpiGate8 {
    static constexpr bool PERM = true;
    bf16* G; const float* b_gate;
    __device__ __forceinline__ void operator()(const f32x4 (&acc)[2][2][4][2], const Unit& u, int wr, int wc, int fr, int fq) const {
        const int c0 = u.pn * 256;
        f32x4 bg[2][2];
#pragma unroll
        for (int bj = 0; bj < 2; ++bj) { const int ct = bj * 128 + wc * 32 + 8 * fq; bg[bj][0] = *(const f32x4*)(b_gate + c0 + ct); bg[bj][1] = *(const f32x4*)(b_gate + c0 + ct + 4); }
        EPI_LOOP_PERM(
_Pragma("unroll")
            for (int e = 0; e < 4; ++e) { v0[e] = fsigmoid(0.0625f * v0[e] + bg[bj][0][e]); v1[e] = fsigmoid(0.0625f * v1[e] + bg[bj][1][e]); }
            *(v4u*)(G + (size_t)row * 2048 + c0 + ct) = PACK8(v0, v1);
        )
    }
};
struct EpiBf16 {
    static constexpr bool PERM = true;
    bf16* O; int ldc; int colmul; size_t pn_stride; float scale;
    __device__ __forceinline__ void operator()(const f32x4 (&acc)[2][2][4][2], const Unit& u, int wr, int wc, int fr, int fq) const {
        bf16* base = O + (size_t)u.pn * pn_stride + (size_t)u.pn * 256 * colmul;
        EPI_LOOP_PERM( v0 = v0 * scale; v1 = v1 * scale; *(v4u*)(base + (size_t)row * ldc + ct) = PACK8(v0, v1); )
    }
};
struct EpiLora {
    static constexpr bool PERM = true;
    bf16* WAG; const float* w0; const float* a0;
    __device__ __forceinline__ void operator()(const f32x4 (&acc)[2][2][4][2], const Unit& u, int wr, int wc, int fr, int fq) const {
        const int seg = u.pn >> 1; const int cc0 = (u.pn & 1) * 256; const float* bias = seg == 0 ? w0 : a0;
        if (seg < 2) {
            const float mul = seg == 0 ? 0.6065306597126334f : 1.0f;
            f32x4 bg[2][2];
#pragma unroll
            for (int bj = 0; bj < 2; ++bj) { const int ct = bj * 128 + wc * 32 + 8 * fq; bg[bj][0] = *(const f32x4*)(bias + cc0 + ct); bg[bj][1] = *(const f32x4*)(bias + cc0 + ct + 4); }
            EPI_LOOP_PERM(
_Pragma("unroll")
                for (int e = 0; e < 4; ++e) { v0[e] = mul * fsigmoid(v0[e] + bg[bj][0][e]); v1[e] = mul * fsigmoid(v1[e] + bg[bj][1][e]); }
                *(v4u*)(WAG + (size_t)row * 1536 + u.pn * 256 + ct) = PACK8(v0, v1);
            )
        } else {
            EPI_LOOP_PERM(
                *(v4u*)(WAG + (size_t)row * 1536 + u.pn * 256 + ct) = PACK8(v0, v1);
            )
        }
    }
};
struct EpiMix {
    static constexpr bool PERM = true;
    bf16* U; const bf16* G; int second;
    __device__ __forceinline__ void operator()(const f32x4 (&acc)[2][2][4][2], const Unit& u, int wr, int wc, int fr, int fq) const {
#pragma unroll
        for (int ai = 0; ai < 2; ++ai) {
            v4u gw[4][2], ow[4][2];
#pragma unroll
            for (int m = 0; m < 4; ++m)
#pragma unroll
                for (int bj = 0; bj < 2; ++bj) { const int row = u.pm * 256 + ai * 128 + wr * 64 + m * 16 + fr, col = u.pn * 256 + bj * 128 + wc * 32 + 8 * fq;
                    gw[m][bj] = *(const v4u*)(G + (size_t)row * 2048 + second * 1024 + col);
                    ow[m][bj] = second ? *(const v4u*)(U + (size_t)row * 1024 + col) : (v4u){0, 0, 0, 0}; }
#pragma unroll
            for (int m = 0; m < 4; ++m)
#pragma unroll
                for (int bj = 0; bj < 2; ++bj) { const int row = u.pm * 256 + ai * 128 + wr * 64 + m * 16 + fr, col = u.pn * 256 + bj * 128 + wc * 32 + 8 * fq;
                    f32x4 v0 = acc[ai][bj][m][0], v1 = acc[ai][bj][m][1]; const v4u g4 = gw[m][bj], o = ow[m][bj];
                    v0[0] = v0[0] * bflo(g4.x) + bflo(o.x); v0[1] = v0[1] * bfhi(g4.x) + bfhi(o.x); v0[2] = v0[2] * bflo(g4.y) + bflo(o.y); v0[3] = v0[3] * bfhi(g4.y) + bfhi(o.y);
                    v1[0] = v1[0] * bflo(g4.z) + bflo(o.z); v1[1] = v1[1] * bfhi(g4.z) + bfhi(o.z); v1[2] = v1[2] * bflo(g4.w) + bflo(o.w); v1[3] = v1[3] * bfhi(g4.w) + bfhi(o.w);
                    *(v4u*)(U + (size_t)row * 1024 + col) = PACK8(v0, v1); }
        }
    }
};
struct EpiRes {
    static constexpr bool PERM = false;
    const float* res; float* out;
    __device__ __forceinline__ void operator()(const f32x4 (&acc)[2][2][4][2], const Unit& u, int wr, int wc, int fr, int fq) const {
#pragma unroll
        for (int ai = 0; ai < 2; ++ai) {
            f32x4 r[4][2][2];
#pragma unroll
            for (int m = 0; m < 4; ++m)
#pragma unroll
                for (int bj = 0; bj < 2; ++bj)
#pragma unroll
                    for (int n = 0; n < 2; ++n) { const int row = u.pm * 256 + ai * 128 + wr * 64 + m * 16 + fr, col = u.pn * 256 + bj * 128 + wc * 32 + 16 * n + 4 * fq; r[m][bj][n] = *(const f32x4*)(res + (size_t)row * 1024 + col); }
#pragma unroll
            for (int m = 0; m < 4; ++m)
#pragma unroll
                for (int bj = 0; bj < 2; ++bj)
#pragma unroll
                    for (int n = 0; n < 2; ++n) { const int row = u.pm * 256 + ai * 128 + wr * 64 + m * 16 + fr, col = u.pn * 256 + bj * 128 + wc * 32 + 16 * n + 4 * fq; *(f32x4*)(out + (size_t)row * 1024 + col) = r[m][bj][n] + acc[ai][bj][m][n]; }
        }
    }
};
struct EpiResB {
    static constexpr bool PERM = true;
    const float* res32; const bf16* res16; bf16* out; float ascale = 1.f;
    __device__ __forceinline__ void operator()(const f32x4 (&acc)[2][2][4][2], const Unit& u, int wr, int wc, int fr, int fq) const {
#pragma unroll
        for (int ai = 0; ai < 2; ++ai) {
            f32x4 r[4][2][2];
#pragma unroll
            for (int m = 0; m < 4; ++m)
#pragma unroll
                for (int bj = 0; bj < 2; ++bj) { const int row = u.pm * 256 + ai * 128 + wr * 64 + m * 16 + fr, col = u.pn * 256 + bj * 128 + wc * 32 + 8 * fq; const size_t o = (size_t)row * 1024 + col;
                    if (res32) { r[m][bj][0] = *(const f32x4*)(res32 + o); r[m][bj][1] = *(const f32x4*)(res32 + o + 4); }
                    else { const v4u w = *(const v4u*)(res16 + o); r[m][bj][0] = (f32x4){bflo(w.x), bfhi(w.x), bflo(w.y), bfhi(w.y)}; r[m][bj][1] = (f32x4){bflo(w.z), bfhi(w.z), bflo(w.w), bfhi(w.w)}; } }
#pragma unroll
            for (int m = 0; m < 4; ++m)
#pragma unroll
                for (int bj = 0; bj < 2; ++bj) { const int row = u.pm * 256 + ai * 128 + wr * 64 + m * 16 + fr, col = u.pn * 256 + bj * 128 + wc * 32 + 8 * fq;
                    const f32x4 v0 = r[m][bj][0] + acc[ai][bj][m][0] * ascale, v1 = r[m][bj][1] + acc[ai][bj][m][1] * ascale;
                    *(v4u*)(out + (size_t)row * 1024 + col) = PACK8(v0, v1); }
        }
    }
};
struct EpiLogit {
    static constexpr bool PERM = false;
    float* L;
    __device__ __forceinline__ void operator()(const f32x4 (&acc)[2][2][4][2], const Unit& u, int wr, int wc, int fr, int fq) const {
        if (wc >= 2) return;
#pragma unroll
        for (int ai = 0; ai < 2; ++ai)
#pragma unroll
            for (int m = 0; m < 4; ++m) { const int row = u.pm * 256 + ai * 128 + wr * 64 + m * 16 + fr;
#pragma unroll
                for (int n = 0; n < 2; ++n) { const int col = wc * 32 + 16 * n + 4 * fq; *(f32x4*)(L + (size_t)row * 64 + col) = acc[ai][0][m][n]; } }
    }
};
struct EpiMoe1 {
    static constexpr bool PERM = true;
    unsigned char* HID;
    __device__ __forceinline__ void operator()(const f32x4 (&acc)[2][2][4][2], const Unit& u, int wr, int wc, int fr, int fq) const {
#pragma unroll
        for (int ai = 0; ai < 2; ++ai)
#pragma unroll
            for (int m = 0; m < 4; ++m) { const int row = u.pm * 256 + ai * 128 + wr * 64 + m * 16 + fr; f32x4 h0, h1;
#pragma unroll
                for (int e = 0; e < 4; ++e) { const float g0 = 0.0625f * acc[ai][0][m][0][e], g1 = 0.0625f * acc[ai][0][m][1][e]; h0[e] = g0 * fsigmoid(g0) * (0.0625f * acc[ai][1][m][0][e]); h1[e] = g1 * fsigmoid(g1) * (0.0625f * acc[ai][1][m][1][e]); }
                *(v2u*)(HID + (size_t)row * 512 + u.pn * 128 + wc * 32 + 8 * fq) = (v2u){pk4_fp8(h0[0], h0[1], h0[2], h0[3]), pk4_fp8(h1[0], h1[1], h1[2], h1[3])}; }
    }
};
struct EpiMoe2 {
    static constexpr bool PERM = true;
    bf16* YS; const float* sgate;
    __device__ __forceinline__ void operator()(const f32x4 (&acc)[2][2][4][2], const Unit& u, int wr, int wc, int fr, int fq) const {
        float gts[2][4];
#pragma unroll
        for (int ai = 0; ai < 2; ++ai)
#pragma unroll
            for (int m = 0; m < 4; ++m) gts[ai][m] = sgate[u.pm * 256 + ai * 128 + wr * 64 + m * 16 + fr];
        EPI_LOOP_PERM( const float gt = 0.0625f * gts[ai][m]; v0 = v0 * gt; v1 = v1 * gt; *(v4u*)(YS + (size_t)row * 1024 + u.pn * 256 + ct) = PACK8(v0, v1); )
    }
};
struct MoeOrder {
    const char* A; const char* Bt; size_t bstride  ; int K; int NPN; const int* stok; volatile LAS int* tstart; int G, c; bool gather;
    __device__ bool next(int i, Unit& u) const {
        const int ntile = tstart[32]; const long L = (long)i * G + c; if (L >= (long)ntile * NPN) return false;
        const int tile = (int)(L / NPN); u.pn = (int)(L % NPN); u.pm = tile;
        int e = 0;
#pragma unroll 1
        for (int j = 1; j < 32; ++j) e += (tstart[j] <= tile) ? 1 : 0;
        u.b = Bt + (size_t)e * bstride + (size_t)u.pn * 256 * K * 2;
        if (gather) { u.a = A; u.gidx = stok + (size_t)tile * 256; } else { u.a = A + (size_t)tile * 256 * K * 2; u.gidx = nullptr; }
        return true;
    }
};

__device__ __forceinline__ void p2_lora_prep(Frame& F) {
    const bf16* Zlora = WSP(bf16, WS_ZLORA); const bf16* Zd = WSP(bf16, WS_ZD); bf16* AL = DOP(bf16, DO_ALORA); bf16* CKV = WSP(bf16, WS_CKV);
    const float* mu = F.in[4] + 1536; const float* kvn = F.in[15];
    const int c = 4 * F.lane;
    const f32x4 m4 = *(const f32x4*)(mu + c);
    const f32x2 kn = *(const f32x2*)(kvn + 2 * F.lane);
    constexpr int NB4 = 4;
    for (int t0 = F.gw; t0 < T; t0 += NB4 * F.NGW) {
        v2u z[NB4], zp[NB4]; unsigned cw[NB4];
#pragma unroll
        for (int u = 0; u < NB4; ++u) { const int t1 = t0 + u * F.NGW, t = t1 < T ? t1 : t0;
            z[u] = *(const v2u*)(Zlora + (size_t)t * 256 + c);
            const int tp = (t & (SEQ - 1)) != 0 ? t - 1 : t;
            zp[u] = *(const v2u*)(Zlora + (size_t)tp * 256 + c);
            cw[u] = *(const unsigned*)(Zd + (size_t)t * 512 + 2 * F.lane); }
#pragma unroll
        for (int u = 0; u < NB4; ++u) { const int t = t0 + u * F.NGW;
            if (t < T) {
                if ((t & (SEQ - 1)) == 0) zp[u] = (v2u){0u, 0u};
                float v[4] = {bflo(z[u].x), bfhi(z[u].x), bflo(z[u].y), bfhi(z[u].y)}; const float p[4] = {bflo(zp[u].x), bfhi(zp[u].x), bflo(zp[u].y), bfhi(zp[u].y)};
#pragma unroll
                for (int e = 0; e < 4; ++e) { float s = v[e] + (p[e] - v[e]) * m4[e];
                    if (c < 64) { const float ex = __expf(2.f * s); s = 1.f - 2.f * __builtin_amdgcn_rcpf(ex + 1.f); }
                    else if (c >= 128) s = fsigmoid(s);
                    v[e] = s; }
                *(v2u*)(AL + (size_t)t * 256 + c) = (v2u){cvt_pk_bf16(v[0], v[1]), cvt_pk_bf16(v[2], v[3])};
                const float c0 = bflo(cw[u]), c1 = bfhi(cw[u]);
                const float rstd = rsqrtf(wave_sum(c0 * c0 + c1 * c1) * (1.f / 128.f) + 1e-6f);
                *(unsigned*)(CKV + (size_t)t * 128 + 2 * F.lane) = cvt_pk_bf16(c0 * rstd * kn.x, c1 * rstd * kn.y);
            }
        }
    }
}

struct ScanRows { v4u zr, zk, zv, pr, pk, pv, ew4, a4, g4; };
__device__ __forceinline__ void scan_load_rows(ScanRows& L, const bf16* Zrkv, const bf16* WAG, size_t tok, int pos, int j0) {
    L.zr = *(const v4u*)(Zrkv + tok * 1536 + j0); L.zk = *(const v4u*)(Zrkv + tok * 1536 + 512 + j0); L.zv = *(const v4u*)(Zrkv + tok * 1536 + 1024 + j0);
    L.pr = (v4u){0, 0, 0, 0}; L.pk = L.pr; L.pv = L.pr;
    if (pos != 0) { L.pr = *(const v4u*)(Zrkv + (tok - 1) * 1536 + j0); L.pk = *(const v4u*)(Zrkv + (tok - 1) * 1536 + 512 + j0); L.pv = *(const v4u*)(Zrkv + (tok - 1) * 1536 + 1024 + j0); }
    L.ew4 = *(const v4u*)(WAG + tok * 1536 + j0); L.a4 = *(const v4u*)(WAG + tok * 1536 + 512 + j0); L.g4 = *(const v4u*)(WAG + tok * 1536 + 1024 + j0);
}
__device__ __forceinline__ void p4_scan(Frame& F) {
    const int bh = F.vcu >> 1, half = F.vcu & 1, b = bh >> 3, h = bh & 7;
    const bf16* Zrkv = WSP(bf16, WS_ZRKV); const bf16* WAG = DOP(bf16, DO_WAG); bf16* YA = WSP(bf16, WS_YA); bf16* YC = WSP(bf16, WS_YC);
    LAS float* sR = (LAS float*)F.lds; LAS float* sDEC = sR + 4096; LAS float* sKK = sR + 8192; LAS float* sBB = sR + 12288; LAS float* sKP = sR + 16384; LAS float* sV = sR + 20480; LAS float* sY = sR + 24576; LAS float* sBR = sR + 28672;
    const int tt = F.tid >> 3, jg = F.tid & 7, j0 = h * 64 + jg * 8;
    const int il = F.lane >> 3, irow = half * 32 + (F.wave & 3) * 8 + il;
    float mu_r[8], mu_k[8], mu_v[8], kkw[8], kaw[8], rkw[8], lnw[8], lnb[8];
#pragma unroll
    for (int e = 0; e < 8; ++e) { mu_r[e] = F.in[4][j0 + e]; mu_k[e] = F.in[4][512 + j0 + e]; mu_v[e] = F.in[4][1024 + j0 + e]; kkw[e] = F.in[10][j0 + e]; kaw[e] = F.in[11][j0 + e]; rkw[e] = F.in[12][j0 + e]; lnw[e] = F.in[13][j0 + e]; lnb[e] = F.in[14][j0 + e]; }
    float S[8];
#pragma unroll
    for (int e = 0; e < 8; ++e) S[e] = 0.f;
    ScanRows L; scan_load_rows(L, Zrkv, WAG, (size_t)b * SEQ + tt, tt, j0);
    for (int tile = 0; tile < SEQ / 64; ++tile) {
        const int pos = tile * 64 + tt; const size_t tok = (size_t)b * SEQ + pos;
        const v4u g4 = L.g4;
        {
            float r[8], k[8], v[8], a[8], ew[8], kk[8];
#pragma unroll
            for (int q = 0; q < 4; ++q) {
                const float zr0 = bflo(L.zr[q]), zr1 = bfhi(L.zr[q]), zk0 = bflo(L.zk[q]), zk1 = bfhi(L.zk[q]), zv0 = bflo(L.zv[q]), zv1 = bfhi(L.zv[q]);
                r[2 * q] = zr0 + (bflo(L.pr[q]) - zr0) * mu_r[2 * q]; r[2 * q + 1] = zr1 + (bfhi(L.pr[q]) - zr1) * mu_r[2 * q + 1];
                k[2 * q] = zk0 + (bflo(L.pk[q]) - zk0) * mu_k[2 * q]; k[2 * q + 1] = zk1 + (bfhi(L.pk[q]) - zk1) * mu_k[2 * q + 1];
                v[2 * q] = zv0 + (bflo(L.pv[q]) - zv0) * mu_v[2 * q]; v[2 * q + 1] = zv1 + (bfhi(L.pv[q]) - zv1) * mu_v[2 * q + 1];
                a[2 * q] = bflo(L.a4[q]); a[2 * q + 1] = bfhi(L.a4[q]); ew[2 * q] = bflo(L.ew4[q]); ew[2 * q + 1] = bfhi(L.ew4[q]);
            }
            float ss = 0.f;
#pragma unroll
            for (int e = 0; e < 8; ++e) { kk[e] = k[e] * kkw[e]; ss += kk[e] * kk[e]; }
            ss = sum8(ss);
            const float inv = 1.0f / fmaxf(sqrtf(ss), 1e-12f);
            float br = 0.f;
#pragma unroll
            for (int e = 0; e < 8; ++e) { kk[e] *= inv; br += kk[e] * a[e] * r[e]; }
            br = sum8(br);
            f32x4 o0, o1;
#define ST8(dst, expr) { _Pragma("unroll") for (int e = 0; e < 4; ++e) { { const int E = e; o0[e] = (expr); } { const int E = e + 4; o1[e] = (expr); } } *(LAS f32x4*)(dst + tt * 64 + jg * 8) = o0; *(LAS f32x4*)(dst + tt * 64 + jg * 8 + 4) = o1; }
            ST8(sR, r[E]);
            ST8(sDEC, __expf(-ew[E]));
            ST8(sKK, kk[E]);
            ST8(sBB, kk[E] * a[E]);
            ST8(sKP, k[E] * (1.f + (a[E] - 1.f) * kaw[E]));
            ST8(sV, v[E]);
#undef ST8
            if (jg == 0) sBR[tt] = br;
        }
        __syncthreads();
        if (tile + 1 < SEQ / 64) scan_load_rows(L, Zrkv, WAG, tok + 64, pos + 64, j0);
        if (F.wave < 4) {
            const LAS float* base = sR + jg * 8;
            f32x4 cr0 = *(const LAS f32x4*)(base), cr1 = *(const LAS f32x4*)(base + 4), cd0 = *(const LAS f32x4*)(base + 4096), cd1 = *(const LAS f32x4*)(base + 4100);
            f32x4 cq0 = *(const LAS f32x4*)(base + 8192), cq1 = *(const LAS f32x4*)(base + 8196), cb0 = *(const LAS f32x4*)(base + 12288), cb1 = *(const LAS f32x4*)(base + 12292);
            f32x4 cp0 = *(const LAS f32x4*)(base + 16384), cp1 = *(const LAS f32x4*)(base + 16388);
            float cvi = sV[irow], cbr = sBR[0];
#pragma unroll 2
            for (int s = 0; s < 64; ++s) {
                const int sn = (s + 1) & 63; const LAS float* nb = base + sn * 64;
                const f32x4 nr0 = *(const LAS f32x4*)(nb), nr1 = *(const LAS f32x4*)(nb + 4), nd0 = *(const LAS f32x4*)(nb + 4096), nd1 = *(const LAS f32x4*)(nb + 4100);
                const f32x4 nq0 = *(const LAS f32x4*)(nb + 8192), nq1 = *(const LAS f32x4*)(nb + 8196), nb0 = *(const LAS f32x4*)(nb + 12288), nb1 = *(const LAS f32x4*)(nb + 12292);
                const f32x4 np0 = *(const LAS f32x4*)(nb + 16384), np1 = *(const LAS f32x4*)(nb + 16388);
                const float nvi = sV[sn * 64 + irow], nbr = sBR[sn];
                float t[8], sa0 = 0.f, sa1 = 0.f, ty0 = 0.f, ty1 = 0.f;
#pragma unroll
                for (int e = 0; e < 4; ++e) {
                    sa0 += S[e] * cq0[e]; sa1 += S[4 + e] * cq1[e];
                    t[e] = S[e] * cd0[e] + cvi * cp0[e]; t[4 + e] = S[4 + e] * cd1[e] + cvi * cp1[e];
                    ty0 += t[e] * cr0[e]; ty1 += t[4 + e] * cr1[e];
                }
                float sa = sa0 + sa1, ty = ty0 + ty1;
                sa += dpp_f(sa, 0); ty += dpp_f(ty, 0); sa += dpp_f(sa, 1); ty += dpp_f(ty, 1); sa += dpp_f(sa, 2); ty += dpp_f(ty, 2);
                sa = -sa;
#pragma unroll
                for (int e = 0; e < 4; ++e) { S[e] = t[e] + sa * cb0[e]; S[4 + e] = t[4 + e] + sa * cb1[e]; }
                if (jg == 0) sY[s * 64 + irow] = ty + sa * cbr;
                cr0 = nr0; cr1 = nr1; cd0 = nd0; cd1 = nd1; cq0 = nq0; cq1 = nq1; cb0 = nb0; cb1 = nb1; cp0 = np0; cp1 = np1; cvi = nvi; cbr = nbr;
            }
        }
        __syncthreads();
        {
            const LAS float* rb = sR + tt * 64 + jg * 8; const LAS float* kb = sKP + tt * 64 + jg * 8; const LAS float* vb = sV + tt * 64 + jg * 8;
            float dot = 0.f;
#pragma unroll
            for (int e = 0; e < 8; ++e) dot += rb[e] * kb[e] * rkw[e];
            dot = sum8(dot);
            if ((jg >> 2) == half) {
                const LAS float* yb = sY + tt * 64 + jg * 8;
                const f32x4 ya = *(const LAS f32x4*)yb, yc = *(const LAS f32x4*)(yb + 4);
                float c[8];
#pragma unroll
                for (int q = 0; q < 4; ++q) { c[2 * q] = (lnb[2 * q] + dot * vb[2 * q]) * bflo(g4[q]); c[2 * q + 1] = (lnb[2 * q + 1] + dot * vb[2 * q + 1]) * bfhi(g4[q]); }
                *(v4u*)(YA + tok * 512 + j0) = (v4u){cvt_pk_bf16(ya[0], ya[1]), cvt_pk_bf16(ya[2], ya[3]), cvt_pk_bf16(yc[0], yc[1]), cvt_pk_bf16(yc[2], yc[3])};
                *(v4u*)(YC + tok * 512 + j0) = (v4u){cvt_pk_bf16(c[0], c[1]), cvt_pk_bf16(c[2], c[3]), cvt_pk_bf16(c[4], c[5]), cvt_pk_bf16(c[6], c[7])};
            }
        }
        __syncthreads();
    }
}

namespace rk {
constexpr int RSB = 144, SLOT = 64 * RSB;
__device__ __forceinline__ int off(int row, int elem) { return row * RSB + ((((elem) >> 3) ^ ((row >> 3) & 7)) << 4) + ((elem) & 7) * 2; }
struct Acc2 { f32x4 a[2]; };
template <bool TWO>
__device__ __forceinline__ Acc2 mm_mul(const LAS unsigned char* lds, int X, int Y, int X2, int Y2, int wave, int lane) {
    const int g = lane >> 4, c15 = lane & 15; Acc2 r;
#pragma unroll
    for (int jj = 0; jj < 2; ++jj) {
        const int job = wave + 8 * jj, yt = job >> 2, xt = job & 3;
        f32x4 acc = (f32x4){0.f, 0.f, 0.f, 0.f};
#pragma unroll
        for (int ks = 0; ks < 2; ++ks) {
            const bf16x8 a = *(const LAS bf16x8*)(lds + X * SLOT + off(16 * xt + c15, ks * 32 + 8 * g)), b = *(const LAS bf16x8*)(lds + Y * SLOT + off(16 * yt + c15, ks * 32 + 8 * g));
            acc = __builtin_amdgcn_mfma_f32_16x16x32_bf16(a, b, acc, 0, 0, 0);
        }
        if (TWO) {
#pragma unroll
            for (int ks = 0; ks < 2; ++ks) {
                const bf16x8 a = *(const LAS bf16x8*)(lds + X2 * SLOT + off(16 * xt + c15, ks * 32 + 8 * g)), b = *(const LAS bf16x8*)(lds + Y2 * SLOT + off(16 * yt + c15, ks * 32 + 8 * g));
                acc = __builtin_amdgcn_mfma_f32_16x16x32_bf16(a, b, acc, 0, 0, 0);
            }
        }
        r.a[jj] = acc;
    }
    return r;
}
template <int EPI>
__device__ __forceinline__ void mm_put(LAS unsigned char* lds, Acc2 r, int Z, int C, const LAS float* gam, int wave, int lane) {
    const int g = lane >> 4, c15 = lane & 15;
#pragma unroll
    for (int jj = 0; jj < 2; ++jj) {
        const int job = wave + 8 * jj, yt = job >> 2, xt = job & 3;
        f32x4 acc = r.a[jj];
        const int y = 16 * yt + c15, x0 = 16 * xt + 4 * g;
        if (EPI == 4) { const v2u cw = *(const LAS v2u*)(lds + C * SLOT + off(y, x0)); acc[0] += bflo(cw.x); acc[1] += bfhi(cw.x); acc[2] += bflo(cw.y); acc[3] += bfhi(cw.y); }
#pragma unroll
        for (int e = 0; e < 4; ++e) { const int x = x0 + e;
            if (EPI == 1) acc[e] = (x < y) ? acc[e] : 0.f;
            if (EPI == 2) acc[e] = (x > y) ? acc[e] : 0.f;
            if (EPI == 3) acc[e] = (x <= y) ? acc[e] : 0.f;
            if (EPI == 5) acc[e] += (x == y) ? gam[x] : 0.f; }
        *(LAS v2u*)(lds + Z * SLOT + off(y, x0)) = (v2u){cvt_pk_bf16(acc[0], acc[1]), cvt_pk_bf16(acc[2], acc[3])};
        if (EPI == 1) { float t[4];
#pragma unroll
            for (int e = 0; e < 4; ++e) t[e] = acc[e] + ((x0 + e == y) ? 1.f : 0.f);
            *(LAS v2u*)(lds + C * SLOT + off(y, x0)) = (v2u){cvt_pk_bf16(t[0], t[1]), cvt_pk_bf16(t[2], t[3])}; }
    }
}
}
__device__ __forceinline__ void p4_rwkv_chunked(Frame& F) {
    using namespace rk;
    const int bh = F.vcu >> 1, par = F.vcu & 1, b = bh >> 3, h = bh & 7;
    bf16* SB = (bf16*)((unsigned char*)F.out + DO_SB) + (size_t)bh * 2 * 4096; unsigned* flag = F.ctl + CW_RK + bh;
    const bf16* Zrkv = WSP(bf16, WS_ZRKV); const bf16* WAG = DOP(bf16, DO_WAG); bf16* YA = WSP(bf16, WS_YA);
    LAS unsigned char* lds = F.lds;
    LAS float* sL = (LAS float*)(lds + 14 * SLOT);
    LAS float* sY = (LAS float*)(lds + 3 * SLOT);
    LAS float* sG = (LAS float*)(lds + 16 * SLOT);
    const int tt = F.tid >> 3, jg = F.tid & 7, j0 = h * 64 + jg * 8, wave = F.wave, lane = F.lane;
    LAS float* sC = (LAS float*)(lds + 16 * SLOT + 256); LAS float* sLN = (LAS float*)(lds + MISC_OFF + 512);
    if (F.tid < 384) { const int jgi = F.tid / 48, r = F.tid % 48, which = r >> 3, e = r & 7; const float* srcp = which < 3 ? F.in[4] + which * 512 : F.in[10 + which - 3]; sC[F.tid] = srcp[h * 64 + jgi * 8 + e]; }
    if (F.tid < 128) { const int jgi = F.tid >> 4, r = F.tid & 15; sLN[F.tid] = (r < 8 ? F.in[13] : F.in[14])[h * 64 + jgi * 8 + (r & 7)]; }
    __syncthreads();
    ScanRows L; scan_load_rows(L, Zrkv, WAG, (size_t)b * SEQ + par * 64 + tt, par * 64 + tt, j0);
    for (int ch = par; ch < SEQ / 64; ch += 2) {
        const int pos = ch * 64 + tt; const size_t tok = (size_t)b * SEQ + pos;
        const v4u g4 = L.g4;
        float r[8], kp[8], v[8], a[8], ew[8], kk[8];
        float dot = 0.f;
        {
            float k[8];
            float mu_r[8], mu_k[8], mu_v[8], kkw[8], kaw[8], rkw[8];
#pragma unroll
            for (int e = 0; e < 8; ++e) { const LAS float* cp = sC + jg * 48 + e; mu_r[e] = cp[0]; mu_k[e] = cp[8]; mu_v[e] = cp[16]; kkw[e] = cp[24]; kaw[e] = cp[32]; rkw[e] = cp[40]; }
#pragma unroll
            for (int q = 0; q < 4; ++q) {
                const float zr0 = bflo(L.zr[q]), zr1 = bfhi(L.zr[q]), zk0 = bflo(L.zk[q]), zk1 = bfhi(L.zk[q]), zv0 = bflo(L.zv[q]), zv1 = bfhi(L.zv[q]);
                r[2 * q] = zr0 + (bflo(L.pr[q]) - zr0) * mu_r[2 * q]; r[2 * q + 1] = zr1 + (bfhi(L.pr[q]) - zr1) * mu_r[2 * q + 1];
                k[2 * q] = zk0 + (bflo(L.pk[q]) - zk0) * mu_k[2 * q]; k[2 * q + 1] = zk1 + (bfhi(L.pk[q]) - zk1) * mu_k[2 * q + 1];
                v[2 * q] = zv0 + (bflo(L.pv[q]) - zv0) * mu_v[2 * q]; v[2 * q + 1] = zv1 + (bfhi(L.pv[q]) - zv1) * mu_v[2 * q + 1];
                a[2 * q] = bflo(L.a4[q]); a[2 * q + 1] = bfhi(L.a4[q]); ew[2 * q] = bflo(L.ew4[q]); ew[2 * q + 1] = bfhi(L.ew4[q]);
            }
            float ss = 0.f;
#pragma unroll
            for (int e = 0; e < 8; ++e) { kk[e] = k[e] * kkw[e]; ss += kk[e] * kk[e]; }
            ss = sum8(ss);
            const float inv = fminf(__builtin_amdgcn_rsqf(ss), 1e12f);
#pragma unroll
            for (int e = 0; e < 8; ++e) { kk[e] *= inv; kp[e] = k[e] * (1.f + (a[e] - 1.f) * kaw[e]); }
#pragma unroll
            for (int e = 0; e < 8; ++e) dot += r[e] * kp[e] * rkw[e];
            dot = sum8(dot);
        }
        __syncthreads();
        {
#pragma unroll
            for (int e = 0; e < 8; ++e) *(LAS unsigned short*)(lds + 11 * SLOT + off(jg * 8 + e, tt)) = (unsigned short)(cvt_pk_bf16(ew[e], 0.f) & 0xffffu);
            unsigned tw[4];
#pragma unroll
            for (int q = 0; q < 4; ++q) tw[q] = ((jg * 8 + 2 * q <= tt) ? 0x3f80u : 0u) | ((jg * 8 + 2 * q + 1 <= tt) ? 0x3f800000u : 0u);
            *(LAS v4u*)(lds + 10 * SLOT + off(tt, jg * 8)) = (v4u){tw[0], tw[1], tw[2], tw[3]};
        }
        __syncthreads();
        { const Acc2 q0 = mm_mul<false>(lds, 11, 10, 0, 0, wave, lane); const int g = lane >> 4, c15 = lane & 15;
#pragma unroll
          for (int jj = 0; jj < 2; ++jj) { const int job = wave + 8 * jj, yt = job >> 2, xt = job & 3; *(LAS f32x4*)(sL + (16 * yt + c15) * 64 + 16 * xt + 4 * g) = -q0.a[jj]; } }
        __syncthreads();
        if (F.tid < 64) sG[F.tid] = __expf(sL[63 * 64 + F.tid]);
        if (ch + 2 < SEQ / 64) scan_load_rows(L, Zrkv, WAG, tok + 128, pos + 128, j0);
        {
            const f32x4 l0 = *(const LAS f32x4*)(sL + tt * 64 + jg * 8), l1 = *(const LAS f32x4*)(sL + tt * 64 + jg * 8 + 4);
            const f32x4 c0 = *(const LAS f32x4*)(sL + 63 * 64 + jg * 8), c1 = *(const LAS f32x4*)(sL + 63 * 64 + jg * 8 + 4);
            float At[8], Bt[8], Kt[8], Rt[8], Bh[8], Kh[8];
#pragma unroll
            for (int e = 0; e < 8; ++e) { const float Lt = e < 4 ? l0[e] : l1[e - 4], LC = e < 4 ? c0[e] : c1[e - 4];
                const float eL = __expf(Lt), eLm1 = __expf(Lt + ew[e]), einv = __builtin_amdgcn_rcpf(eL), eC = __expf(LC) * einv, ba = kk[e] * a[e];
                At[e] = -kk[e] * eLm1; Bt[e] = ba * einv; Kt[e] = kp[e] * einv; Rt[e] = r[e] * eL; Bh[e] = ba * eC; Kh[e] = kp[e] * eC; }
#define RK_ROW(slot, arr) *(LAS v4u*)(lds + (slot) * SLOT + off(tt, jg * 8)) = (v4u){cvt_pk_bf16(arr[0], arr[1]), cvt_pk_bf16(arr[2], arr[3]), cvt_pk_bf16(arr[4], arr[5]), cvt_pk_bf16(arr[6], arr[7])}
#define RK_COL(slot, arr) { _Pragma("unroll") for (int e = 0; e < 8; ++e) *(LAS unsigned short*)(lds + (slot) * SLOT + off(jg * 8 + e, tt)) = (unsigned short)(cvt_pk_bf16(arr[e], 0.f) & 0xffffu); }
            RK_ROW(0, At); RK_COL(1, At); RK_ROW(2, Bt); RK_ROW(3, Kt); RK_ROW(4, Rt); RK_COL(5, Bh); RK_COL(6, Kh); RK_COL(7, v);
#undef RK_ROW
#undef RK_COL
        }
        __syncthreads();
#define MUL1(X_, Y_) mm_mul<false>(lds, X_, Y_, 0, 0, wave, lane)
#define MUL2(X_, Y_, X2_, Y2_) mm_mul<true>(lds, X_, Y_, X2_, Y2_, wave, lane)
#define PUT(E_, R_, Z_, C_) mm_put<E_>(lds, R_, Z_, C_, sG, wave, lane)
        { const Acc2 q0 = MUL1(2, 0), q1 = MUL1(0, 2), q2 = MUL1(3, 0), q3 = MUL1(2, 4), q4 = MUL1(3, 4);
          PUT(1, q0, 8, 13); PUT(2, q1, 14, 0); PUT(1, q2, 10, 15); PUT(3, q3, 11, 0); PUT(3, q4, 12, 0); }
        __syncthreads();
        { const Acc2 q0 = MUL1(14, 8), q1 = MUL1(8, 14); PUT(0, q0, 0, 0); PUT(0, q1, 2, 0); }
        __syncthreads();
        { const Acc2 q0 = MUL1(2, 13), q1 = MUL1(2, 0), q2 = MUL1(0, 2); PUT(4, q0, 3, 13); PUT(0, q1, 8, 0); PUT(0, q2, 14, 0); }
        __syncthreads();
        { const Acc2 q0 = MUL1(14, 3), q1 = MUL1(14, 8), q2 = MUL1(8, 14); PUT(4, q0, 13, 3); PUT(0, q1, 0, 0); PUT(0, q2, 2, 0); }
        __syncthreads();
        { const Acc2 q0 = MUL1(2, 13), q1 = MUL1(2, 0), q2 = MUL1(0, 2); PUT(4, q0, 3, 13); PUT(0, q1, 8, 0); PUT(0, q2, 14, 0); }
        __syncthreads();
        { const Acc2 q0 = MUL1(14, 3), q1 = MUL1(8, 14); PUT(4, q0, 13, 3); PUT(0, q1, 0, 0); }
        __syncthreads();
        { const Acc2 q0 = MUL1(0, 13); PUT(4, q0, 3, 13); }
        __syncthreads();
        { const Acc2 q0 = MUL1(3, 1), q1 = MUL1(10, 7); PUT(0, q0, 8, 0); PUT(0, q1, 0, 0); }
        __syncthreads();
        { const Acc2 q0 = MUL1(3, 0); PUT(0, q0, 13, 0); }
        __syncthreads();
        { const Acc2 q0 = MUL1(8, 5), q1 = MUL2(5, 13, 6, 7), q2 = MUL1(8, 11), q3 = MUL2(11, 13, 12, 7);
          PUT(5, q0, 2, 0); PUT(0, q1, 14, 0); PUT(4, q2, 15, 4); PUT(0, q3, 0, 0); }
        __syncthreads();
#undef MUL1
#undef MUL2
#undef PUT
        if (ch == 0) { for (int i = F.tid; i < SLOT / 4; i += NTHREADS) ((LAS unsigned*)(lds + 9 * SLOT))[i] = 0u; }
        else {
            if (F.tid == 0) { unsigned sp = 0; while (__hip_atomic_load(flag, __ATOMIC_RELAXED, __HIP_MEMORY_SCOPE_AGENT) < (unsigned)ch && ++sp < (1u << 22)) __builtin_amdgcn_s_sleep(1); }
            __syncthreads();
            const unsigned long long* sp8 = (const unsigned long long*)(SB + (size_t)(ch & 1) * 4096 + F.tid * 8);
            const unsigned long long w0 = __hip_atomic_load(sp8, __ATOMIC_RELAXED, __HIP_MEMORY_SCOPE_AGENT), w1 = __hip_atomic_load(sp8 + 1, __ATOMIC_RELAXED, __HIP_MEMORY_SCOPE_AGENT);
            *(LAS v4u*)(lds + 9 * SLOT + off(F.tid >> 3, (F.tid & 7) * 8)) = (v4u){(unsigned)w0, (unsigned)(w0 >> 32), (unsigned)w1, (unsigned)(w1 >> 32)};
        }
        __syncthreads();
        v2u snew[2];
        {
            const int g = lane >> 4, c15 = lane & 15;
#pragma unroll
            for (int jj = 0; jj < 2; ++jj) {
                const int job = wave + 8 * jj, yt = job >> 2, xt = job & 3;
                f32x4 ya = (f32x4){0.f, 0.f, 0.f, 0.f}, sa2 = (f32x4){0.f, 0.f, 0.f, 0.f};
#pragma unroll
                for (int ks = 0; ks < 2; ++ks) {
                    const bf16x8 sf = *(const LAS bf16x8*)(lds + 9 * SLOT + off(16 * yt + c15, ks * 32 + 8 * g));
                    const bf16x8 rf = *(const LAS bf16x8*)(lds + 15 * SLOT + off(16 * xt + c15, ks * 32 + 8 * g)), mf = *(const LAS bf16x8*)(lds + 2 * SLOT + off(16 * xt + c15, ks * 32 + 8 * g));
                    ya = __builtin_amdgcn_mfma_f32_16x16x32_bf16(rf, sf, ya, 0, 0, 0); sa2 = __builtin_amdgcn_mfma_f32_16x16x32_bf16(mf, sf, sa2, 0, 0, 0);
                }
                const int yy = 16 * yt + c15, x0 = 16 * xt + 4 * g;
                const v2u y0w = *(const LAS v2u*)(lds + 0 * SLOT + off(yy, x0)), nw = *(const LAS v2u*)(lds + 14 * SLOT + off(yy, x0));
                ya[0] += bflo(y0w.x); ya[1] += bfhi(y0w.x); ya[2] += bflo(y0w.y); ya[3] += bfhi(y0w.y);
                sa2[0] += bflo(nw.x); sa2[1] += bfhi(nw.x); sa2[2] += bflo(nw.y); sa2[3] += bfhi(nw.y);
#pragma unroll
                for (int e = 0; e < 4; ++e) sY[(x0 + e) * 64 + yy] = ya[e];
                snew[jj] = (v2u){cvt_pk_bf16(sa2[0], sa2[1]), cvt_pk_bf16(sa2[2], sa2[3])};
            }
        }
        {
            const int g = lane >> 4, c15 = lane & 15;
#pragma unroll
            for (int jj = 0; jj < 2; ++jj) { const int job = wave + 8 * jj, yt = job >> 2, xt = job & 3;
                __hip_atomic_store((unsigned long long*)(SB + (size_t)((ch + 1) & 1) * 4096 + (16 * yt + c15) * 64 + 16 * xt + 4 * g), (unsigned long long)snew[jj].x | ((unsigned long long)snew[jj].y << 32), __ATOMIC_RELAXED, __HIP_MEMORY_SCOPE_AGENT); }
            asm volatile("s_waitcnt vmcnt(0)" ::: "memory");
            __syncthreads();
            if (F.tid == 0) __hip_atomic_store(flag, (unsigned)(ch + 1), __ATOMIC_RELAXED, __HIP_MEMORY_SCOPE_AGENT);
        }
        {
            const LAS float* yb = sY + tt * 64 + jg * 8;
            const f32x4 ya = *(const LAS f32x4*)yb, yc = *(const LAS f32x4*)(yb + 4);
            float y[8] = {ya[0], ya[1], ya[2], ya[3], yc[0], yc[1], yc[2], yc[3]};
            float sm = 0.f;
#pragma unroll
            for (int e = 0; e < 8; ++e) sm += y[e];
            const float mean = sum8(sm) * (1.f / 64.f);
            float sv = 0.f;
#pragma unroll
            for (int e = 0; e < 8; ++e) { y[e] -= mean; sv += y[e] * y[e]; }
            const float rstd = rsqrtf(sum8(sv) * (1.f / 64.f) + 64e-5f);
            float lnw[8], lnb[8];
#pragma unroll
            for (int e = 0; e < 8; ++e) { lnw[e] = sLN[jg * 16 + e]; lnb[e] = sLN[jg * 16 + 8 + e]; }
            float o[8];
#pragma unroll
            for (int q = 0; q < 4; ++q) {
                o[2 * q] = (y[2 * q] * rstd * lnw[2 * q] + lnb[2 * q] + dot * v[2 * q]) * bflo(g4[q]);
                o[2 * q + 1] = (y[2 * q + 1] * rstd * lnw[2 * q + 1] + lnb[2 * q + 1] + dot * v[2 * q + 1]) * bfhi(g4[q]);
            }
            *(v4u*)(YA + tok * 512 + j0) = (v4u){cvt_pk_bf16(o[0], o[1]), cvt_pk_bf16(o[2], o[3]), cvt_pk_bf16(o[4], o[5]), cvt_pk_bf16(o[6], o[7])};
        }
    }
    __syncthreads();
}

__device__ __forceinline__ void p5_post(Frame& F) {
    bf16* YA = WSP(bf16, WS_YA); const bf16* YC = WSP(bf16, WS_YC); const bf16* WAG = DOP(bf16, DO_WAG);
    const int gt = F.vcu * NTHREADS + F.tid, NGT = F.G * NTHREADS;
    for (int it = gt; it < T * 64; it += NGT) {
        const size_t tok = (size_t)(it >> 6); const int c0 = (it & 63) * 8;
        const v4u yw = *(const v4u*)(YA + tok * 512 + c0), cw = *(const v4u*)(YC + tok * 512 + c0), gw = *(const v4u*)(WAG + tok * 1536 + 1024 + c0);
        float y[8], sm = 0.f;
#pragma unroll
        for (int q = 0; q < 4; ++q) { y[2 * q] = bflo(yw[q]); y[2 * q + 1] = bfhi(yw[q]); sm += y[2 * q] + y[2 * q + 1]; }
        const float mean = sum8(sm) * (1.f / 64.f); float sv = 0.f;
#pragma unroll
        for (int e = 0; e < 8; ++e) { y[e] -= mean; sv += y[e] * y[e]; }
        const float rstd = rsqrtf(sum8(sv) * (1.f / 64.f) + 64e-5f);
        const f32x4 l0 = *(const f32x4*)(F.in[13] + c0), l1 = *(const f32x4*)(F.in[13] + c0 + 4);
        const float lw[8] = {l0[0], l0[1], l0[2], l0[3], l1[0], l1[1], l1[2], l1[3]};
        float o[8];
#pragma unroll
        for (int q = 0; q < 4; ++q) { o[2 * q] = y[2 * q] * rstd * lw[2 * q] * bflo(gw[q]) + bflo(cw[q]); o[2 * q + 1] = y[2 * q + 1] * rstd * lw[2 * q + 1] * bfhi(gw[q]) + bfhi(cw[q]); }
        *(v4u*)(YA + tok * 512 + c0) = (v4u){cvt_pk_bf16(o[0], o[1]), cvt_pk_bf16(o[2], o[3]), cvt_pk_bf16(o[4], o[5]), cvt_pk_bf16(o[6], o[7])};
    }
}

__device__ __forceinline__ unsigned score_key(float s) {
    s = s + 0.0f;
    const _Float16 hv = (_Float16)s; const unsigned u = (unsigned)__builtin_bit_cast(unsigned short, hv);
    return (u & 0x8000u) ? (~u & 0xffffu) : (u | 0x8000u);
}
__device__ __forceinline__ void find_bin(const LAS unsigned* hist, unsigned need, int lane, unsigned& bsel, unsigned& above) {
    const v4u c = *(const LAS v4u*)(hist + 4 * lane);
    const unsigned sl = c.x + c.y + c.z + c.w;
    unsigned suf = sl;
#pragma unroll
    for (int d = 1; d < 64; d <<= 1) { const unsigned o = (unsigned)__shfl_down((int)suf, d); suf += (lane + d < 64) ? o : 0u; }
    const unsigned long long bal = __ballot(suf >= need);
    const int L = 63 - __builtin_clzll(bal | 1ull);
    unsigned run = suf - sl;
    unsigned bb, ab;
    if (run + c.w >= need) { bb = 3; ab = run; }
    else if (run + c.w + c.z >= need) { bb = 2; ab = run + c.w; }
    else if (run + c.w + c.z + c.y >= need) { bb = 1; ab = run + c.w + c.z; }
    else { bb = 0; ab = run + c.w + c.z + c.y; }
    bsel = (unsigned)__shfl((int)(4 * lane + bb), L); above = (unsigned)__shfl((int)ab, L);
}
constexpr int HP = 260;
constexpr int HIST_WAVE_BYTES = 16 * HP * 4, KBUF_OFF = NWAVES * HIST_WAVE_BYTES;
template <int PASS>
__device__ __forceinline__ void idx_tile(const bf16x8 K0, const bf16x8 K1, const int kt, const bool diag, const bf16x8 (&Q)[4][2], const float (&w)[4], LAS unsigned* hrow, const int g, const int c15,
                                         const unsigned b1, const unsigned thr, const unsigned rr, unsigned& cnt, unsigned& ties, unsigned short* idxrow, unsigned short* sink) {
    float sc[4] = {0.f, 0.f, 0.f, 0.f};
#pragma unroll
    for (int hh = 0; hh < 4; ++hh) {
        f32x4 acc = (f32x4){0.f, 0.f, 0.f, 0.f};
        acc = __builtin_amdgcn_mfma_f32_16x16x32_bf16(K0, Q[hh][0], acc, 0, 0, 0);
        acc = __builtin_amdgcn_mfma_f32_16x16x32_bf16(K1, Q[hh][1], acc, 0, 0, 0);
#pragma unroll
        for (int i = 0; i < 4; ++i) sc[i] += w[hh] * __builtin_amdgcn_fmed3f(acc[i], 0.f, __builtin_inff());
    }
    unsigned key[4]; bool valid[4];
#pragma unroll
    for (int i = 0; i < 4; ++i) { valid[i] = !diag || (4 * g + i <= c15); key[i] = score_key(sc[i]); }
    if (PASS == 0) {
#pragma unroll
        for (int i = 0; i < 4; ++i) lds_add(hrow + (key[i] >> 8), valid[i] ? 1u : 0u);
    } else if (PASS == 1) {
#pragma unroll
        for (int i = 0; i < 4; ++i) if (valid[i] && (key[i] >> 8) == b1) lds_add(hrow + (key[i] & 255u), 1u);
    } else {
        const unsigned long long qmask = 0x0001000100010001ull << c15, lowerG = qmask & ((1ull << (16 * g)) - 1ull);
        bool tie[4]; unsigned tlow = 0;
#pragma unroll
        for (int i = 0; i < 4; ++i) tie[i] = valid[i] && key[i] == thr;
        unsigned tb[4];
#pragma unroll
        for (int i = 0; i < 4; ++i) { const unsigned long long bl = __ballot(tie[i]); tb[i] = (unsigned)__popcll(bl & qmask); tlow += (unsigned)__popcll(bl & lowerG); }
        bool sel[4]; unsigned trun = ties + tlow;
#pragma unroll
        for (int i = 0; i < 4; ++i) { const bool tacc = tie[i] && trun < rr; sel[i] = (valid[i] && key[i] > thr) || tacc; trun += tie[i] ? 1u : 0u; }
        unsigned slow = 0, stot = 0;
#pragma unroll
        for (int i = 0; i < 4; ++i) { const unsigned long long bl = __ballot(sel[i]); stot += (unsigned)__popcll(bl & qmask); slow += (unsigned)__popcll(bl & lowerG); }
        unsigned pos = cnt + slow;
#pragma unroll
        for (int i = 0; i < 4; ++i) { if (sel[i] && pos < 256u) ((LAS unsigned short*)hrow)[pos] = (unsigned short)(kt * 16 + 4 * g + i); pos += sel[i] ? 1u : 0u; }
        cnt += stot; ties += tb[0] + tb[1] + tb[2] + tb[3];
    }
}
template <int PASS>
__device__ __forceinline__ void idx_pass(Frame& F, const bf16* kb_batch  , const int p, const int pmax, const bf16x8 (&Q)[4][2], const float (&w)[4], LAS unsigned* hrow,
                                         const unsigned b1, const unsigned thr, const unsigned rr, unsigned& cnt, unsigned& ties, unsigned short* idxrow, unsigned short* sink) {
    const int g = F.lane >> 4, c15 = F.lane & 15;
    LAS unsigned char* kbuf = F.lds + KBUF_OFF;
    const int skey = F.tid >> 3, sd8 = F.tid & 7;
    const unsigned sdst = (unsigned)((skey >> 4) * 2048 + (sd8 >> 2) * 1024 + (sd8 & 3) * 256 + (skey & 15) * 16);
    const bf16* ssrc = kb_batch + (size_t)skey * 512 + sd8 * 8;
    const int nchunk = (pmax >> 2) + 1;
    v4u st = *(const v4u*)ssrc;
    __syncthreads();
    *(LAS v4u*)(kbuf + sdst) = st;
    for (int c = 0; c < nchunk; ++c) {
        if (c + 1 < nchunk) st = *(const v4u*)(ssrc + (size_t)(c + 1) * 64 * 512);
        __syncthreads();
        const LAS unsigned char* kb = kbuf + (c & 1) * 8192 + g * 256 + c15 * 16;
        if (c * 4 + 3 < p) {
            bf16x8 K0[4], K1[4];
#pragma unroll
            for (int u = 0; u < 4; ++u) { K0[u] = *(const LAS bf16x8*)(kb + u * 2048); K1[u] = *(const LAS bf16x8*)(kb + u * 2048 + 1024); }
#pragma unroll
            for (int u = 0; u < 4; ++u) idx_tile<PASS>(K0[u], K1[u], c * 4 + u, false, Q, w, hrow, g, c15, b1, thr, rr, cnt, ties, idxrow, sink);
        } else {
#pragma unroll
            for (int u = 0; u < 4; ++u) {
                const int kt = c * 4 + u;
                if (kt <= p) {
                    const bf16x8 K0 = *(const LAS bf16x8*)(kb + u * 2048), K1 = *(const LAS bf16x8*)(kb + u * 2048 + 1024);
                    idx_tile<PASS>(K0, K1, kt, kt == p, Q, w, hrow, g, c15, b1, thr, rr, cnt, ties, idxrow, sink);
                }
            }
        }
        if (c + 1 < nchunk) *(LAS v4u*)(kbuf + ((c + 1) & 1) * 8192 + sdst) = st;
    }
}
namespace ix3 {
constexpr int KP = 8208, KEYS_B = 16 * KP, HIST_OFF = KEYS_B, CNT_OFF = HIST_OFF + 16 * HP * 4, QI_OFF = CNT_OFF + 8 * 16 * 2 * 4, END_OFF = QI_OFF + 16 * 4 * 4;
static_assert(END_OFF <= MISC_OFF, "indexer LDS map");
}
__device__ __forceinline__ void p4_indexer(Frame& F) {
    using namespace ix3;
    const bf16* Zd = WSP(bf16, WS_ZD); unsigned short* IDX = WSP(unsigned short, WS_IDX);
    LAS unsigned char* lds = F.lds;
    LAS unsigned* hist = (LAS unsigned*)(lds + HIST_OFF); LAS unsigned* cntt = (LAS unsigned*)(lds + CNT_OFF); LAS unsigned* qi = (LAS unsigned*)(lds + QI_OFF);
    const int lane = F.lane, wave = F.wave, g = lane >> 4, c15 = lane & 15;
    const int b = F.vcu >> 4, vb = F.vcu & 15;
    if (b >= NB) return;
    LAS unsigned* hrow = hist + c15 * HP;
    LAS unsigned char* krow = lds + c15 * KP;
    const unsigned long long qmask = 0x0001000100010001ull << c15, lowerG = qmask & ((1ull << (16 * g)) - 1ull);
    for (int ti = 0; ti < 16; ++ti) {
        const int pr = vb * 8 + (ti & 7), p = (ti & 8) ? 255 - pr : pr;
        const int q0 = p * 16; const size_t tok0 = (size_t)b * SEQ + q0;
        if (p < 16) {
            for (int i = F.tid; i < 16 * 256; i += NTHREADS) { const int r = i >> 8, jx = i & 255; IDX[(tok0 + r) * 256 + jx] = (unsigned short)(jx <= q0 + r ? jx : 0); }
            continue;
        }
        const int np = p + 1, K8 = (np + 7) >> 3, lo = wave * K8, hi = (lo + K8 < np) ? lo + K8 : np;
        for (int z = F.tid; z < 16 * HP; z += NTHREADS) hist[z] = 0u;
        bf16x8 Q[4][2];
#pragma unroll
        for (int hh = 0; hh < 4; ++hh)
#pragma unroll
            for (int ks = 0; ks < 2; ++ks) Q[hh][ks] = *(const bf16x8*)(Zd + (tok0 + c15) * 512 + 256 + hh * 64 + ks * 32 + 8 * g);
        float w[4];
        { const v2u ww = *(const v2u*)(Zd + (tok0 + c15) * 512 + 192); w[0] = bflo(ww.x) * 0.0625f; w[1] = bfhi(ww.x) * 0.0625f; w[2] = bflo(ww.y) * 0.0625f; w[3] = bfhi(ww.y) * 0.0625f; }
        __syncthreads();
        if (lo < hi) {
            const bf16* kbase = Zd + ((size_t)b * SEQ + c15) * 512 + 128 + 8 * g;
            constexpr int NPF = 2;
            bf16x8 R[NPF][2];
#pragma unroll
            for (int u = 0; u < NPF; ++u) { const int kl = lo + u < hi ? lo + u : hi - 1; R[u][0] = *(const bf16x8*)(kbase + (size_t)kl * 8192); R[u][1] = *(const bf16x8*)(kbase + (size_t)kl * 8192 + 32);
                __builtin_amdgcn_sched_barrier(0); }
            auto keys2 = [&](const float s0, const float s1) __attribute__((always_inline)) -> unsigned {
                typedef _Float16 h2_t __attribute__((ext_vector_type(2))); typedef short s2_t __attribute__((ext_vector_type(2)));
                h2_t hv = __builtin_convertvector((f32x2){s0, s1}, h2_t); hv = hv + (h2_t){(_Float16)0.0f, (_Float16)0.0f};
                const s2_t hs = __builtin_bit_cast(s2_t, hv); const s2_t sg = hs >> (s2_t){15, 15};
                return __builtin_bit_cast(unsigned, hs) ^ (__builtin_bit_cast(unsigned, sg) | 0x80008000u);
            };
            for (int kt0 = lo; kt0 < hi; kt0 += NPF) {
#pragma unroll
                for (int u = 0; u < NPF; ++u) {
                    const int kt = kt0 + u;
                    f32x4 acc[4];
#pragma unroll
                    for (int hh = 0; hh < 4; ++hh) {
                        acc[hh] = __builtin_amdgcn_mfma_f32_16x16x32_bf16(R[u][0], Q[hh][0], (f32x4){0.f, 0.f, 0.f, 0.f}, 0, 0, 0);
                        acc[hh] = __builtin_amdgcn_mfma_f32_16x16x32_bf16(R[u][1], Q[hh][1], acc[hh], 0, 0, 0);
                    }
                    { const int kn = kt + NPF, kl = kn < hi ? kn : hi - 1; R[u][0] = *(const bf16x8*)(kbase + (size_t)kl * 8192); R[u][1] = *(const bf16x8*)(kbase + (size_t)kl * 8192 + 32); }
                    float sc[4] = {0.f, 0.f, 0.f, 0.f};
#pragma unroll
                    for (int hh = 0; hh < 4; ++hh)
#pragma unroll
                        for (int i = 0; i < 4; ++i) { const float av = acc[hh][i]; const int ai = __builtin_bit_cast(int, av); const int ar = ai > 0 ? ai : 0; sc[i] += w[hh] * __builtin_bit_cast(float, ar); }
                    if (kt < hi) {
                        const unsigned k01 = keys2(sc[0], sc[1]), k23 = keys2(sc[2], sc[3]);
                        const unsigned bin[4] = {(k01 >> 8) & 255u, k01 >> 24, (k23 >> 8) & 255u, k23 >> 24};
                        if (kt == p) {
                            asm volatile("" ::: "memory");
#pragma unroll
                            for (int i = 0; i < 4; ++i) lds_add(hrow + bin[i], (4 * g + i <= c15) ? 1u : 0u);
                        } else {
#pragma unroll
                            for (int i = 0; i < 4; ++i) lds_add(hrow + bin[i], 1u);
                        }
                        *(LAS v2u*)(krow + (kt * 16 + 4 * g) * 2) = (v2u){k01, k23};
                    }
                }
            }
        }
        __syncthreads();
        {
            LAS unsigned* hq[2]; const LAS unsigned char* kq[2]; unsigned qpos[2], b1[2], ab1[2], thr[2], rr[2];
            const int nsteps = (np * 16 + 255) >> 8;
#pragma unroll
            for (int qq = 0; qq < 2; ++qq) { const int q = 2 * wave + qq; hq[qq] = hist + q * HP; kq[qq] = lds + q * KP; qpos[qq] = (unsigned)(q0 + q); }
#pragma unroll
            for (int qq = 0; qq < 2; ++qq) find_bin(hq[qq], 256u, lane, b1[qq], ab1[qq]);
#pragma unroll
            for (int qq = 0; qq < 2; ++qq) for (int z = lane; z < HP; z += 64) hq[qq][z] = 0u;
            {
                auto step = [&](const int s, const bool mk) __attribute__((always_inline)) {
                    const unsigned k0 = (unsigned)(s * 256 + 4 * lane);
                    v2u kw[2];
#pragma unroll
                    for (int qq = 0; qq < 2; ++qq) kw[qq] = *(const LAS v2u*)(kq[qq] + k0 * 2);
#pragma unroll
                    for (int qq = 0; qq < 2; ++qq) { const unsigned key[4] = {kw[qq].x & 0xffffu, kw[qq].x >> 16, kw[qq].y & 0xffffu, kw[qq].y >> 16};
#pragma unroll
                        for (int i = 0; i < 4; ++i) if ((!mk || k0 + i <= qpos[qq]) && (key[i] >> 8) == b1[qq]) lds_add(hq[qq] + (key[i] & 255u), 1u); }
                };
                for (int s = 0; s < nsteps - 1; ++s) step(s, false);
                step(nsteps - 1, true);
            }
#pragma unroll
            for (int qq = 0; qq < 2; ++qq) { unsigned bs, ab; find_bin(hq[qq], 256u - ab1[qq], lane, bs, ab); thr[qq] = (b1[qq] << 8) | bs; rr[qq] = 256u - (ab1[qq] + ab); }
            unsigned cnt[2] = {0u, 0u}, ties[2] = {0u, 0u};
            {
                auto step = [&](const int s, const bool mk) __attribute__((always_inline)) {
                    const unsigned k0 = (unsigned)(s * 256 + 4 * lane);
                    v2u kw[2];
#pragma unroll
                    for (int qq = 0; qq < 2; ++qq) kw[qq] = *(const LAS v2u*)(kq[qq] + k0 * 2);
                    bool tie[2][4], sel[2][4]; bool anyt = false;
#pragma unroll
                    for (int qq = 0; qq < 2; ++qq) { const unsigned key[4] = {kw[qq].x & 0xffffu, kw[qq].x >> 16, kw[qq].y & 0xffffu, kw[qq].y >> 16};
#pragma unroll
                        for (int i = 0; i < 4; ++i) { const bool valid = !mk || k0 + i <= qpos[qq]; tie[qq][i] = valid && key[i] == thr[qq]; sel[qq][i] = valid && key[i] > thr[qq]; anyt = anyt || tie[qq][i]; } }
                    if (__ballot(anyt) != 0ull) {
                        asm volatile("" ::: "memory");
#pragma unroll
                        for (int qq = 0; qq < 2; ++qq) { unsigned tlow = 0, tall = 0;
#pragma unroll
                            for (int i = 0; i < 4; ++i) { const unsigned long long bm = __ballot(tie[qq][i]); tlow = __builtin_amdgcn_mbcnt_hi((unsigned)(bm >> 32), __builtin_amdgcn_mbcnt_lo((unsigned)bm, tlow)); tall += (unsigned)__popcll(bm); }
                            unsigned trun = ties[qq] + tlow;
#pragma unroll
                            for (int i = 0; i < 4; ++i) { sel[qq][i] = sel[qq][i] || (tie[qq][i] && trun < rr[qq]); trun += tie[qq][i] ? 1u : 0u; }
                            ties[qq] += tall; }
                    }
#pragma unroll
                    for (int qq = 0; qq < 2; ++qq) { LAS unsigned short* list = (LAS unsigned short*)hq[qq];
                        unsigned slow = 0, sall = 0;
#pragma unroll
                        for (int i = 0; i < 4; ++i) { const unsigned long long bm = __ballot(sel[qq][i]); slow = __builtin_amdgcn_mbcnt_hi((unsigned)(bm >> 32), __builtin_amdgcn_mbcnt_lo((unsigned)bm, slow)); sall += (unsigned)__popcll(bm); }
                        unsigned pos = cnt[qq] + slow;
#pragma unroll
                        for (int i = 0; i < 4; ++i) { const unsigned wpos = (sel[qq][i] && pos < 256u) ? pos : 256u + (unsigned)lane; list[wpos] = (unsigned short)(k0 + i); pos += sel[qq][i] ? 1u : 0u; }
                        cnt[qq] += sall; }
                };
                for (int s = 0; s < nsteps - 1; ++s) step(s, false);
                step(nsteps - 1, true);
            }
        }
        __syncthreads();
        { const int q = F.tid >> 5, ch = F.tid & 31; const v4u v = *(const LAS v4u*)((const LAS unsigned char*)(hist + q * HP) + ch * 16); *(v4u*)((unsigned char*)(IDX + (tok0 + q) * 256) + ch * 16) = v; }
        __syncthreads();
    }
}

__device__ __forceinline__ unsigned off_b(unsigned row, unsigned ch) { return 256u * row + 16u * (ch ^ (((row & 3) << 2) | ((row >> 2) & 3))); }
__device__ __forceinline__ void p4_sparse_attn(Frame& F) {
    const bf16* CKV = WSP(bf16, WS_CKV); const unsigned short* IDX = WSP(unsigned short, WS_IDX); bf16* QL = WSP(bf16, WS_QLAT);
    LAS unsigned char* img0 = F.lds + F.wave * 16384;
    const int lane = F.lane, g = lane >> 4, c15 = lane & 15, qq = c15 >> 2, pp = lane & 3;
    const int t0 = F.gw * 32; constexpr int NF = 256;
    v4u ixw; v4u rw[8];
    const unsigned goff = 16u * g, coff = 16u * c15;
#define SA_LOAD_IDX(f_) { const int f2 = (f_) < NF ? (f_) : NF - 1; ixw = *(const v4u*)((const unsigned char*)(IDX + (size_t)(t0 + (f2 >> 3)) * 256 + (f2 & 7) * 32) + goff); }
#define SA_IX(c_) (((c_) & 1) ? (ixw[(c_) >> 1] >> 16) : (ixw[(c_) >> 1] & 0xffffu))
#define SA_LOAD_ROWS(f_) { const int f2 = (f_) < NF ? (f_) : NF - 1; const unsigned char* rbp = (const unsigned char*)(CKV + (size_t)((t0 + (f2 >> 3)) >> 12) * SEQ * 128); \
        _Pragma("unroll") for (int c = 0; c < 8; ++c) rw[c] = *(const v4u*)(rbp + ((SA_IX(c) << 8) + coff)); }
    SA_LOAD_IDX(0); SA_LOAD_ROWS(0); SA_LOAD_IDX(1);
    bf16x8 Bq[4], Bqn[4];
#pragma unroll
    for (int ks = 0; ks < 4; ++ks) { Bqn[ks] = (bf16x8){0, 0, 0, 0, 0, 0, 0, 0}; if (c15 < 8) Bqn[ks] = *(const bf16x8*)(QL + (size_t)t0 * 1024 + c15 * 128 + ks * 32 + 8 * g); Bq[ks] = Bqn[ks]; }
    float mrun = -1e30f, lsum = 0.f;
    f32x4 O[8];
#pragma unroll
    for (int c = 0; c < 8; ++c) O[c] = (f32x4){0.f, 0.f, 0.f, 0.f};
    for (int f = 0; f < NF; ++f) {
        const int t = t0 + (f >> 3), im = f & 7; const int pos = t & (SEQ - 1); const int nsel = pos + 1 < 256 ? pos + 1 : 256;
        LAS unsigned char* img = img0 + (f & 1) * 8192;
#pragma unroll
        for (int c = 0; c < 8; ++c) *(LAS v4u*)(img + off_b(8 * g + c, c15)) = rw[c];
        SA_LOAD_ROWS(f + 1);
        SA_LOAD_IDX(f + 2);
        if (im == 0) {
#pragma unroll
            for (int ks = 0; ks < 4; ++ks) Bq[ks] = Bqn[ks];
            mrun = -1e30f; lsum = 0.f;
#pragma unroll
            for (int c = 0; c < 8; ++c) O[c] = (f32x4){0.f, 0.f, 0.f, 0.f};
        }
        if (im == 2) { const int tn = (t + 1 < t0 + 32) ? t + 1 : t;
#pragma unroll
            for (int ks = 0; ks < 4; ++ks) if (c15 < 8) Bqn[ks] = *(const bf16x8*)(QL + (size_t)tn * 1024 + c15 * 128 + ks * 32 + 8 * g); }
        f32x4 sacc[2];
#pragma unroll
        for (int rb = 0; rb < 2; ++rb) { sacc[rb] = (f32x4){0.f, 0.f, 0.f, 0.f};
#pragma unroll
            for (int ks = 0; ks < 4; ++ks) { const bf16x8 a = *(const LAS bf16x8*)(img + off_b(c15 + 16 * rb, 4 * ks + g)); sacc[rb] = __builtin_amdgcn_mfma_f32_16x16x32_bf16(a, Bq[ks], sacc[rb], 0, 0, 0); } }
        if (nsel < 256) {
            asm volatile("" ::: "memory");
#pragma unroll
            for (int rb = 0; rb < 2; ++rb)
#pragma unroll
                for (int i = 0; i < 4; ++i) { const int j = im * 32 + 16 * rb + 4 * g + i; if (j >= nsel) sacc[rb][i] = -1e30f; }
        }
        float mx = -1e30f;
#pragma unroll
        for (int rb = 0; rb < 2; ++rb)
#pragma unroll
            for (int i = 0; i < 4; ++i) mx = fmaxf(mx, sacc[rb][i]);
        mx = fmaxf(mx, __shfl_xor(mx, 16)); mx = fmaxf(mx, __shfl_xor(mx, 32));
        const float mnew = fmaxf(mrun, mx), alpha = __expf(mrun - mnew), mneg = -1.4426950408889634f * mnew;
        float ps = 0.f; float pv[8];
#pragma unroll
        for (int rb = 0; rb < 2; ++rb)
#pragma unroll
            for (int i = 0; i < 4; ++i) { const float pe = __builtin_amdgcn_exp2f(__builtin_fmaf(sacc[rb][i], 1.4426950408889634f, mneg)); pv[4 * rb + i] = pe; ps += pe; }
        ps += __shfl_xor(ps, 16); ps += __shfl_xor(ps, 32);
        lsum = lsum * alpha + ps; mrun = mnew;
        const v4u pw = (v4u){cvt_pk_bf16(pv[0], pv[1]), cvt_pk_bf16(pv[2], pv[3]), cvt_pk_bf16(pv[4], pv[5]), cvt_pk_bf16(pv[6], pv[7])};
        const bf16x8 pa = __builtin_bit_cast(bf16x8, pw);
        float al[4];
#pragma unroll
        for (int i = 0; i < 4; ++i) al[i] = __shfl(alpha, (4 * g + i) & 15);
#pragma unroll
        for (int c = 0; c < 8; ++c) {
#pragma unroll
            for (int i = 0; i < 4; ++i) O[c][i] *= al[i];
            const s16x4 lo = __builtin_bit_cast(s16x4, __builtin_amdgcn_ds_read_tr16_b64_v4i16((LAS s16x4*)(img + off_b(4 * g + qq, 2 * c + (pp >> 1)) + 8 * (pp & 1))));
            const s16x4 hi = __builtin_bit_cast(s16x4, __builtin_amdgcn_ds_read_tr16_b64_v4i16((LAS s16x4*)(img + off_b(16 + 4 * g + qq, 2 * c + (pp >> 1)) + 8 * (pp & 1))));
            const bf16x8 bv = (bf16x8){lo[0], lo[1], lo[2], lo[3], hi[0], hi[1], hi[2], hi[3]};
            O[c] = __builtin_amdgcn_mfma_f32_16x16x32_bf16(pa, bv, O[c], 0, 0, 0);
        }
        if (im == 7) {
            float inv[4];
#pragma unroll
            for (int i = 0; i < 4; ++i) inv[i] = __builtin_amdgcn_rcpf(__shfl(lsum, (4 * g + i) & 15));
            if (g < 2) {
#pragma unroll
                for (int c = 0; c < 8; ++c)
#pragma unroll
                    for (int i = 0; i < 4; ++i) *(LAS unsigned short*)(img + ((4 * g + i) * 128 + 16 * c + c15) * 2) = (unsigned short)(cvt_pk_bf16(O[c][i] * inv[i], 0.f) & 0xffffu);
            }
            const v4u o0 = *(const LAS v4u*)(img + lane * 32), o1 = *(const LAS v4u*)(img + lane * 32 + 16);
            *(v4u*)(QL + (size_t)t * 1024 + lane * 16) = o0; *(v4u*)(QL + (size_t)t * 1024 + lane * 16 + 8) = o1;
        }
    }
#undef SA_LOAD_IDX
#undef SA_IX
#undef SA_LOAD_ROWS
}

__device__ __forceinline__ void p10_cross_attn(Frame& F) {
    const bf16* QC = WSP(bf16, WS_QC); bf16* XO = WSP(bf16, WS_XO); const bf16* Km = WSP(bf16, WS_KMEM); const bf16* Vt = WSP(bf16, WS_VT);
    const int lane = F.lane, g = lane >> 4, c15 = lane & 15;
    constexpr int RS = 528, BUFB = 64 * RS, NU = NB * 4 * 16;
    const int srow = F.tid >> 5, spc = F.tid & 31;
#define X_SRC(u_, c_) ((c_) < 4 ? (const unsigned char*)(Km + ((size_t)((u_) >> 6) * 256 + (c_) * 64 + srow) * 1024 + (((u_) >> 4) & 3) * 256) + spc * 16 \
                               : (const unsigned char*)(Vt + ((size_t)((u_) >> 4) * 256 + ((c_) - 4) * 64 + srow) * 256) + spc * 16)
#define X_LOAD(st_, u_, c_) { const unsigned char* s_ = X_SRC(u_, c_); _Pragma("unroll") for (int j = 0; j < 4; ++j) st_[j] = *(const v4u*)(s_ + (size_t)j * 16 * ((c_) < 4 ? 2048 : 512)); }
#define X_PUT(st_, bi_) { _Pragma("unroll") for (int j = 0; j < 4; ++j) *(LAS v4u*)(F.lds + (bi_) * BUFB + (srow + 16 * j) * RS + spc * 16) = st_[j]; }
#define X_QROW(u_, t_) (QC + ((size_t)((u_) >> 6) * SEQ + ((u_) & 15) * 256 + F.wave * 32 + (t_) * 16 + c15) * 1024 + (((u_) >> 4) & 3) * 256)
    if (F.vcu >= NU) return;
    v4u st0[4], st1[4];
    bf16x8 Bq[2][8];
    {
        const int u = F.vcu;
        X_LOAD(st0, u, 0); X_LOAD(st1, u, 1);
#pragma unroll
        for (int t = 0; t < 2; ++t) { const bf16* qrow = X_QROW(u, t);
#pragma unroll
            for (int ks = 0; ks < 8; ++ks) Bq[t][ks] = *(const bf16x8*)(qrow + ks * 32 + 8 * g); }
        X_PUT(st0, 0);
    }
    for (int u = F.vcu; u < NU; u += F.G) {
        const int un = (u + F.G < NU) ? u + F.G : u;
        bf16x8 pb[2][8]; float mc[2][4], Ls[2] = {0.f, 0.f}, inv[2] = {0.f, 0.f};
#pragma unroll
        for (int cs = 0; cs < 8; ++cs) {
            if (cs & 1) { if (cs + 2 < 8) { X_LOAD(st1, u, cs + 2); } else { X_LOAD(st1, un, cs + 2 - 8); } }
            else        { if (cs + 2 < 8) { X_LOAD(st0, u, cs + 2); } else { X_LOAD(st0, un, cs + 2 - 8); } }
            __syncthreads();
            const LAS unsigned char* buf = F.lds + (cs & 1) * BUFB;
            if (cs < 4) {
                f32x4 acc[2][4];
                bf16x8 Af[2][4];
                const LAS unsigned char* kb = buf + c15 * RS + 16 * g;
#define X_LDK(gi_) { _Pragma("unroll") for (int q = 0; q < 4; ++q) Af[(gi_) & 1][q] = *(const LAS bf16x8*)(kb + ((gi_) >> 1) * 16 * RS + (((gi_) & 1) * 4 + q) * 64); }
                X_LDK(0);
                f32x4 a0 = (f32x4){0.f, 0.f, 0.f, 0.f}, a1 = a0;
#pragma unroll
                for (int gi = 0; gi < 8; ++gi) {
                    if (gi + 1 < 8) X_LDK(gi + 1);
                    __builtin_amdgcn_sched_barrier(0);
                    if (!(gi & 1)) { a0 = (f32x4){0.f, 0.f, 0.f, 0.f}; a1 = a0; }
#pragma unroll
                    for (int q = 0; q < 4; ++q) { a0 = __builtin_amdgcn_mfma_f32_16x16x32_bf16(Af[gi & 1][q], Bq[0][(gi & 1) * 4 + q], a0, 0, 0, 0); a1 = __builtin_amdgcn_mfma_f32_16x16x32_bf16(Af[gi & 1][q], Bq[1][(gi & 1) * 4 + q], a1, 0, 0, 0); }
                    if (gi & 1) { acc[0][gi >> 1] = a0; acc[1][gi >> 1] = a1; }
                    __builtin_amdgcn_sched_barrier(0);
                }
#undef X_LDK
#pragma unroll
                for (int t = 0; t < 2; ++t) {
                    float mx = -1e30f;
#pragma unroll
                    for (int m4 = 0; m4 < 4; ++m4)
#pragma unroll
                        for (int i = 0; i < 4; ++i) mx = fmaxf(mx, acc[t][m4][i]);
                    mx = fmaxf(mx, __shfl_xor(mx, 16)); mx = fmaxf(mx, __shfl_xor(mx, 32));
                    if (cs > 0) mx = fmaxf(mx, mc[t][cs > 0 ? cs - 1 : 0]);
                    float ps = (cs > 0) ? Ls[t] * __expf(mc[t][cs > 0 ? cs - 1 : 0] - mx) : 0.f;
#pragma unroll
                    for (int s2 = 0; s2 < 2; ++s2) { float e[8];
#pragma unroll
                        for (int i = 0; i < 4; ++i) { e[i] = __expf(acc[t][2 * s2][i] - mx); e[4 + i] = __expf(acc[t][2 * s2 + 1][i] - mx); ps += e[i] + e[4 + i]; }
                        const v4u w = (v4u){cvt_pk_bf16(e[0], e[1]), cvt_pk_bf16(e[2], e[3]), cvt_pk_bf16(e[4], e[5]), cvt_pk_bf16(e[6], e[7])}; pb[t][cs * 2 + s2] = __builtin_bit_cast(bf16x8, w); }
                    mc[t][cs] = mx; Ls[t] = ps;
                }
                if (cs == 3) {
#pragma unroll
                    for (int t = 0; t < 2; ++t) {
                        const float M = mc[t][3];
                        float L = Ls[t];
#pragma unroll
                        for (int c = 0; c < 3; ++c) { const float f = __expf(mc[t][c] - M);
#pragma unroll
                            for (int s2 = 0; s2 < 2; ++s2) { const v4u w = __builtin_bit_cast(v4u, pb[t][c * 2 + s2]);
                                const v4u r = (v4u){cvt_pk_bf16(bflo(w.x) * f, bfhi(w.x) * f), cvt_pk_bf16(bflo(w.y) * f, bfhi(w.y) * f), cvt_pk_bf16(bflo(w.z) * f, bfhi(w.z) * f), cvt_pk_bf16(bflo(w.w) * f, bfhi(w.w) * f)};
                                pb[t][c * 2 + s2] = __builtin_bit_cast(bf16x8, r); } }
                        L += __shfl_xor(L, 16); L += __shfl_xor(L, 32);
                        inv[t] = 1.0f / L;
                    }
#pragma unroll
                    for (int t = 0; t < 2; ++t) { const bf16* qn = X_QROW(un, t);
#pragma unroll
                        for (int ks = 0; ks < 8; ++ks) Bq[t][ks] = *(const bf16x8*)(qn + ks * 32 + 8 * g); }
                }
            } else {
                unsigned char* q0 = (unsigned char*)XO + (X_QROW(u, 0) - QC); unsigned char* q1 = (unsigned char*)XO + (X_QROW(u, 1) - QC);
                v4u Vf[2][4];
                const LAS unsigned char* vb = buf + c15 * RS + 8 * g;
#define X_LDV(gi_) { _Pragma("unroll") for (int q = 0; q < 4; ++q) { const LAS unsigned char* p_ = vb + ((gi_) >> 1) * 16 * RS + (((gi_) & 1) * 4 + q) * 64; \
                        const v2u lo = *(const LAS v2u*)p_, hi = *(const LAS v2u*)(p_ + 32); Vf[(gi_) & 1][q] = (v4u){lo.x, lo.y, hi.x, hi.y}; } }
                X_LDV(0);
                f32x4 o0 = (f32x4){0.f, 0.f, 0.f, 0.f}, o1 = o0;
#pragma unroll
                for (int gi = 0; gi < 8; ++gi) {
                    if (gi + 1 < 8) X_LDV(gi + 1);
                    __builtin_amdgcn_sched_barrier(0);
                    if (!(gi & 1)) { o0 = (f32x4){0.f, 0.f, 0.f, 0.f}; o1 = o0; }
#pragma unroll
                    for (int q = 0; q < 4; ++q) { const bf16x8 av = __builtin_bit_cast(bf16x8, Vf[gi & 1][q]);
                        o0 = __builtin_amdgcn_mfma_f32_16x16x32_bf16(av, pb[0][(gi & 1) * 4 + q], o0, 0, 0, 0); o1 = __builtin_amdgcn_mfma_f32_16x16x32_bf16(av, pb[1][(gi & 1) * 4 + q], o1, 0, 0, 0); }
                    if (gi & 1) { const int d4 = gi >> 1;
                        *(unsigned*)(q0 + ((cs - 4) * 4 + d4) * 16 + 4 * g) = pk4_fp8(o0[0] * inv[0], o0[1] * inv[0], o0[2] * inv[0], o0[3] * inv[0]);
                        *(unsigned*)(q1 + ((cs - 4) * 4 + d4) * 16 + 4 * g) = pk4_fp8(o1[0] * inv[1], o1[1] * inv[1], o1[2] * inv[1], o1[3] * inv[1]); }
                    __builtin_amdgcn_sched_barrier(0);
                }
#undef X_LDV
            }
            if (cs & 1) { X_PUT(st0, 0); } else { X_PUT(st1, 1); }
        }
    }
    __syncthreads();
#undef X_SRC
#undef X_LOAD
#undef X_PUT
#undef X_QROW
}

__device__ __forceinline__ void rms_row16(const bf16* xrow, const float* g, bf16* orow, int lane, unsigned char* o8row) {
    const v4u a = *((const v4u*)xrow + 2 * lane), b = *((const v4u*)xrow + 2 * lane + 1);
    float v[16] = {bflo(a.x), bfhi(a.x), bflo(a.y), bfhi(a.y), bflo(a.z), bfhi(a.z), bflo(a.w), bfhi(a.w), bflo(b.x), bfhi(b.x), bflo(b.y), bfhi(b.y), bflo(b.z), bfhi(b.z), bflo(b.w), bfhi(b.w)};
    float s = 0.f;
#pragma unroll
    for (int e = 0; e < 16; ++e) s += v[e] * v[e];
    const float rstd = rsqrtf(wave_sum(s) * (1.f / 1024.f) + 1e-6f);
    const f32x4* gr = (const f32x4*)g + 4 * lane;
#pragma unroll
    for (int q = 0; q < 4; ++q) { const f32x4 gg = gr[q]; v[4 * q] *= rstd * gg[0]; v[4 * q + 1] *= rstd * gg[1]; v[4 * q + 2] *= rstd * gg[2]; v[4 * q + 3] *= rstd * gg[3]; }
    *((v4u*)orow + 2 * lane) = (v4u){cvt_pk_bf16(v[0], v[1]), cvt_pk_bf16(v[2], v[3]), cvt_pk_bf16(v[4], v[5]), cvt_pk_bf16(v[6], v[7])};
    *((v4u*)orow + 2 * lane + 1) = (v4u){cvt_pk_bf16(v[8], v[9]), cvt_pk_bf16(v[10], v[11]), cvt_pk_bf16(v[12], v[13]), cvt_pk_bf16(v[14], v[15])};
    if (o8row) *((v4u*)o8row + lane) = (v4u){pk4_fp8(v[0], v[1], v[2], v[3]), pk4_fp8(v[4], v[5], v[6], v[7]), pk4_fp8(v[8], v[9], v[10], v[11]), pk4_fp8(v[12], v[13], v[14], v[15])};
}
__device__ __forceinline__ void rms_row16_do(const v4u a, const v4u b, const f32x4 (&gv)[4], bf16* orow, int lane, unsigned char* o8row) {
    float v[16] = {bflo(a.x), bfhi(a.x), bflo(a.y), bfhi(a.y), bflo(a.z), bfhi(a.z), bflo(a.w), bfhi(a.w), bflo(b.x), bfhi(b.x), bflo(b.y), bfhi(b.y), bflo(b.z), bfhi(b.z), bflo(b.w), bfhi(b.w)};
    float s = 0.f;
#pragma unroll
    for (int e = 0; e < 16; ++e) s += v[e] * v[e];
    const float rstd = rsqrtf(wave_sum(s) * (1.f / 1024.f) + 1e-6f);
#pragma unroll
    for (int q = 0; q < 4; ++q) { const f32x4 gg = gv[q]; v[4 * q] *= rstd * gg[0]; v[4 * q + 1] *= rstd * gg[1]; v[4 * q + 2] *= rstd * gg[2]; v[4 * q + 3] *= rstd * gg[3]; }
    if (orow) {
        *((v4u*)orow + 2 * lane) = (v4u){cvt_pk_bf16(v[0], v[1]), cvt_pk_bf16(v[2], v[3]), cvt_pk_bf16(v[4], v[5]), cvt_pk_bf16(v[6], v[7])};
        *((v4u*)orow + 2 * lane + 1) = (v4u){cvt_pk_bf16(v[8], v[9]), cvt_pk_bf16(v[10], v[11]), cvt_pk_bf16(v[12], v[13]), cvt_pk_bf16(v[14], v[15])}; }
    if (o8row) *((v4u*)o8row + lane) = (v4u){pk4_fp8(v[0], v[1], v[2], v[3]), pk4_fp8(v[4], v[5], v[6], v[7]), pk4_fp8(v[8], v[9], v[10], v[11]), pk4_fp8(v[12], v[13], v[14], v[15])};
}
__device__ __forceinline__ void p_norm_rows16(Frame& F, const bf16* src, const float* g, bf16* dst, unsigned char* dst8) {
    const int lane = F.lane, step = F.NGW; int m = F.gw;
    if (m >= T) return;
    f32x4 gv[4];
#pragma unroll
    for (int q = 0; q < 4; ++q) gv[q] = *((const f32x4*)g + 4 * lane + q);
#define NR_LD(a_, b_, m_) { const int mm_ = (m_) < T ? (m_) : m; a_ = *((const v4u*)(src + (size_t)mm_ * D) + 2 * lane); b_ = *((const v4u*)(src + (size_t)mm_ * D) + 2 * lane + 1); __builtin_amdgcn_sched_barrier(0); }
#define NR_DO(a_, b_) { if (m < T) { const v4u ca_ = a_, cb_ = b_; NR_LD(a_, b_, m + 3 * step); rms_row16_do(ca_, cb_, gv, dst ? dst + (size_t)m * D : nullptr, lane, dst8 ? dst8 + (size_t)m * D : nullptr); m += step; } }
    v4u a0, b0, a1, b1, a2, b2;
    NR_LD(a0, b0, m); NR_LD(a1, b1, m + step); NR_LD(a2, b2, m + 2 * step);
    while (m < T) { NR_DO(a0, b0); NR_DO(a1, b1); NR_DO(a2, b2); }
#undef NR_LD
#undef NR_DO
}
__device__ __forceinline__ void p_norm_rows(Frame& F, const float* g, bf16* dst, unsigned char* dst8 = nullptr) {
    for (int m = F.gw; m < T; m += F.NGW) rms_row_to_bf16(F.out + (size_t)m * D, g, dst + (size_t)m * D, F.lane, dst8 ? (unsigned*)(dst8 + (size_t)m * D) : nullptr);
}

struct TokInfo { int e0, e1; float g0, g1; };
__device__ __forceinline__ void p14a_route(Frame& F) {
    const float* L = WSP(float, WS_LOGIT); TokInfo* TI = WSP(TokInfo, WS_ROUTE); const float* bg = F.in[29]; const float* be = F.in[31];
    volatile LAS unsigned* lh = (volatile LAS unsigned*)F.lds;
    if (F.tid < 32) lh[F.tid] = 0u;
    __syncthreads();
    const int t = F.vcu * 256 + F.tid;
    if (F.tid < 256) {
        const float* l = L + (size_t)t * 64;
        float gl[4]; int grp = 0; float gm = -1e30f;
#pragma unroll
        for (int i = 0; i < 4; ++i) { gl[i] = l[i] + bg[i]; if (gl[i] > gm) { gm = gl[i]; grp = i; } }
        float gs = 0.f;
#pragma unroll
        for (int i = 0; i < 4; ++i) gs += __expf(gl[i] - gm);
        const float pgrp = 1.0f / gs;
        float el[8];
#pragma unroll
        for (int i = 0; i < 8; ++i) el[i] = l[4 + grp * 8 + i] + be[grp * 8 + i];
        int i0 = 0; float m0 = -1e30f;
#pragma unroll
        for (int i = 0; i < 8; ++i) if (el[i] > m0) { m0 = el[i]; i0 = i; }
        int i1 = 0; float m1 = -1e30f;
#pragma unroll
        for (int i = 0; i < 8; ++i) if (i != i0 && el[i] > m1) { m1 = el[i]; i1 = i; }
        const float p1 = __expf(m1 - m0);
        TokInfo ti; ti.e0 = grp * 8 + i0; ti.e1 = grp * 8 + i1; ti.g0 = pgrp / (1.f + p1); ti.g1 = pgrp * p1 / (1.f + p1);
        TI[t] = ti;
        lds_add((LAS unsigned*)&lh[ti.e0], 1u); lds_add((LAS unsigned*)&lh[ti.e1], 1u);
    }
    __syncthreads();
    if (F.tid < 32 && lh[F.tid]) atomicAdd(F.ctl + CW_CNT + F.tid, lh[F.tid]);
}
__device__ __forceinline__ void moe_tstart(Frame& F, volatile LAS int* tstart) {
    if (F.tid == 0) { int acc = 0; for (int e = 0; e < 32; ++e) { tstart[e] = acc; acc += (int)((__hip_atomic_load(F.ctl + CW_CNT + e, __ATOMIC_RELAXED, __HIP_MEMORY_SCOPE_AGENT) + 255u) >> 8); } tstart[32] = acc; }
    __syncthreads();
}
__device__ __forceinline__ void p14b_slots(Frame& F) {
    const TokInfo* TI = WSP(TokInfo, WS_ROUTE); int* TS = (int*)(F.ws + WS_ROUTE + 1 * MiB); int* stok = (int*)(F.ws + WS_ROUTE + 2 * MiB); float* sgate = (float*)(F.ws + WS_ROUTE + 3 * MiB);
    volatile LAS int* tstart = (volatile LAS int*)(F.lds + MISC_OFF + 256);
    volatile LAS unsigned* lh = (volatile LAS unsigned*)F.lds; volatile LAS unsigned* lbase = lh + 32;
    if (F.tid < 32) lh[F.tid] = 0u;
    moe_tstart(F, tstart);
    const int t = F.vcu * 256 + F.tid; TokInfo ti; unsigned r0 = 0, r1 = 0;
    if (F.tid < 256) { ti = TI[t]; r0 = lds_add((LAS unsigned*)&lh[ti.e0], 1u); r1 = lds_add((LAS unsigned*)&lh[ti.e1], 1u); }
    __syncthreads();
    if (F.tid < 32) lbase[F.tid] = lh[F.tid] ? atomicAdd(F.ctl + CW_FILL + F.tid, lh[F.tid]) : 0u;
    __syncthreads();
    if (F.tid < 256) {
        const int s0 = tstart[ti.e0] * 256 + (int)(lbase[ti.e0] + r0), s1 = tstart[ti.e1] * 256 + (int)(lbase[ti.e1] + r1);
        stok[s0] = t; sgate[s0] = ti.g0; stok[s1] = t; sgate[s1] = ti.g1; TS[2 * t] = s0; TS[2 * t + 1] = s1;
    }
    if (F.vcu < 32) {
        const int e = F.vcu; const int cnt = (int)__hip_atomic_load(F.ctl + CW_CNT + e, __ATOMIC_RELAXED, __HIP_MEMORY_SCOPE_AGENT); const int base = tstart[e] * 256, end = tstart[e + 1] * 256;
        for (int s = base + cnt + F.tid; s < end; s += NTHREADS) { stok[s] = 0; sgate[s] = 0.f; }
    }
}

__device__ __forceinline__ void p17_final(Frame& F) {
    const int* TS = (const int*)(F.ws + WS_ROUTE + 1 * MiB); const bf16* YS = WSP(bf16, WS_YS); const bf16* H2 = WSP(bf16, WS_H2B); const float* gn = F.in[35];
    const int lane = F.lane, step = F.NGW; int m = F.gw;
    if (m >= T) return;
    f32x4 gg[4];
#pragma unroll
    for (int j = 0; j < 4; ++j) gg[j] = *((const f32x4*)gn + lane + 64 * j);
    struct Row { v2u h[4], a[4], c[4]; };
#define FN_IDX(i_, m_) { const int mm_ = (m_) < T ? (m_) : F.gw; i_ = *(const int2*)(TS + 2 * mm_); }
#define FN_LD(r_, i_, m_) { const int mm_ = (m_) < T ? (m_) : F.gw; const v2u* hr = (const v2u*)(H2 + (size_t)mm_ * D) + lane; const v2u* y0 = (const v2u*)(YS + (size_t)i_.x * 1024) + lane; \
        const v2u* y1 = (const v2u*)(YS + (size_t)i_.y * 1024) + lane; _Pragma("unroll") for (int j = 0; j < 4; ++j) { r_.h[j] = hr[64 * j]; r_.a[j] = y0[64 * j]; r_.c[j] = y1[64 * j]; } __builtin_amdgcn_sched_barrier(0); }
    Row r0, r1; int2 i0, i1, j0, j1;
    FN_IDX(i0, m); FN_IDX(i1, m + step);
    FN_LD(r0, i0, m); FN_LD(r1, i1, m + step);
    FN_IDX(j0, m + 2 * step); FN_IDX(j1, m + 3 * step);
#define FN_DO(r_, jn_) { if (m < T) { const Row q_ = r_; const int2 in_ = jn_; FN_LD(r_, in_, m + 2 * step); FN_IDX(jn_, m + 4 * step); \
        f32x4 v[4]; float s = 0.f; \
        _Pragma("unroll") for (int j = 0; j < 4; ++j) { v[j] = (f32x4){bflo(q_.h[j].x), bfhi(q_.h[j].x), bflo(q_.h[j].y), bfhi(q_.h[j].y)}; \
            v[j].x += bflo(q_.a[j].x) + bflo(q_.c[j].x); v[j].y += bfhi(q_.a[j].x) + bfhi(q_.c[j].x); v[j].z += bflo(q_.a[j].y) + bflo(q_.c[j].y); v[j].w += bfhi(q_.a[j].y) + bfhi(q_.c[j].y); \
            s += (v[j].x * v[j].x + v[j].y * v[j].y) + (v[j].z * v[j].z + v[j].w * v[j].w); } \
        const float rstd = rsqrtf(wave_sum(s) * (1.f / 1024.f) + 1e-6f); f32x4* xr = (f32x4*)(F.out + (size_t)m * D) + lane; \
        _Pragma("unroll") for (int j = 0; j < 4; ++j) xr[64 * j] = (f32x4){v[j].x * rstd * gg[j].x, v[j].y * rstd * gg[j].y, v[j].z * rstd * gg[j].z, v[j].w * rstd * gg[j].w}; \
        m += step; } }
    while (m < T) { FN_DO(r0, j0); FN_DO(r1, j1); }
#undef FN_IDX
#undef FN_LD
#undef FN_DO
}

__global__ void __launch_bounds__(NTHREADS, 2) hybrid_fwd(Args args) {
    extern __shared__ __attribute__((aligned(16))) unsigned char lds_raw[];
    cg::grid_group grid = cg::this_grid();
    Frame F;
    F.lds = (LAS unsigned char*)lds_raw; F.MISC = (volatile LAS unsigned*)(F.lds + MISC_OFF);
    F.tid = threadIdx.x; F.lane = F.tid & 63; F.wave = __builtin_amdgcn_readfirstlane(F.tid >> 6);
    F.G = gridDim.x; { const int bx = blockIdx.x; F.vcu = (F.G % 8 == 0) ? (bx % 8) * (F.G / 8) + bx / 8 : bx; }
    F.gw = F.vcu * NWAVES + F.wave; F.NGW = F.G * NWAVES;
    F.in = args.in; F.out = args.out; F.ws = args.ws; F.ctl = (unsigned*)(args.ws + WS_CTL);
    for (int u = F.tid; u < (LDS_BYTES - MISC_OFF) / 4; u += NTHREADS) ((LAS unsigned*)(F.lds + MISC_OFF))[u] = 0u;
    __syncthreads();
    XcdBarrier bar = xcd_barrier_post(F.ctl + CW_BAR, F.MISC + 8);
#ifdef USE_CG_BAR
#define GRID_BAR() grid.sync()
#else
#define GRID_BAR() do { xcd_barrier(bar); asm volatile("" : "+v"(F.tid), "+v"(F.lane)); } while (0)
#endif
    const int c = (int)blockIdx.x;

#ifndef PHASE_MASK
#define PHASE_MASK 0xffffffffu
#endif
#ifndef PROBE_DUP
#define PROBE_DUP 0u
#endif
#define PH(n) for (int _rep = 0; _rep < (((PROBE_DUP) >> (n)) & 1u) + 1; ++_rep) if (PHASE_MASK & (1u << (n)))
#ifdef DIAG_FILL
    {
        const size_t n16 = (WS_END - 2 * MiB) / 16; v4u* p = (v4u*)(F.ws + 2 * MiB);
        for (size_t i = (size_t)F.vcu * NTHREADS + F.tid; i < n16; i += (size_t)F.G * NTHREADS) p[i] = (v4u){0, 0, 0, 0};
        const size_t m16 = ((size_t)T * D * 4) / 16; v4u* q = (v4u*)F.out;
        for (size_t i = (size_t)F.vcu * NTHREADS + F.tid; i < m16; i += (size_t)F.G * NTHREADS) q[i] = (v4u){0, 0, 0, 0};
        grid.sync();
    }
#endif
    PH(0) p0_prologue(F);
    grid.sync();
    asm volatile("" : "+v"(F.tid), "+v"(F.lane));
    PH(1) { pg8::StaticOrder S; S.init(DOP(bf16, DO_XN), WSP(bf16, WS_WIN), T, 1792, 1024, F.G, c);
      EpiMain E{WSP(bf16, WS_ZRKV), WSP(bf16, WS_ZLORA), WSP(bf16, WS_QLAT), WSP(bf16, WS_ZD), WSP(bf16, WS_G), F.in[20]};
      pg8::gemm_phase<EpiMain, pg8::StaticOrder, false>(F.lds, 1024, S, E); }
    PH(1) { pg8::StaticOrder S; S.init(DOP(bf16, DO_XN), WSP(bf16, WS_WIN) + (size_t)2816 * 1024, T, 512, 1024, F.G, c);
      EpiMain E{WSP(bf16, WS_ZRKV), WSP(bf16, WS_ZLORA), WSP(bf16, WS_QLAT), WSP(bf16, WS_ZD), WSP(bf16, WS_G), F.in[20], 11};
      pg8::gemm_phase<EpiMain, pg8::StaticOrder, false>(F.lds, 1024, S, E); }
    PH(1) { pg8::StaticOrder S; S.init(F.ws + WS_XN8, F.ws + WS_WQ8, T, 1024, 512, F.G, c);
      EpiBf16 E{WSP(bf16, WS_QLAT), 1024, 1, 0, 1.0f / 256.f};
      pg8::gemm_phase<EpiBf16, pg8::StaticOrder, false, true>(F.lds, 512, S, E); }
    PH(1) { pg8::SkewOrder S; S.S.init(F.ws + WS_XN8, F.ws + WS_WG8, T, 2048, 512, F.G, c); S.per = 8; S.nlow = (F.G == 256) ? 128 : 0;
      EpiGate8 E{WSP(bf16, WS_G), F.in[20]};
      pg8::gemm_phase<EpiGate8, pg8::SkewOrder, false, true>(F.lds, 512, S, E); }
    PH(2) { pg8::StaticOrder S; S.init(WSP(bf16, WS_MEMN), WSP(bf16, WS_WCKV), NB * 256, 1024, 1024, F.G, c);
      EpiBf16 E{WSP(bf16, WS_KMEM), 1024, 1, 0, 1.0f};
      pg8::gemm_phase<EpiBf16, pg8::StaticOrder, false>(F.lds, 1024, S, E); }
    PH(21) { pg8::StaticOrder S; S.init(WSP(bf16, WS_WCKV) + (size_t)1024 * 1024, WSP(bf16, WS_MEMN), 1024, NB * 256, 1024, F.G, (F.G == 256) ? ((c + 192) & 255) : c);
      EpiBf16 E{WSP(bf16, WS_VT), 256, 0, (size_t)1024 * 256, 1.0f};
      pg8::gemm_phase<EpiBf16, pg8::StaticOrder, false>(F.lds, 1024, S, E); }
    GRID_BAR();
    PH(3) p2_lora_prep(F);
    GRID_BAR();
    PH(4) { pg8::StaticOrder S; S.init(DOP(bf16, DO_ALORA), WSP(bf16, WS_BLORA), T, 1536, 256, F.G, c);
      EpiLora E{DOP(bf16, DO_WAG), F.in[5], F.in[7]};
      pg8::gemm_phase<EpiLora, pg8::StaticOrder, false>(F.lds, 256, S, E); }
    PH(5) p4_indexer(F);
    GRID_BAR();
#ifdef RWKV_CHUNKED
    PH(6) p4_rwkv_chunked(F);
    PH(7) p4_sparse_attn(F);
    GRID_BAR();
#else
    PH(6) p4_scan(F);
    PH(7) p4_sparse_attn(F);
    GRID_BAR();
    PH(22) p5_post(F);
    GRID_BAR();
#endif
    PH(8) { pg8::StaticOrder S; S.init(WSP(bf16, WS_YA), WSP(bf16, WS_WA), T, 1024, 512, F.G, c);
      EpiMix E{WSP(bf16, WS_U), WSP(bf16, WS_G), 0};
      pg8::gemm_phase<EpiMix, pg8::StaticOrder, false>(F.lds, 512, S, E); }
    PH(8) { pg8::StaticOrder S; S.init(WSP(bf16, WS_QLAT), WSP(bf16, WS_WB), T, 1024, 1024, F.G, c);
      EpiMix E{WSP(bf16, WS_U), WSP(bf16, WS_G), 1};
      pg8::gemm_phase<EpiMix, pg8::StaticOrder, false>(F.lds, 1024, S, E); }
    GRID_BAR();
    PH(9) { pg8::StaticOrder S; S.init(WSP(bf16, WS_U), WSP(bf16, WS_WOUT), T, 1024, 1024, F.G, c);
      EpiResB E{F.in[0], nullptr, WSP(bf16, WS_H1B)};
      pg8::gemm_phase<EpiResB, pg8::StaticOrder, false>(F.lds, 1024, S, E); }
    GRID_BAR();
    PH(10) p_norm_rows16(F, WSP(bf16, WS_H1B), F.in[22], nullptr, F.ws + WS_XO);
    GRID_BAR();
    PH(11) { pg8::StaticOrder S; S.init(F.ws + WS_XO, F.ws + WS_WCQ, T, 1024, 512, F.G, c);
      EpiBf16 E{WSP(bf16, WS_QC), 1024, 1, 0, 0.0625f * 0.0625f};
      pg8::gemm_phase<EpiBf16, pg8::StaticOrder, false, true>(F.lds, 512, S, E); }
    GRID_BAR();
    PH(12) p10_cross_attn(F);
    GRID_BAR();
    PH(13) { pg8::StaticOrder S; S.init(F.ws + WS_XO, F.ws + WS_WCO, T, 1024, 512, F.G, c);
      EpiResB E{nullptr, WSP(bf16, WS_H1B), WSP(bf16, WS_H2B), 0.0625f};
      pg8::gemm_phase<EpiResB, pg8::StaticOrder, false, true>(F.lds, 512, S, E); }
    GRID_BAR();
    PH(14) p_norm_rows16(F, WSP(bf16, WS_H2B), F.in[27], WSP(bf16, WS_HN), F.ws + WS_HN8);
    GRID_BAR();
    PH(15) { pg8::StaticOrder S; S.init(WSP(bf16, WS_HN), WSP(bf16, WS_WR), T, 256, 1024, F.G, c);
      EpiLogit E{WSP(float, WS_LOGIT)};
      pg8::gemm_phase<EpiLogit, pg8::StaticOrder, false>(F.lds, 1024, S, E); }
    GRID_BAR();
    PH(16) p14a_route(F);
    GRID_BAR();
    PH(17) p14b_slots(F);
    GRID_BAR();
    { volatile LAS int* tstart = (volatile LAS int*)(F.lds + MISC_OFF + 256);
      const int* stok = (const int*)(F.ws + WS_ROUTE + 2 * MiB); const float* sgate = (const float*)(F.ws + WS_ROUTE + 3 * MiB);
      PH(18) { MoeOrder S{(const char*)(F.ws + WS_HN8), (const char*)(F.ws + WS_WGU), (size_t)1024 * 1024, 512, 4, stok, tstart, F.G, c, true};
        EpiMoe1 E{F.ws + WS_HID};
        pg8::gemm_phase<EpiMoe1, MoeOrder, true, true>(F.lds, 512, S, E); }
      GRID_BAR();
      PH(19) { MoeOrder S{(const char*)(F.ws + WS_HID), (const char*)(F.ws + WS_WD), (size_t)1024 * 512, 256, 4, stok, tstart, F.G, c, false};
        EpiMoe2 E{WSP(bf16, WS_YS), sgate};
        pg8::gemm_phase<EpiMoe2, MoeOrder, false, true>(F.lds, 256, S, E); }
    }
    GRID_BAR();
    PH(20) p17_final(F);
}

extern "C" void kernel_launch(void* const* d_in, const int* in_sizes, int n_in, void* d_out, int out_size, void* d_ws, size_t ws_size, hipStream_t stream) {
    static int grid = 0;
    if (grid == 0) {
        if (n_in != 36 || out_size != T * D || ws_size < WS_END) { fprintf(stderr, "kernel_launch: unexpected shapes (n_in %d out %d ws %zu)\n", n_in, out_size, ws_size); grid = -1; return; }
        int dev = 0, cus = 0, per_cu = 0;
        hipGetDevice(&dev); hipDeviceGetAttribute(&cus, hipDeviceAttributeMultiprocessorCount, dev);
        hipFuncSetAttribute((const void*)hybrid_fwd, hipFuncAttributeMaxDynamicSharedMemorySize, LDS_BYTES);
        hipOccupancyMaxActiveBlocksPerMultiprocessor(&per_cu, (const void*)hybrid_fwd, NTHREADS, LDS_BYTES);
        (void)hipGetLastError();
        if (per_cu < 1) { fprintf(stderr, "kernel_launch: occupancy query says %d blocks per CU\n", per_cu); grid = -1; return; }
        grid = cus;
    }
    if (grid < 0) return;
    hipMemsetAsync((char*)d_ws + WS_CTL, 0, CTL_ZERO_BYTES, stream);
    Args a{};
    for (int i = 0; i < 36; ++i) a.in[i] = (const float*)d_in[i];
    a.out = (float*)d_out; a.ws = (unsigned char*)d_ws;
    void* params[] = {&a};
    hipError_t e = hipLaunchCooperativeKernel((const void*)hybrid_fwd, dim3(grid), dim3(NTHREADS), params, LDS_BYTES, stream);
    if (e != hipSuccess) fprintf(stderr, "kernel_launch: cooperative launch failed: %s (grid %d)\n", hipGetErrorString(e), grid);
}
```

```cpp
#include <hip/hip_runtime.h>
#include <hip/hip_cooperative_groups.h>
#include <cstdio>
#include <cstdint>
namespace cg = cooperative_groups;
#define RWKV_CHUNKED 1
#define PROBE_DUP 0u

#define GAS __attribute__((address_space(1)))
#define LAS __attribute__((address_space(3)))
typedef unsigned short bf16;
typedef unsigned v4u __attribute__((ext_vector_type(4)));
typedef unsigned v2u __attribute__((ext_vector_type(2)));
typedef float f32x4 __attribute__((ext_vector_type(4)));
typedef float f32x2 __attribute__((ext_vector_type(2)));
typedef short bf16x8 __attribute__((ext_vector_type(8)));
typedef short s16x4 __attribute__((ext_vector_type(4)));

constexpr int NB = 16, SEQ = 4096, T = NB * SEQ, D = 1024;
constexpr int NIN = 5376;
constexpr int NWAVES = 8, NTHREADS = 512;
constexpr int PSLOT = 2 * T + 32 * 256;

constexpr size_t MiB = 1u << 20;
constexpr size_t WS_CTL = 0, CTL_ZERO_BYTES = 1 * MiB;
constexpr size_t WS_WIN = 2 * MiB, WS_WA = 13 * MiB, WS_WB = 14 * MiB, WS_WOUT = 16 * MiB, WS_WCQ = 18 * MiB, WS_WCKV = 20 * MiB, WS_WCO = 24 * MiB;
constexpr size_t WS_BLORA = 26 * MiB, WS_WR = 27 * MiB, WS_WGU = 28 * MiB, WS_WD = 92 * MiB;
constexpr size_t WS_MEMN = 124 * MiB, WS_KMEM = 132 * MiB, WS_VT = 140 * MiB;
constexpr size_t WS_ZRKV = 150 * MiB, WS_ZLORA = 342 * MiB, WS_QLAT = 374 * MiB, WS_ZD = 502 * MiB, WS_G = 566 * MiB, WS_CKV = 822 * MiB, WS_IDX = 838 * MiB, WS_YA = 870 * MiB, WS_YC = 934 * MiB;
constexpr size_t WS_H1B = 694 * MiB  , WS_H2B = 218 * MiB  ;
constexpr size_t WS_U = WS_ZRKV, WS_HN = WS_G, WS_QC = WS_QLAT, WS_HN8 = WS_QLAT  , WS_LOGIT = 694 * MiB, WS_ROUTE = 710 * MiB, WS_HID = WS_ZRKV, WS_YS = 714 * MiB, WS_XO = WS_YA  , WS_XN8 = WS_YA  , WS_WG8 = 60 * MiB  , WS_WQ8 = 62 * MiB  , WS_END = 998 * MiB;
constexpr size_t DO_XN = 0, DO_ALORA = 0, DO_WAG = 32 * MiB, DO_SB = 224 * MiB;
constexpr int CW_BAR = 4096, CW_CNT = 1024, CW_FILL = 1088, CW_RK = 2048;

constexpr int RING_BYTES = 131072, MISC_OFF = 8 * 16 * 260 * 4 + 16384  , LDS_BYTES = MISC_OFF + 1024;

typedef __bf16 bf16x2_t __attribute__((ext_vector_type(2)));
__device__ __forceinline__ unsigned cvt_pk_bf16(float lo, float hi) { const f32x2 v = {lo, hi}; const bf16x2_t b = __builtin_convertvector(v, bf16x2_t); return __builtin_bit_cast(unsigned, b); }
typedef int v8i __attribute__((ext_vector_type(8)));
typedef int v4i __attribute__((ext_vector_type(4)));
typedef v8i v8i_a16 __attribute__((aligned(16)));
__device__ __forceinline__ unsigned pk4_fp8(float a, float b, float c, float d) { unsigned w = (unsigned)__builtin_amdgcn_cvt_pk_fp8_f32(a, b, 0, false); return (unsigned)__builtin_amdgcn_cvt_pk_fp8_f32(c, d, (int)w, true); }
__device__ __forceinline__ float bf2f(unsigned b) { return __uint_as_float(b << 16); }
__device__ __forceinline__ float bflo(unsigned w) { return __uint_as_float(w << 16); }
__device__ __forceinline__ float bfhi(unsigned w) { return __uint_as_float(w & 0xffff0000u); }
__device__ __forceinline__ float fsigmoid(float x) { return __builtin_amdgcn_rcpf(1.0f + __expf(-x)); }
__device__ __forceinline__ unsigned lds_add(LAS unsigned* p, unsigned v) { return __hip_atomic_fetch_add(p, v, __ATOMIC_RELAXED, __HIP_MEMORY_SCOPE_WORKGROUP); }
__device__ __forceinline__ float wave_sum(float v) {
#pragma unroll
    for (int o = 1; o < 64; o <<= 1) v += __shfl_xor(v, o);
    return v;
}
__device__ __forceinline__ float dpp_f(float v, const int ctrl_sel) {
    int x = __builtin_bit_cast(int, v), r;
    if (ctrl_sel == 0) r = __builtin_amdgcn_update_dpp(x, x, 0xB1, 0xF, 0xF, false);
    else if (ctrl_sel == 1) r = __builtin_amdgcn_update_dpp(x, x, 0x4E, 0xF, 0xF, false);
    else if (ctrl_sel == 2) r = __builtin_amdgcn_update_dpp(x, x, 0x141, 0xF, 0xF, false);
    else r = __builtin_amdgcn_update_dpp(x, x, 0x140, 0xF, 0xF, false);
    return __builtin_bit_cast(float, r);
}
__device__ __forceinline__ float sum8(float v) {
    v += dpp_f(v, 0); v += dpp_f(v, 1); v += dpp_f(v, 2); return v;
}

#define XB_TMO      128
#define XB_XCNT(j)  (256  + 64 * (j))
#define XB_XSUB(j)  (1280 + 64 * (j))
#define XB_XGEN(j)  (2304 + 64 * (j))
#define XB_TOP      3328
#define XB_TOPGEN   3392
#define XCD_BAR_WORDS 3456
#define XB_SPIN_CAP (1u << 20)
__device__ __forceinline__ unsigned xb_ld(unsigned* p)              { return __hip_atomic_load(p, __ATOMIC_RELAXED, __HIP_MEMORY_SCOPE_AGENT); }
__device__ __forceinline__ unsigned xb_add(unsigned* p, unsigned v) { return __hip_atomic_fetch_add(p, v, __ATOMIC_RELAXED, __HIP_MEMORY_SCOPE_AGENT); }
__device__ __forceinline__ unsigned xb_xcc_id() { return (unsigned)__builtin_amdgcn_s_getreg((3 << 11) | 20) & 0xFu; }
#define XB_SPIN(cond, bar) do { unsigned _sp = 0; while (cond) { __builtin_amdgcn_s_sleep(1); \
    if ((++_sp & 255u) == 0u) { if (xb_ld(&(bar)[XB_TMO])) break; if (_sp > XB_SPIN_CAP) { atomicAdd(&(bar)[XB_TMO], 1u); break; } } } } while (0)
struct XcdBarrier { unsigned* bar; unsigned x; volatile LAS unsigned* st; };
__device__ __forceinline__ XcdBarrier xcd_barrier_post(unsigned* bar, volatile LAS unsigned* st) {
    XcdBarrier b; b.bar = bar; b.x = xb_xcc_id(); b.st = st;
    if (threadIdx.x == 0) (void)xb_add(&bar[XB_XCNT(b.x)], 1u);
    return b;
}
__device__ __forceinline__ void xcd_barrier_complete(unsigned* bar, unsigned x, unsigned& nloc, unsigned& nx) {
    const unsigned G = gridDim.x * gridDim.y * gridDim.z;
    unsigned sum, cnt, mine, sp = 0u;
    for (;;) {
        sum = 0u; cnt = 0u; mine = 0u;
#pragma unroll
        for (unsigned j = 0; j < 16; ++j) { const unsigned c = xb_ld(&bar[XB_XCNT(j)]); sum += c; cnt += (c > 0u) ? 1u : 0u; mine = (j == x) ? c : mine; }
        if (sum == G) break;
        __builtin_amdgcn_s_sleep(1);
        if ((++sp & 255u) == 0u) { if (xb_ld(&bar[XB_TMO])) break; if (sp > XB_SPIN_CAP) { atomicAdd(&bar[XB_TMO], 1u); break; } }
    }
    nloc = mine > 0u ? mine : 1u; nx = cnt > 0u ? cnt : 1u;
}
__device__ __forceinline__ void xcd_barrier(const XcdBarrier& b) {
    asm volatile("s_waitcnt vmcnt(0)" ::: "memory");
    __syncthreads();
    if (threadIdx.x == 0) {
        unsigned* bar = b.bar;
        __builtin_amdgcn_s_waitcnt(0);
        unsigned nloc = b.st[0], nx = b.st[1];
        if (nloc == 0u) { xcd_barrier_complete(bar, b.x, nloc, nx); b.st[0] = nloc; b.st[1] = nx; }
        const unsigned old = xb_add(&bar[XB_XSUB(b.x)], 1u);
        const unsigned gen = old / nloc;
        if (old + 1u == (gen + 1u) * nloc) {
            __builtin_amdgcn_fence(__ATOMIC_RELEASE, "agent");
            asm volatile("s_waitcnt vmcnt(0)" ::: "memory");
            const unsigned og = xb_add(&bar[XB_TOP], 1u);
            const unsigned tg = og / nx;
            if (og + 1u == (tg + 1u) * nx) xb_add(&bar[XB_TOPGEN], 1u);
            else XB_SPIN(xb_ld(&bar[XB_TOPGEN]) == tg, bar);
            __builtin_amdgcn_fence(__ATOMIC_ACQUIRE, "agent");
            xb_add(&bar[XB_XGEN(b.x)], 1u);
            asm volatile("s_waitcnt vmcnt(0)" ::: "memory");
        } else {
            XB_SPIN(xb_ld(&bar[XB_XGEN(b.x)]) == gen, bar);
            __builtin_amdgcn_fence(__ATOMIC_ACQUIRE, "agent");
            asm volatile("s_waitcnt vmcnt(0)" ::: "memory");
        }
    }
    __syncthreads();
}

namespace pg8 {
constexpr int BM = 256, BK = 64, HALF = 128, HTB = HALF * BK * 2, NXCD = 8, WGM = 2;
__host__ __device__ __forceinline__ int lds_byte(int r, int c) { const int st = (r >> 4) * 2 + (c >> 5), rr = r & 15, cc = c & 31, ob = rr * 64 + cc * 2; return st * 1024 + (ob ^ (((ob >> 9) & 1) << 5)); }
__host__ __device__ __forceinline__ void stage_rc(int b, int& R, int& C) { const int st = b / 1024, sb = b % 1024, swz = sb ^ (((sb >> 9) & 1) << 5); R = (st >> 1) * 16 + swz / 64; C = (st & 1) * 32 + (swz % 64) / 2; }
__host__ __device__ __forceinline__ int perm32(int rho) { const int n = rho >> 4, i = rho & 15; return 8 * (i >> 2) + 4 * n + (i & 3); }

struct Unit { int pm, pn; const char* a; const char* b; const int* gidx; };

struct StaticOrder {
    const char* A; const char* Bt; int K; int nM, nN, nwg, G, c;
    __device__ void init(const void* A_, const void* Bt_, int M, int N, int K_, int G_, int c_) { A = (const char*)A_; Bt = (const char*)Bt_; K = K_; nM = M / BM; nN = N / BM; nwg = nM * nN; G = G_; c = c_; }
    __device__ bool next(int i, Unit& u) const { return nextL((long)i * G + c, u); }
    __device__ bool nextL(const long L, Unit& u) const {
        if (L >= nwg) return false;
        int wgid = (int)L; { const int q = nwg / NXCD, r = nwg % NXCD, xcd = wgid % NXCD, off = wgid / NXCD; wgid = (xcd < r ? xcd * (q + 1) : r * (q + 1) + (xcd - r) * q) + off; }
        const int nig = WGM * nN, gid = wgid / nig, fm = gid * WGM, gsz = (nM - fm) < WGM ? (nM - fm) : WGM;
        u.pm = fm + ((wgid % nig) % gsz); u.pn = (wgid % nig) / gsz;
        u.a = A + (size_t)u.pm * 256 * K * 2; u.b = Bt + (size_t)u.pn * 256 * K * 2; u.gidx = nullptr; return true;
    }
};

struct SkewOrder {
    StaticOrder S; int per, nlow;
    __device__ bool next(int i, Unit& u) const {
        const int c = S.c, G = S.G;
        if (i < per - 1) return S.nextL((long)i * G + c, u);
        if (c < nlow) return false;
        if (i == per - 1) return S.nextL((long)(per - 1) * G + c, u);
        if (i == per && c < 2 * nlow) return S.nextL((long)(per - 1) * G + (c - nlow), u);
        return false;
    }
};

template <class Epi, class Sched, bool GATHER, bool F8 = false>
__device__ __forceinline__ void gemm_phase(LAS unsigned char* lds, const int K_, const Sched& S, const Epi& E) {
    int K = K_; asm volatile("" : "+s"(K));
    int tid = threadIdx.x; asm volatile("" : "+v"(tid));
    const int wid = __builtin_amdgcn_readfirstlane(tid >> 6), lane = tid & 63, wr = wid >> 2, wc = wid & 3, fr = lane & 15, fq = lane >> 4;
    const int nt = K / BK;
    const size_t kstep = (size_t)(BK * 2);
    const size_t hstep = (size_t)HALF * K * 2;
    int stR[2], stC[2];
    unsigned voffB[2], cvo[2][2], nvo[2][2];
#pragma unroll
    for (int i = 0; i < 2; ++i) { int R, C; stage_rc(tid * 16 + i * 8192, R, C); stR[i] = R; stC[i] = C; const int Rb = Epi::PERM ? ((R & ~31) + perm32(R & 31)) : R;
        voffB[i] = (unsigned)(Rb * K + C) * 2u;
        cvo[0][i] = (unsigned)(R * K + C) * 2u; cvo[1][i] = cvo[0][i] + (unsigned)hstep; nvo[0][i] = cvo[0][i]; nvo[1][i] = cvo[1][i]; }
    const unsigned ldsw = (unsigned)wid * 1024u;
    const int aoff = F8 ? lds_byte(wr * 64 + fr, fq * 16) : lds_byte(wr * 64 + fr, fq * 8), boff = F8 ? lds_byte(wc * 32 + fr, fq * 16) : lds_byte(wc * 32 + fr, fq * 8);
#define PG8_SA(b, h) (((b) * 2 + (h)) * HTB)
#define PG8_SB(b, h) ((4 + (b) * 2 + (h)) * HTB)
#define PG8_STAGE(bufoff, gbase, voff) do { _Pragma("unroll") for (int _i = 0; _i < 2; ++_i) \
        __builtin_amdgcn_global_load_lds((const unsigned*)((const char*)(gbase) + (voff)[_i]), (LAS unsigned*)(lds + (bufoff) + ldsw + _i * 8192), 16, 0, 0); } while (0)
#define PG8_LDA(dst, b, h) do { if constexpr (F8) { _Pragma("unroll") for (int m = 0; m < 4; ++m) dst##8[m] = *(const LAS v8i_a16*)(lds + PG8_SA(b, h) + aoff + m * 2048); } \
    else { _Pragma("unroll") for (int m = 0; m < 4; ++m) _Pragma("unroll") for (int k = 0; k < 2; ++k) dst[m][k] = *(const LAS bf16x8*)(lds + PG8_SA(b, h) + aoff + m * 2048 + k * 1024); } } while (0)
#define PG8_LDB(dst, b, h) do { if constexpr (F8) { _Pragma("unroll") for (int n = 0; n < 2; ++n) dst##8[n] = *(const LAS v8i_a16*)(lds + PG8_SB(b, h) + boff + n * 2048); } \
    else { _Pragma("unroll") for (int n = 0; n < 2; ++n) _Pragma("unroll") for (int k = 0; k < 2; ++k) dst[n][k] = *(const LAS bf16x8*)(lds + PG8_SB(b, h) + boff + n * 2048 + k * 1024); } } while (0)
#define PG8_MMA(ai, bj, At, Bt) do { __builtin_amdgcn_s_setprio(1); if constexpr (F8) { _Pragma("unroll") for (int m = 0; m < 4; ++m) _Pragma("unroll") for (int n = 0; n < 2; ++n) { \
            asm volatile("v_mfma_scale_f32_16x16x128_f8f6f4 %0, %1, %2, %0, %3, %3 op_sel_hi:[0,0,0]" : "+v"(acc[ai][bj][m][n]) : "v"(Bt##8[n]), "v"(At##8[m]), "v"(f8one)); } } \
        else { _Pragma("unroll") for (int m = 0; m < 4; ++m) _Pragma("unroll") for (int n = 0; n < 2; ++n) _Pragma("unroll") for (int k = 0; k < 2; ++k) \
        acc[ai][bj][m][n] = __builtin_amdgcn_mfma_f32_16x16x32_bf16(Bt[n][k], At[m][k], acc[ai][bj][m][n], 0, 0, 0); } __builtin_amdgcn_s_setprio(0); } while (0)
#define PG8_WAIT_V(n) asm volatile("s_waitcnt vmcnt(" #n ")" ::: "memory")
#define PG8_WAIT_L(n) asm volatile("s_waitcnt lgkmcnt(" #n ")" ::: "memory")
#define PG8_BAR __builtin_amdgcn_s_barrier()
#define PG8_SCHED __builtin_amdgcn_sched_barrier(0)
    Unit cur, nxt; int ui = 0;
    if (!S.next(0, cur)) return;
    if constexpr (GATHER) {
#pragma unroll
        for (int h = 0; h < 2; ++h)
#pragma unroll
            for (int i = 0; i < 2; ++i) cvo[h][i] = (unsigned)(cur.gidx[h * HALF + stR[i]] * K + stC[i]) * 2u;
    }
    f32x4 acc[2][2][4][2];
#pragma unroll
    for (int a = 0; a < 2; ++a)
#pragma unroll
        for (int b = 0; b < 2; ++b)
#pragma unroll
            for (int m = 0; m < 4; ++m)
#pragma unroll
                for (int n = 0; n < 2; ++n) acc[a][b][m][n] = (f32x4){0.f, 0.f, 0.f, 0.f};
    bf16x8 At[4][2], B0[2][2], B1[2][2]; v8i At8[4], B08[2], B18[2];
    const int f8one = 0x7f7f7f7f;
    const char* cA = cur.a; const char* cB = cur.b;
    PG8_STAGE(PG8_SB(0, 0), cB, voffB); PG8_STAGE(PG8_SB(0, 1), cB + hstep, voffB); PG8_STAGE(PG8_SA(0, 0), cA, cvo[0]); PG8_STAGE(PG8_SA(0, 1), cA, cvo[1]);
    if (wr == 1) PG8_BAR;
    PG8_WAIT_V(2); PG8_BAR;
    PG8_STAGE(PG8_SB(1, 0), cB + kstep, voffB); PG8_STAGE(PG8_SA(1, 0), cA + kstep, cvo[0]); PG8_STAGE(PG8_SB(1, 1), cB + hstep + kstep, voffB);
    PG8_WAIT_V(6); PG8_BAR;
    for (;;) {
        const bool has_next = S.next(ui + 1, nxt);
        const char* nA = has_next ? nxt.a : cA; const char* nB = has_next ? nxt.b : cB;
        if constexpr (GATHER) {
            if (has_next) {
#pragma unroll
                for (int h = 0; h < 2; ++h)
#pragma unroll
                    for (int i = 0; i < 2; ++i) nvo[h][i] = (unsigned)(nxt.gidx[h * HALF + stR[i]] * K + stC[i]) * 2u;
            } else {
#pragma unroll
                for (int h = 0; h < 2; ++h)
#pragma unroll
                    for (int i = 0; i < 2; ++i) nvo[h][i] = cvo[h][i];
            }
        }
        for (int t = 0; t < nt; t += 2) {
            const bool last = (t == nt - 2);
            const char* a1 = cA + (size_t)(t + 1) * kstep;
            const char* a2 = last ? nA : cA + (size_t)(t + 2) * kstep; const char* b2 = last ? nB : cB + (size_t)(t + 2) * kstep;
            const char* a3 = a2 + kstep; const char* b3 = b2 + kstep;
            unsigned v2[2][2];
#pragma unroll
            for (int h = 0; h < 2; ++h)
#pragma unroll
                for (int i = 0; i < 2; ++i) v2[h][i] = (GATHER && last) ? nvo[h][i] : cvo[h][i];
            PG8_LDB(B0, 0, 0); PG8_LDB(B1, 0, 1); PG8_SCHED; PG8_LDA(At, 0, 0); PG8_STAGE(PG8_SA(1, 1), a1, cvo[1]);
            PG8_WAIT_V(8); PG8_WAIT_L(0); PG8_BAR; PG8_MMA(0, 0, At, B0); PG8_MMA(0, 1, At, B1); PG8_BAR; PG8_SCHED;
            PG8_LDA(At, 0, 1); PG8_STAGE(PG8_SB(0, 0), b2, voffB); PG8_STAGE(PG8_SB(0, 1), b2 + hstep, voffB); PG8_STAGE(PG8_SA(0, 0), a2, v2[0]);
            PG8_WAIT_V(8); PG8_WAIT_L(0); PG8_BAR; PG8_MMA(1, 0, At, B0); PG8_MMA(1, 1, At, B1); PG8_BAR; PG8_SCHED;
            PG8_LDB(B0, 1, 0); PG8_LDB(B1, 1, 1); PG8_SCHED; PG8_LDA(At, 1, 0); PG8_STAGE(PG8_SA(0, 1), a2, v2[1]);
            PG8_WAIT_V(8); PG8_WAIT_L(0); PG8_BAR; PG8_MMA(0, 0, At, B0); PG8_MMA(0, 1, At, B1); PG8_BAR; PG8_SCHED;
            PG8_LDA(At, 1, 1); PG8_STAGE(PG8_SB(1, 0), b3, voffB); PG8_STAGE(PG8_SB(1, 1), b3 + hstep, voffB); PG8_STAGE(PG8_SA(1, 0), a3, v2[0]);
            PG8_WAIT_V(8); PG8_WAIT_L(0); PG8_BAR; PG8_MMA(1, 0, At, B0); PG8_MMA(1, 1, At, B1); PG8_BAR; PG8_SCHED;
        }
        if (wr == 0) PG8_BAR;
        if constexpr (F8) asm volatile("s_nop 15\n\ts_nop 15" ::: "memory");
        E(acc, cur, wr, wc, fr, fq);
        if (!has_next) break;
#pragma unroll
        for (int a = 0; a < 2; ++a)
#pragma unroll
            for (int b = 0; b < 2; ++b)
#pragma unroll
                for (int m = 0; m < 4; ++m)
#pragma unroll
                    for (int n = 0; n < 2; ++n) acc[a][b][m][n] = (f32x4){0.f, 0.f, 0.f, 0.f};
        cur = nxt; cA = nA; cB = nB; ++ui;
        if constexpr (GATHER) {
#pragma unroll
            for (int h = 0; h < 2; ++h)
#pragma unroll
                for (int i = 0; i < 2; ++i) cvo[h][i] = nvo[h][i];
        }
        if (wr == 1) PG8_BAR;
    }
    PG8_WAIT_V(0);
    PG8_BAR;
#undef PG8_SA
#undef PG8_SB
#undef PG8_STAGE
#undef PG8_LDA
#undef PG8_LDB
#undef PG8_MMA
#undef PG8_WAIT_V
#undef PG8_WAIT_L
#undef PG8_BAR
#undef PG8_SCHED
}
}
using pg8::Unit;

struct Args { const float* in[36]; float* out; unsigned char* ws; };
struct Frame {
    LAS unsigned char* lds; volatile LAS unsigned* MISC; unsigned* ctl;
    int tid, lane, wave, vcu, G, gw, NGW;
    const float* const* in; float* out; unsigned char* ws;
};
#define WSP(T_, off) ((T_*)(F.ws + (off)))
#define DOP(T_, off) ((T_*)((unsigned char*)F.out + (off)))

struct XArg { const float* W; int ldw, col0; bf16* WT; int ldt, row_off, kdst, kb, nb; float f8scale; };
__device__ __forceinline__ void xpose_load(const XArg& x, int lane, f32x4 (&r)[8]) {
    const float* p = x.W + (size_t)(64 * x.kb + (lane >> 3)) * x.ldw + x.col0 + 32 * x.nb + 4 * (lane & 7);
#pragma unroll
    for (int i = 0; i < 8; ++i) r[i] = *(const f32x4*)(p + (size_t)(8 * i) * x.ldw);
    __builtin_amdgcn_sched_barrier(0);
}
__device__ __forceinline__ void xpose_store(const XArg& x, int lane, const f32x4 (&r)[8], LAS float* scr) {
    const int k0 = 64 * x.kb, n0 = 32 * x.nb;
#pragma unroll
    for (int i = 0; i < 8; ++i) { LAS float* d = scr + (8 * i + (lane >> 3)) * 33 + 4 * (lane & 7); d[0] = r[i].x; d[1] = r[i].y; d[2] = r[i].z; d[3] = r[i].w; }
    asm volatile("s_waitcnt lgkmcnt(0)" ::: "memory");
    const int c = lane & 7; const float f8scale = x.f8scale; bf16* WT = x.WT;
#pragma unroll
    for (int j = 0; j < 4; ++j) { const int n = (lane >> 3) + 8 * j; const LAS float* s = scr + (8 * c) * 33 + n;
        if (f8scale != 0.f) *(v2u*)((unsigned char*)WT + (size_t)(x.row_off + n0 + n) * x.ldt + x.kdst + k0 + 8 * c) = (v2u){pk4_fp8(s[0 * 33] * f8scale, s[1 * 33] * f8scale, s[2 * 33] * f8scale, s[3 * 33] * f8scale), pk4_fp8(s[4 * 33] * f8scale, s[5 * 33] * f8scale, s[6 * 33] * f8scale, s[7 * 33] * f8scale)};
        else { v4u o; o.x = cvt_pk_bf16(s[0 * 33], s[1 * 33]); o.y = cvt_pk_bf16(s[2 * 33], s[3 * 33]); o.z = cvt_pk_bf16(s[4 * 33], s[5 * 33]); o.w = cvt_pk_bf16(s[6 * 33], s[7 * 33]);
            *(v4u*)(WT + (size_t)(x.row_off + n0 + n) * x.ldt + x.kdst + k0 + 8 * c) = o; } }
    asm volatile("s_waitcnt lgkmcnt(0)" ::: "memory");
}
template <class GetArg>
__device__ __forceinline__ void xpose_pipe(Frame& F, int nit, GetArg getarg) {
    LAS float* scr = (LAS float*)(F.lds + F.wave * 16384);
    const int lane = F.lane, step = F.NGW; int it = F.gw;
    if (it >= nit) return;
    f32x4 A[8], B[8];
    XArg aA = getarg(it), aB = getarg(it + step < nit ? it + step : it);
    xpose_load(aA, lane, A); xpose_load(aB, lane, B);
#define XP_DO(S_, a_) { if (it < nit) { f32x4 c_[8]; _Pragma("unroll") for (int i = 0; i < 8; ++i) c_[i] = S_[i]; const XArg ca_ = a_; const int itn_ = it + 2 * step; \
        a_ = getarg(itn_ < nit ? itn_ : it); xpose_load(a_, lane, S_); xpose_store(ca_, lane, c_, scr); it += step; } }
    while (it < nit) { XP_DO(A, aA); XP_DO(B, aB); }
#undef XP_DO
}
__device__ __forceinline__ void xpose_job(Frame& F, const float* W, int ldw, int col0, int K, int N, bf16* WT, int ldt, int row_off, int kdst) {
    const int nblk = N / 32, nit = (K / 64) * nblk;
    xpose_pipe(F, nit, [&](int it) { return XArg{W, ldw, col0, WT, ldt, row_off, kdst, it / nblk, it % nblk, 0.f}; });
}
__device__ __forceinline__ void rms_row_to_bf16(const float* xrow, const float* g, bf16* orow, int lane, unsigned* o8row = nullptr) {
    const f32x4* xr = (const f32x4*)xrow + lane; const f32x4* gr = (const f32x4*)g + lane;
    f32x4 v[4]; float s = 0.f;
#pragma unroll
    for (int j = 0; j < 4; ++j) { v[j] = xr[64 * j]; s += (v[j].x * v[j].x + v[j].y * v[j].y) + (v[j].z * v[j].z + v[j].w * v[j].w); }
    const float rstd = rsqrtf(wave_sum(s) * (1.f / 1024.f) + 1e-6f);
    v2u* o8 = (v2u*)orow + lane;
#pragma unroll
    for (int j = 0; j < 4; ++j) { const f32x4 gg = gr[64 * j]; v2u o; o.x = cvt_pk_bf16(v[j].x * rstd * gg.x, v[j].y * rstd * gg.y); o.y = cvt_pk_bf16(v[j].z * rstd * gg.z, v[j].w * rstd * gg.w); o8[64 * j] = o;
        if (o8row) o8row[64 * j + lane] = pk4_fp8(v[j].x * rstd * gg.x, v[j].y * rstd * gg.y, v[j].z * rstd * gg.z, v[j].w * rstd * gg.w); }
}

__device__ __forceinline__ void p0_prologue(Frame& F) {
    const float* w_in = F.in[3];
    bf16* WinT = WSP(bf16, WS_WIN);
    {
        struct Job { const float* W; int ldw, col0; void* WT; int ldt, row_off, kdst, nblk, nit; float f8; };
        const Job jobs[13] = {
            {w_in, 4804, 0, WinT, 1024, 0, 0, 56, 16 * 56, 0.f},
            {w_in, 4804, 2304, WinT, 1024, 2816, 0, 4, 16 * 4, 0.f},
            {w_in, 4804, 2688, WinT, 1024, 2816 + 128, 0, 2, 16 * 2, 0.f},
            {w_in, 4804, 2432, WinT, 1024, 2816 + 256, 0, 8, 16 * 8, 0.f},
            {w_in, 4804, 2756, F.ws + WS_WG8, 1024, 0, 0, 64, 16 * 64, 16.f},
            {F.in[18], 1024, 0, F.ws + WS_WA, 512, 0, 0, 32, 8 * 32, 0.f},
            {F.in[21], 1024, 0, F.ws + WS_WOUT, 1024, 0, 0, 32, 16 * 32, 0.f},
            {F.in[24], 1024, 0, F.ws + WS_WCQ, 1024, 0, 0, 32, 16 * 32, 16.f},
            {F.in[25], 2048, 0, F.ws + WS_WCKV, 1024, 0, 0, 64, 16 * 64, 0.f},
            {F.in[26], 1024, 0, F.ws + WS_WCO, 1024, 0, 0, 32, 16 * 32, 16.f},
            {F.in[6], 512, 0, F.ws + WS_BLORA, 256, 0, 0, 16, 1 * 16, 0.f},
            {F.in[8], 512, 0, F.ws + WS_BLORA, 256, 512, 64, 16, 1 * 16, 0.f},
            {F.in[9], 512, 0, F.ws + WS_BLORA, 256, 1024, 128, 16, 2 * 16, 0.f}};
        constexpr int NGU = 32 * 2 * 16 * 16, NDN = 32 * 8 * 32;
        int nsmall = 0;
#pragma unroll
        for (int j = 0; j < 13; ++j) nsmall += jobs[j].nit;
        xpose_pipe(F, NGU + NDN + nsmall, [&](int it) {
            if (it < NGU) {
                const int nb = it & 15, kb = (it >> 4) & 15, which = (it >> 8) & 1, e = it >> 9;
                const float* W = (which ? F.in[33] : F.in[32]) + (size_t)e * 1024 * 512;
                const int n0 = 32 * nb, drow = 256 * (n0 >> 7) + (n0 & 127) + 128 * which;
                return XArg{W, 512, 0, (bf16*)(F.ws + WS_WGU + (size_t)e * 1024 * 1024), 1024, drow - n0, 0, kb, nb, 16.f}; }
            it -= NGU;
            if (it < NDN) {
                const int nb = it & 31, kb = (it >> 5) & 7, e = it >> 8;
                return XArg{F.in[34] + (size_t)e * 512 * 1024, 1024, 0, (bf16*)(F.ws + WS_WD + (size_t)e * 1024 * 512), 512, 0, 0, kb, nb, 16.f}; }
            it -= NDN;
            XArg r = XArg{jobs[12].W, jobs[12].ldw, jobs[12].col0, (bf16*)jobs[12].WT, jobs[12].ldt, jobs[12].row_off, jobs[12].kdst, 0, 0, jobs[12].f8}; int nblk = jobs[12].nblk, loc = it;
            int acc = 0; bool found = false;
#pragma unroll
            for (int j = 0; j < 13; ++j) { const bool here = !found && it < acc + jobs[j].nit;
                if (here) { r = XArg{jobs[j].W, jobs[j].ldw, jobs[j].col0, (bf16*)jobs[j].WT, jobs[j].ldt, jobs[j].row_off, jobs[j].kdst, 0, 0, jobs[j].f8}; nblk = jobs[j].nblk; loc = it - acc; found = true; }
                acc += jobs[j].nit; }
            r.kb = loc / nblk; r.nb = loc % nblk; return r; });
    }
    const int gt = F.vcu * NTHREADS + F.tid, NGT = F.G * NTHREADS;
    for (int i = gt; i < 64 * 1024; i += NGT) { const int n = i >> 10, k = i & 1023; WinT[(size_t)(2816 + 192 + n) * 1024 + k] = (n < 4) ? (bf16)(cvt_pk_bf16(w_in[(size_t)k * 4804 + 2752 + n], 0.f) & 0xffff) : (bf16)0; }
    { bf16* BL = WSP(bf16, WS_BLORA);
      for (int i = gt; i < 1536 * 256; i += NGT) { const int n = i >> 8, k = i & 255; const int seg = n >> 9; const bool diag = (seg == 0) ? (k < 64) : (seg == 1) ? (k >= 64 && k < 128) : (k >= 128); if (!diag) BL[i] = 0; } }
    { bf16* WR = WSP(bf16, WS_WR);
      for (int i = gt; i < 256 * 1024; i += NGT) { const int n = i >> 10, k = i & 1023; float v = 0.f; if (n < 4) v = F.in[28][k * 4 + n]; else if (n < 36) v = F.in[30][k * 32 + (n - 4)]; WR[i] = (bf16)(cvt_pk_bf16(v, 0.f) & 0xffff); } }
    for (int task = F.vcu; task < 256; task += F.G) {
        const bool isq = task < 128; const int h = (task >> 4) & 7, chunk = task & 15;
        LAS float* sw = (LAS float*)F.lds;
        const float* src = isq ? F.in[16] : F.in[17]; const float* wpb = F.in[19]; bf16* WbT = WSP(bf16, WS_WB);
        __syncthreads();
        for (int i = F.tid; i < 128 * 16; i += NTHREADS) { const int r = i >> 4, q = i & 15; *(LAS f32x4*)(sw + r * 64 + q * 4) = *(const f32x4*)(src + (size_t)r * 512 + h * 64 + q * 4); }
        __syncthreads();
        const int idx = chunk * 64 + F.lane;
        float a[64];
        if (isq) {
#pragma unroll
            for (int q = 0; q < 16; ++q) { const f32x4 t4 = *(const f32x4*)(w_in + (size_t)idx * 4804 + 1792 + h * 64 + 4 * q); a[4 * q] = t4[0]; a[4 * q + 1] = t4[1]; a[4 * q + 2] = t4[2]; a[4 * q + 3] = t4[3]; }
        } else {
            const float* p = wpb + (size_t)(h * 64) * 1024 + idx;
#pragma unroll
            for (int g4 = 0; g4 < 8; ++g4) {
#pragma unroll
                for (int d = 0; d < 8; ++d) a[8 * g4 + d] = p[(size_t)(8 * g4 + d) * 1024];
                __builtin_amdgcn_sched_barrier(0); }
        }
#pragma unroll 1
        for (int r0 = F.wave * 16; r0 < F.wave * 16 + 16; r0 += 2) { float o[2];
#pragma unroll
            for (int rr = 0; rr < 2; ++rr) { const LAS f32x4* b4 = (const LAS f32x4*)(sw + (r0 + rr) * 64); float s0 = 0.f, s1 = 0.f;
#pragma unroll
                for (int q = 0; q < 16; q += 2) { const f32x4 b0 = b4[q], b1 = b4[q + 1];
                    s0 += a[4 * q] * b0[0] + a[4 * q + 1] * b0[1] + a[4 * q + 2] * b0[2] + a[4 * q + 3] * b0[3]; s1 += a[4 * q + 4] * b1[0] + a[4 * q + 5] * b1[1] + a[4 * q + 6] * b1[2] + a[4 * q + 7] * b1[3]; }
                o[rr] = s0 + s1; __builtin_amdgcn_sched_barrier(0); }
            if (isq) {
#pragma unroll
                for (int rr = 0; rr < 2; ++rr) (F.ws + WS_WQ8)[(size_t)(h * 128 + r0 + rr) * 1024 + idx] = (unsigned char)(pk4_fp8(o[rr] * (0.125f * 256.f), 0.f, 0.f, 0.f) & 0xffu);
            } else *(unsigned*)(WbT + (size_t)idx * 1024 + h * 128 + r0) = cvt_pk_bf16(o[0], o[1]);
        }
    }
    __syncthreads();
    {
        const int lane = F.lane, step = F.NGW; const float* x = F.in[0]; bf16* xn = DOP(bf16, DO_XN);
        f32x4 gg[4], v0[4], v1[4];
#pragma unroll
        for (int j = 0; j < 4; ++j) gg[j] = *((const f32x4*)F.in[2] + lane + 64 * j);
        int m = F.gw;
#define XN_LD(v_, m_) { const int mm_ = (m_) < T ? (m_) : F.gw; _Pragma("unroll") for (int j = 0; j < 4; ++j) v_[j] = *((const f32x4*)(x + (size_t)mm_ * D) + lane + 64 * j); __builtin_amdgcn_sched_barrier(0); }
#define XN_DO(v_) { if (m < T) { f32x4 c_[4]; _Pragma("unroll") for (int j = 0; j < 4; ++j) c_[j] = v_[j]; XN_LD(v_, m + 2 * step); float s = 0.f; \
            _Pragma("unroll") for (int j = 0; j < 4; ++j) s += (c_[j].x * c_[j].x + c_[j].y * c_[j].y) + (c_[j].z * c_[j].z + c_[j].w * c_[j].w); \
            const float rstd = rsqrtf(wave_sum(s) * (1.f / 1024.f) + 1e-6f); v2u* o8 = (v2u*)(xn + (size_t)m * D) + lane; \
            unsigned* q8 = (unsigned*)(F.ws + WS_XN8 + (size_t)m * D) + lane; \
            _Pragma("unroll") for (int j = 0; j < 4; ++j) { const float y0 = c_[j].x * rstd * gg[j].x, y1 = c_[j].y * rstd * gg[j].y, y2 = c_[j].z * rstd * gg[j].z, y3 = c_[j].w * rstd * gg[j].w; \
                v2u o; o.x = cvt_pk_bf16(y0, y1); o.y = cvt_pk_bf16(y2, y3); o8[64 * j] = o; q8[64 * j] = pk4_fp8(y0, y1, y2, y3); } \
            m += step; } }
        if (m < T) {
            XN_LD(v0, m); XN_LD(v1, m + step);
            while (m < T) { XN_DO(v0); XN_DO(v1); }
        }
#undef XN_LD
#undef XN_DO
    }
    for (int m = F.gw; m < NB * 256; m += F.NGW) rms_row_to_bf16(F.in[1] + (size_t)m * D, F.in[23], WSP(bf16, WS_MEMN) + (size_t)m * D, F.lane);
}

#define EPI_LOOP_PERM(...) \
    _Pragma("unroll") for (int ai = 0; ai < 2; ++ai) _Pragma("unroll") for (int m = 0; m < 4; ++m) { const int row = u.pm * 256 + ai * 128 + wr * 64 + m * 16 + fr; \
        _Pragma("unroll") for (int bj = 0; bj < 2; ++bj) { const int ct = bj * 128 + wc * 32 + 8 * fq;   f32x4 v0 = acc[ai][bj][m][0], v1 = acc[ai][bj][m][1]; __VA_ARGS__ } }
#define PACK8(v0, v1) ((v4u){cvt_pk_bf16((v0)[0], (v0)[1]), cvt_pk_bf16((v0)[2], (v0)[3]), cvt_pk_bf16((v1)[0], (v1)[1]), cvt_pk_bf16((v1)[2], (v1)[3])})

struct EpiMain {
    static constexpr bool PERM = true;
    bf16 *Zrkv, *Zlora, *QLAT, *Zd, *G; const float* b_gate; int pn_off = 0;
    __device__ __forceinline__ void operator()(const f32x4 (&acc)[2][2][4][2], const Unit& u, int wr, int wc, int fr, int fq) const {
        const int pn = u.pn + pn_off; bf16* base; int ldc, c0; bool act = false;
        if (pn < 6) { base = Zrkv; ldc = 1536; c0 = pn * 256; }
        else if (pn == 6) { base = Zlora; ldc = 256; c0 = 0; }
        else if (pn < 11) { base = QLAT; ldc = 1024; c0 = (pn - 7) * 256; }
        else if (pn < 13) { base = Zd; ldc = 512; c0 = (pn - 11) * 256; }
        else { base = G; ldc = 2048; c0 = (pn - 13) * 256; act = true; }
        if (act) {
            f32x4 bg[2][2];
#pragma unroll
            for (int bj = 0; bj < 2; ++bj) { const int ct = bj * 128 + wc * 32 + 8 * fq; bg[bj][0] = *(const f32x4*)(b_gate + c0 + ct); bg[bj][1] = *(const f32x4*)(b_gate + c0 + ct + 4); }
            EPI_LOOP_PERM(
_Pragma("unroll")
                for (int e = 0; e < 4; ++e) { v0[e] = fsigmoid(v0[e] + bg[bj][0][e]); v1[e] = fsigmoid(v1[e] + bg[bj][1][e]); }
                *(v4u*)(base + (size_t)row * ldc + c0 + ct) = PACK8(v0, v1);
            )
        } else {
            EPI_LOOP_PERM(
                *(v4u*)(base + (size_t)row * ldc + c0 + ct) = PACK8(v0, v1);
            )
        }
    }
};
struct EpiGate8 {
    static constexpr bool PERM = true;
    bf16* G; const float* b_gate;
    __device__ __forceinline__ void operator()(const f32x4 (&acc)[2][2][4][2], const Unit& u, int wr, int wc, int fr, int fq) const {
        const int c0 = u.pn * 256;
        f32x4 bg[2][2];
#pragma unroll
        for (int bj = 0; bj < 2; ++bj) { const int ct = bj * 128 + wc * 32 + 8 * fq; bg[bj][0] = *(const f32x4*)(b_gate + c0 + ct); bg[bj][1] = *(const f32x4*)(b_gate + c0 + ct + 4); }
        EPI_LOOP_PERM(
_Pragma("unroll")
            for (int e = 0; e < 4; ++e) { v0[e] = fsigmoid(0.0625f * v0[e] + bg[bj][0][e]); v1[e] = fsigmoid(0.0625f * v1[e] + bg[bj][1][e]); }
            *(v4u*)(G + (size_t)row * 2048 + c0 + ct) = PACK8(v0, v1);
        )
    }
};
struct EpiBf16 {
    static constexpr bool PERM = true;
    bf16* O; int ldc; int colmul; size_t pn_stride; float scale;
    __device__ __forceinline__ void operator()(const f32x4 (&acc)[2][2][4][2], const Unit& u, int wr, int wc, int fr, int fq) const {
        bf16* base = O + (size_t)u.pn * pn_stride + (size_t)u.pn * 256 * colmul;
        EPI_LOOP_PERM( v0 = v0 * scale; v1 = v1 * scale; *(v4u*)(base + (size_t)row * ldc + ct) = PACK8(v0, v1); )
    }
};
struct EpiLora {
    static constexpr bool PERM = true;
    bf16* WAG; const float* w0; const float* a0;
    __device__ __forceinline__ void operator()(const f32x4 (&acc)[2][2][4][2], const Unit& u, int wr, int wc, int fr, int fq) const {
        const int seg = u.pn >> 1; const int cc0 = (u.pn & 1) * 256; const float* bias = seg == 0 ? w0 : a0;
        if (seg < 2) {
            const float mul = seg == 0 ? 0.6065306597126334f : 1.0f;
            f32x4 bg[2][2];
#pragma unroll
            for (int bj = 0; bj < 2; ++bj) { const int ct = bj * 128 + wc * 32 + 8 * fq; bg[bj][0] = *(const f32x4*)(bias + cc0 + ct); bg[bj][1] = *(const f32x4*)(bias + cc0 + ct + 4); }
            EPI_LOOP_PERM(
_Pragma("unroll")
                for (int e = 0; e < 4; ++e) { v0[e] = mul * fsigmoid(v0[e] + bg[bj][0][e]); v1[e] = mul * fsigmoid(v1[e] + bg[bj][1][e]); }
                *(v4u*)(WAG + (size_t)row * 1536 + u.pn * 256 + ct) = PACK8(v0, v1);
            )
        } else {
            EPI_LOOP_PERM(
                *(v4u*)(WAG + (size_t)row * 1536 + u.pn * 256 + ct) = PACK8(v0, v1);
            )
        }
    }
};
struct EpiMix {
    static constexpr bool PERM = true;
    bf16* U; const bf16* G; int second;
    __device__ __forceinline__ void operator()(const f32x4 (&acc)[2][2][4][2], const Unit& u, int wr, int wc, int fr, int fq) const {
#pragma unroll
        for (int ai = 0; ai < 2; ++ai) {
            v4u gw[4][2], ow[4][2];
#pragma unroll
            for (int m = 0; m < 4; ++m)
#pragma unroll
                for (int bj = 0; bj < 2; ++bj) { const int row = u.pm * 256 + ai * 128 + wr * 64 + m * 16 + fr, col = u.pn * 256 + bj * 128 + wc * 32 + 8 * fq;
                    gw[m][bj] = *(const v4u*)(G + (size_t)row * 2048 + second * 1024 + col);
                    ow[m][bj] = second ? *(const v4u*)(U + (size_t)row * 1024 + col) : (v4u){0, 0, 0, 0}; }
#pragma unroll
            for (int m = 0; m < 4; ++m)
#pragma unroll
                for (int bj = 0; bj < 2; ++bj) { const int row = u.pm * 256 + ai * 128 + wr * 64 + m * 16 + fr, col = u.pn * 256 + bj * 128 + wc * 32 + 8 * fq;
                    f32x4 v0 = acc[ai][bj][m][0], v1 = acc[ai][bj][m][1]; const v4u g4 = gw[m][bj], o = ow[m][bj];
                    v0[0] = v0[0] * bflo(g4.x) + bflo(o.x); v0[1] = v0[1] * bfhi(g4.x) + bfhi(o.x); v0[2] = v0[2] * bflo(g4.y) + bflo(o.y); v0[3] = v0[3] * bfhi(g4.y) + bfhi(o.y);
                    v1[0] = v1[0] * bflo(g4.z) + bflo(o.z); v1[1] = v1[1] * bfhi(g4.z) + bfhi(o.z); v1[2] = v1[2] * bflo(g4.w) + bflo(o.w); v1[3] = v1[3] * bfhi(g4.w) + bfhi(o.w);
                    *(v4u*)(U + (size_t)row * 1024 + col) = PACK8(v0, v1); }
        }
    }
};
struct EpiRes {
    static constexpr bool PERM = false;
    const float* res; float* out;
    __device__ __forceinline__ void operator()(const f32x4 (&acc)[2][2][4][2], const Unit& u, int wr, int wc, int fr, int fq) const {
#pragma unroll
        for (int ai = 0; ai < 2; ++ai) {
            f32x4 r[4][2][2];
#pragma unroll
            for (int m = 0; m < 4; ++m)
#pragma unroll
                for (int bj = 0; bj < 2; ++bj)
#pragma unroll
                    for (int n = 0; n < 2; ++n) { const int row = u.pm * 256 + ai * 128 + wr * 64 + m * 16 + fr, col = u.pn * 256 + bj * 128 + wc * 32 + 16 * n + 4 * fq; r[m][bj][n] = *(const f32x4*)(res + (size_t)row * 1024 + col); }
#pragma unroll
            for (int m = 0; m < 4; ++m)
#pragma unroll
                for (int bj = 0; bj < 2; ++bj)
#pragma unroll
                    for (int n = 0; n < 2; ++n) { const int row = u.pm * 256 + ai * 128 + wr * 64 + m * 16 + fr, col = u.pn * 256 + bj * 128 + wc * 32 + 16 * n + 4 * fq; *(f32x4*)(out + (size_t)row * 1024 + col) = r[m][bj][n] + acc[ai][bj][m][n]; }
        }
    }
};
struct EpiResB {
    static constexpr bool PERM = true;
    const float* res32; const bf16* res16; bf16* out; float ascale = 1.f;
    __device__ __forceinline__ void operator()(const f32x4 (&acc)[2][2][4][2], const Unit& u, int wr, int wc, int fr, int fq) const {
#pragma unroll
        for (int ai = 0; ai < 2; ++ai) {
            f32x4 r[4][2][2];
#pragma unroll
            for (int m = 0; m < 4; ++m)
#pragma unroll
                for (int bj = 0; bj < 2; ++bj) { const int row = u.pm * 256 + ai * 128 + wr * 64 + m * 16 + fr, col = u.pn * 256 + bj * 128 + wc * 32 + 8 * fq; const size_t o = (size_t)row * 1024 + col;
                    if (res32) { r[m][bj][0] = *(const f32x4*)(res32 + o); r[m][bj][1] = *(const f32x4*)(res32 + o + 4); }
                    else { const v4u w = *(const v4u*)(res16 + o); r[m][bj][0] = (f32x4){bflo(w.x), bfhi(w.x), bflo(w.y), bfhi(w.y)}; r[m][bj][1] = (f32x4){bflo(w.z), bfhi(w.z), bflo(w.w), bfhi(w.w)}; } }
#pragma unroll
            for (int m = 0; m < 4; ++m)
#pragma unroll
                for (int bj = 0; bj < 2; ++bj) { const int row = u.pm * 256 + ai * 128 + wr * 64 + m * 16 + fr, col = u.pn * 256 + bj * 128 + wc * 32 + 8 * fq;
                    const f32x4 v0 = r[m][bj][0] + acc[ai][bj][m][0] * ascale, v1 = r[m][bj][1] + acc[ai][bj][m][1] * ascale;
                    *(v4u*)(out + (size_t)row * 1024 + col) = PACK8(v0, v1); }
        }
    }
};
struct EpiLogit {
    static constexpr bool PERM = false;
    float* L;
    __device__ __forceinline__ void operator()(const f32x4 (&acc)[2][2][4][2], const Unit& u, int wr, int wc, int fr, int fq) const {
        if (wc >= 2) return;
#pragma unroll
        for (int ai = 0; ai < 2; ++ai)
#pragma unroll
            for (int m = 0; m < 4; ++m) { const int row = u.pm * 256 + ai * 128 + wr * 64 + m * 16 + fr;
#pragma unroll
                for (int n = 0; n < 2; ++n) { const int col = wc * 32 + 16 * n + 4 * fq; *(f32x4*)(L + (size_t)row * 64 + col) = acc[ai][0][m][n]; } }
    }
};
struct EpiMoe1 {
    static constexpr bool PERM = true;
    unsigned char* HID;
    __device__ __forceinline__ void operator()(const f32x4 (&acc)[2][2][4][2], const Unit& u, int wr, int wc, int fr, int fq) const {
#pragma unroll
        for (int ai = 0; ai < 2; ++ai)
#pragma unroll
            for (int m = 0; m < 4; ++m) { const int row = u.pm * 256 + ai * 128 + wr * 64 + m * 16 + fr; f32x4 h0, h1;
#pragma unroll
                for (int e = 0; e < 4; ++e) { const float g0 = 0.0625f * acc[ai][0][m][0][e], g1 = 0.0625f * acc[ai][0][m][1][e]; h0[e] = g0 * fsigmoid(g0) * (0.0625f * acc[ai][1][m][0][e]); h1[e] = g1 * fsigmoid(g1) * (0.0625f * acc[ai][1][m][1][e]); }
                *(v2u*)(HID + (size_t)row * 512 + u.pn * 128 + wc * 32 + 8 * fq) = (v2u){pk4_fp8(h0[0], h0[1], h0[2], h0[3]), pk4_fp8(h1[0], h1[1], h1[2], h1[3])}; }
    }
};
struct EpiMoe2 {
    static constexpr bool PERM = true;
    bf16* YS; const float* sgate;
    __device__ __forceinline__ void operator()(const f32x4 (&acc)[2][2][4][2], const Unit& u, int wr, int wc, int fr, int fq) const {
        float gts[2][4];
#pragma unroll
        for (int ai = 0; ai < 2; ++ai)
#pragma unroll
            for (int m = 0; m < 4; ++m) gts[ai][m] = sgate[u.pm * 256 + ai * 128 + wr * 64 + m * 16 + fr];
        EPI_LOOP_PERM( const float gt = 0.0625f * gts[ai][m]; v0 = v0 * gt; v1 = v1 * gt; *(v4u*)(YS + (size_t)row * 1024 + u.pn * 256 + ct) = PACK8(v0, v1); )
    }
};
struct MoeOrder {
    const char* A; const char* Bt; size_t bstride  ; int K; int NPN; const int* stok; volatile LAS int* tstart; int G, c; bool gather;
    __device__ bool next(int i, Unit& u) const {
        const int ntile = tstart[32]; const long L = (long)i * G + c; if (L >= (long)ntile * NPN) return false;
        const int tile = (int)(L / NPN); u.pn = (int)(L % NPN); u.pm = tile;
        int e = 0;
#pragma unroll 1
        for (int j = 1; j < 32; ++j) e += (tstart[j] <= tile) ? 1 : 0;
        u.b = Bt + (size_t)e * bstride + (size_t)u.pn * 256 * K * 2;
        if (gather) { u.a = A; u.gidx = stok + (size_t)tile * 256; } else { u.a = A + (size_t)tile * 256 * K * 2; u.gidx = nullptr; }
        return true;
    }
};

__device__ __forceinline__ void p2_lora_prep(Frame& F) {
    const bf16* Zlora = WSP(bf16, WS_ZLORA); const bf16* Zd = WSP(bf16, WS_ZD); bf16* AL = DOP(bf16, DO_ALORA); bf16* CKV = WSP(bf16, WS_CKV);
    const float* mu = F.in[4] + 1536; const float* kvn = F.in[15];
    const int c = 4 * F.lane;
    const f32x4 m4 = *(const f32x4*)(mu + c);
    const f32x2 kn = *(const f32x2*)(kvn + 2 * F.lane);
    constexpr int NB4 = 4;
    for (int t0 = F.gw; t0 < T; t0 += NB4 * F.NGW) {
        v2u z[NB4], zp[NB4]; unsigned cw[NB4];
#pragma unroll
        for (int u = 0; u < NB4; ++u) { const int t1 = t0 + u * F.NGW, t = t1 < T ? t1 : t0;
            z[u] = *(const v2u*)(Zlora + (size_t)t * 256 + c);
            const int tp = (t & (SEQ - 1)) != 0 ? t - 1 : t;
            zp[u] = *(const v2u*)(Zlora + (size_t)tp * 256 + c);
            cw[u] = *(const unsigned*)(Zd + (size_t)t * 512 + 2 * F.lane); }
#pragma unroll
        for (int u = 0; u < NB4; ++u) { const int t = t0 + u * F.NGW;
            if (t < T) {
                if ((t & (SEQ - 1)) == 0) zp[u] = (v2u){0u, 0u};
                float v[4] = {bflo(z[u].x), bfhi(z[u].x), bflo(z[u].y), bfhi(z[u].y)}; const float p[4] = {bflo(zp[u].x), bfhi(zp[u].x), bflo(zp[u].y), bfhi(zp[u].y)};
#pragma unroll
                for (int e = 0; e < 4; ++e) { float s = v[e] + (p[e] - v[e]) * m4[e];
                    if (c < 64) { const float ex = __expf(2.f * s); s = 1.f - 2.f * __builtin_amdgcn_rcpf(ex + 1.f); }
                    else if (c >= 128) s = fsigmoid(s);
                    v[e] = s; }
                *(v2u*)(AL + (size_t)t * 256 + c) = (v2u){cvt_pk_bf16(v[0], v[1]), cvt_pk_bf16(v[2], v[3])};
                const float c0 = bflo(cw[u]), c1 = bfhi(cw[u]);
                const float rstd = rsqrtf(wave_sum(c0 * c0 + c1 * c1) * (1.f / 128.f) + 1e-6f);
                *(unsigned*)(CKV + (size_t)t * 128 + 2 * F.lane) = cvt_pk_bf16(c0 * rstd * kn.x, c1 * rstd * kn.y);
            }
        }
    }
}

struct ScanRows { v4u zr, zk, zv, pr, pk, pv, ew4, a4, g4; };
__device__ __forceinline__ void scan_load_rows(ScanRows& L, const bf16* Zrkv, const bf16* WAG, size_t tok, int pos, int j0) {
    L.zr = *(const v4u*)(Zrkv + tok * 1536 + j0); L.zk = *(const v4u*)(Zrkv + tok * 1536 + 512 + j0); L.zv = *(const v4u*)(Zrkv + tok * 1536 + 1024 + j0);
    L.pr = (v4u){0, 0, 0, 0}; L.pk = L.pr; L.pv = L.pr;
    if (pos != 0) { L.pr = *(const v4u*)(Zrkv + (tok - 1) * 1536 + j0); L.pk = *(const v4u*)(Zrkv + (tok - 1) * 1536 + 512 + j0); L.pv = *(const v4u*)(Zrkv + (tok - 1) * 1536 + 1024 + j0); }
    L.ew4 = *(const v4u*)(WAG + tok * 1536 + j0); L.a4 = *(const v4u*)(WAG + tok * 1536 + 512 + j0); L.g4 = *(const v4u*)(WAG + tok * 1536 + 1024 + j0);
}
__device__ __forceinline__ void p4_scan(Frame& F) {
    const int bh = F.vcu >> 1, half = F.vcu & 1, b = bh >> 3, h = bh & 7;
    const bf16* Zrkv = WSP(bf16, WS_ZRKV); const bf16* WAG = DOP(bf16, DO_WAG); bf16* YA = WSP(bf16, WS_YA); bf16* YC = WSP(bf16, WS_YC);
    LAS float* sR = (LAS float*)F.lds; LAS float* sDEC = sR + 4096; LAS float* sKK = sR + 8192; LAS float* sBB = sR + 12288; LAS float* sKP = sR + 16384; LAS float* sV = sR + 20480; LAS float* sY = sR + 24576; LAS float* sBR = sR + 28672;
    const int tt = F.tid >> 3, jg = F.tid & 7, j0 = h * 64 + jg * 8;
    const int il = F.lane >> 3, irow = half * 32 + (F.wave & 3) * 8 + il;
    float mu_r[8], mu_k[8], mu_v[8], kkw[8], kaw[8], rkw[8], lnw[8], lnb[8];
#pragma unroll
    for (int e = 0; e < 8; ++e) { mu_r[e] = F.in[4][j0 + e]; mu_k[e] = F.in[4][512 + j0 + e]; mu_v[e] = F.in[4][1024 + j0 + e]; kkw[e] = F.in[10][j0 + e]; kaw[e] = F.in[11][j0 + e]; rkw[e] = F.in[12][j0 + e]; lnw[e] = F.in[13][j0 + e]; lnb[e] = F.in[14][j0 + e]; }
    float S[8];
#pragma unroll
    for (int e = 0; e < 8; ++e) S[e] = 0.f;
    ScanRows L; scan_load_rows(L, Zrkv, WAG, (size_t)b * SEQ + tt, tt, j0);
    for (int tile = 0; tile < SEQ / 64; ++tile) {
        const int pos = tile * 64 + tt; const size_t tok = (size_t)b * SEQ + pos;
        const v4u g4 = L.g4;
        {
            float r[8], k[8], v[8], a[8], ew[8], kk[8];
#pragma unroll
            for (int q = 0; q < 4; ++q) {
                const float zr0 = bflo(L.zr[q]), zr1 = bfhi(L.zr[q]), zk0 = bflo(L.zk[q]), zk1 = bfhi(L.zk[q]), zv0 = bflo(L.zv[q]), zv1 = bfhi(L.zv[q]);
                r[2 * q] = zr0 + (bflo(L.pr[q]) - zr0) * mu_r[2 * q]; r[2 * q + 1] = zr1 + (bfhi(L.pr[q]) - zr1) * mu_r[2 * q + 1];
                k[2 * q] = zk0 + (bflo(L.pk[q]) - zk0) * mu_k[2 * q]; k[2 * q + 1] = zk1 + (bfhi(L.pk[q]) - zk1) * mu_k[2 * q + 1];
                v[2 * q] = zv0 + (bflo(L.pv[q]) - zv0) * mu_v[2 * q]; v[2 * q + 1] = zv1 + (bfhi(L.pv[q]) - zv1) * mu_v[2 * q + 1];
                a[2 * q] = bflo(L.a4[q]); a[2 * q + 1] = bfhi(L.a4[q]); ew[2 * q] = bflo(L.ew4[q]); ew[2 * q + 1] = bfhi(L.ew4[q]);
            }
            float ss = 0.f;
#pragma unroll
            for (int e = 0; e < 8; ++e) { kk[e] = k[e] * kkw[e]; ss += kk[e] * kk[e]; }
            ss = sum8(ss);
            const float inv = 1.0f / fmaxf(sqrtf(ss), 1e-12f);
            float br = 0.f;
#pragma unroll
            for (int e = 0; e < 8; ++e) { kk[e] *= inv; br += kk[e] * a[e] * r[e]; }
            br = sum8(br);
            f32x4 o0, o1;
#define ST8(dst, expr) { _Pragma("unroll") for (int e = 0; e < 4; ++e) { { const int E = e; o0[e] = (expr); } { const int E = e + 4; o1[e] = (expr); } } *(LAS f32x4*)(dst + tt * 64 + jg * 8) = o0; *(LAS f32x4*)(dst + tt * 64 + jg * 8 + 4) = o1; }
            ST8(sR, r[E]);
            ST8(sDEC, __expf(-ew[E]));
            ST8(sKK, kk[E]);
            ST8(sBB, kk[E] * a[E]);
            ST8(sKP, k[E] * (1.f + (a[E] - 1.f) * kaw[E]));
            ST8(sV, v[E]);
#undef ST8
            if (jg == 0) sBR[tt] = br;
        }
        __syncthreads();
        if (tile + 1 < SEQ / 64) scan_load_rows(L, Zrkv, WAG, tok + 64, pos + 64, j0);
        if (F.wave < 4) {
            const LAS float* base = sR + jg * 8;
            f32x4 cr0 = *(const LAS f32x4*)(base), cr1 = *(const LAS f32x4*)(base + 4), cd0 = *(const LAS f32x4*)(base + 4096), cd1 = *(const LAS f32x4*)(base + 4100);
            f32x4 cq0 = *(const LAS f32x4*)(base + 8192), cq1 = *(const LAS f32x4*)(base + 8196), cb0 = *(const LAS f32x4*)(base + 12288), cb1 = *(const LAS f32x4*)(base + 12292);
            f32x4 cp0 = *(const LAS f32x4*)(base + 16384), cp1 = *(const LAS f32x4*)(base + 16388);
            float cvi = sV[irow], cbr = sBR[0];
#pragma unroll 2
            for (int s = 0; s < 64; ++s) {
                const int sn = (s + 1) & 63; const LAS float* nb = base + sn * 64;
                const f32x4 nr0 = *(const LAS f32x4*)(nb), nr1 = *(const LAS f32x4*)(nb + 4), nd0 = *(const LAS f32x4*)(nb + 4096), nd1 = *(const LAS f32x4*)(nb + 4100);
                const f32x4 nq0 = *(const LAS f32x4*)(nb + 8192), nq1 = *(const LAS f32x4*)(nb + 8196), nb0 = *(const LAS f32x4*)(nb + 12288), nb1 = *(const LAS f32x4*)(nb + 12292);
                const f32x4 np0 = *(const LAS f32x4*)(nb + 16384), np1 = *(const LAS f32x4*)(nb + 16388);
                const float nvi = sV[sn * 64 + irow], nbr = sBR[sn];
                float t[8], sa0 = 0.f, sa1 = 0.f, ty0 = 0.f, ty1 = 0.f;
#pragma unroll
                for (int e = 0; e < 4; ++e) {
                    sa0 += S[e] * cq0[e]; sa1 += S[4 + e] * cq1[e];
                    t[e] = S[e] * cd0[e] + cvi * cp0[e]; t[4 + e] = S[4 + e] * cd1[e] + cvi * cp1[e];
                    ty0 += t[e] * cr0[e]; ty1 += t[4 + e] * cr1[e];
                }
                float sa = sa0 + sa1, ty = ty0 + ty1;
                sa += dpp_f(sa, 0); ty += dpp_f(ty, 0); sa += dpp_f(sa, 1); ty += dpp_f(ty, 1); sa += dpp_f(sa, 2); ty += dpp_f(ty, 2);
                sa = -sa;
#pragma unroll
                for (int e = 0; e < 4; ++e) { S[e] = t[e] + sa * cb0[e]; S[4 + e] = t[4 + e] + sa * cb1[e]; }
                if (jg == 0) sY[s * 64 + irow] = ty + sa * cbr;
                cr0 = nr0; cr1 = nr1; cd0 = nd0; cd1 = nd1; cq0 = nq0; cq1 = nq1; cb0 = nb0; cb1 = nb1; cp0 = np0; cp1 = np1; cvi = nvi; cbr = nbr;
            }
        }
        __syncthreads();
        {
            const LAS float* rb = sR + tt * 64 + jg * 8; const LAS float* kb = sKP + tt * 64 + jg * 8; const LAS float* vb = sV + tt * 64 + jg * 8;
            float dot = 0.f;
#pragma unroll
            for (int e = 0; e < 8; ++e) dot += rb[e] * kb[e] * rkw[e];
            dot = sum8(dot);
            if ((jg >> 2) == half) {
                const LAS float* yb = sY + tt * 64 + jg * 8;
                const f32x4 ya = *(const LAS f32x4*)yb, yc = *(const LAS f32x4*)(yb + 4);
                float c[8];
#pragma unroll
                for (int q = 0; q < 4; ++q) { c[2 * q] = (lnb[2 * q] + dot * vb[2 * q]) * bflo(g4[q]); c[2 * q + 1] = (lnb[2 * q + 1] + dot * vb[2 * q + 1]) * bfhi(g4[q]); }
                *(v4u*)(YA + tok * 512 + j0) = (v4u){cvt_pk_bf16(ya[0], ya[1]), cvt_pk_bf16(ya[2], ya[3]), cvt_pk_bf16(yc[0], yc[1]), cvt_pk_bf16(yc[2], yc[3])};
                *(v4u*)(YC + tok * 512 + j0) = (v4u){cvt_pk_bf16(c[0], c[1]), cvt_pk_bf16(c[2], c[3]), cvt_pk_bf16(c[4], c[5]), cvt_pk_bf16(c[6], c[7])};
            }
        }
        __syncthreads();
    }
}

namespace rk {
constexpr int RSB = 144, SLOT = 64 * RSB;
__device__ __forceinline__ int off(int row, int elem) { return row * RSB + ((((elem) >> 3) ^ ((row >> 3) & 7)) << 4) + ((elem) & 7) * 2; }
struct Acc2 { f32x4 a[2]; };
template <bool TWO>
__device__ __forceinline__ Acc2 mm_mul(const LAS unsigned char* lds, int X, int Y, int X2, int Y2, int wave, int lane) {
    const int g = lane >> 4, c15 = lane & 15; Acc2 r;
#pragma unroll
    for (int jj = 0; jj < 2; ++jj) {
        const int job = wave + 8 * jj, yt = job >> 2, xt = job & 3;
        f32x4 acc = (f32x4){0.f, 0.f, 0.f, 0.f};
#pragma unroll
        for (int ks = 0; ks < 2; ++ks) {
            const bf16x8 a = *(const LAS bf16x8*)(lds + X * SLOT + off(16 * xt + c15, ks * 32 + 8 * g)), b = *(const LAS bf16x8*)(lds + Y * SLOT + off(16 * yt + c15, ks * 32 + 8 * g));
            acc = __builtin_amdgcn_mfma_f32_16x16x32_bf16(a, b, acc, 0, 0, 0);
        }
        if (TWO) {
#pragma unroll
            for (int ks = 0; ks < 2; ++ks) {
                const bf16x8 a = *(const LAS bf16x8*)(lds + X2 * SLOT + off(16 * xt + c15, ks * 32 + 8 * g)), b = *(const LAS bf16x8*)(lds + Y2 * SLOT + off(16 * yt + c15, ks * 32 + 8 * g));
                acc = __builtin_amdgcn_mfma_f32_16x16x32_bf16(a, b, acc, 0, 0, 0);
            }
        }
        r.a[jj] = acc;
    }
    return r;
}
template <int EPI>
__device__ __forceinline__ void mm_put(LAS unsigned char* lds, Acc2 r, int Z, int C, const LAS float* gam, int wave, int lane) {
    const int g = lane >> 4, c15 = lane & 15;
#pragma unroll
    for (int jj = 0; jj < 2; ++jj) {
        const int job = wave + 8 * jj, yt = job >> 2, xt = job & 3;
        f32x4 acc = r.a[jj];
        const int y = 16 * yt + c15, x0 = 16 * xt + 4 * g;
        if (EPI == 4) { const v2u cw = *(const LAS v2u*)(lds + C * SLOT + off(y, x0)); acc[0] += bflo(cw.x); acc[1] += bfhi(cw.x); acc[2] += bflo(cw.y); acc[3] += bfhi(cw.y); }
#pragma unroll
        for (int e = 0; e < 4; ++e) { const int x = x0 + e;
            if (EPI == 1) acc[e] = (x < y) ? acc[e] : 0.f;
            if (EPI == 2) acc[e] = (x > y) ? acc[e] : 0.f;
            if (EPI == 3) acc[e] = (x <= y) ? acc[e] : 0.f;
            if (EPI == 5) acc[e] += (x == y) ? gam[x] : 0.f; }
        *(LAS v2u*)(lds + Z * SLOT + off(y, x0)) = (v2u){cvt_pk_bf16(acc[0], acc[1]), cvt_pk_bf16(acc[2], acc[3])};
        if (EPI == 1) { float t[4];
#pragma unroll
            for (int e = 0; e < 4; ++e) t[e] = acc[e] + ((x0 + e == y) ? 1.f : 0.f);
            *(LAS v2u*)(lds + C * SLOT + off(y, x0)) = (v2u){cvt_pk_bf16(t[0], t[1]), cvt_pk_bf16(t[2], t[3])}; }
    }
}
}
__device__ __forceinline__ void p4_rwkv_chunked(Frame& F) {
    using namespace rk;
    const int bh = F.vcu >> 1, par = F.vcu & 1, b = bh >> 3, h = bh & 7;
    bf16* SB = (bf16*)((unsigned char*)F.out + DO_SB) + (size_t)bh * 2 * 4096; unsigned* flag = F.ctl + CW_RK + bh;
    const bf16* Zrkv = WSP(bf16, WS_ZRKV); const bf16* WAG = DOP(bf16, DO_WAG); bf16* YA = WSP(bf16, WS_YA);
    LAS unsigned char* lds = F.lds;
    LAS float* sL = (LAS float*)(lds + 14 * SLOT);
    LAS float* sY = (LAS float*)(lds + 3 * SLOT);
    LAS float* sG = (LAS float*)(lds + 16 * SLOT);
    const int tt = F.tid >> 3, jg = F.tid & 7, j0 = h * 64 + jg * 8, wave = F.wave, lane = F.lane;
    LAS float* sC = (LAS float*)(lds + 16 * SLOT + 256); LAS float* sLN = (LAS float*)(lds + MISC_OFF + 512);
    if (F.tid < 384) { const int jgi = F.tid / 48, r = F.tid % 48, which = r >> 3, e = r & 7; const float* srcp = which < 3 ? F.in[4] + which * 512 : F.in[10 + which - 3]; sC[F.tid] = srcp[h * 64 + jgi * 8 + e]; }
    if (F.tid < 128) { const int jgi = F.tid >> 4, r = F.tid & 15; sLN[F.tid] = (r < 8 ? F.in[13] : F.in[14])[h * 64 + jgi * 8 + (r & 7)]; }
    __syncthreads();
    ScanRows L; scan_load_rows(L, Zrkv, WAG, (size_t)b * SEQ + par * 64 + tt, par * 64 + tt, j0);
    unsigned pend = 0u;
    for (int ch = par; ch < SEQ / 64; ch += 2) {
        const int pos = ch * 64 + tt; const size_t tok = (size_t)b * SEQ + pos;
        const v4u g4 = L.g4;
        float r[8], kp[8], v[8], a[8], ew[8], kk[8];
        float dot = 0.f;
        {
            float k[8];
            float mu_r[8], mu_k[8], mu_v[8], kkw[8], kaw[8], rkw[8];
#pragma unroll
            for (int e = 0; e < 8; ++e) { const LAS float* cp = sC + jg * 48 + e; mu_r[e] = cp[0]; mu_k[e] = cp[8]; mu_v[e] = cp[16]; kkw[e] = cp[24]; kaw[e] = cp[32]; rkw[e] = cp[40]; }
#pragma unroll
            for (int q = 0; q < 4; ++q) {
                const float zr0 = bflo(L.zr[q]), zr1 = bfhi(L.zr[q]), zk0 = bflo(L.zk[q]), zk1 = bfhi(L.zk[q]), zv0 = bflo(L.zv[q]), zv1 = bfhi(L.zv[q]);
                r[2 * q] = zr0 + (bflo(L.pr[q]) - zr0) * mu_r[2 * q]; r[2 * q + 1] = zr1 + (bfhi(L.pr[q]) - zr1) * mu_r[2 * q + 1];
                k[2 * q] = zk0 + (bflo(L.pk[q]) - zk0) * mu_k[2 * q]; k[2 * q + 1] = zk1 + (bfhi(L.pk[q]) - zk1) * mu_k[2 * q + 1];
                v[2 * q] = zv0 + (bflo(L.pv[q]) - zv0) * mu_v[2 * q]; v[2 * q + 1] = zv1 + (bfhi(L.pv[q]) - zv1) * mu_v[2 * q + 1];
                a[2 * q] = bflo(L.a4[q]); a[2 * q + 1] = bfhi(L.a4[q]); ew[2 * q] = bflo(L.ew4[q]); ew[2 * q + 1] = bfhi(L.ew4[q]);
            }
            float ss = 0.f;
#pragma unroll
            for (int e = 0; e < 8; ++e) { kk[e] = k[e] * kkw[e]; ss += kk[e] * kk[e]; }
            ss = sum8(ss);
            const float inv = fminf(__builtin_amdgcn_rsqf(ss), 1e12f);
#pragma unroll
            for (int e = 0; e < 8; ++e) { kk[e] *= inv; kp[e] = k[e] * (1.f + (a[e] - 1.f) * kaw[e]); }
#pragma unroll
            for (int e = 0; e < 8; ++e) dot += r[e] * kp[e] * rkw[e];
            dot = sum8(dot);
        }
        __syncthreads();
        if (F.tid == 0 && pend) __hip_atomic_store(flag, pend, __ATOMIC_RELAXED, __HIP_MEMORY_SCOPE_AGENT);
        {
#pragma unroll
            for (int e = 0; e < 8; ++e) *(LAS unsigned short*)(lds + 11 * SLOT + off(jg * 8 + e, tt)) = (unsigned short)(cvt_pk_bf16(ew[e], 0.f) & 0xffffu);
            unsigned tw[4];
#pragma unroll
            for (int q = 0; q < 4; ++q) tw[q] = ((jg * 8 + 2 * q <= tt) ? 0x3f80u : 0u) | ((jg * 8 + 2 * q + 1 <= tt) ? 0x3f800000u : 0u);
            *(LAS v4u*)(lds + 10 * SLOT + off(tt, jg * 8)) = (v4u){tw[0], tw[1], tw[2], tw[3]};
        }
        __syncthreads();
        { const Acc2 q0 = mm_mul<false>(lds, 11, 10, 0, 0, wave, lane); const int g = lane >> 4, c15 = lane & 15;
#pragma unroll
          for (int jj = 0; jj < 2; ++jj) { const int job = wave + 8 * jj, yt = job >> 2, xt = job & 3; *(LAS f32x4*)(sL + (16 * yt + c15) * 64 + 16 * xt + 4 * g) = -q0.a[jj]; } }
        __syncthreads();
        if (F.tid < 64) sG[F.tid] = __expf(sL[63 * 64 + F.tid]);
        if (ch + 2 < SEQ / 64) scan_load_rows(L, Zrkv, WAG, tok + 128, pos + 128, j0);
        {
            const f32x4 l0 = *(const LAS f32x4*)(sL + tt * 64 + jg * 8), l1 = *(const LAS f32x4*)(sL + tt * 64 + jg * 8 + 4);
            const f32x4 c0 = *(const LAS f32x4*)(sL + 63 * 64 + jg * 8), c1 = *(const LAS f32x4*)(sL + 63 * 64 + jg * 8 + 4);
            float At[8], Bt[8], Kt[8], Rt[8], Bh[8], Kh[8];
#pragma unroll
            for (int e = 0; e < 8; ++e) { const float Lt = e < 4 ? l0[e] : l1[e - 4], LC = e < 4 ? c0[e] : c1[e - 4];
                const float eL = __expf(Lt), eLm1 = __expf(Lt + ew[e]), einv = __builtin_amdgcn_rcpf(eL), eC = __expf(LC) * einv, ba = kk[e] * a[e];
                At[e] = -kk[e] * eLm1; Bt[e] = ba * einv; Kt[e] = kp[e] * einv; Rt[e] = r[e] * eL; Bh[e] = ba * eC; Kh[e] = kp[e] * eC; }
#define RK_ROW(slot, arr) *(LAS v4u*)(lds + (slot) * SLOT + off(tt, jg * 8)) = (v4u){cvt_pk_bf16(arr[0], arr[1]), cvt_pk_bf16(arr[2], arr[3]), cvt_pk_bf16(arr[4], arr[5]), cvt_pk_bf16(arr[6], arr[7])}
#define RK_COL(slot, arr) { _Pragma("unroll") for (int e = 0; e < 8; ++e) *(LAS unsigned short*)(lds + (slot) * SLOT + off(jg * 8 + e, tt)) = (unsigned short)(cvt_pk_bf16(arr[e], 0.f) & 0xffffu); }
            RK_ROW(0, At); RK_COL(1, At); RK_ROW(2, Bt); RK_ROW(3, Kt); RK_ROW(4, Rt); RK_COL(5, Bh); RK_COL(6, Kh); RK_COL(7, v);
#undef RK_ROW
#undef RK_COL
        }
        __syncthreads();
#define MUL1(X_, Y_) mm_mul<false>(lds, X_, Y_, 0, 0, wave, lane)
#define MUL2(X_, Y_, X2_, Y2_) mm_mul<true>(lds, X_, Y_, X2_, Y2_, wave, lane)
#define PUT(E_, R_, Z_, C_) mm_put<E_>(lds, R_, Z_, C_, sG, wave, lane)
        { const Acc2 q0 = MUL1(2, 0), q1 = MUL1(0, 2), q2 = MUL1(3, 0), q3 = MUL1(2, 4), q4 = MUL1(3, 4);
          PUT(1, q0, 8, 13); PUT(2, q1, 14, 0); PUT(1, q2, 10, 15); PUT(3, q3, 11, 0); PUT(3, q4, 12, 0); }
        __syncthreads();
        { const Acc2 q0 = MUL1(14, 8), q1 = MUL1(8, 14); PUT(0, q0, 0, 0); PUT(0, q1, 2, 0); }
        __syncthreads();
        { const Acc2 q0 = MUL1(2, 13), q1 = MUL1(2, 0), q2 = MUL1(0, 2); PUT(4, q0, 3, 13); PUT(0, q1, 8, 0); PUT(0, q2, 14, 0); }
        __syncthreads();
        { const Acc2 q0 = MUL1(14, 3), q1 = MUL1(14, 8), q2 = MUL1(8, 14); PUT(4, q0, 13, 3); PUT(0, q1, 0, 0); PUT(0, q2, 2, 0); }
        __syncthreads();
        { const Acc2 q0 = MUL1(2, 13), q1 = MUL1(2, 0), q2 = MUL1(0, 2); PUT(4, q0, 3, 13); PUT(0, q1, 8, 0); PUT(0, q2, 14, 0); }
        __syncthreads();
        { const Acc2 q0 = MUL1(14, 3), q1 = MUL1(8, 14); PUT(4, q0, 13, 3); PUT(0, q1, 0, 0); }
        __syncthreads();
        { const Acc2 q0 = MUL1(0, 13); PUT(4, q0, 3, 13); }
        __syncthreads();
        { const Acc2 q0 = MUL1(3, 1), q1 = MUL1(10, 7); PUT(0, q0, 8, 0); PUT(0, q1, 0, 0); }
        __syncthreads();
        { const Acc2 q0 = MUL1(3, 0); PUT(0, q0, 13, 0); }
        __syncthreads();
        { const Acc2 q0 = MUL1(8, 5), q1 = MUL2(5, 13, 6, 7), q2 = MUL1(8, 11), q3 = MUL2(11, 13, 12, 7);
          PUT(5, q0, 2, 0); PUT(0, q1, 14, 0); PUT(4, q2, 15, 4); PUT(0, q3, 0, 0); }
        __syncthreads();
#undef MUL1
#undef MUL2
#undef PUT
        if (ch == 0) { for (int i = F.tid; i < SLOT / 4; i += NTHREADS) ((LAS unsigned*)(lds + 9 * SLOT))[i] = 0u; }
        else {
            if (F.tid == 0) { unsigned sp = 0; while (__hip_atomic_load(flag, __ATOMIC_RELAXED, __HIP_MEMORY_SCOPE_AGENT) < (unsigned)ch && ++sp < (1u << 22)) __builtin_amdgcn_s_sleep(1); }
            __syncthreads();
            const unsigned long long* sp8 = (const unsigned long long*)(SB + (size_t)(ch & 1) * 4096 + F.tid * 8);
            const unsigned long long w0 = __hip_atomic_load(sp8, __ATOMIC_RELAXED, __HIP_MEMORY_SCOPE_AGENT), w1 = __hip_atomic_load(sp8 + 1, __ATOMIC_RELAXED, __HIP_MEMORY_SCOPE_AGENT);
            *(LAS v4u*)(lds + 9 * SLOT + off(F.tid >> 3, (F.tid & 7) * 8)) = (v4u){(unsigned)w0, (unsigned)(w0 >> 32), (unsigned)w1, (unsigned)(w1 >> 32)};
        }
        __syncthreads();
        v2u snew[2];
        {
            const int g = lane >> 4, c15 = lane & 15;
#pragma unroll
            for (int jj = 0; jj < 2; ++jj) {
                const int job = wave + 8 * jj, yt = job >> 2, xt = job & 3;
                f32x4 ya = (f32x4){0.f, 0.f, 0.f, 0.f}, sa2 = (f32x4){0.f, 0.f, 0.f, 0.f};
#pragma unroll
                for (int ks = 0; ks < 2; ++ks) {
                    const bf16x8 sf = *(const LAS bf16x8*)(lds + 9 * SLOT + off(16 * yt + c15, ks * 32 + 8 * g));
                    const bf16x8 rf = *(const LAS bf16x8*)(lds + 15 * SLOT + off(16 * xt + c15, ks * 32 + 8 * g)), mf = *(const LAS bf16x8*)(lds + 2 * SLOT + off(16 * xt + c15, ks * 32 + 8 * g));
                    ya = __builtin_amdgcn_mfma_f32_16x16x32_bf16(rf, sf, ya, 0, 0, 0); sa2 = __builtin_amdgcn_mfma_f32_16x16x32_bf16(mf, sf, sa2, 0, 0, 0);
                }
                const int yy = 16 * yt + c15, x0 = 16 * xt + 4 * g;
                const v2u y0w = *(const LAS v2u*)(lds + 0 * SLOT + off(yy, x0)), nw = *(const LAS v2u*)(lds + 14 * SLOT + off(yy, x0));
                ya[0] += bflo(y0w.x); ya[1] += bfhi(y0w.x); ya[2] += bflo(y0w.y); ya[3] += bfhi(y0w.y);
                sa2[0] += bflo(nw.x); sa2[1] += bfhi(nw.x); sa2[2] += bflo(nw.y); sa2[3] += bfhi(nw.y);
#pragma unroll
                for (int e = 0; e < 4; ++e) sY[(x0 + e) * 64 + yy] = ya[e];
                snew[jj] = (v2u){cvt_pk_bf16(sa2[0], sa2[1]), cvt_pk_bf16(sa2[2], sa2[3])};
            }
        }
        {
            const int g = lane >> 4, c15 = lane & 15;
#pragma unroll
            for (int jj = 0; jj < 2; ++jj) { const int job = wave + 8 * jj, yt = job >> 2, xt = job & 3;
                __hip_atomic_store((unsigned long long*)(SB + (size_t)((ch + 1) & 1) * 4096 + (16 * yt + c15) * 64 + 16 * xt + 4 * g), (unsigned long long)snew[jj].x | ((unsigned long long)snew[jj].y << 32), __ATOMIC_RELAXED, __HIP_MEMORY_SCOPE_AGENT); }
            __syncthreads();
            pend = (unsigned)(ch + 1);
        }
        {
            const LAS float* yb = sY + tt * 64 + jg * 8;
            const f32x4 ya = *(const LAS f32x4*)yb, yc = *(const LAS f32x4*)(yb + 4);
            float y[8] = {ya[0], ya[1], ya[2], ya[3], yc[0], yc[1], yc[2], yc[3]};
            float sm = 0.f;
#pragma unroll
            for (int e = 0; e < 8; ++e) sm += y[e];
            const float mean = sum8(sm) * (1.f / 64.f);
            float sv = 0.f;
#pragma unroll
            for (int e = 0; e < 8; ++e) { y[e] -= mean; sv += y[e] * y[e]; }
            const float rstd = rsqrtf(sum8(sv) * (1.f / 64.f) + 64e-5f);
            float lnw[8], lnb[8];
#pragma unroll
            for (int e = 0; e < 8; ++e) { lnw[e] = sLN[jg * 16 + e]; lnb[e] = sLN[jg * 16 + 8 + e]; }
            float o[8];
#pragma unroll
            for (int q = 0; q < 4; ++q) {
                o[2 * q] = (y[2 * q] * rstd * lnw[2 * q] + lnb[2 * q] + dot * v[2 * q]) * bflo(g4[q]);
                o[2 * q + 1] = (y[2 * q + 1] * rstd * lnw[2 * q + 1] + lnb[2 * q + 1] + dot * v[2 * q + 1]) * bfhi(g4[q]);
            }
            asm volatile("s_waitcnt vmcnt(0)" ::: "memory");
            *(v4u*)(YA + tok * 512 + j0) = (v4u){cvt_pk_bf16(o[0], o[1]), cvt_pk_bf16(o[2], o[3]), cvt_pk_bf16(o[4], o[5]), cvt_pk_bf16(o[6], o[7])};
        }
    }
    __syncthreads();
    if (F.tid == 0 && pend) __hip_atomic_store(flag, pend, __ATOMIC_RELAXED, __HIP_MEMORY_SCOPE_AGENT);
}

__device__ __forceinline__ void p5_post(Frame& F) {
    bf16* YA = WSP(bf16, WS_YA); const bf16* YC = WSP(bf16, WS_YC); const bf16* WAG = DOP(bf16, DO_WAG);
    const int gt = F.vcu * NTHREADS + F.tid, NGT = F.G * NTHREADS;
    for (int it = gt; it < T * 64; it += NGT) {
        const size_t tok = (size_t)(it >> 6); const int c0 = (it & 63) * 8;
        const v4u yw = *(const v4u*)(YA + tok * 512 + c0), cw = *(const v4u*)(YC + tok * 512 + c0), gw = *(const v4u*)(WAG + tok * 1536 + 1024 + c0);
        float y[8], sm = 0.f;
#pragma unroll
        for (int q = 0; q < 4; ++q) { y[2 * q] = bflo(yw[q]); y[2 * q + 1] = bfhi(yw[q]); sm += y[2 * q] + y[2 * q + 1]; }
        const float mean = sum8(sm) * (1.f / 64.f); float sv = 0.f;
#pragma unroll
        for (int e = 0; e < 8; ++e) { y[e] -= mean; sv += y[e] * y[e]; }
        const float rstd = rsqrtf(sum8(sv) * (1.f / 64.f) + 64e-5f);
        const f32x4 l0 = *(const f32x4*)(F.in[13] + c0), l1 = *(const f32x4*)(F.in[13] + c0 + 4);
        const float lw[8] = {l0[0], l0[1], l0[2], l0[3], l1[0], l1[1], l1[2], l1[3]};
        float o[8];
#pragma unroll
        for (int q = 0; q < 4; ++q) { o[2 * q] = y[2 * q] * rstd * lw[2 * q] * bflo(gw[q]) + bflo(cw[q]); o[2 * q + 1] = y[2 * q + 1] * rstd * lw[2 * q + 1] * bfhi(gw[q]) + bfhi(cw[q]); }
        *(v4u*)(YA + tok * 512 + c0) = (v4u){cvt_pk_bf16(o[0], o[1]), cvt_pk_bf16(o[2], o[3]), cvt_pk_bf16(o[4], o[5]), cvt_pk_bf16(o[6], o[7])};
    }
}

__device__ __forceinline__ unsigned score_key(float s) {
    s = s + 0.0f;
    const _Float16 hv = (_Float16)s; const unsigned u = (unsigned)__builtin_bit_cast(unsigned short, hv);
    return (u & 0x8000u) ? (~u & 0xffffu) : (u | 0x8000u);
}
__device__ __forceinline__ void find_bin(const LAS unsigned* hist, unsigned need, int lane, unsigned& bsel, unsigned& above) {
    const v4u c = *(const LAS v4u*)(hist + 4 * lane);
    const unsigned sl = c.x + c.y + c.z + c.w;
    unsigned suf = sl;
#pragma unroll
    for (int d = 1; d < 64; d <<= 1) { const unsigned o = (unsigned)__shfl_down((int)suf, d); suf += (lane + d < 64) ? o : 0u; }
    const unsigned long long bal = __ballot(suf >= need);
    const int L = 63 - __builtin_clzll(bal | 1ull);
    unsigned run = suf - sl;
    unsigned bb, ab;
    if (run + c.w >= need) { bb = 3; ab = run; }
    else if (run + c.w + c.z >= need) { bb = 2; ab = run + c.w; }
    else if (run + c.w + c.z + c.y >= need) { bb = 1; ab = run + c.w + c.z; }
    else { bb = 0; ab = run + c.w + c.z + c.y; }
    bsel = (unsigned)__shfl((int)(4 * lane + bb), L); above = (unsigned)__shfl((int)ab, L);
}
constexpr int HP = 260;
constexpr int HIST_WAVE_BYTES = 16 * HP * 4, KBUF_OFF = NWAVES * HIST_WAVE_BYTES;
template <int PASS>
__device__ __forceinline__ void idx_tile(const bf16x8 K0, const bf16x8 K1, const int kt, const bool diag, const bf16x8 (&Q)[4][2], const float (&w)[4], LAS unsigned* hrow, const int g, const int c15,
                                         const unsigned b1, const unsigned thr, const unsigned rr, unsigned& cnt, unsigned& ties, unsigned short* idxrow, unsigned short* sink) {
    float sc[4] = {0.f, 0.f, 0.f, 0.f};
#pragma unroll
    for (int hh = 0; hh < 4; ++hh) {
        f32x4 acc = (f32x4){0.f, 0.f, 0.f, 0.f};
        acc = __builtin_amdgcn_mfma_f32_16x16x32_bf16(K0, Q[hh][0], acc, 0, 0, 0);
        acc = __builtin_amdgcn_mfma_f32_16x16x32_bf16(K1, Q[hh][1], acc, 0, 0, 0);
#pragma unroll
        for (int i = 0; i < 4; ++i) sc[i] += w[hh] * __builtin_amdgcn_fmed3f(acc[i], 0.f, __builtin_inff());
    }
    unsigned key[4]; bool valid[4];
#pragma unroll
    for (int i = 0; i < 4; ++i) { valid[i] = !diag || (4 * g + i <= c15); key[i] = score_key(sc[i]); }
    if (PASS == 0) {
#pragma unroll
        for (int i = 0; i < 4; ++i) lds_add(hrow + (key[i] >> 8), valid[i] ? 1u : 0u);
    } else if (PASS == 1) {
#pragma unroll
        for (int i = 0; i < 4; ++i) if (valid[i] && (key[i] >> 8) == b1) lds_add(hrow + (key[i] & 255u), 1u);
    } else {
        const unsigned long long qmask = 0x0001000100010001ull << c15, lowerG = qmask & ((1ull << (16 * g)) - 1ull);
        bool tie[4]; unsigned tlow = 0;
#pragma unroll
        for (int i = 0; i < 4; ++i) tie[i] = valid[i] && key[i] == thr;
        unsigned tb[4];
#pragma unroll
        for (int i = 0; i < 4; ++i) { const unsigned long long bl = __ballot(tie[i]); tb[i] = (unsigned)__popcll(bl & qmask); tlow += (unsigned)__popcll(bl & lowerG); }
        bool sel[4]; unsigned trun = ties + tlow;
#pragma unroll
        for (int i = 0; i < 4; ++i) { const bool tacc = tie[i] && trun < rr; sel[i] = (valid[i] && key[i] > thr) || tacc; trun += tie[i] ? 1u : 0u; }
        unsigned slow = 0, stot = 0;
#pragma unroll
        for (int i = 0; i < 4; ++i) { const unsigned long long bl = __ballot(sel[i]); stot += (unsigned)__popcll(bl & qmask); slow += (unsigned)__popcll(bl & lowerG); }
        unsigned pos = cnt + slow;
#pragma unroll
        for (int i = 0; i < 4; ++i) { if (sel[i] && pos < 256u) ((LAS unsigned short*)hrow)[pos] = (unsigned short)(kt * 16 + 4 * g + i); pos += sel[i] ? 1u : 0u; }
        cnt += stot; ties += tb[0] + tb[1] + tb[2] + tb[3];
    }
}
template <int PASS>
__device__ __forceinline__ void idx_pass(Frame& F, const bf16* kb_batch  , const int p, const int pmax, const bf16x8 (&Q)[4][2], const float (&w)[4], LAS unsigned* hrow,
                                         const unsigned b1, const unsigned thr, const unsigned rr, unsigned& cnt, unsigned& ties, unsigned short* idxrow, unsigned short* sink) {
    const int g = F.lane >> 4, c15 = F.lane & 15;
    LAS unsigned char* kbuf = F.lds + KBUF_OFF;
    const int skey = F.tid >> 3, sd8 = F.tid & 7;
    const unsigned sdst = (unsigned)((skey >> 4) * 2048 + (sd8 >> 2) * 1024 + (sd8 & 3) * 256 + (skey & 15) * 16);
    const bf16* ssrc = kb_batch + (size_t)skey * 512 + sd8 * 8;
    const int nchunk = (pmax >> 2) + 1;
    v4u st = *(const v4u*)ssrc;
    __syncthreads();
    *(LAS v4u*)(kbuf + sdst) = st;
    for (int c = 0; c < nchunk; ++c) {
        if (c + 1 < nchunk) st = *(const v4u*)(ssrc + (size_t)(c + 1) * 64 * 512);
        __syncthreads();
        const LAS unsigned char* kb = kbuf + (c & 1) * 8192 + g * 256 + c15 * 16;
        if (c * 4 + 3 < p) {
            bf16x8 K0[4], K1[4];
#pragma unroll
            for (int u = 0; u < 4; ++u) { K0[u] = *(const LAS bf16x8*)(kb + u * 2048); K1[u] = *(const LAS bf16x8*)(kb + u * 2048 + 1024); }
#pragma unroll
            for (int u = 0; u < 4; ++u) idx_tile<PASS>(K0[u], K1[u], c * 4 + u, false, Q, w, hrow, g, c15, b1, thr, rr, cnt, ties, idxrow, sink);
        } else {
#pragma unroll
            for (int u = 0; u < 4; ++u) {
                const int kt = c * 4 + u;
                if (kt <= p) {
                    const bf16x8 K0 = *(const LAS bf16x8*)(kb + u * 2048), K1 = *(const LAS bf16x8*)(kb + u * 2048 + 1024);
                    idx_tile<PASS>(K0, K1, kt, kt == p, Q, w, hrow, g, c15, b1, thr, rr, cnt, ties, idxrow, sink);
                }
            }
        }
        if (c + 1 < nchunk) *(LAS v4u*)(kbuf + ((c + 1) & 1) * 8192 + sdst) = st;
    }
}
namespace ix3 {
constexpr int KP = 8208, KEYS_B = 16 * KP, HIST_OFF = KEYS_B, CNT_OFF = HIST_OFF + 16 * HP * 4, QI_OFF = CNT_OFF + 8 * 16 * 2 * 4, END_OFF = QI_OFF + 16 * 4 * 4;
static_assert(END_OFF <= MISC_OFF, "indexer LDS map");
}
__device__ __forceinline__ void p4_indexer(Frame& F) {
    using namespace ix3;
    const bf16* Zd = WSP(bf16, WS_ZD); unsigned short* IDX = WSP(unsigned short, WS_IDX);
    LAS unsigned char* lds = F.lds;
    LAS unsigned* hist = (LAS unsigned*)(lds + HIST_OFF); LAS unsigned* cntt = (LAS unsigned*)(lds + CNT_OFF); LAS unsigned* qi = (LAS unsigned*)(lds + QI_OFF);
    const int lane = F.lane, wave = F.wave, g = lane >> 4, c15 = lane & 15;
    const int b = F.vcu >> 4, vb = F.vcu & 15;
    if (b >= NB) return;
    LAS unsigned* hrow = hist + c15 * HP;
    LAS unsigned char* krow = lds + c15 * KP;
    const unsigned long long qmask = 0x0001000100010001ull << c15, lowerG = qmask & ((1ull << (16 * g)) - 1ull);
    for (int ti = 0; ti < 16; ++ti) {
        const int pr = vb * 8 + (ti & 7), p = (ti & 8) ? 255 - pr : pr;
        const int q0 = p * 16; const size_t tok0 = (size_t)b * SEQ + q0;
        if (p < 16) {
            for (int i = F.tid; i < 16 * 256; i += NTHREADS) { const int r = i >> 8, jx = i & 255; IDX[(tok0 + r) * 256 + jx] = (unsigned short)(jx <= q0 + r ? jx : 0); }
            continue;
        }
        const int np = p + 1, K8 = (np + 7) >> 3, lo = wave * K8, hi = (lo + K8 < np) ? lo + K8 : np;
        for (int z = F.tid; z < 16 * HP; z += NTHREADS) hist[z] = 0u;
        bf16x8 Q[4][2];
#pragma unroll
        for (int hh = 0; hh < 4; ++hh)
#pragma unroll
            for (int ks = 0; ks < 2; ++ks) Q[hh][ks] = *(const bf16x8*)(Zd + (tok0 + c15) * 512 + 256 + hh * 64 + ks * 32 + 8 * g);
        float w[4];
        { const v2u ww = *(const v2u*)(Zd + (tok0 + c15) * 512 + 192); w[0] = bflo(ww.x) * 0.0625f; w[1] = bfhi(ww.x) * 0.0625f; w[2] = bflo(ww.y) * 0.0625f; w[3] = bfhi(ww.y) * 0.0625f; }
        __syncthreads();
        if (lo < hi) {
            const bf16* kbase = Zd + ((size_t)b * SEQ + c15) * 512 + 128 + 8 * g;
            constexpr int NPF = 2;
            bf16x8 R[NPF][2];
#pragma unroll
            for (int u = 0; u < NPF; ++u) { const int kl = lo + u < hi ? lo + u : hi - 1; R[u][0] = *(const bf16x8*)(kbase + (size_t)kl * 8192); R[u][1] = *(const bf16x8*)(kbase + (size_t)kl * 8192 + 32);
                __builtin_amdgcn_sched_barrier(0); }
            auto keys2 = [&](const float s0, const float s1) __attribute__((always_inline)) -> unsigned {
                typedef _Float16 h2_t __attribute__((ext_vector_type(2))); typedef short s2_t __attribute__((ext_vector_type(2)));
                h2_t hv = __builtin_convertvector((f32x2){s0, s1}, h2_t); hv = hv + (h2_t){(_Float16)0.0f, (_Float16)0.0f};
                const s2_t hs = __builtin_bit_cast(s2_t, hv); const s2_t sg = hs >> (s2_t){15, 15};
                return __builtin_bit_cast(unsigned, hs) ^ (__builtin_bit_cast(unsigned, sg) | 0x80008000u);
            };
            for (int kt0 = lo; kt0 < hi; kt0 += NPF) {
#pragma unroll
                for (int u = 0; u < NPF; ++u) {
                    const int kt = kt0 + u;
                    f32x4 acc[4];
#pragma unroll
                    for (int hh = 0; hh < 4; ++hh) {
                        acc[hh] = __builtin_amdgcn_mfma_f32_16x16x32_bf16(R[u][0], Q[hh][0], (f32x4){0.f, 0.f, 0.f, 0.f}, 0, 0, 0);
                        acc[hh] = __builtin_amdgcn_mfma_f32_16x16x32_bf16(R[u][1], Q[hh][1], acc[hh], 0, 0, 0);
                    }
                    { const int kn = kt + NPF, kl = kn < hi ? kn : hi - 1; R[u][0] = *(const bf16x8*)(kbase + (size_t)kl * 8192); R[u][1] = *(const bf16x8*)(kbase + (size_t)kl * 8192 + 32); }
                    float sc[4] = {0.f, 0.f, 0.f, 0.f};
#pragma unroll
                    for (int hh = 0; hh < 4; ++hh)
#pragma unroll
                        for (int i = 0; i < 4; ++i) { const float av = acc[hh][i]; const int ai = __builtin_bit_cast(int, av); const int ar = ai > 0 ? ai : 0; sc[i] += w[hh] * __builtin_bit_cast(float, ar); }
                    if (kt < hi) {
                        const unsigned k01 = keys2(sc[0], sc[1]), k23 = keys2(sc[2], sc[3]);
                        const unsigned bin[4] = {(k01 >> 8) & 255u, k01 >> 24, (k23 >> 8) & 255u, k23 >> 24};
                        if (kt == p) {
                            asm volatile("" ::: "memory");
#pragma unroll
                            for (int i = 0; i < 4; ++i) lds_add(hrow + bin[i], (4 * g + i <= c15) ? 1u : 0u);
                        } else {
#pragma unroll
                            for (int i = 0; i < 4; ++i) lds_add(hrow + bin[i], 1u);
                        }
                        *(LAS v2u*)(krow + (kt * 16 + 4 * g) * 2) = (v2u){k01, k23};
                    }
                }
            }
        }
        __syncthreads();
        {
            LAS unsigned* hq[2]; const LAS unsigned char* kq[2]; unsigned qpos[2], b1[2], ab1[2], thr[2], rr[2];
            const int nsteps = (np * 16 + 255) >> 8;
#pragma unroll
            for (int qq = 0; qq < 2; ++qq) { const int q = 2 * wave + qq; hq[qq] = hist + q * HP; kq[qq] = lds + q * KP; qpos[qq] = (unsigned)(q0 + q); }
#pragma unroll
            for (int qq = 0; qq < 2; ++qq) find_bin(hq[qq], 256u, lane, b1[qq], ab1[qq]);
#pragma unroll
            for (int qq = 0; qq < 2; ++qq) for (int z = lane; z < HP; z += 64) hq[qq][z] = 0u;
            {
                auto step = [&](const int s, const bool mk) __attribute__((always_inline)) {
                    const unsigned k0 = (unsigned)(s * 256 + 4 * lane);
                    v2u kw[2];
#pragma unroll
                    for (int qq = 0; qq < 2; ++qq) kw[qq] = *(const LAS v2u*)(kq[qq] + k0 * 2);
#pragma unroll
                    for (int qq = 0; qq < 2; ++qq) { const unsigned key[4] = {kw[qq].x & 0xffffu, kw[qq].x >> 16, kw[qq].y & 0xffffu, kw[qq].y >> 16};
#pragma unroll
                        for (int i = 0; i < 4; ++i) if ((!mk || k0 + i <= qpos[qq]) && (key[i] >> 8) == b1[qq]) lds_add(hq[qq] + (key[i] & 255u), 1u); }
                };
                for (int s = 0; s < nsteps - 1; ++s) step(s, false);
                step(nsteps - 1, true);
            }
#pragma unroll
            for (int qq = 0; qq < 2; ++qq) { unsigned bs, ab; find_bin(hq[qq], 256u - ab1[qq], lane, bs, ab); thr[qq] = (b1[qq] << 8) | bs; rr[qq] = 256u - (ab1[qq] + ab); }
            unsigned cnt[2] = {0u, 0u}, ties[2] = {0u, 0u};
            {
                auto step = [&](const int s, const bool mk) __attribute__((always_inline)) {
                    const unsigned k0 = (unsigned)(s * 256 + 4 * lane);
                    v2u kw[2];
#pragma unroll
                    for (int qq = 0; qq < 2; ++qq) kw[qq] = *(const LAS v2u*)(kq[qq] + k0 * 2);
                    bool tie[2][4], sel[2][4]; bool anyt = false;
#pragma unroll
                    for (int qq = 0; qq < 2; ++qq) { const unsigned key[4] = {kw[qq].x & 0xffffu, kw[qq].x >> 16, kw[qq].y & 0xffffu, kw[qq].y >> 16};
#pragma unroll
                        for (int i = 0; i < 4; ++i) { const bool valid = !mk || k0 + i <= qpos[qq]; tie[qq][i] = valid && key[i] == thr[qq]; sel[qq][i] = valid && key[i] > thr[qq]; anyt = anyt || tie[qq][i]; } }
                    if (__ballot(anyt) != 0ull) {
                        asm volatile("" ::: "memory");
#pragma unroll
                        for (int qq = 0; qq < 2; ++qq) { unsigned tlow = 0, tall = 0;
#pragma unroll
                            for (int i = 0; i < 4; ++i) { const unsigned long long bm = __ballot(tie[qq][i]); tlow = __builtin_amdgcn_mbcnt_hi((unsigned)(bm >> 32), __builtin_amdgcn_mbcnt_lo((unsigned)bm, tlow)); tall += (unsigned)__popcll(bm); }
                            unsigned trun = ties[qq] + tlow;
#pragma unroll
                            for (int i = 0; i < 4; ++i) { sel[qq][i] = sel[qq][i] || (tie[qq][i] && trun < rr[qq]); trun += tie[qq][i] ? 1u : 0u; }
                            ties[qq] += tall; }
                    }
#pragma unroll
                    for (int qq = 0; qq < 2; ++qq) { LAS unsigned short* list = (LAS unsigned short*)hq[qq];
                        unsigned slow = 0, sall = 0;
#pragma unroll
                        for (int i = 0; i < 4; ++i) { const unsigned long long bm = __ballot(sel[qq][i]); slow = __builtin_amdgcn_mbcnt_hi((unsigned)(bm >> 32), __builtin_amdgcn_mbcnt_lo((unsigned)bm, slow)); sall += (unsigned)__popcll(bm); }
                        unsigned pos = cnt[qq] + slow;
#pragma unroll
                        for (int i = 0; i < 4; ++i) { const unsigned wpos = (sel[qq][i] && pos < 256u) ? pos : 256u + (unsigned)lane; list[wpos] = (unsigned short)(k0 + i); pos += sel[qq][i] ? 1u : 0u; }
                        cnt[qq] += sall; }
                };
                for (int s = 0; s < nsteps - 1; ++s) step(s, false);
                step(nsteps - 1, true);
            }
        }
        __syncthreads();
        { const int q = F.tid >> 5, ch = F.tid & 31; const v4u v = *(const LAS v4u*)((const LAS unsigned char*)(hist + q * HP) + ch * 16); *(v4u*)((unsigned char*)(IDX + (tok0 + q) * 256) + ch * 16) = v; }
        __syncthreads();
    }
}

__device__ __forceinline__ unsigned off_b(unsigned row, unsigned ch) { return 256u * row + 16u * (ch ^ (((row & 3) << 2) | ((row >> 2) & 3))); }
__device__ __forceinline__ void p4_sparse_attn(Frame& F) {
    const bf16* CKV = WSP(bf16, WS_CKV); const unsigned short* IDX = WSP(unsigned short, WS_IDX); bf16* QL = WSP(bf16, WS_QLAT);
    LAS unsigned char* img0 = F.lds + F.wave * 16384;
    const int lane = F.lane, g = lane >> 4, c15 = lane & 15, qq = c15 >> 2, pp = lane & 3;
    const int t0 = F.gw * 32; constexpr int NF = 256;
    v4u ixw; v4u rw[8];
    const unsigned goff = 16u * g, coff = 16u * c15;
#define SA_LOAD_IDX(f_) { const int f2 = (f_) < NF ? (f_) : NF - 1; ixw = *(const v4u*)((const unsigned char*)(IDX + (size_t)(t0 + (f2 >> 3)) * 256 + (f2 & 7) * 32) + goff); }
#define SA_IX(c_) (((c_) & 1) ? (ixw[(c_) >> 1] >> 16) : (ixw[(c_) >> 1] & 0xffffu))
#define SA_LOAD_ROWS(f_) { const int f2 = (f_) < NF ? (f_) : NF - 1; const unsigned char* rbp = (const unsigned char*)(CKV + (size_t)((t0 + (f2 >> 3)) >> 12) * SEQ * 128); \
        _Pragma("unroll") for (int c = 0; c < 8; ++c) rw[c] = *(const v4u*)(rbp + ((SA_IX(c) << 8) + coff)); }
    SA_LOAD_IDX(0); SA_LOAD_ROWS(0); SA_LOAD_IDX(1);
    bf16x8 Bq[4], Bqn[4];
#pragma unroll
    for (int ks = 0; ks < 4; ++ks) { Bqn[ks] = (bf16x8){0, 0, 0, 0, 0, 0, 0, 0}; if (c15 < 8) Bqn[ks] = *(const bf16x8*)(QL + (size_t)t0 * 1024 + c15 * 128 + ks * 32 + 8 * g); Bq[ks] = Bqn[ks]; }
    float mrun = -1e30f, lsum = 0.f;
    f32x4 O[8];
#pragma unroll
    for (int c = 0; c < 8; ++c) O[c] = (f32x4){0.f, 0.f, 0.f, 0.f};
    for (int f = 0; f < NF; ++f) {
        const int t = t0 + (f >> 3), im = f & 7; const int pos = t & (SEQ - 1); const int nsel = pos + 1 < 256 ? pos + 1 : 256;
        LAS unsigned char* img = img0 + (f & 1) * 8192;
#pragma unroll
        for (int c = 0; c < 8; ++c) *(LAS v4u*)(img + off_b(8 * g + c, c15)) = rw[c];
        SA_LOAD_ROWS(f + 1);
        SA_LOAD_IDX(f + 2);
        if (im == 0) {
#pragma unroll
            for (int ks = 0; ks < 4; ++ks) Bq[ks] = Bqn[ks];
            mrun = -1e30f; lsum = 0.f;
#pragma unroll
            for (int c = 0; c < 8; ++c) O[c] = (f32x4){0.f, 0.f, 0.f, 0.f};
        }
        if (im == 2) { const int tn = (t + 1 < t0 + 32) ? t + 1 : t;
#pragma unroll
            for (int ks = 0; ks < 4; ++ks) if (c15 < 8) Bqn[ks] = *(const bf16x8*)(QL + (size_t)tn * 1024 + c15 * 128 + ks * 32 + 8 * g); }
        f32x4 sacc[2];
#pragma unroll
        for (int rb = 0; rb < 2; ++rb) { sacc[rb] = (f32x4){0.f, 0.f, 0.f, 0.f};
#pragma unroll
            for (int ks = 0; ks < 4; ++ks) { const bf16x8 a = *(const LAS bf16x8*)(img + off_b(c15 + 16 * rb, 4 * ks + g)); sacc[rb] = __builtin_amdgcn_mfma_f32_16x16x32_bf16(a, Bq[ks], sacc[rb], 0, 0, 0); } }
        if (nsel < 256) {
            asm volatile("" ::: "memory");
#pragma unroll
            for (int rb = 0; rb < 2; ++rb)
#pragma unroll
                for (int i = 0; i < 4; ++i) { const int j = im * 32 + 16 * rb + 4 * g + i; if (j >= nsel) sacc[rb][i] = -1e30f; }
        }
        float mx = -1e30f;
#pragma unroll
        for (int rb = 0; rb < 2; ++rb)
#pragma unroll
            for (int i = 0; i < 4; ++i) mx = fmaxf(mx, sacc[rb][i]);
        mx = fmaxf(mx, __shfl_xor(mx, 16)); mx = fmaxf(mx, __shfl_xor(mx, 32));
        const float mnew = fmaxf(mrun, mx), alpha = __expf(mrun - mnew), mneg = -1.4426950408889634f * mnew;
        float ps = 0.f; float pv[8];
#pragma unroll
        for (int rb = 0; rb < 2; ++rb)
#pragma unroll
            for (int i = 0; i < 4; ++i) { const float pe = __builtin_amdgcn_exp2f(__builtin_fmaf(sacc[rb][i], 1.4426950408889634f, mneg)); pv[4 * rb + i] = pe; ps += pe; }
        ps += __shfl_xor(ps, 16); ps += __shfl_xor(ps, 32);
        lsum = lsum * alpha + ps; mrun = mnew;
        const v4u pw = (v4u){cvt_pk_bf16(pv[0], pv[1]), cvt_pk_bf16(pv[2], pv[3]), cvt_pk_bf16(pv[4], pv[5]), cvt_pk_bf16(pv[6], pv[7])};
        const bf16x8 pa = __builtin_bit_cast(bf16x8, pw);
        float al[4];
#pragma unroll
        for (int i = 0; i < 4; ++i) al[i] = __shfl(alpha, (4 * g + i) & 15);
#pragma unroll
        for (int c = 0; c < 8; ++c) {
#pragma unroll
            for (int i = 0; i < 4; ++i) O[c][i] *= al[i];
            const s16x4 lo = __builtin_bit_cast(s16x4, __builtin_amdgcn_ds_read_tr16_b64_v4i16((LAS s16x4*)(img + off_b(4 * g + qq, 2 * c + (pp >> 1)) + 8 * (pp & 1))));
            const s16x4 hi = __builtin_bit_cast(s16x4, __builtin_amdgcn_ds_read_tr16_b64_v4i16((LAS s16x4*)(img + off_b(16 + 4 * g + qq, 2 * c + (pp >> 1)) + 8 * (pp & 1))));
            const bf16x8 bv = (bf16x8){lo[0], lo[1], lo[2], lo[3], hi[0], hi[1], hi[2], hi[3]};
            O[c] = __builtin_amdgcn_mfma_f32_16x16x32_bf16(pa, bv, O[c], 0, 0, 0);
        }
        if (im == 7) {
            float inv[4];
#pragma unroll
            for (int i = 0; i < 4; ++i) inv[i] = __builtin_amdgcn_rcpf(__shfl(lsum, (4 * g + i) & 15));
            if (g < 2) {
#pragma unroll
                for (int c = 0; c < 8; ++c)
#pragma unroll
                    for (int i = 0; i < 4; ++i) *(LAS unsigned short*)(img + ((4 * g + i) * 128 + 16 * c + c15) * 2) = (unsigned short)(cvt_pk_bf16(O[c][i] * inv[i], 0.f) & 0xffffu);
            }
            const v4u o0 = *(const LAS v4u*)(img + lane * 32), o1 = *(const LAS v4u*)(img + lane * 32 + 16);
            *(v4u*)(QL + (size_t)t * 1024 + lane * 16) = o0; *(v4u*)(QL + (size_t)t * 1024 + lane * 16 + 8) = o1;
        }
    }
#undef SA_LOAD_IDX
#undef SA_IX
#undef SA_LOAD_ROWS
}

__device__ __forceinline__ void p10_cross_attn(Frame& F) {
    const bf16* QC = WSP(bf16, WS_QC); bf16* XO = WSP(bf16, WS_XO); const bf16* Km = WSP(bf16, WS_KMEM); const bf16* Vt = WSP(bf16, WS_VT);
    const int lane = F.lane, g = lane >> 4, c15 = lane & 15;
    constexpr int RS = 528, BUFB = 64 * RS, NU = NB * 4 * 16;
    const int srow = F.tid >> 5, spc = F.tid & 31;
#define X_SRC(u_, c_) ((c_) < 4 ? (const unsigned char*)(Km + ((size_t)((u_) >> 6) * 256 + (c_) * 64 + srow) * 1024 + (((u_) >> 4) & 3) * 256) + spc * 16 \
                               : (const unsigned char*)(Vt + ((size_t)((u_) >> 4) * 256 + ((c_) - 4) * 64 + srow) * 256) + spc * 16)
#define X_LOAD(st_, u_, c_) { const unsigned char* s_ = X_SRC(u_, c_); _Pragma("unroll") for (int j = 0; j < 4; ++j) st_[j] = *(const v4u*)(s_ + (size_t)j * 16 * ((c_) < 4 ? 2048 : 512)); }
#define X_PUT(st_, bi_) { _Pragma("unroll") for (int j = 0; j < 4; ++j) *(LAS v4u*)(F.lds + (bi_) * BUFB + (srow + 16 * j) * RS + spc * 16) = st_[j]; }
#define X_QROW(u_, t_) (QC + ((size_t)((u_) >> 6) * SEQ + ((u_) & 15) * 256 + F.wave * 32 + (t_) * 16 + c15) * 1024 + (((u_) >> 4) & 3) * 256)
    if (F.vcu >= NU) return;
    v4u st0[4], st1[4];
    bf16x8 Bq[2][8];
    {
        const int u = F.vcu;
        X_LOAD(st0, u, 0); X_LOAD(st1, u, 1);
#pragma unroll
        for (int t = 0; t < 2; ++t) { const bf16* qrow = X_QROW(u, t);
#pragma unroll
            for (int ks = 0; ks < 8; ++ks) Bq[t][ks] = *(const bf16x8*)(qrow + ks * 32 + 8 * g); }
        X_PUT(st0, 0);
    }
    for (int u = F.vcu; u < NU; u += F.G) {
        const int un = (u + F.G < NU) ? u + F.G : u;
        bf16x8 pb[2][8]; float mc[2][4], Ls[2] = {0.f, 0.f}, inv[2] = {0.f, 0.f};
#pragma unroll
        for (int cs = 0; cs < 8; ++cs) {
            if (cs & 1) { if (cs + 2 < 8) { X_LOAD(st1, u, cs + 2); } else { X_LOAD(st1, un, cs + 2 - 8); } }
            else        { if (cs + 2 < 8) { X_LOAD(st0, u, cs + 2); } else { X_LOAD(st0, un, cs + 2 - 8); } }
            __syncthreads();
            const LAS unsigned char* buf = F.lds + (cs & 1) * BUFB;
            if (cs < 4) {
                f32x4 acc[2][4];
                bf16x8 Af[2][4];
                const LAS unsigned char* kb = buf + c15 * RS + 16 * g;
#define X_LDK(gi_) { _Pragma("unroll") for (int q = 0; q < 4; ++q) Af[(gi_) & 1][q] = *(const LAS bf16x8*)(kb + ((gi_) >> 1) * 16 * RS + (((gi_) & 1) * 4 + q) * 64); }
                X_LDK(0);
                f32x4 a0 = (f32x4){0.f, 0.f, 0.f, 0.f}, a1 = a0;
#pragma unroll
                for (int gi = 0; gi < 8; ++gi) {
                    if (gi + 1 < 8) X_LDK(gi + 1);
                    __builtin_amdgcn_sched_barrier(0);
                    if (!(gi & 1)) { a0 = (f32x4){0.f, 0.f, 0.f, 0.f}; a1 = a0; }
#pragma unroll
                    for (int q = 0; q < 4; ++q) { a0 = __builtin_amdgcn_mfma_f32_16x16x32_bf16(Af[gi & 1][q], Bq[0][(gi & 1) * 4 + q], a0, 0, 0, 0); a1 = __builtin_amdgcn_mfma_f32_16x16x32_bf16(Af[gi & 1][q], Bq[1][(gi & 1) * 4 + q], a1, 0, 0, 0); }
                    if (gi & 1) { acc[0][gi >> 1] = a0; acc[1][gi >> 1] = a1; }
                    __builtin_amdgcn_sched_barrier(0);
                }
#undef X_LDK
#pragma unroll
                for (int t = 0; t < 2; ++t) {
                    float mx = -1e30f;
#pragma unroll
                    for (int m4 = 0; m4 < 4; ++m4)
#pragma unroll
                        for (int i = 0; i < 4; ++i) mx = fmaxf(mx, acc[t][m4][i]);
                    mx = fmaxf(mx, __shfl_xor(mx, 16)); mx = fmaxf(mx, __shfl_xor(mx, 32));
                    if (cs > 0) mx = fmaxf(mx, mc[t][cs > 0 ? cs - 1 : 0]);
                    float ps = (cs > 0) ? Ls[t] * __expf(mc[t][cs > 0 ? cs - 1 : 0] - mx) : 0.f;
#pragma unroll
                    for (int s2 = 0; s2 < 2; ++s2) { float e[8];
#pragma unroll
                        for (int i = 0; i < 4; ++i) { e[i] = __expf(acc[t][2 * s2][i] - mx); e[4 + i] = __expf(acc[t][2 * s2 + 1][i] - mx); ps += e[i] + e[4 + i]; }
                        const v4u w = (v4u){cvt_pk_bf16(e[0], e[1]), cvt_pk_bf16(e[2], e[3]), cvt_pk_bf16(e[4], e[5]), cvt_pk_bf16(e[6], e[7])}; pb[t][cs * 2 + s2] = __builtin_bit_cast(bf16x8, w); }
                    mc[t][cs] = mx; Ls[t] = ps;
                }
                if (cs == 3) {
#pragma unroll
                    for (int t = 0; t < 2; ++t) {
                        const float M = mc[t][3];
                        float L = Ls[t];
#pragma unroll
                        for (int c = 0; c < 3; ++c) { const float f = __expf(mc[t][c] - M);
#pragma unroll
                            for (int s2 = 0; s2 < 2; ++s2) { const v4u w = __builtin_bit_cast(v4u, pb[t][c * 2 + s2]);
                                const v4u r = (v4u){cvt_pk_bf16(bflo(w.x) * f, bfhi(w.x) * f), cvt_pk_bf16(bflo(w.y) * f, bfhi(w.y) * f), cvt_pk_bf16(bflo(w.z) * f, bfhi(w.z) * f), cvt_pk_bf16(bflo(w.w) * f, bfhi(w.w) * f)};
                                pb[t][c * 2 + s2] = __builtin_bit_cast(bf16x8, r); } }
                        L += __shfl_xor(L, 16); L += __shfl_xor(L, 32);
                        inv[t] = 1.0f / L;
                    }
#pragma unroll
                    for (int t = 0; t < 2; ++t) { const bf16* qn = X_QROW(un, t);
#pragma unroll
                        for (int ks = 0; ks < 8; ++ks) Bq[t][ks] = *(const bf16x8*)(qn + ks * 32 + 8 * g); }
                }
            } else {
                unsigned char* q0 = (unsigned char*)XO + (X_QROW(u, 0) - QC); unsigned char* q1 = (unsigned char*)XO + (X_QROW(u, 1) - QC);
                v4u Vf[2][4];
                const LAS unsigned char* vb = buf + c15 * RS + 8 * g;
#define X_LDV(gi_) { _Pragma("unroll") for (int q = 0; q < 4; ++q) { const LAS unsigned char* p_ = vb + ((gi_) >> 1) * 16 * RS + (((gi_) & 1) * 4 + q) * 64; \
                        const v2u lo = *(const LAS v2u*)p_, hi = *(const LAS v2u*)(p_ + 32); Vf[(gi_) & 1][q] = (v4u){lo.x, lo.y, hi.x, hi.y}; } }
                X_LDV(0);
                f32x4 o0 = (f32x4){0.f, 0.f, 0.f, 0.f}, o1 = o0;
#pragma unroll
                for (int gi = 0; gi < 8; ++gi) {
                    if (gi + 1 < 8) X_LDV(gi + 1);
                    __builtin_amdgcn_sched_barrier(0);
                    if (!(gi & 1)) { o0 = (f32x4){0.f, 0.f, 0.f, 0.f}; o1 = o0; }
#pragma unroll
                    for (int q = 0; q < 4; ++q) { const bf16x8 av = __builtin_bit_cast(bf16x8, Vf[gi & 1][q]);
                        o0 = __builtin_amdgcn_mfma_f32_16x16x32_bf16(av, pb[0][(gi & 1) * 4 + q], o0, 0, 0, 0); o1 = __builtin_amdgcn_mfma_f32_16x16x32_bf16(av, pb[1][(gi & 1) * 4 + q], o1, 0, 0, 0); }
                    if (gi & 1) { const int d4 = gi >> 1;
                        *(unsigned*)(q0 + ((cs - 4) * 4 + d4) * 16 + 4 * g) = pk4_fp8(o0[0] * inv[0], o0[1] * inv[0], o0[2] * inv[0], o0[3] * inv[0]);
                        *(unsigned*)(q1 + ((cs - 4) * 4 + d4) * 16 + 4 * g) = pk4_fp8(o1[0] * inv[1], o1[1] * inv[1], o1[2] * inv[1], o1[3] * inv[1]); }
                    __builtin_amdgcn_sched_barrier(0);
                }
#undef X_LDV
            }
            if (cs & 1) { X_PUT(st0, 0); } else { X_PUT(st1, 1); }
        }
    }
    __syncthreads();
#undef X_SRC
#undef X_LOAD
#undef X_PUT
#undef X_QROW
}

__device__ __forceinline__ void rms_row16(const bf16* xrow, const float* g, bf16* orow, int lane, unsigned char* o8row) {
    const v4u a = *((const v4u*)xrow + 2 * lane), b = *((const v4u*)xrow + 2 * lane + 1);
    float v[16] = {bflo(a.x), bfhi(a.x), bflo(a.y), bfhi(a.y), bflo(a.z), bfhi(a.z), bflo(a.w), bfhi(a.w), bflo(b.x), bfhi(b.x), bflo(b.y), bfhi(b.y), bflo(b.z), bfhi(b.z), bflo(b.w), bfhi(b.w)};
    float s = 0.f;
#pragma unroll
    for (int e = 0; e < 16; ++e) s += v[e] * v[e];
    const float rstd = rsqrtf(wave_sum(s) * (1.f / 1024.f) + 1e-6f);
    const f32x4* gr = (const f32x4*)g + 4 * lane;
#pragma unroll
    for (int q = 0; q < 4; ++q) { const f32x4 gg = gr[q]; v[4 * q] *= rstd * gg[0]; v[4 * q + 1] *= rstd * gg[1]; v[4 * q + 2] *= rstd * gg[2]; v[4 * q + 3] *= rstd * gg[3]; }
    *((v4u*)orow + 2 * lane) = (v4u){cvt_pk_bf16(v[0], v[1]), cvt_pk_bf16(v[2], v[3]), cvt_pk_bf16(v[4], v[5]), cvt_pk_bf16(v[6], v[7])};
    *((v4u*)orow + 2 * lane + 1) = (v4u){cvt_pk_bf16(v[8], v[9]), cvt_pk_bf16(v[10], v[11]), cvt_pk_bf16(v[12], v[13]), cvt_pk_bf16(v[14], v[15])};
    if (o8row) *((v4u*)o8row + lane) = (v4u){pk4_fp8(v[0], v[1], v[2], v[3]), pk4_fp8(v[4], v[5], v[6], v[7]), pk4_fp8(v[8], v[9], v[10], v[11]), pk4_fp8(v[12], v[13], v[14], v[15])};
}
__device__ __forceinline__ void rms_row16_do(const v4u a, const v4u b, const f32x4 (&gv)[4], bf16* orow, int lane, unsigned char* o8row) {
    float v[16] = {bflo(a.x), bfhi(a.x), bflo(a.y), bfhi(a.y), bflo(a.z), bfhi(a.z), bflo(a.w), bfhi(a.w), bflo(b.x), bfhi(b.x), bflo(b.y), bfhi(b.y), bflo(b.z), bfhi(b.z), bflo(b.w), bfhi(b.w)};
    float s = 0.f;
#pragma unroll
    for (int e = 0; e < 16; ++e) s += v[e] * v[e];
    const float rstd = rsqrtf(wave_sum(s) * (1.f / 1024.f) + 1e-6f);
#pragma unroll
    for (int q = 0; q < 4; ++q) { const f32x4 gg = gv[q]; v[4 * q] *= rstd * gg[0]; v[4 * q + 1] *= rstd * gg[1]; v[4 * q + 2] *= rstd * gg[2]; v[4 * q + 3] *= rstd * gg[3]; }
    if (orow) {
        *((v4u*)orow + 2 * lane) = (v4u){cvt_pk_bf16(v[0], v[1]), cvt_pk_bf16(v[2], v[3]), cvt_pk_bf16(v[4], v[5]), cvt_pk_bf16(v[6], v[7])};
        *((v4u*)orow + 2 * lane + 1) = (v4u){cvt_pk_bf16(v[8], v[9]), cvt_pk_bf16(v[10], v[11]), cvt_pk_bf16(v[12], v[13]), cvt_pk_bf16(v[14], v[15])}; }
    if (o8row) *((v4u*)o8row + lane) = (v4u){pk4_fp8(v[0], v[1], v[2], v[3]), pk4_fp8(v[4], v[5], v[6], v[7]), pk4_fp8(v[8], v[9], v[10], v[11]), pk4_fp8(v[12], v[13], v[14], v[15])};
}
__device__ __forceinline__ void p_norm_rows16(Frame& F, const bf16* src, const float* g, bf16* dst, unsigned char* dst8) {
    const int lane = F.lane, step = F.NGW; int m = F.gw;
    if (m >= T) return;
    f32x4 gv[4];
#pragma unroll
    for (int q = 0; q < 4; ++q) gv[q] = *((const f32x4*)g + 4 * lane + q);
#define NR_LD(a_, b_, m_) { const int mm_ = (m_) < T ? (m_) : m; a_ = *((const v4u*)(src + (size_t)mm_ * D) + 2 * lane); b_ = *((const v4u*)(src + (size_t)mm_ * D) + 2 * lane + 1); __builtin_amdgcn_sched_barrier(0); }
#define NR_DO(a_, b_) { if (m < T) { const v4u ca_ = a_, cb_ = b_; NR_LD(a_, b_, m + 3 * step); rms_row16_do(ca_, cb_, gv, dst ? dst + (size_t)m * D : nullptr, lane, dst8 ? dst8 + (size_t)m * D : nullptr); m += step; } }
    v4u a0, b0, a1, b1, a2, b2;
    NR_LD(a0, b0, m); NR_LD(a1, b1, m + step); NR_LD(a2, b2, m + 2 * step);
    while (m < T) { NR_DO(a0, b0); NR_DO(a1, b1); NR_DO(a2, b2); }
#undef NR_LD
#undef NR_DO
}
__device__ __forceinline__ void p_norm_rows(Frame& F, const float* g, bf16* dst, unsigned char* dst8 = nullptr) {
    for (int m = F.gw; m < T; m += F.NGW) rms_row_to_bf16(F.out + (size_t)m * D, g, dst + (size_t)m * D, F.lane, dst8 ? (unsigned*)(dst8 + (size_t)m * D) : nullptr);
}

struct TokInfo { int e0, e1; float g0, g1; };
__device__ __forceinline__ void p14a_route(Frame& F) {
    const float* L = WSP(float, WS_LOGIT); TokInfo* TI = WSP(TokInfo, WS_ROUTE); const float* bg = F.in[29]; const float* be = F.in[31];
    volatile LAS unsigned* lh = (volatile LAS unsigned*)F.lds;
    if (F.tid < 32) lh[F.tid] = 0u;
    __syncthreads();
    const int t = F.vcu * 256 + F.tid;
    if (F.tid < 256) {
        const float* l = L + (size_t)t * 64;
        float gl[4]; int grp = 0; float gm = -1e30f;
#pragma unroll
        for (int i = 0; i < 4; ++i) { gl[i] = l[i] + bg[i]; if (gl[i] > gm) { gm = gl[i]; grp = i; } }
        float gs = 0.f;
#pragma unroll
        for (int i = 0; i < 4; ++i) gs += __expf(gl[i] - gm);
        const float pgrp = 1.0f / gs;
        float el[8];
#pragma unroll
        for (int i = 0; i < 8; ++i) el[i] = l[4 + grp * 8 + i] + be[grp * 8 + i];
        int i0 = 0; float m0 = -1e30f;
#pragma unroll
        for (int i = 0; i < 8; ++i) if (el[i] > m0) { m0 = el[i]; i0 = i; }
        int i1 = 0; float m1 = -1e30f;
#pragma unroll
        for (int i = 0; i < 8; ++i) if (i != i0 && el[i] > m1) { m1 = el[i]; i1 = i; }
        const float p1 = __expf(m1 - m0);
        TokInfo ti; ti.e0 = grp * 8 + i0; ti.e1 = grp * 8 + i1; ti.g0 = pgrp / (1.f + p1); ti.g1 = pgrp * p1 / (1.f + p1);
        TI[t] = ti;
        lds_add((LAS unsigned*)&lh[ti.e0], 1u); lds_add((LAS unsigned*)&lh[ti.e1], 1u);
    }
    __syncthreads();
    if (F.tid < 32 && lh[F.tid]) atomicAdd(F.ctl + CW_CNT + F.tid, lh[F.tid]);
}
__device__ __forceinline__ void moe_tstart(Frame& F, volatile LAS int* tstart) {
    if (F.tid == 0) { int acc = 0; for (int e = 0; e < 32; ++e) { tstart[e] = acc; acc += (int)((__hip_atomic_load(F.ctl + CW_CNT + e, __ATOMIC_RELAXED, __HIP_MEMORY_SCOPE_AGENT) + 255u) >> 8); } tstart[32] = acc; }
    __syncthreads();
}
__device__ __forceinline__ void p14b_slots(Frame& F) {
    const TokInfo* TI = WSP(TokInfo, WS_ROUTE); int* TS = (int*)(F.ws + WS_ROUTE + 1 * MiB); int* stok = (int*)(F.ws + WS_ROUTE + 2 * MiB); float* sgate = (float*)(F.ws + WS_ROUTE + 3 * MiB);
    volatile LAS int* tstart = (volatile LAS int*)(F.lds + MISC_OFF + 256);
    volatile LAS unsigned* lh = (volatile LAS unsigned*)F.lds; volatile LAS unsigned* lbase = lh + 32;
    if (F.tid < 32) lh[F.tid] = 0u;
    moe_tstart(F, tstart);
    const int t = F.vcu * 256 + F.tid; TokInfo ti; unsigned r0 = 0, r1 = 0;
    if (F.tid < 256) { ti = TI[t]; r0 = lds_add((LAS unsigned*)&lh[ti.e0], 1u); r1 = lds_add((LAS unsigned*)&lh[ti.e1], 1u); }
    __syncthreads();
    if (F.tid < 32) lbase[F.tid] = lh[F.tid] ? atomicAdd(F.ctl + CW_FILL + F.tid, lh[F.tid]) : 0u;
    __syncthreads();
    if (F.tid < 256) {
        const int s0 = tstart[ti.e0] * 256 + (int)(lbase[ti.e0] + r0), s1 = tstart[ti.e1] * 256 + (int)(lbase[ti.e1] + r1);
        stok[s0] = t; sgate[s0] = ti.g0; stok[s1] = t; sgate[s1] = ti.g1; TS[2 * t] = s0; TS[2 * t + 1] = s1;
    }
    if (F.vcu < 32) {
        const int e = F.vcu; const int cnt = (int)__hip_atomic_load(F.ctl + CW_CNT + e, __ATOMIC_RELAXED, __HIP_MEMORY_SCOPE_AGENT); const int base = tstart[e] * 256, end = tstart[e + 1] * 256;
        for (int s = base + cnt + F.tid; s < end; s += NTHREADS) { stok[s] = 0; sgate[s] = 0.f; }
    }
}

__device__ __forceinline__ void p17_final(Frame& F) {
    const int* TS = (const int*)(F.ws + WS_ROUTE + 1 * MiB); const bf16* YS = WSP(bf16, WS_YS); const bf16* H2 = WSP(bf16, WS_H2B); const float* gn = F.in[35];
    const int lane = F.lane, step = F.NGW; int m = F.gw;
    if (m >= T) return;
    f32x4 gg[4];
#pragma unroll
    for (int j = 0; j < 4; ++j) gg[j] = *((const f32x4*)gn + lane + 64 * j);
    struct Row { v2u h[4], a[4], c[4]; };
#define FN_IDX(i_, m_) { const int mm_ = (m_) < T ? (m_) : F.gw; i_ = *(const int2*)(TS + 2 * mm_); }
#define FN_LD(r_, i_, m_) { const int mm_ = (m_) < T ? (m_) : F.gw; const v2u* hr = (const v2u*)(H2 + (size_t)mm_ * D) + lane; const v2u* y0 = (const v2u*)(YS + (size_t)i_.x * 1024) + lane; \
        const v2u* y1 = (const v2u*)(YS + (size_t)i_.y * 1024) + lane; _Pragma("unroll") for (int j = 0; j < 4; ++j) { r_.h[j] = hr[64 * j]; r_.a[j] = y0[64 * j]; r_.c[j] = y1[64 * j]; } __builtin_amdgcn_sched_barrier(0); }
    Row r0, r1; int2 i0, i1, j0, j1;
    FN_IDX(i0, m); FN_IDX(i1, m + step);
    FN_LD(r0, i0, m); FN_LD(r1, i1, m + step);
    FN_IDX(j0, m + 2 * step); FN_IDX(j1, m + 3 * step);
#define FN_DO(r_, jn_) { if (m < T) { const Row q_ = r_; const int2 in_ = jn_; FN_LD(r_, in_, m + 2 * step); FN_IDX(jn_, m + 4 * step); \
        f32x4 v[4]; float s = 0.f; \
        _Pragma("unroll") for (int j = 0; j < 4; ++j) { v[j] = (f32x4){bflo(q_.h[j].x), bfhi(q_.h[j].x), bflo(q_.h[j].y), bfhi(q_.h[j].y)}; \
            v[j].x += bflo(q_.a[j].x) + bflo(q_.c[j].x); v[j].y += bfhi(q_.a[j].x) + bfhi(q_.c[j].x); v[j].z += bflo(q_.a[j].y) + bflo(q_.c[j].y); v[j].w += bfhi(q_.a[j].y) + bfhi(q_.c[j].y); \
            s += (v[j].x * v[j].x + v[j].y * v[j].y) + (v[j].z * v[j].z + v[j].w * v[j].w); } \
        const float rstd = rsqrtf(wave_sum(s) * (1.f / 1024.f) + 1e-6f); f32x4* xr = (f32x4*)(F.out + (size_t)m * D) + lane; \
        _Pragma("unroll") for (int j = 0; j < 4; ++j) xr[64 * j] = (f32x4){v[j].x * rstd * gg[j].x, v[j].y * rstd * gg[j].y, v[j].z * rstd * gg[j].z, v[j].w * rstd * gg[j].w}; \
        m += step; } }
    while (m < T) { FN_DO(r0, j0); FN_DO(r1, j1); }
#undef FN_IDX
#undef FN_LD
#undef FN_DO
}

__global__ void __launch_bounds__(NTHREADS, 2) hybrid_fwd(Args args) {
    extern __shared__ __attribute__((aligned(16))) unsigned char lds_raw[];
    cg::grid_group grid = cg::this_grid();
    Frame F;
    F.lds = (LAS unsigned char*)lds_raw; F.MISC = (volatile LAS unsigned*)(F.lds + MISC_OFF);
    F.tid = threadIdx.x; F.lane = F.tid & 63; F.wave = __builtin_amdgcn_readfirstlane(F.tid >> 6);
    F.G = gridDim.x; { const int bx = blockIdx.x; F.vcu = (F.G % 8 == 0) ? (bx % 8) * (F.G / 8) + bx / 8 : bx; }
    F.gw = F.vcu * NWAVES + F.wave; F.NGW = F.G * NWAVES;
    F.in = args.in; F.out = args.out; F.ws = args.ws; F.ctl = (unsigned*)(args.ws + WS_CTL);
    for (int u = F.tid; u < (LDS_BYTES - MISC_OFF) / 4; u += NTHREADS) ((LAS unsigned*)(F.lds + MISC_OFF))[u] = 0u;
    __syncthreads();
    XcdBarrier bar = xcd_barrier_post(F.ctl + CW_BAR, F.MISC + 8);
#ifdef USE_CG_BAR
#define GRID_BAR() grid.sync()
#else
#define GRID_BAR() do { xcd_barrier(bar); asm volatile("" : "+v"(F.tid), "+v"(F.lane)); } while (0)
#endif
    const int c = (int)blockIdx.x;

#ifndef PHASE_MASK
#define PHASE_MASK 0xffffffffu
#endif
#ifndef PROBE_DUP
#define PROBE_DUP 0u
#endif
#define PH(n) for (int _rep = 0; _rep < (((PROBE_DUP) >> (n)) & 1u) + 1; ++_rep) if (PHASE_MASK & (1u << (n)))
#ifdef DIAG_FILL
    {
        const size_t n16 = (WS_END - 2 * MiB) / 16; v4u* p = (v4u*)(F.ws + 2 * MiB);
        for (size_t i = (size_t)F.vcu * NTHREADS + F.tid; i < n16; i += (size_t)F.G * NTHREADS) p[i] = (v4u){0, 0, 0, 0};
        const size_t m16 = ((size_t)T * D * 4) / 16; v4u* q = (v4u*)F.out;
        for (size_t i = (size_t)F.vcu * NTHREADS + F.tid; i < m16; i += (size_t)F.G * NTHREADS) q[i] = (v4u){0, 0, 0, 0};
        grid.sync();
    }
#endif
    PH(0) p0_prologue(F);
    grid.sync();
    asm volatile("" : "+v"(F.tid), "+v"(F.lane));
    PH(1) { pg8::StaticOrder S; S.init(DOP(bf16, DO_XN), WSP(bf16, WS_WIN), T, 1792, 1024, F.G, c);
      EpiMain E{WSP(bf16, WS_ZRKV), WSP(bf16, WS_ZLORA), WSP(bf16, WS_QLAT), WSP(bf16, WS_ZD), WSP(bf16, WS_G), F.in[20]};
      pg8::gemm_phase<EpiMain, pg8::StaticOrder, false>(F.lds, 1024, S, E); }
    PH(1) { pg8::StaticOrder S; S.init(DOP(bf16, DO_XN), WSP(bf16, WS_WIN) + (size_t)2816 * 1024, T, 512, 1024, F.G, c);
      EpiMain E{WSP(bf16, WS_ZRKV), WSP(bf16, WS_ZLORA), WSP(bf16, WS_QLAT), WSP(bf16, WS_ZD), WSP(bf16, WS_G), F.in[20], 11};
      pg8::gemm_phase<EpiMain, pg8::StaticOrder, false>(F.lds, 1024, S, E); }
    PH(1) { pg8::StaticOrder S; S.init(F.ws + WS_XN8, F.ws + WS_WQ8, T, 1024, 512, F.G, c);
      EpiBf16 E{WSP(bf16, WS_QLAT), 1024, 1, 0, 1.0f / 256.f};
      pg8::gemm_phase<EpiBf16, pg8::StaticOrder, false, true>(F.lds, 512, S, E); }
    PH(1) { pg8::SkewOrder S; S.S.init(F.ws + WS_XN8, F.ws + WS_WG8, T, 2048, 512, F.G, c); S.per = 8; S.nlow = (F.G == 256) ? 128 : 0;
      EpiGate8 E{WSP(bf16, WS_G), F.in[20]};
      pg8::gemm_phase<EpiGate8, pg8::SkewOrder, false, true>(F.lds, 512, S, E); }
    PH(2) { pg8::StaticOrder S; S.init(WSP(bf16, WS_MEMN), WSP(bf16, WS_WCKV), NB * 256, 1024, 1024, F.G, c);
      EpiBf16 E{WSP(bf16, WS_KMEM), 1024, 1, 0, 1.0f};
      pg8::gemm_phase<EpiBf16, pg8::StaticOrder, false>(F.lds, 1024, S, E); }
    PH(21) { pg8::StaticOrder S; S.init(WSP(bf16, WS_WCKV) + (size_t)1024 * 1024, WSP(bf16, WS_MEMN), 1024, NB * 256, 1024, F.G, (F.G == 256) ? ((c + 192) & 255) : c);
      EpiBf16 E{WSP(bf16, WS_VT), 256, 0, (size_t)1024 * 256, 1.0f};
      pg8::gemm_phase<EpiBf16, pg8::StaticOrder, false>(F.lds, 1024, S, E); }
    GRID_BAR();
    PH(3) p2_lora_prep(F);
    GRID_BAR();
    PH(4) { pg8::StaticOrder S; S.init(DOP(bf16, DO_ALORA), WSP(bf16, WS_BLORA), T, 1536, 256, F.G, c);
      EpiLora E{DOP(bf16, DO_WAG), F.in[5], F.in[7]};
      pg8::gemm_phase<EpiLora, pg8::StaticOrder, false>(F.lds, 256, S, E); }
    PH(5) p4_indexer(F);
    GRID_BAR();
#ifdef RWKV_CHUNKED
    PH(6) p4_rwkv_chunked(F);
    PH(7) p4_sparse_attn(F);
    GRID_BAR();
#else
    PH(6) p4_scan(F);
    PH(7) p4_sparse_attn(F);
    GRID_BAR();
    PH(22) p5_post(F);
    GRID_BAR();
#endif
    PH(8) { pg8::StaticOrder S; S.init(WSP(bf16, WS_YA), WSP(bf16, WS_WA), T, 1024, 512, F.G, c);
      EpiMix E{WSP(bf16, WS_U), WSP(bf16, WS_G), 0};
      pg8::gemm_phase<EpiMix, pg8::StaticOrder, false>(F.lds, 512, S, E); }
    PH(8) { pg8::StaticOrder S; S.init(WSP(bf16, WS_QLAT), WSP(bf16, WS_WB), T, 1024, 1024, F.G, c);
      EpiMix E{WSP(bf16, WS_U), WSP(bf16, WS_G), 1};
      pg8::gemm_phase<EpiMix, pg8::StaticOrder, false>(F.lds, 1024, S, E); }
    GRID_BAR();
    PH(9) { pg8::StaticOrder S; S.init(WSP(bf16, WS_U), WSP(bf16, WS_WOUT), T, 1024, 1024, F.G, c);
      EpiResB E{F.in[0], nullptr, WSP(bf16, WS_H1B)};
      pg8::gemm_phase<EpiResB, pg8::StaticOrder, false>(F.lds, 1024, S, E); }
    GRID_BAR();
    PH(10) p_norm_rows16(F, WSP(bf16, WS_H1B), F.in[22], nullptr, F.ws + WS_XO);
    GRID_BAR();
    PH(11) { pg8::StaticOrder S; S.init(F.ws + WS_XO, F.ws + WS_WCQ, T, 1024, 512, F.G, c);
      EpiBf16 E{WSP(bf16, WS_QC), 1024, 1, 0, 0.0625f * 0.0625f};
      pg8::gemm_phase<EpiBf16, pg8::StaticOrder, false, true>(F.lds, 512, S, E); }
    GRID_BAR();
    PH(12) p10_cross_attn(F);
    GRID_BAR();
    PH(13) { pg8::StaticOrder S; S.init(F.ws + WS_XO, F.ws + WS_WCO, T, 1024, 512, F.G, c);
      EpiResB E{nullptr, WSP(bf16, WS_H1B), WSP(bf16, WS_H2B), 0.0625f};
      pg8::gemm_phase<EpiResB, pg8::StaticOrder, false, true>(F.lds, 512, S, E); }
    GRID_BAR();
    PH(14) p_norm_rows16(F, WSP(bf16, WS_H2B), F.in[27], WSP(bf16, WS_HN), F.ws + WS_HN8);
    GRID_BAR();
    PH(15) { pg8::StaticOrder S; S.init(WSP(bf16, WS_HN), WSP(bf16, WS_WR), T, 256, 1024, F.G, c);
      EpiLogit E{WSP(float, WS_LOGIT)};
      pg8::gemm_phase<EpiLogit, pg8::StaticOrder, false>(F.lds, 1024, S, E); }
    GRID_BAR();
    PH(16) p14a_route(F);
    GRID_BAR();
    PH(17) p14b_slots(F);
    GRID_BAR();
    { volatile LAS int* tstart = (volatile LAS int*)(F.lds + MISC_OFF + 256);
      const int* stok = (const int*)(F.ws + WS_ROUTE + 2 * MiB); const float* sgate = (const float*)(F.ws + WS_ROUTE + 3 * MiB);
      PH(18) { MoeOrder S{(const char*)(F.ws + WS_HN8), (const char*)(F.ws + WS_WGU), (size_t)1024 * 1024, 512, 4, stok, tstart, F.G, c, true};
        EpiMoe1 E{F.ws + WS_HID};
        pg8::gemm_phase<EpiMoe1, MoeOrder, true, true>(F.lds, 512, S, E); }
      GRID_BAR();
      PH(19) { MoeOrder S{(const char*)(F.ws + WS_HID), (const char*)(F.ws + WS_WD), (size_t)1024 * 512, 256, 4, stok, tstart, F.G, c, false};
        EpiMoe2 E{WSP(bf16, WS_YS), sgate};
        pg8::gemm_phase<EpiMoe2, MoeOrder, false, true>(F.lds, 256, S, E); }
    }
    GRID_BAR();
    PH(20) p17_final(F);
}

extern "C" void kernel_launch(void* const* d_in, const int* in_sizes, int n_in, void* d_out, int out_size, void* d_ws, size_t ws_size, hipStream_t stream) {
    static int grid = 0;
    if (grid == 0) {
        if (n_in != 36 || out_size != T * D || ws_size < WS_END) { fprintf(stderr, "kernel_launch: unexpected shapes (n_in %d out %d ws %zu)\n", n_in, out_size, ws_size); grid = -1; return; }
        int dev = 0, cus = 0, per_cu = 0;
        hipGetDevice(&dev); hipDeviceGetAttribute(&cus, hipDeviceAttributeMultiprocessorCount, dev);
        hipFuncSetAttribute((const void*)hybrid_fwd, hipFuncAttributeMaxDynamicSharedMemorySize, LDS_BYTES);
        hipOccupancyMaxActiveBlocksPerMultiprocessor(&per_cu, (const void*)hybrid_fwd, NTHREADS, LDS_BYTES);
        (void)hipGetLastError();
        if (per_cu < 1) { fprintf(stderr, "kernel_launch: occupancy query says %d blocks per CU\n", per_cu); grid = -1; return; }
        grid = cus;
    }
    if (grid < 0) return;
    hipMemsetAsync((char*)d_ws + WS_CTL, 0, CTL_ZERO_BYTES, stream);
    Args a{};
    for (int i = 0; i < 36; ++i) a.in[i] = (const float*)d_in[i];
    a.out = (float*)d_out; a.ws = (unsigned char*)d_ws;
    void* params[] = {&a};
    hipError_t e = hipLaunchCooperativeKernel((const void*)hybrid_fwd, dim3(grid), dim3(NTHREADS), params, LDS_BYTES, stream);
    if (e != hipSuccess) fprintf(stderr, "kernel_launch: cooperative launch failed: %s (grid %d)\n", hipGetErrorString(e), grid);
}
```

```cpp
#include <hip/hip_runtime.h>
#include <hip/hip_cooperative_groups.h>
#include <cstdio>
#include <cstdint>
namespace cg = cooperative_groups;
#define RWKV_CHUNKED 1
#define PROBE_DUP 0u

#define GAS __attribute__((address_space(1)))
#define LAS __attribute__((address_space(3)))
typedef unsigned short bf16;
typedef unsigned v4u __attribute__((ext_vector_type(4)));
typedef unsigned v2u __attribute__((ext_vector_type(2)));
typedef float f32x4 __attribute__((ext_vector_type(4)));
typedef float f32x2 __attribute__((ext_vector_type(2)));
typedef short bf16x8 __attribute__((ext_vector_type(8)));
typedef short s16x4 __attribute__((ext_vector_type(4)));

constexpr int NB = 16, SEQ = 4096, T = NB * SEQ, D = 1024;
constexpr int NIN = 5376;
constexpr int NWAVES = 8, NTHREADS = 512;
constexpr int PSLOT = 2 * T + 32 * 256;

constexpr size_t MiB = 1u << 20;
constexpr size_t WS_CTL = 0, CTL_ZERO_BYTES = 1 * MiB;
constexpr size_t WS_WIN = 2 * MiB, WS_WA = 13 * MiB, WS_WB = 14 * MiB, WS_WOUT = 16 * MiB, WS_WCQ = 18 * MiB, WS_WCKV = 20 * MiB, WS_WCO = 24 * MiB;
constexpr size_t WS_BLORA = 26 * MiB, WS_WR = 27 * MiB, WS_WGU = 28 * MiB, WS_WD = 92 * MiB;
constexpr size_t WS_MEMN = 124 * MiB, WS_KMEM = 132 * MiB, WS_VT = 140 * MiB;
constexpr size_t WS_ZRKV = 150 * MiB, WS_ZLORA = 342 * MiB, WS_QLAT = 374 * MiB, WS_ZD = 502 * MiB, WS_G = 566 * MiB, WS_CKV = 822 * MiB, WS_IDX = 838 * MiB, WS_YA = 870 * MiB, WS_YC = 934 * MiB;
constexpr size_t WS_H1B = 694 * MiB  , WS_H2B = 218 * MiB  ;
constexpr size_t WS_U = WS_ZRKV, WS_HN = WS_G, WS_QC = WS_QLAT, WS_HN8 = WS_QLAT  , WS_LOGIT = 694 * MiB, WS_ROUTE = 710 * MiB, WS_HID = WS_ZRKV, WS_YS = 714 * MiB, WS_XO = WS_YA  , WS_XN8 = WS_YA  , WS_WG8 = 60 * MiB  , WS_WQ8 = 62 * MiB  , WS_WR8 = 64 * MiB  , WS_SSP = 358 * MiB  , WS_END = 998 * MiB;
constexpr size_t DO_XN = 0, DO_ALORA = 0, DO_WAG = 32 * MiB, DO_SB = 224 * MiB;
constexpr int CW_BAR = 4096, CW_CNT = 1024, CW_FILL = 1088, CW_RK = 2048;

constexpr int RING_BYTES = 131072, MISC_OFF = 8 * 16 * 260 * 4 + 16384  , LDS_BYTES = MISC_OFF + 1024;

typedef __bf16 bf16x2_t __attribute__((ext_vector_type(2)));
__device__ __forceinline__ unsigned cvt_pk_bf16(float lo, float hi) { const f32x2 v = {lo, hi}; const bf16x2_t b = __builtin_convertvector(v, bf16x2_t); return __builtin_bit_cast(unsigned, b); }
typedef int v8i __attribute__((ext_vector_type(8)));
typedef int v4i __attribute__((ext_vector_type(4)));
typedef v8i v8i_a16 __attribute__((aligned(16)));
struct Bf16x8Pair { bf16x8 lo, hi; };
__device__ __forceinline__ v8i lds_v8i(const LAS unsigned char* p) { const Bf16x8Pair t{*(const LAS bf16x8*)p, *(const LAS bf16x8*)(p + 16)}; return __builtin_bit_cast(v8i, t); }
#define LDS_V8I(p_) lds_v8i((const LAS unsigned char*)(p_))
__device__ __forceinline__ unsigned pk4_fp8(float a, float b, float c, float d) { unsigned w = (unsigned)__builtin_amdgcn_cvt_pk_fp8_f32(a, b, 0, false); return (unsigned)__builtin_amdgcn_cvt_pk_fp8_f32(c, d, (int)w, true); }
__device__ __forceinline__ float bf2f(unsigned b) { return __uint_as_float(b << 16); }
__device__ __forceinline__ float bflo(unsigned w) { return __uint_as_float(w << 16); }
__device__ __forceinline__ float bfhi(unsigned w) { return __uint_as_float(w & 0xffff0000u); }
__device__ __forceinline__ float fsigmoid(float x) { return __builtin_amdgcn_rcpf(1.0f + __expf(-x)); }
__device__ __forceinline__ unsigned lds_add(LAS unsigned* p, unsigned v) { return __hip_atomic_fetch_add(p, v, __ATOMIC_RELAXED, __HIP_MEMORY_SCOPE_WORKGROUP); }
__device__ __forceinline__ float wave_sum(float v) {
#pragma unroll
    for (int o = 1; o < 64; o <<= 1) v += __shfl_xor(v, o);
    return v;
}
__device__ __forceinline__ float dpp_f(float v, const int ctrl_sel) {
    int x = __builtin_bit_cast(int, v), r;
    if (ctrl_sel == 0) r = __builtin_amdgcn_update_dpp(x, x, 0xB1, 0xF, 0xF, false);
    else if (ctrl_sel == 1) r = __builtin_amdgcn_update_dpp(x, x, 0x4E, 0xF, 0xF, false);
    else if (ctrl_sel == 2) r = __builtin_amdgcn_update_dpp(x, x, 0x141, 0xF, 0xF, false);
    else r = __builtin_amdgcn_update_dpp(x, x, 0x140, 0xF, 0xF, false);
    return __builtin_bit_cast(float, r);
}
__device__ __forceinline__ float sum8(float v) {
    v += dpp_f(v, 0); v += dpp_f(v, 1); v += dpp_f(v, 2); return v;
}

#define XB_TMO      128
#define XB_XCNT(j)  (256  + 64 * (j))
#define XB_XSUB(j)  (1280 + 64 * (j))
#define XB_XGEN(j)  (2304 + 64 * (j))
#define XB_TOP      3328
#define XB_TOPGEN   3392
#define XCD_BAR_WORDS 3456
#define XB_SPIN_CAP (1u << 20)
__device__ __forceinline__ unsigned xb_ld(unsigned* p)              { return __hip_atomic_load(p, __ATOMIC_RELAXED, __HIP_MEMORY_SCOPE_AGENT); }
__device__ __forceinline__ unsigned xb_add(unsigned* p, unsigned v) { return __hip_atomic_fetch_add(p, v, __ATOMIC_RELAXED, __HIP_MEMORY_SCOPE_AGENT); }
__device__ __forceinline__ unsigned xb_xcc_id() { return (unsigned)__builtin_amdgcn_s_getreg((3 << 11) | 20) & 0xFu; }
#define XB_SPIN(cond, bar) do { unsigned _sp = 0; while (cond) { __builtin_amdgcn_s_sleep(1); \
    if ((++_sp & 255u) == 0u) { if (xb_ld(&(bar)[XB_TMO])) break; if (_sp > XB_SPIN_CAP) { atomicAdd(&(bar)[XB_TMO], 1u); break; } } } } while (0)
struct XcdBarrier { unsigned* bar; unsigned x; volatile LAS unsigned* st; };
__device__ __forceinline__ XcdBarrier xcd_barrier_post(unsigned* bar, volatile LAS unsigned* st) {
    XcdBarrier b; b.bar = bar; b.x = xb_xcc_id(); b.st = st;
    if (threadIdx.x == 0) (void)xb_add(&bar[XB_XCNT(b.x)], 1u);
    return b;
}
__device__ __forceinline__ void xcd_barrier_complete(unsigned* bar, unsigned x, unsigned& nloc, unsigned& nx) {
    const unsigned G = gridDim.x * gridDim.y * gridDim.z;
    unsigned sum, cnt, mine, sp = 0u;
    for (;;) {
        sum = 0u; cnt = 0u; mine = 0u;
#pragma unroll
        for (unsigned j = 0; j < 16; ++j) { const unsigned c = xb_ld(&bar[XB_XCNT(j)]); sum += c; cnt += (c > 0u) ? 1u : 0u; mine = (j == x) ? c : mine; }
        if (sum == G) break;
        __builtin_amdgcn_s_sleep(1);
        if ((++sp & 255u) == 0u) { if (xb_ld(&bar[XB_TMO])) break; if (sp > XB_SPIN_CAP) { atomicAdd(&bar[XB_TMO], 1u); break; } }
    }
    nloc = mine > 0u ? mine : 1u; nx = cnt > 0u ? cnt : 1u;
}
__device__ __forceinline__ void xcd_barrier(const XcdBarrier& b) {
    asm volatile("s_waitcnt vmcnt(0)" ::: "memory");
    __syncthreads();
    if (threadIdx.x == 0) {
        unsigned* bar = b.bar;
        __builtin_amdgcn_s_waitcnt(0);
        unsigned nloc = b.st[0], nx = b.st[1];
        if (nloc == 0u) { xcd_barrier_complete(bar, b.x, nloc, nx); b.st[0] = nloc; b.st[1] = nx; }
        const unsigned old = xb_add(&bar[XB_XSUB(b.x)], 1u);
        const unsigned gen = old / nloc;
        if (old + 1u == (gen + 1u) * nloc) {
            __builtin_amdgcn_fence(__ATOMIC_RELEASE, "agent");
            asm volatile("s_waitcnt vmcnt(0)" ::: "memory");
            const unsigned og = xb_add(&bar[XB_TOP], 1u);
            const unsigned tg = og / nx;
            if (og + 1u == (tg + 1u) * nx) xb_add(&bar[XB_TOPGEN], 1u);
            else XB_SPIN(xb_ld(&bar[XB_TOPGEN]) == tg, bar);
            __builtin_amdgcn_fence(__ATOMIC_ACQUIRE, "agent");
            xb_add(&bar[XB_XGEN(b.x)], 1u);
            asm volatile("s_waitcnt vmcnt(0)" ::: "memory");
        } else {
            XB_SPIN(xb_ld(&bar[XB_XGEN(b.x)]) == gen, bar);
            __builtin_amdgcn_fence(__ATOMIC_ACQUIRE, "agent");
            asm volatile("s_waitcnt vmcnt(0)" ::: "memory");
        }
    }
    __syncthreads();
}

namespace pg8 {
constexpr int BM = 256, BK = 64, HALF = 128, HTB = HALF * BK * 2, NXCD = 8, WGM = 2;
__host__ __device__ __forceinline__ int lds_byte(int r, int c) { const int st = (r >> 4) * 2 + (c >> 5), rr = r & 15, cc = c & 31, ob = rr * 64 + cc * 2; return st * 1024 + (ob ^ (((ob >> 9) & 1) << 5)); }
__host__ __device__ __forceinline__ void stage_rc(int b, int& R, int& C) { const int st = b / 1024, sb = b % 1024, swz = sb ^ (((sb >> 9) & 1) << 5); R = (st >> 1) * 16 + swz / 64; C = (st & 1) * 32 + (swz % 64) / 2; }
__host__ __device__ __forceinline__ int perm32(int rho) { const int n = rho >> 4, i = rho & 15; return 8 * (i >> 2) + 4 * n + (i & 3); }

struct Unit { int pm, pn; const char* a; const char* b; const int* gidx; };

struct StaticOrder {
    const char* A; const char* Bt; int K; int nM, nN, nwg, G, c; float rnig;
    __device__ void init(const void* A_, const void* Bt_, int M, int N, int K_, int G_, int c_) { A = (const char*)A_; Bt = (const char*)Bt_; K = K_; nM = M / BM; nN = N / BM; nwg = nM * nN; G = G_; c = c_; rnig = 1.0f / (float)(WGM * nN); }
    __device__ bool next(int i, Unit& u) const { return nextL((long)i * G + c, u); }
    __device__ bool nextL(const long L, Unit& u) const {
        if (L >= nwg) return false;
        int wgid = (int)L; { const int q = nwg / NXCD, r = nwg % NXCD, xcd = wgid % NXCD, off = wgid / NXCD; wgid = (xcd < r ? xcd * (q + 1) : r * (q + 1) + (xcd - r) * q) + off; }
        const int nig = WGM * nN, gid = (int)(((float)wgid + 0.5f) * rnig), rem = wgid - gid * nig, fm = gid * WGM, gsz = (nM - fm) < WGM ? (nM - fm) : WGM;
        if (WGM == 2 && gsz == 2) { u.pm = fm + (rem & 1); u.pn = rem >> 1; } else { u.pm = fm + (rem % gsz); u.pn = rem / gsz; }
        u.a = A + (size_t)u.pm * 256 * K * 2; u.b = Bt + (size_t)u.pn * 256 * K * 2; u.gidx = nullptr; return true;
    }
};

struct SkewOrder {
    StaticOrder S; int per, nlow;
    __device__ bool next(int i, Unit& u) const {
        const int c = S.c, G = S.G;
        if (i < per - 1) return S.nextL((long)i * G + c, u);
        if (c < nlow) return false;
        if (i == per - 1) return S.nextL((long)(per - 1) * G + c, u);
        if (i == per && c < 2 * nlow) return S.nextL((long)(per - 1) * G + (c - nlow), u);
        return false;
    }
};

template <class Epi, class Sched, bool GATHER, bool F8 = false>
__device__ __forceinline__ void gemm_phase(LAS unsigned char* lds, const int K_, const Sched& S, const Epi& E) {
    int K = K_; asm volatile("" : "+s"(K));
    int tid = threadIdx.x; asm volatile("" : "+v"(tid));
    const int wid = __builtin_amdgcn_readfirstlane(tid >> 6), lane = tid & 63, wr = wid >> 2, wc = wid & 3, fr = lane & 15, fq = lane >> 4;
    const int nt = K / BK;
    const size_t kstep = (size_t)(BK * 2);
    const size_t hstep = (size_t)HALF * K * 2;
    int stR[2], stC[2];
    unsigned voffB[2], cvo[2][2], nvo[2][2];
#pragma unroll
    for (int i = 0; i < 2; ++i) { int R, C; stage_rc(tid * 16 + i * 8192, R, C); stR[i] = R; stC[i] = C; const int Rb = Epi::PERM ? ((R & ~31) + perm32(R & 31)) : R;
        voffB[i] = (unsigned)(Rb * K + C) * 2u;
        cvo[0][i] = (unsigned)(R * K + C) * 2u; cvo[1][i] = cvo[0][i] + (unsigned)hstep; nvo[0][i] = cvo[0][i]; nvo[1][i] = cvo[1][i]; }
    const unsigned ldsw = (unsigned)wid * 1024u;
    const int aoff = F8 ? lds_byte(wr * 64 + fr, fq * 16) : lds_byte(wr * 64 + fr, fq * 8), boff = F8 ? lds_byte(wc * 32 + fr, fq * 16) : lds_byte(wc * 32 + fr, fq * 8);
#define PG8_SA(b, h) (((b) * 2 + (h)) * HTB)
#define PG8_SB(b, h) ((4 + (b) * 2 + (h)) * HTB)
#define PG8_STAGE(bufoff, gbase, voff) do { _Pragma("unroll") for (int _i = 0; _i < 2; ++_i) \
        __builtin_amdgcn_global_load_lds((const unsigned*)((const char*)(gbase) + (voff)[_i]), (LAS unsigned*)(lds + (bufoff) + ldsw + _i * 8192), 16, 0, 0); } while (0)
#define PG8_LDA(dst, b, h) do { if constexpr (F8) { _Pragma("unroll") for (int m = 0; m < 4; ++m) dst##8[m] = LDS_V8I(lds + PG8_SA(b, h) + aoff + m * 2048); } \
    else { _Pragma("unroll") for (int m = 0; m < 4; ++m) _Pragma("unroll") for (int k = 0; k < 2; ++k) dst[m][k] = *(const LAS bf16x8*)(lds + PG8_SA(b, h) + aoff + m * 2048 + k * 1024); } } while (0)
#define PG8_LDB(dst, b, h) do { if constexpr (F8) { _Pragma("unroll") for (int n = 0; n < 2; ++n) dst##8[n] = LDS_V8I(lds + PG8_SB(b, h) + boff + n * 2048); } \
    else { _Pragma("unroll") for (int n = 0; n < 2; ++n) _Pragma("unroll") for (int k = 0; k < 2; ++k) dst[n][k] = *(const LAS bf16x8*)(lds + PG8_SB(b, h) + boff + n * 2048 + k * 1024); } } while (0)
#define PG8_MMA(ai, bj, At, Bt) do { __builtin_amdgcn_s_setprio(1); if constexpr (F8) { _Pragma("unroll") for (int m = 0; m < 4; ++m) _Pragma("unroll") for (int n = 0; n < 2; ++n) { \
            asm volatile("v_mfma_scale_f32_16x16x128_f8f6f4 %0, %1, %2, %0, %3, %3 op_sel_hi:[0,0,0]" : "+v"(acc[ai][bj][m][n]) : "v"(Bt##8[n]), "v"(At##8[m]), "v"(f8one)); } } \
        else { _Pragma("unroll") for (int m = 0; m < 4; ++m) _Pragma("unroll") for (int n = 0; n < 2; ++n) _Pragma("unroll") for (int k = 0; k < 2; ++k) \
        acc[ai][bj][m][n] = __builtin_amdgcn_mfma_f32_16x16x32_bf16(Bt[n][k], At[m][k], acc[ai][bj][m][n], 0, 0, 0); } __builtin_amdgcn_s_setprio(0); } while (0)
#define PG8_WAIT_V(n) asm volatile("s_waitcnt vmcnt(" #n ")" ::: "memory")
#define PG8_WAIT_L(n) asm volatile("s_waitcnt lgkmcnt(" #n ")" ::: "memory")
#define PG8_BAR __builtin_amdgcn_s_barrier()
#define PG8_SCHED __builtin_amdgcn_sched_barrier(0)
    Unit cur, nxt; int ui = 0;
    if (!S.next(0, cur)) return;
    if constexpr (GATHER) {
#pragma unroll
        for (int h = 0; h < 2; ++h)
#pragma unroll
            for (int i = 0; i < 2; ++i) cvo[h][i] = (unsigned)(cur.gidx[h * HALF + stR[i]] * K + stC[i]) * 2u;
    }
    f32x4 acc[2][2][4][2];
#pragma unroll
    for (int a = 0; a < 2; ++a)
#pragma unroll
        for (int b = 0; b < 2; ++b)
#pragma unroll
            for (int m = 0; m < 4; ++m)
#pragma unroll
                for (int n = 0; n < 2; ++n) acc[a][b][m][n] = (f32x4){0.f, 0.f, 0.f, 0.f};
    bf16x8 At[4][2], B0[2][2], B1[2][2]; v8i At8[4], B08[2], B18[2];
    const int f8one = 0x7f7f7f7f;
    const char* cA = cur.a; const char* cB = cur.b;
    const unsigned kmask = (unsigned)(K * 2 - 1);
    const unsigned pmm = (unsigned)((nt >> 2) - 1);
    unsigned rot = (unsigned)(cur.pn & 3) * (unsigned)(K >> 1) + ((unsigned)cur.pm & pmm) * 128u;
#define PG8_KOF(t_, r_) ((size_t)(((unsigned)(t_) * 128u + (r_)) & kmask))
    PG8_STAGE(PG8_SB(0, 0), cB + PG8_KOF(0, rot), voffB); PG8_STAGE(PG8_SB(0, 1), cB + hstep + PG8_KOF(0, rot), voffB); PG8_STAGE(PG8_SA(0, 0), cA + PG8_KOF(0, rot), cvo[0]); PG8_STAGE(PG8_SA(0, 1), cA + PG8_KOF(0, rot), cvo[1]);
    if (wr == 1) PG8_BAR;
    PG8_WAIT_V(2); PG8_BAR;
    PG8_STAGE(PG8_SB(1, 0), cB + PG8_KOF(1, rot), voffB); PG8_STAGE(PG8_SA(1, 0), cA + PG8_KOF(1, rot), cvo[0]); PG8_STAGE(PG8_SB(1, 1), cB + hstep + PG8_KOF(1, rot), voffB);
    if constexpr (F8) { PG8_WAIT_V(0); } else { PG8_WAIT_V(6); }
    PG8_BAR;
    for (;;) {
        const bool has_next = S.next(ui + 1, nxt);
        const char* nA = has_next ? nxt.a : cA; const char* nB = has_next ? nxt.b : cB;
        const unsigned rotN = has_next ? (unsigned)(nxt.pn & 3) * (unsigned)(K >> 1) + ((unsigned)nxt.pm & pmm) * 128u : rot;
        int gi[2][2];
        if constexpr (GATHER) {
            const int* gp = has_next ? nxt.gidx : cur.gidx;
#pragma unroll
            for (int h = 0; h < 2; ++h)
#pragma unroll
                for (int i = 0; i < 2; ++i) gi[h][i] = gp[h * HALF + stR[i]];
        }
#define PG8_ITER(t, WV_) { \
            const bool last = ((t) == nt - 2); \
            if constexpr (GATHER) { if (last) { _Pragma("unroll") for (int h = 0; h < 2; ++h) _Pragma("unroll") for (int i = 0; i < 2; ++i) nvo[h][i] = (unsigned)(gi[h][i] * K + stC[i]) * 2u; } } \
            const char* a1 = cA + PG8_KOF((t) + 1, rot); \
            const char* a2 = last ? nA + PG8_KOF(0, rotN) : cA + PG8_KOF((t) + 2, rot); const char* b2 = last ? nB + PG8_KOF(0, rotN) : cB + PG8_KOF((t) + 2, rot); \
            const char* a3 = last ? nA + PG8_KOF(1, rotN) : cA + PG8_KOF((t) + 3, rot); const char* b3 = last ? nB + PG8_KOF(1, rotN) : cB + PG8_KOF((t) + 3, rot); \
            unsigned v2[2][2]; \
            _Pragma("unroll") for (int h = 0; h < 2; ++h) _Pragma("unroll") for (int i = 0; i < 2; ++i) v2[h][i] = (GATHER && last) ? nvo[h][i] : cvo[h][i]; \
            PG8_LDB(B0, 0, 0); PG8_LDB(B1, 0, 1); PG8_SCHED; PG8_LDA(At, 0, 0); PG8_STAGE(PG8_SA(1, 1), a1, cvo[1]); \
            WV_; PG8_WAIT_L(0); PG8_BAR; PG8_MMA(0, 0, At, B0); PG8_MMA(0, 1, At, B1); PG8_BAR; PG8_SCHED; \
            PG8_LDA(At, 0, 1); PG8_STAGE(PG8_SB(0, 0), b2, voffB); PG8_STAGE(PG8_SB(0, 1), b2 + hstep, voffB); PG8_STAGE(PG8_SA(0, 0), a2, v2[0]); \
            WV_; PG8_WAIT_L(0); PG8_BAR; PG8_MMA(1, 0, At, B0); PG8_MMA(1, 1, At, B1); PG8_BAR; PG8_SCHED; \
            PG8_LDB(B0, 1, 0); PG8_LDB(B1, 1, 1); PG8_SCHED; PG8_LDA(At, 1, 0); PG8_STAGE(PG8_SA(0, 1), a2, v2[1]); \
            PG8_WAIT_V(8); PG8_WAIT_L(0); PG8_BAR; PG8_MMA(0, 0, At, B0); PG8_MMA(0, 1, At, B1); PG8_BAR; PG8_SCHED; \
            PG8_LDA(At, 1, 1); PG8_STAGE(PG8_SB(1, 0), b3, voffB); PG8_STAGE(PG8_SB(1, 1), b3 + hstep, voffB); PG8_STAGE(PG8_SA(1, 0), a3, v2[0]); \
            PG8_WAIT_V(8); PG8_WAIT_L(0); PG8_BAR; PG8_MMA(1, 0, At, B0); PG8_MMA(1, 1, At, B1); PG8_BAR; PG8_SCHED; }
        if constexpr (F8) {
            PG8_ITER(0, asm volatile("s_waitcnt vmcnt(%0)" :: "n"(8 + Epi::NVM) : "memory"))
            for (int t = 2; t < nt; t += 2) PG8_ITER(t, PG8_WAIT_V(8))
        } else {
            for (int t = 0; t < nt; t += 2) PG8_ITER(t, PG8_WAIT_V(8))
        }
#undef PG8_ITER
        if (wr == 0) PG8_BAR;
        if constexpr (F8) asm volatile("s_nop 15\n\ts_nop 15" ::: "memory");
        E(acc, cur, wr, wc, fr, fq);
        if (!has_next) break;
#pragma unroll
        for (int a = 0; a < 2; ++a)
#pragma unroll
            for (int b = 0; b < 2; ++b)
#pragma unroll
                for (int m = 0; m < 4; ++m)
#pragma unroll
                    for (int n = 0; n < 2; ++n) acc[a][b][m][n] = (f32x4){0.f, 0.f, 0.f, 0.f};
        cur = nxt; cA = nA; cB = nB; rot = rotN; ++ui;
        if constexpr (GATHER) {
#pragma unroll
            for (int h = 0; h < 2; ++h)
#pragma unroll
                for (int i = 0; i < 2; ++i) cvo[h][i] = nvo[h][i];
        }
        if (wr == 1) PG8_BAR;
    }
    PG8_WAIT_V(0);
    PG8_BAR;
#undef PG8_KOF
#undef PG8_SA
#undef PG8_SB
#undef PG8_STAGE
#undef PG8_LDA
#undef PG8_LDB
#undef PG8_MMA
#undef PG8_WAIT_V
#undef PG8_WAIT_L
#undef PG8_BAR
#undef PG8_SCHED
}
}
using pg8::Unit;

struct Args { const float* in[36]; float* out; unsigned char* ws; };
struct Frame {
    LAS unsigned char* lds; volatile LAS unsigned* MISC; unsigned* ctl;
    int tid, lane, wave, vcu, G, gw, NGW;
    const float* const* in; float* out; unsigned char* ws;
};
#define WSP(T_, off) ((T_*)(F.ws + (off)))
#define DOP(T_, off) ((T_*)((unsigned char*)F.out + (off)))

struct XArg { const float* W; int ldw, col0; bf16* WT; int ldt, row_off, kdst, kb, nb; float f8scale; };
__device__ __forceinline__ void xpose_load(const XArg& x, int lane, f32x4 (&r)[8]) {
    const float* p = x.W + (size_t)(64 * x.kb + (lane >> 3)) * x.ldw + x.col0 + 32 * x.nb + 4 * (lane & 7);
#pragma unroll
    for (int i = 0; i < 8; ++i) r[i] = *(const f32x4*)(p + (size_t)(8 * i) * x.ldw);
    __builtin_amdgcn_sched_barrier(0);
}
__device__ __forceinline__ void xpose_store(const XArg& x, int lane, const f32x4 (&r)[8], LAS float* scr) {
    const int k0 = 64 * x.kb, n0 = 32 * x.nb;
#pragma unroll
    for (int i = 0; i < 8; ++i) { LAS float* d = scr + (8 * i + (lane >> 3)) * 33 + 4 * (lane & 7); d[0] = r[i].x; d[1] = r[i].y; d[2] = r[i].z; d[3] = r[i].w; }
    asm volatile("s_waitcnt lgkmcnt(0)" ::: "memory");
    const int c = lane & 7; const float f8scale = x.f8scale; bf16* WT = x.WT;
#pragma unroll
    for (int j = 0; j < 4; ++j) { const int n = (lane >> 3) + 8 * j; const LAS float* s = scr + (8 * c) * 33 + n;
        if (f8scale != 0.f) *(v2u*)((unsigned char*)WT + (size_t)(x.row_off + n0 + n) * x.ldt + x.kdst + k0 + 8 * c) = (v2u){pk4_fp8(s[0 * 33] * f8scale, s[1 * 33] * f8scale, s[2 * 33] * f8scale, s[3 * 33] * f8scale), pk4_fp8(s[4 * 33] * f8scale, s[5 * 33] * f8scale, s[6 * 33] * f8scale, s[7 * 33] * f8scale)};
        else { v4u o; o.x = cvt_pk_bf16(s[0 * 33], s[1 * 33]); o.y = cvt_pk_bf16(s[2 * 33], s[3 * 33]); o.z = cvt_pk_bf16(s[4 * 33], s[5 * 33]); o.w = cvt_pk_bf16(s[6 * 33], s[7 * 33]);
            *(v4u*)(WT + (size_t)(x.row_off + n0 + n) * x.ldt + x.kdst + k0 + 8 * c) = o; } }
    asm volatile("s_waitcnt lgkmcnt(0)" ::: "memory");
}
template <class GetArg>
__device__ __forceinline__ void xpose_pipe(Frame& F, int nit, GetArg getarg) {
    LAS float* scr = (LAS float*)(F.lds + F.wave * 16384);
    const int lane = F.lane, step = F.NGW; int it = F.gw;
    if (it >= nit) return;
    f32x4 A[8], B[8];
    XArg aA = getarg(it), aB = getarg(it + step < nit ? it + step : it);
    xpose_load(aA, lane, A); xpose_load(aB, lane, B);
#define XP_DO(S_, a_) { if (it < nit) { f32x4 c_[8]; _Pragma("unroll") for (int i = 0; i < 8; ++i) c_[i] = S_[i]; const XArg ca_ = a_; const int itn_ = it + 2 * step; \
        a_ = getarg(itn_ < nit ? itn_ : it); xpose_load(a_, lane, S_); xpose_store(ca_, lane, c_, scr); it += step; } }
    while (it < nit) { XP_DO(A, aA); XP_DO(B, aB); }
#undef XP_DO
}
__device__ __forceinline__ void xpose_job(Frame& F, const float* W, int ldw, int col0, int K, int N, bf16* WT, int ldt, int row_off, int kdst) {
    const int nblk = N / 32, nit = (K / 64) * nblk;
    xpose_pipe(F, nit, [&](int it) { return XArg{W, ldw, col0, WT, ldt, row_off, kdst, it / nblk, it % nblk, 0.f}; });
}
__device__ __forceinline__ void rms_row_to_bf16(const float* xrow, const float* g, bf16* orow, int lane, unsigned* o8row = nullptr) {
    const f32x4* xr = (const f32x4*)xrow + lane; const f32x4* gr = (const f32x4*)g + lane;
    f32x4 v[4]; float s = 0.f;
#pragma unroll
    for (int j = 0; j < 4; ++j) { v[j] = xr[64 * j]; s += (v[j].x * v[j].x + v[j].y * v[j].y) + (v[j].z * v[j].z + v[j].w * v[j].w); }
    const float rstd = rsqrtf(wave_sum(s) * (1.f / 1024.f) + 1e-6f);
    v2u* o8 = (v2u*)orow + lane;
#pragma unroll
    for (int j = 0; j < 4; ++j) { const f32x4 gg = gr[64 * j]; v2u o; o.x = cvt_pk_bf16(v[j].x * rstd * gg.x, v[j].y * rstd * gg.y); o.y = cvt_pk_bf16(v[j].z * rstd * gg.z, v[j].w * rstd * gg.w); o8[64 * j] = o;
        if (o8row) o8row[64 * j + lane] = pk4_fp8(v[j].x * rstd * gg.x, v[j].y * rstd * gg.y, v[j].z * rstd * gg.z, v[j].w * rstd * gg.w); }
}

__device__ __forceinline__ void p0_prologue(Frame& F) {
    const float* w_in = F.in[3];
    bf16* WinT = WSP(bf16, WS_WIN);
    {
        struct Job { const float* W; int ldw, col0; void* WT; int ldt, row_off, kdst, nblk, nit; float f8; };
        const Job jobs[14] = {
            {w_in, 4804, 0, F.ws + WS_WR8, 1024, 0, 0, 48, 16 * 48, 16.f},
            {w_in, 4804, 1536, WinT, 1024, 1536, 0, 8, 16 * 8, 0.f},
            {w_in, 4804, 2304, WinT, 1024, 2816, 0, 4, 16 * 4, 0.f},
            {w_in, 4804, 2688, WinT, 1024, 2816 + 128, 0, 2, 16 * 2, 0.f},
            {w_in, 4804, 2432, WinT, 1024, 2816 + 256, 0, 8, 16 * 8, 0.f},
            {w_in, 4804, 2756, F.ws + WS_WG8, 1024, 0, 0, 64, 16 * 64, 16.f},
            {F.in[18], 1024, 0, F.ws + WS_WA, 512, 0, 0, 32, 8 * 32, 0.f},
            {F.in[21], 1024, 0, F.ws + WS_WOUT, 1024, 0, 0, 32, 16 * 32, 0.f},
            {F.in[24], 1024, 0, F.ws + WS_WCQ, 1024, 0, 0, 32, 16 * 32, 16.f},
            {F.in[25], 2048, 0, F.ws + WS_WCKV, 1024, 0, 0, 64, 16 * 64, 0.f},
            {F.in[26], 1024, 0, F.ws + WS_WCO, 1024, 0, 0, 32, 16 * 32, 16.f},
            {F.in[6], 512, 0, F.ws + WS_BLORA, 256, 0, 0, 16, 1 * 16, 0.f},
            {F.in[8], 512, 0, F.ws + WS_BLORA, 256, 512, 64, 16, 1 * 16, 0.f},
            {F.in[9], 512, 0, F.ws + WS_BLORA, 256, 1024, 128, 16, 2 * 16, 0.f}};
        constexpr int NGU = 32 * 2 * 16 * 16, NDN = 32 * 8 * 32;
        int nsmall = 0;
#pragma unroll
        for (int j = 0; j < 14; ++j) nsmall += jobs[j].nit;
        xpose_pipe(F, NGU + NDN + nsmall, [&](int it) {
            if (it < NGU) {
                const int nb = it & 15, kb = (it >> 4) & 15, which = (it >> 8) & 1, e = it >> 9;
                const float* W = (which ? F.in[33] : F.in[32]) + (size_t)e * 1024 * 512;
                const int n0 = 32 * nb, drow = 256 * (n0 >> 7) + (n0 & 127) + 128 * which;
                return XArg{W, 512, 0, (bf16*)(F.ws + WS_WGU + (size_t)e * 1024 * 1024), 1024, drow - n0, 0, kb, nb, 16.f}; }
            it -= NGU;
            if (it < NDN) {
                const int nb = it & 31, kb = (it >> 5) & 7, e = it >> 8;
                return XArg{F.in[34] + (size_t)e * 512 * 1024, 1024, 0, (bf16*)(F.ws + WS_WD + (size_t)e * 1024 * 512), 512, 0, 0, kb, nb, 16.f}; }
            it -= NDN;
            XArg r = XArg{jobs[13].W, jobs[13].ldw, jobs[13].col0, (bf16*)jobs[13].WT, jobs[13].ldt, jobs[13].row_off, jobs[13].kdst, 0, 0, jobs[13].f8}; int nblk = jobs[13].nblk, loc = it;
            int acc = 0; bool found = false;
#pragma unroll
            for (int j = 0; j < 14; ++j) { const bool here = !found && it < acc + jobs[j].nit;
                if (here) { r = XArg{jobs[j].W, jobs[j].ldw, jobs[j].col0, (bf16*)jobs[j].WT, jobs[j].ldt, jobs[j].row_off, jobs[j].kdst, 0, 0, jobs[j].f8}; nblk = jobs[j].nblk; loc = it - acc; found = true; }
                acc += jobs[j].nit; }
            r.kb = loc / nblk; r.nb = loc % nblk; return r; });
    }
    const int gt = F.vcu * NTHREADS + F.tid, NGT = F.G * NTHREADS;
    for (int i = gt; i < 64 * 1024; i += NGT) { const int n = i >> 10, k = i & 1023; WinT[(size_t)(2816 + 192 + n) * 1024 + k] = (n < 4) ? (bf16)(cvt_pk_bf16(w_in[(size_t)k * 4804 + 2752 + n], 0.f) & 0xffff) : (bf16)0; }
    { bf16* BL = WSP(bf16, WS_BLORA);
      for (int i = gt; i < 1536 * 256; i += NGT) { const int n = i >> 8, k = i & 255; const int seg = n >> 9; const bool diag = (seg == 0) ? (k < 64) : (seg == 1) ? (k >= 64 && k < 128) : (k >= 128); if (!diag) BL[i] = 0; } }
    { bf16* WR = WSP(bf16, WS_WR);
      for (int i = gt; i < 256 * 1024; i += NGT) { const int n = i >> 10, k = i & 1023; float v = 0.f; if (n < 4) v = F.in[28][k * 4 + n]; else if (n < 36) v = F.in[30][k * 32 + (n - 4)]; WR[i] = (bf16)(cvt_pk_bf16(v, 0.f) & 0xffff); } }
    for (int task = F.vcu; task < 256; task += F.G) {
        const bool isq = task < 128; const int h = (task >> 4) & 7, chunk = task & 15;
        LAS float* sw = (LAS float*)F.lds;
        const float* src = isq ? F.in[16] : F.in[17]; const float* wpb = F.in[19]; bf16* WbT = WSP(bf16, WS_WB);
        __syncthreads();
        for (int i = F.tid; i < 128 * 16; i += NTHREADS) { const int r = i >> 4, q = i & 15; *(LAS f32x4*)(sw + r * 64 + q * 4) = *(const f32x4*)(src + (size_t)r * 512 + h * 64 + q * 4); }
        __syncthreads();
        const int idx = chunk * 64 + F.lane;
        float a[64];
        if (isq) {
#pragma unroll
            for (int q = 0; q < 16; ++q) { const f32x4 t4 = *(const f32x4*)(w_in + (size_t)idx * 4804 + 1792 + h * 64 + 4 * q); a[4 * q] = t4[0]; a[4 * q + 1] = t4[1]; a[4 * q + 2] = t4[2]; a[4 * q + 3] = t4[3]; }
        } else {
            const float* p = wpb + (size_t)(h * 64) * 1024 + idx;
#pragma unroll
            for (int g4 = 0; g4 < 8; ++g4) {
#pragma unroll
                for (int d = 0; d < 8; ++d) a[8 * g4 + d] = p[(size_t)(8 * g4 + d) * 1024];
                __builtin_amdgcn_sched_barrier(0); }
        }
#pragma unroll 1
        for (int r0 = F.wave * 16; r0 < F.wave * 16 + 16; r0 += 2) { float o[2];
#pragma unroll
            for (int rr = 0; rr < 2; ++rr) { const LAS f32x4* b4 = (const LAS f32x4*)(sw + (r0 + rr) * 64); float s0 = 0.f, s1 = 0.f;
#pragma unroll
                for (int q = 0; q < 16; q += 2) { const f32x4 b0 = b4[q], b1 = b4[q + 1];
                    s0 += a[4 * q] * b0[0] + a[4 * q + 1] * b0[1] + a[4 * q + 2] * b0[2] + a[4 * q + 3] * b0[3]; s1 += a[4 * q + 4] * b1[0] + a[4 * q + 5] * b1[1] + a[4 * q + 6] * b1[2] + a[4 * q + 7] * b1[3]; }
                o[rr] = s0 + s1; __builtin_amdgcn_sched_barrier(0); }
            if (isq) {
#pragma unroll
                for (int rr = 0; rr < 2; ++rr) (F.ws + WS_WQ8)[(size_t)(h * 128 + r0 + rr) * 1024 + idx] = (unsigned char)(pk4_fp8(o[rr] * (0.125f * 256.f), 0.f, 0.f, 0.f) & 0xffu);
            } else *(unsigned*)(WbT + (size_t)idx * 1024 + h * 128 + r0) = cvt_pk_bf16(o[0], o[1]);
        }
    }
    __syncthreads();
    {
        const int lane = F.lane, step = F.NGW; const float* x = F.in[0]; bf16* xn = DOP(bf16, DO_XN);
        f32x4 gg[4], v0[4], v1[4];
#pragma unroll
        for (int j = 0; j < 4; ++j) gg[j] = *((const f32x4*)F.in[2] + lane + 64 * j);
        int m = F.gw;
#define XN_LD(v_, m_) { const int mm_ = (m_) < T ? (m_) : F.gw; _Pragma("unroll") for (int j = 0; j < 4; ++j) v_[j] = *((const f32x4*)(x + (size_t)mm_ * D) + lane + 64 * j); __builtin_amdgcn_sched_barrier(0); }
#define XN_DO(v_) { if (m < T) { f32x4 c_[4]; _Pragma("unroll") for (int j = 0; j < 4; ++j) c_[j] = v_[j]; XN_LD(v_, m + 2 * step); float s = 0.f; \
            _Pragma("unroll") for (int j = 0; j < 4; ++j) s += (c_[j].x * c_[j].x + c_[j].y * c_[j].y) + (c_[j].z * c_[j].z + c_[j].w * c_[j].w); \
            const float rstd = rsqrtf(wave_sum(s) * (1.f / 1024.f) + 1e-6f); v2u* o8 = (v2u*)(xn + (size_t)m * D) + lane; \
            unsigned* q8 = (unsigned*)(F.ws + WS_XN8 + (size_t)m * D) + lane; \
            _Pragma("unroll") for (int j = 0; j < 4; ++j) { const float y0 = c_[j].x * rstd * gg[j].x, y1 = c_[j].y * rstd * gg[j].y, y2 = c_[j].z * rstd * gg[j].z, y3 = c_[j].w * rstd * gg[j].w; \
                v2u o; o.x = cvt_pk_bf16(y0, y1); o.y = cvt_pk_bf16(y2, y3); o8[64 * j] = o; q8[64 * j] = pk4_fp8(y0, y1, y2, y3); } \
            m += step; } }
        if (m < T) {
            XN_LD(v0, m); XN_LD(v1, m + step);
            while (m < T) { XN_DO(v0); XN_DO(v1); }
        }
#undef XN_LD
#undef XN_DO
    }
    for (int m = F.gw; m < NB * 256; m += F.NGW) rms_row_to_bf16(F.in[1] + (size_t)m * D, F.in[23], WSP(bf16, WS_MEMN) + (size_t)m * D, F.lane);
}

#define EPI_LOOP_PERM(...) \
    _Pragma("unroll") for (int ai = 0; ai < 2; ++ai) _Pragma("unroll") for (int m = 0; m < 4; ++m) { const int row = u.pm * 256 + ai * 128 + wr * 64 + m * 16 + fr; \
        _Pragma("unroll") for (int bj = 0; bj < 2; ++bj) { const int ct = bj * 128 + wc * 32 + 8 * fq;   f32x4 v0 = acc[ai][bj][m][0], v1 = acc[ai][bj][m][1]; __VA_ARGS__ } }
#define PACK8(v0, v1) ((v4u){cvt_pk_bf16((v0)[0], (v0)[1]), cvt_pk_bf16((v0)[2], (v0)[3]), cvt_pk_bf16((v1)[0], (v1)[1]), cvt_pk_bf16((v1)[2], (v1)[3])})

struct EpiMain {
    static constexpr bool PERM = true;
    static constexpr int NVM = 16;
    bf16 *Zrkv, *Zlora, *QLAT, *Zd, *G; const float* b_gate; int pn_off = 0;
    __device__ __forceinline__ void operator()(const f32x4 (&acc)[2][2][4][2], const Unit& u, int wr, int wc, int fr, int fq) const {
        const int pn = u.pn + pn_off; bf16* base; int ldc, c0; bool act = false;
        if (pn < 6) { base = Zrkv; ldc = 1536; c0 = pn * 256; }
        else if (pn == 6) { base = Zlora; ldc = 256; c0 = 0; }
        else if (pn < 11) { base = QLAT; ldc = 1024; c0 = (pn - 7) * 256; }
        else if (pn < 13) { base = Zd; ldc = 512; c0 = (pn - 11) * 256; }
        else { base = G; ldc = 2048; c0 = (pn - 13) * 256; act = true; }
        if (act) {
            f32x4 bg[2][2];
#pragma unroll
            for (int bj = 0; bj < 2; ++bj) { const int ct = bj * 128 + wc * 32 + 8 * fq; bg[bj][0] = *(const f32x4*)(b_gate + c0 + ct); bg[bj][1] = *(const f32x4*)(b_gate + c0 + ct + 4); }
            EPI_LOOP_PERM(
_Pragma("unroll")
                for (int e = 0; e < 4; ++e) { v0[e] = fsigmoid(v0[e] + bg[bj][0][e]); v1[e] = fsigmoid(v1[e] + bg[bj][1][e]); }
                *(v4u*)(base + (size_t)row * ldc + c0 + ct) = PACK8(v0, v1);
            )
        } else {
            EPI_LOOP_PERM(
                *(v4u*)(base + (size_t)row * ldc + c0 + ct) = PACK8(v0, v1);
            )
        }
    }
};
struct EpiGate8 {
    static constexpr bool PERM = true;
    static constexpr int NVM = 16;
    bf16* G; const float* b_gate;
    __device__ __forceinline__ void operator()(const f32x4 (&acc)[2][2][4][2], const Unit& u, int wr, int wc, int fr, int fq) const {
        const int c0 = u.pn * 256;
        f32x4 bg[2][2];
#pragma unroll
        for (int bj = 0; bj < 2; ++bj) { const int ct = bj * 128 + wc * 32 + 8 * fq; bg[bj][0] = *(const f32x4*)(b_gate + c0 + ct); bg[bj][1] = *(const f32x4*)(b_gate + c0 + ct + 4); }
        EPI_LOOP_PERM(
_Pragma("unroll")
            for (int e = 0; e < 4; ++e) { v0[e] = fsigmoid(0.0625f * v0[e] + bg[bj][0][e]); v1[e] = fsigmoid(0.0625f * v1[e] + bg[bj][1][e]); }
            *(v4u*)(G + (size_t)row * 2048 + c0 + ct) = PACK8(v0, v1);
        )
    }
};
struct EpiBf16 {
    static constexpr bool PERM = true;
    static constexpr int NVM = 16;
    bf16* O; int ldc; int colmul; size_t pn_stride; float scale;
    __device__ __forceinline__ void operator()(const f32x4 (&acc)[2][2][4][2], const Unit& u, int wr, int wc, int fr, int fq) const {
        bf16* base = O + (size_t)u.pn * pn_stride + (size_t)u.pn * 256 * colmul;
        EPI_LOOP_PERM( v0 = v0 * scale; v1 = v1 * scale; *(v4u*)(base + (size_t)row * ldc + ct) = PACK8(v0, v1); )
    }
};
struct EpiLora {
    static constexpr bool PERM = true;
    static constexpr int NVM = 16;
    bf16* WAG; const float* w0; const float* a0;
    __device__ __forceinline__ void operator()(const f32x4 (&acc)[2][2][4][2], const Unit& u, int wr, int wc, int fr, int fq) const {
        const int seg = u.pn >> 1; const int cc0 = (u.pn & 1) * 256; const float* bias = seg == 0 ? w0 : a0;
        if (seg < 2) {
            const float mul = seg == 0 ? 0.6065306597126334f : 1.0f;
            f32x4 bg[2][2];
#pragma unroll
            for (int bj = 0; bj < 2; ++bj) { const int ct = bj * 128 + wc * 32 + 8 * fq; bg[bj][0] = *(const f32x4*)(bias + cc0 + ct); bg[bj][1] = *(const f32x4*)(bias + cc0 + ct + 4); }
            EPI_LOOP_PERM(
_Pragma("unroll")
                for (int e = 0; e < 4; ++e) { v0[e] = mul * fsigmoid(v0[e] + bg[bj][0][e]); v1[e] = mul * fsigmoid(v1[e] + bg[bj][1][e]); }
                *(v4u*)(WAG + (size_t)row * 1536 + u.pn * 256 + ct) = PACK8(v0, v1);
            )
        } else {
            EPI_LOOP_PERM(
                *(v4u*)(WAG + (size_t)row * 1536 + u.pn * 256 + ct) = PACK8(v0, v1);
            )
        }
    }
};
struct EpiMix {
    static constexpr bool PERM = true;
    static constexpr int NVM = 16;
    bf16* U; const bf16* G; int second;
    __device__ __forceinline__ void operator()(const f32x4 (&acc)[2][2][4][2], const Unit& u, int wr, int wc, int fr, int fq) const {
#pragma unroll
        for (int ai = 0; ai < 2; ++ai) {
            v4u gw[4][2], ow[4][2];
#pragma unroll
            for (int m = 0; m < 4; ++m)
#pragma unroll
                for (int bj = 0; bj < 2; ++bj) { const int row = u.pm * 256 + ai * 128 + wr * 64 + m * 16 + fr, col = u.pn * 256 + bj * 128 + wc * 32 + 8 * fq;
                    gw[m][bj] = *(const v4u*)(G + (size_t)row * 2048 + second * 1024 + col);
                    ow[m][bj] = second ? *(const v4u*)(U + (size_t)row * 1024 + col) : (v4u){0, 0, 0, 0}; }
#pragma unroll
            for (int m = 0; m < 4; ++m)
#pragma unroll
                for (int bj = 0; bj < 2; ++bj) { const int row = u.pm * 256 + ai * 128 + wr * 64 + m * 16 + fr, col = u.pn * 256 + bj * 128 + wc * 32 + 8 * fq;
                    f32x4 v0 = acc[ai][bj][m][0], v1 = acc[ai][bj][m][1]; const v4u g4 = gw[m][bj], o = ow[m][bj];
                    v0[0] = v0[0] * bflo(g4.x) + bflo(o.x); v0[1] = v0[1] * bfhi(g4.x) + bfhi(o.x); v0[2] = v0[2] * bflo(g4.y) + bflo(o.y); v0[3] = v0[3] * bfhi(g4.y) + bfhi(o.y);
                    v1[0] = v1[0] * bflo(g4.z) + bflo(o.z); v1[1] = v1[1] * bfhi(g4.z) + bfhi(o.z); v1[2] = v1[2] * bflo(g4.w) + bflo(o.w); v1[3] = v1[3] * bfhi(g4.w) + bfhi(o.w);
                    *(v4u*)(U + (size_t)row * 1024 + col) = PACK8(v0, v1); }
        }
    }
};
struct EpiRes {
    static constexpr bool PERM = false;
    static constexpr int NVM = 16;
    const float* res; float* out;
    __device__ __forceinline__ void operator()(const f32x4 (&acc)[2][2][4][2], const Unit& u, int wr, int wc, int fr, int fq) const {
#pragma unroll
        for (int ai = 0; ai < 2; ++ai) {
            f32x4 r[4][2][2];
#pragma unroll
            for (int m = 0; m < 4; ++m)
#pragma unroll
                for (int bj = 0; bj < 2; ++bj)
#pragma unroll
                    for (int n = 0; n < 2; ++n) { const int row = u.pm * 256 + ai * 128 + wr * 64 + m * 16 + fr, col = u.pn * 256 + bj * 128 + wc * 32 + 16 * n + 4 * fq; r[m][bj][n] = *(const f32x4*)(res + (size_t)row * 1024 + col); }
#pragma unroll
            for (int m = 0; m < 4; ++m)
#pragma unroll
                for (int bj = 0; bj < 2; ++bj)
#pragma unroll
                    for (int n = 0; n < 2; ++n) { const int row = u.pm * 256 + ai * 128 + wr * 64 + m * 16 + fr, col = u.pn * 256 + bj * 128 + wc * 32 + 16 * n + 4 * fq; *(f32x4*)(out + (size_t)row * 1024 + col) = r[m][bj][n] + acc[ai][bj][m][n]; }
        }
    }
};
struct EpiResB {
    static constexpr bool PERM = true;
    static constexpr int NVM = 16;
    const float* res32; const bf16* res16; bf16* out; float ascale = 1.f;
    __device__ __forceinline__ void operator()(const f32x4 (&acc)[2][2][4][2], const Unit& u, int wr, int wc, int fr, int fq) const {
#pragma unroll
        for (int ai = 0; ai < 2; ++ai) {
            f32x4 r[4][2][2];
#pragma unroll
            for (int m = 0; m < 4; ++m)
#pragma unroll
                for (int bj = 0; bj < 2; ++bj) { const int row = u.pm * 256 + ai * 128 + wr * 64 + m * 16 + fr, col = u.pn * 256 + bj * 128 + wc * 32 + 8 * fq; const size_t o = (size_t)row * 1024 + col;
                    if (res32) { r[m][bj][0] = *(const f32x4*)(res32 + o); r[m][bj][1] = *(const f32x4*)(res32 + o + 4); }
                    else { const v4u w = *(const v4u*)(res16 + o); r[m][bj][0] = (f32x4){bflo(w.x), bfhi(w.x), bflo(w.y), bfhi(w.y)}; r[m][bj][1] = (f32x4){bflo(w.z), bfhi(w.z), bflo(w.w), bfhi(w.w)}; } }
#pragma unroll
            for (int m = 0; m < 4; ++m)
#pragma unroll
                for (int bj = 0; bj < 2; ++bj) { const int row = u.pm * 256 + ai * 128 + wr * 64 + m * 16 + fr, col = u.pn * 256 + bj * 128 + wc * 32 + 8 * fq;
                    const f32x4 v0 = r[m][bj][0] + acc[ai][bj][m][0] * ascale, v1 = r[m][bj][1] + acc[ai][bj][m][1] * ascale;
                    *(v4u*)(out + (size_t)row * 1024 + col) = PACK8(v0, v1); }
        }
    }
};
struct EpiResN {
    static constexpr bool PERM = true;
    static constexpr int NVM = 16;
    const float* res32; bf16* out; unsigned char* o8; const float* gain; float* ssp;
    __device__ __forceinline__ void operator()(const f32x4 (&acc)[2][2][4][2], const Unit& u, int wr, int wc, int fr, int fq) const {
        f32x4 gg[2][2];
#pragma unroll
        for (int bj = 0; bj < 2; ++bj) { const int col = u.pn * 256 + bj * 128 + wc * 32 + 8 * fq; gg[bj][0] = *(const f32x4*)(gain + col); gg[bj][1] = *(const f32x4*)(gain + col + 4); }
#pragma unroll
        for (int ai = 0; ai < 2; ++ai) {
            f32x4 r[4][2][2];
#pragma unroll
            for (int m = 0; m < 4; ++m)
#pragma unroll
                for (int bj = 0; bj < 2; ++bj) { const int row = u.pm * 256 + ai * 128 + wr * 64 + m * 16 + fr, col = u.pn * 256 + bj * 128 + wc * 32 + 8 * fq; const size_t o = (size_t)row * 1024 + col;
                    r[m][bj][0] = *(const f32x4*)(res32 + o); r[m][bj][1] = *(const f32x4*)(res32 + o + 4); }
            float sq[4];
#pragma unroll
            for (int m = 0; m < 4; ++m) { sq[m] = 0.f;
#pragma unroll
                for (int bj = 0; bj < 2; ++bj) { const int row = u.pm * 256 + ai * 128 + wr * 64 + m * 16 + fr, col = u.pn * 256 + bj * 128 + wc * 32 + 8 * fq;
                    const f32x4 v0 = r[m][bj][0] + acc[ai][bj][m][0], v1 = r[m][bj][1] + acc[ai][bj][m][1];
                    *(v4u*)(out + (size_t)row * 1024 + col) = PACK8(v0, v1);
                    const f32x4 q0 = v0 * v0, q1 = v1 * v1; sq[m] += (q0[0] + q0[1]) + (q0[2] + q0[3]) + (q1[0] + q1[1]) + (q1[2] + q1[3]);
                    const f32x4 w0 = v0 * gg[bj][0], w1 = v1 * gg[bj][1];
                    *(v2u*)(o8 + (size_t)row * 1024 + col) = (v2u){pk4_fp8(w0[0], w0[1], w0[2], w0[3]), pk4_fp8(w1[0], w1[1], w1[2], w1[3])}; } }
#pragma unroll
            for (int m = 0; m < 4; ++m) { sq[m] += __shfl_xor(sq[m], 16); sq[m] += __shfl_xor(sq[m], 32); }
            if (fq == 0) {
#pragma unroll
                for (int m = 0; m < 4; ++m) { const int row = u.pm * 256 + ai * 128 + wr * 64 + m * 16 + fr; ssp[(size_t)row * 16 + u.pn * 4 + wc] = sq[m]; }
            }
        }
    }
};
struct EpiBf16R {
    static constexpr bool PERM = true;
    static constexpr int NVM = 16;
    bf16* O; const float* ssp; float scale;
    __device__ __forceinline__ void operator()(const f32x4 (&acc)[2][2][4][2], const Unit& u, int wr, int wc, int fr, int fq) const {
        float rs[2][4];
#pragma unroll
        for (int ai = 0; ai < 2; ++ai)
#pragma unroll
            for (int m = 0; m < 4; ++m) { const int row = u.pm * 256 + ai * 128 + wr * 64 + m * 16 + fr; const f32x4 p = *(const f32x4*)(ssp + (size_t)row * 16 + 4 * fq);
                float s = (p[0] + p[1]) + (p[2] + p[3]); s += __shfl_xor(s, 16); s += __shfl_xor(s, 32); rs[ai][m] = __builtin_amdgcn_rsqf(s * (1.f / 1024.f) + 1e-6f) * scale; }
        bf16* base = O + (size_t)u.pn * 256;
        EPI_LOOP_PERM( const float r_ = rs[ai][m]; v0 = v0 * r_; v1 = v1 * r_; *(v4u*)(base + (size_t)row * 1024 + ct) = PACK8(v0, v1); )
    }
};
struct EpiLogit {
    static constexpr bool PERM = false;
    static constexpr int NVM = 0;
    float* L;
    __device__ __forceinline__ void operator()(const f32x4 (&acc)[2][2][4][2], const Unit& u, int wr, int wc, int fr, int fq) const {
        if (wc >= 2) return;
#pragma unroll
        for (int ai = 0; ai < 2; ++ai)
#pragma unroll
            for (int m = 0; m < 4; ++m) { const int row = u.pm * 256 + ai * 128 + wr * 64 + m * 16 + fr;
#pragma unroll
                for (int n = 0; n < 2; ++n) { const int col = wc * 32 + 16 * n + 4 * fq; *(f32x4*)(L + (size_t)row * 64 + col) = acc[ai][0][m][n]; } }
    }
};
struct EpiMoe1 {
    static constexpr bool PERM = true;
    static constexpr int NVM = 8;
    unsigned char* HID;
    __device__ __forceinline__ void operator()(const f32x4 (&acc)[2][2][4][2], const Unit& u, int wr, int wc, int fr, int fq) const {
#pragma unroll
        for (int ai = 0; ai < 2; ++ai)
#pragma unroll
            for (int m = 0; m < 4; ++m) { const int row = u.pm * 256 + ai * 128 + wr * 64 + m * 16 + fr; f32x4 h0, h1;
#pragma unroll
                for (int e = 0; e < 4; ++e) { const float g0 = 0.0625f * acc[ai][0][m][0][e], g1 = 0.0625f * acc[ai][0][m][1][e]; h0[e] = g0 * fsigmoid(g0) * (0.0625f * acc[ai][1][m][0][e]); h1[e] = g1 * fsigmoid(g1) * (0.0625f * acc[ai][1][m][1][e]); }
                *(v2u*)(HID + (size_t)row * 512 + u.pn * 128 + wc * 32 + 8 * fq) = (v2u){pk4_fp8(h0[0], h0[1], h0[2], h0[3]), pk4_fp8(h1[0], h1[1], h1[2], h1[3])}; }
    }
};
struct EpiMoe2 {
    static constexpr bool PERM = true;
    static constexpr int NVM = 16;
    bf16* YS; const float* sgate;
    __device__ __forceinline__ void operator()(const f32x4 (&acc)[2][2][4][2], const Unit& u, int wr, int wc, int fr, int fq) const {
        EPI_LOOP_PERM( v0 = v0 * 0.0625f; v1 = v1 * 0.0625f; *(v4u*)(YS + (size_t)row * 1024 + u.pn * 256 + ct) = PACK8(v0, v1); )
    }
};
struct MoeOrder {
    const char* A; const char* Bt; size_t bstride  ; int K; int NPN; const int* stok; volatile LAS int* tstart; int G, c; bool gather; const LAS int* texp; int ntile;
    __device__ bool next(int i, Unit& u) const {
        const long L = (long)i * G + c; if (L >= (long)ntile * 4) return false;
        const int tile = (int)(L >> 2); u.pn = (int)(L & 3); u.pm = tile;
        const int e = texp[tile];
        u.b = Bt + (size_t)e * bstride + (size_t)u.pn * 256 * K * 2;
        if (gather) { u.a = A; u.gidx = stok + (size_t)tile * 256; } else { u.a = A + (size_t)tile * 256 * K * 2; u.gidx = nullptr; }
        return true;
    }
};

__device__ __forceinline__ void p2_lora_prep(Frame& F) {
    const bf16* Zlora = WSP(bf16, WS_ZLORA); const bf16* Zd = WSP(bf16, WS_ZD); bf16* AL = DOP(bf16, DO_ALORA); bf16* CKV = WSP(bf16, WS_CKV);
    const float* mu = F.in[4] + 1536; const float* kvn = F.in[15];
    const int c = 4 * F.lane;
    const f32x4 m4 = *(const f32x4*)(mu + c);
    const f32x2 kn = *(const f32x2*)(kvn + 2 * F.lane);
    constexpr int NB4 = 4;
    for (int t0 = F.gw; t0 < T; t0 += NB4 * F.NGW) {
        v2u z[NB4], zp[NB4]; unsigned cw[NB4];
#pragma unroll
        for (int u = 0; u < NB4; ++u) { const int t1 = t0 + u * F.NGW, t = t1 < T ? t1 : t0;
            z[u] = *(const v2u*)(Zlora + (size_t)t * 256 + c);
            const int tp = (t & (SEQ - 1)) != 0 ? t - 1 : t;
            zp[u] = *(const v2u*)(Zlora + (size_t)tp * 256 + c);
            cw[u] = *(const unsigned*)(Zd + (size_t)t * 512 + 2 * F.lane); }
#pragma unroll
        for (int u = 0; u < NB4; ++u) { const int t = t0 + u * F.NGW;
            if (t < T) {
                if ((t & (SEQ - 1)) == 0) zp[u] = (v2u){0u, 0u};
                float v[4] = {bflo(z[u].x), bfhi(z[u].x), bflo(z[u].y), bfhi(z[u].y)}; const float p[4] = {bflo(zp[u].x), bfhi(zp[u].x), bflo(zp[u].y), bfhi(zp[u].y)};
#pragma unroll
                for (int e = 0; e < 4; ++e) { float s = v[e] + (p[e] - v[e]) * m4[e];
                    if (c < 64) { const float ex = __expf(2.f * s); s = 1.f - 2.f * __builtin_amdgcn_rcpf(ex + 1.f); }
                    else if (c >= 128) s = fsigmoid(s);
                    v[e] = s; }
                *(v2u*)(AL + (size_t)t * 256 + c) = (v2u){cvt_pk_bf16(v[0], v[1]), cvt_pk_bf16(v[2], v[3])};
                const float c0 = bflo(cw[u]), c1 = bfhi(cw[u]);
                const float rstd = rsqrtf(wave_sum(c0 * c0 + c1 * c1) * (1.f / 128.f) + 1e-6f);
                *(unsigned*)(CKV + (size_t)t * 128 + 2 * F.lane) = cvt_pk_bf16(c0 * rstd * kn.x, c1 * rstd * kn.y);
            }
        }
    }
}

struct ScanRows { v4u zr, zk, zv, pr, pk, pv, ew4, a4, g4; };
__device__ __forceinline__ void scan_load_rows(ScanRows& L, const bf16* Zrkv, const bf16* WAG, size_t tok, int pos, int j0) {
    L.zr = *(const v4u*)(Zrkv + tok * 1536 + j0); L.zk = *(const v4u*)(Zrkv + tok * 1536 + 512 + j0); L.zv = *(const v4u*)(Zrkv + tok * 1536 + 1024 + j0);
    L.pr = (v4u){0, 0, 0, 0}; L.pk = L.pr; L.pv = L.pr;
    if (pos != 0) { L.pr = *(const v4u*)(Zrkv + (tok - 1) * 1536 + j0); L.pk = *(const v4u*)(Zrkv + (tok - 1) * 1536 + 512 + j0); L.pv = *(const v4u*)(Zrkv + (tok - 1) * 1536 + 1024 + j0); }
    L.ew4 = *(const v4u*)(WAG + tok * 1536 + j0); L.a4 = *(const v4u*)(WAG + tok * 1536 + 512 + j0); L.g4 = *(const v4u*)(WAG + tok * 1536 + 1024 + j0);
}
__device__ __forceinline__ void p4_scan(Frame& F) {
    const int bh = F.vcu >> 1, half = F.vcu & 1, b = bh >> 3, h = bh & 7;
    const bf16* Zrkv = WSP(bf16, WS_ZRKV); const bf16* WAG = DOP(bf16, DO_WAG); bf16* YA = WSP(bf16, WS_YA); bf16* YC = WSP(bf16, WS_YC);
    LAS float* sR = (LAS float*)F.lds; LAS float* sDEC = sR + 4096; LAS float* sKK = sR + 8192; LAS float* sBB = sR + 12288; LAS float* sKP = sR + 16384; LAS float* sV = sR + 20480; LAS float* sY = sR + 24576; LAS float* sBR = sR + 28672;
    const int tt = F.tid >> 3, jg = F.tid & 7, j0 = h * 64 + jg * 8;
    const int il = F.lane >> 3, irow = half * 32 + (F.wave & 3) * 8 + il;
    float mu_r[8], mu_k[8], mu_v[8], kkw[8], kaw[8], rkw[8], lnw[8], lnb[8];
#pragma unroll
    for (int e = 0; e < 8; ++e) { mu_r[e] = F.in[4][j0 + e]; mu_k[e] = F.in[4][512 + j0 + e]; mu_v[e] = F.in[4][1024 + j0 + e]; kkw[e] = F.in[10][j0 + e]; kaw[e] = F.in[11][j0 + e]; rkw[e] = F.in[12][j0 + e]; lnw[e] = F.in[13][j0 + e]; lnb[e] = F.in[14][j0 + e]; }
    float S[8];
#pragma unroll
    for (int e = 0; e < 8; ++e) S[e] = 0.f;
    ScanRows L; scan_load_rows(L, Zrkv, WAG, (size_t)b * SEQ + tt, tt, j0);
    for (int tile = 0; tile < SEQ / 64; ++tile) {
        const int pos = tile * 64 + tt; const size_t tok = (size_t)b * SEQ + pos;
        const v4u g4 = L.g4;
        {
            float r[8], k[8], v[8], a[8], ew[8], kk[8];
#pragma unroll
            for (int q = 0; q < 4; ++q) {
                const float zr0 = bflo(L.zr[q]), zr1 = bfhi(L.zr[q]), zk0 = bflo(L.zk[q]), zk1 = bfhi(L.zk[q]), zv0 = bflo(L.zv[q]), zv1 = bfhi(L.zv[q]);
                r[2 * q] = zr0 + (bflo(L.pr[q]) - zr0) * mu_r[2 * q]; r[2 * q + 1] = zr1 + (bfhi(L.pr[q]) - zr1) * mu_r[2 * q + 1];
                k[2 * q] = zk0 + (bflo(L.pk[q]) - zk0) * mu_k[2 * q]; k[2 * q + 1] = zk1 + (bfhi(L.pk[q]) - zk1) * mu_k[2 * q + 1];
                v[2 * q] = zv0 + (bflo(L.pv[q]) - zv0) * mu_v[2 * q]; v[2 * q + 1] = zv1 + (bfhi(L.pv[q]) - zv1) * mu_v[2 * q + 1];
                a[2 * q] = bflo(L.a4[q]); a[2 * q + 1] = bfhi(L.a4[q]); ew[2 * q] = bflo(L.ew4[q]); ew[2 * q + 1] = bfhi(L.ew4[q]);
            }
            float ss = 0.f;
#pragma unroll
            for (int e = 0; e < 8; ++e) { kk[e] = k[e] * kkw[e]; ss += kk[e] * kk[e]; }
            ss = sum8(ss);
            const float inv = 1.0f / fmaxf(sqrtf(ss), 1e-12f);
            float br = 0.f;
#pragma unroll
            for (int e = 0; e < 8; ++e) { kk[e] *= inv; br += kk[e] * a[e] * r[e]; }
            br = sum8(br);
            f32x4 o0, o1;
#define ST8(dst, expr) { _Pragma("unroll") for (int e = 0; e < 4; ++e) { { const int E = e; o0[e] = (expr); } { const int E = e + 4; o1[e] = (expr); } } *(LAS f32x4*)(dst + tt * 64 + jg * 8) = o0; *(LAS f32x4*)(dst + tt * 64 + jg * 8 + 4) = o1; }
            ST8(sR, r[E]);
            ST8(sDEC, __expf(-ew[E]));
            ST8(sKK, kk[E]);
            ST8(sBB, kk[E] * a[E]);
            ST8(sKP, k[E] * (1.f + (a[E] - 1.f) * kaw[E]));
            ST8(sV, v[E]);
#undef ST8
            if (jg == 0) sBR[tt] = br;
        }
        __syncthreads();
        if (tile + 1 < SEQ / 64) scan_load_rows(L, Zrkv, WAG, tok + 64, pos + 64, j0);
        if (F.wave < 4) {
            const LAS float* base = sR + jg * 8;
            f32x4 cr0 = *(const LAS f32x4*)(base), cr1 = *(const LAS f32x4*)(base + 4), cd0 = *(const LAS f32x4*)(base + 4096), cd1 = *(const LAS f32x4*)(base + 4100);
            f32x4 cq0 = *(const LAS f32x4*)(base + 8192), cq1 = *(const LAS f32x4*)(base + 8196), cb0 = *(const LAS f32x4*)(base + 12288), cb1 = *(const LAS f32x4*)(base + 12292);
            f32x4 cp0 = *(const LAS f32x4*)(base + 16384), cp1 = *(const LAS f32x4*)(base + 16388);
            float cvi = sV[irow], cbr = sBR[0];
#pragma unroll 2
            for (int s = 0; s < 64; ++s) {
                const int sn = (s + 1) & 63; const LAS float* nb = base + sn * 64;
                const f32x4 nr0 = *(const LAS f32x4*)(nb), nr1 = *(const LAS f32x4*)(nb + 4), nd0 = *(const LAS f32x4*)(nb + 4096), nd1 = *(const LAS f32x4*)(nb + 4100);
                const f32x4 nq0 = *(const LAS f32x4*)(nb + 8192), nq1 = *(const LAS f32x4*)(nb + 8196), nb0 = *(const LAS f32x4*)(nb + 12288), nb1 = *(const LAS f32x4*)(nb + 12292);
                const f32x4 np0 = *(const LAS f32x4*)(nb + 16384), np1 = *(const LAS f32x4*)(nb + 16388);
                const float nvi = sV[sn * 64 + irow], nbr = sBR[sn];
                float t[8], sa0 = 0.f, sa1 = 0.f, ty0 = 0.f, ty1 = 0.f;
#pragma unroll
                for (int e = 0; e < 4; ++e) {
                    sa0 += S[e] * cq0[e]; sa1 += S[4 + e] * cq1[e];
                    t[e] = S[e] * cd0[e] + cvi * cp0[e]; t[4 + e] = S[4 + e] * cd1[e] + cvi * cp1[e];
                    ty0 += t[e] * cr0[e]; ty1 += t[4 + e] * cr1[e];
                }
                float sa = sa0 + sa1, ty = ty0 + ty1;
                sa += dpp_f(sa, 0); ty += dpp_f(ty, 0); sa += dpp_f(sa, 1); ty += dpp_f(ty, 1); sa += dpp_f(sa, 2); ty += dpp_f(ty, 2);
                sa = -sa;
#pragma unroll
                for (int e = 0; e < 4; ++e) { S[e] = t[e] + sa * cb0[e]; S[4 + e] = t[4 + e] + sa * cb1[e]; }
                if (jg == 0) sY[s * 64 + irow] = ty + sa * cbr;
                cr0 = nr0; cr1 = nr1; cd0 = nd0; cd1 = nd1; cq0 = nq0; cq1 = nq1; cb0 = nb0; cb1 = nb1; cp0 = np0; cp1 = np1; cvi = nvi; cbr = nbr;
            }
        }
        __syncthreads();
        {
            const LAS float* rb = sR + tt * 64 + jg * 8; const LAS float* kb = sKP + tt * 64 + jg * 8; const LAS float* vb = sV + tt * 64 + jg * 8;
            float dot = 0.f;
#pragma unroll
            for (int e = 0; e < 8; ++e) dot += rb[e] * kb[e] * rkw[e];
            dot = sum8(dot);
            if ((jg >> 2) == half) {
                const LAS float* yb = sY + tt * 64 + jg * 8;
                const f32x4 ya = *(const LAS f32x4*)yb, yc = *(const LAS f32x4*)(yb + 4);
                float c[8];
#pragma unroll
                for (int q = 0; q < 4; ++q) { c[2 * q] = (lnb[2 * q] + dot * vb[2 * q]) * bflo(g4[q]); c[2 * q + 1] = (lnb[2 * q + 1] + dot * vb[2 * q + 1]) * bfhi(g4[q]); }
                *(v4u*)(YA + tok * 512 + j0) = (v4u){cvt_pk_bf16(ya[0], ya[1]), cvt_pk_bf16(ya[2], ya[3]), cvt_pk_bf16(yc[0], yc[1]), cvt_pk_bf16(yc[2], yc[3])};
                *(v4u*)(YC + tok * 512 + j0) = (v4u){cvt_pk_bf16(c[0], c[1]), cvt_pk_bf16(c[2], c[3]), cvt_pk_bf16(c[4], c[5]), cvt_pk_bf16(c[6], c[7])};
            }
        }
        __syncthreads();
    }
}

namespace rk {
constexpr int RSB = 144, SLOT = 64 * RSB;
__device__ __forceinline__ int off(int row, int elem) { return row * RSB + ((((elem) >> 3) ^ ((row >> 3) & 7)) << 4) + ((elem) & 7) * 2; }
struct Acc2 { f32x4 a[2]; };
template <bool TWO>
__device__ __forceinline__ Acc2 mm_mul(const LAS unsigned char* lds, int X, int Y, int X2, int Y2, int wave, int lane) {
    const int g = lane >> 4, c15 = lane & 15; Acc2 r;
#pragma unroll
    for (int jj = 0; jj < 2; ++jj) {
        const int job = wave + 8 * jj, yt = job >> 2, xt = job & 3;
        f32x4 acc = (f32x4){0.f, 0.f, 0.f, 0.f};
#pragma unroll
        for (int ks = 0; ks < 2; ++ks) {
            const bf16x8 a = *(const LAS bf16x8*)(lds + X * SLOT + off(16 * xt + c15, ks * 32 + 8 * g)), b = *(const LAS bf16x8*)(lds + Y * SLOT + off(16 * yt + c15, ks * 32 + 8 * g));
            acc = __builtin_amdgcn_mfma_f32_16x16x32_bf16(a, b, acc, 0, 0, 0);
        }
        if (TWO) {
#pragma unroll
            for (int ks = 0; ks < 2; ++ks) {
                const bf16x8 a = *(const LAS bf16x8*)(lds + X2 * SLOT + off(16 * xt + c15, ks * 32 + 8 * g)), b = *(const LAS bf16x8*)(lds + Y2 * SLOT + off(16 * yt + c15, ks * 32 + 8 * g));
                acc = __builtin_amdgcn_mfma_f32_16x16x32_bf16(a, b, acc, 0, 0, 0);
            }
        }
        r.a[jj] = acc;
    }
    return r;
}
template <int EPI>
__device__ __forceinline__ void mm_put(LAS unsigned char* lds, Acc2 r, int Z, int C, const LAS float* gam, int wave, int lane) {
    const int g = lane >> 4, c15 = lane & 15;
#pragma unroll
    for (int jj = 0; jj < 2; ++jj) {
        const int job = wave + 8 * jj, yt = job >> 2, xt = job & 3;
        f32x4 acc = r.a[jj];
        const int y = 16 * yt + c15, x0 = 16 * xt + 4 * g;
        if (EPI == 4) { const v2u cw = *(const LAS v2u*)(lds + C * SLOT + off(y, x0)); acc[0] += bflo(cw.x); acc[1] += bfhi(cw.x); acc[2] += bflo(cw.y); acc[3] += bfhi(cw.y); }
#pragma unroll
        for (int e = 0; e < 4; ++e) { const int x = x0 + e;
            if (EPI == 1) acc[e] = (x < y) ? acc[e] : 0.f;
            if (EPI == 2) acc[e] = (x > y) ? acc[e] : 0.f;
            if (EPI == 3) acc[e] = (x <= y) ? acc[e] : 0.f;
            if (EPI == 5) acc[e] += (x == y) ? gam[x] : 0.f; }
        *(LAS v2u*)(lds + Z * SLOT + off(y, x0)) = (v2u){cvt_pk_bf16(acc[0], acc[1]), cvt_pk_bf16(acc[2], acc[3])};
        if (EPI == 1) { float t[4];
#pragma unroll
            for (int e = 0; e < 4; ++e) t[e] = acc[e] + ((x0 + e == y) ? 1.f : 0.f);
            *(LAS v2u*)(lds + C * SLOT + off(y, x0)) = (v2u){cvt_pk_bf16(t[0], t[1]), cvt_pk_bf16(t[2], t[3])}; }
    }
}
}
__device__ __forceinline__ void p4_rwkv_chunked(Frame& F) {
    using namespace rk;
    const int bh = F.vcu >> 1, par = F.vcu & 1, b = bh >> 3, h = bh & 7;
    bf16* SB = (bf16*)((unsigned char*)F.out + DO_SB) + (size_t)bh * 2 * 4096; unsigned* flag = F.ctl + CW_RK + bh;
    const bf16* Zrkv = WSP(bf16, WS_ZRKV); const bf16* WAG = DOP(bf16, DO_WAG); bf16* YA = WSP(bf16, WS_YA);
    LAS unsigned char* lds = F.lds;
    LAS float* sL = (LAS float*)(lds + 14 * SLOT);
    LAS float* sY = (LAS float*)(lds + 3 * SLOT);
    LAS float* sG = (LAS float*)(lds + 16 * SLOT);
    const int tt = F.tid >> 3, jg = F.tid & 7, j0 = h * 64 + jg * 8, wave = F.wave, lane = F.lane;
    LAS float* sC = (LAS float*)(lds + 16 * SLOT + 256); LAS float* sLN = (LAS float*)(lds + MISC_OFF + 512);
    LAS unsigned* sEarly = (LAS unsigned*)(lds + 16 * SLOT + 256 + 1536);
    if (F.tid < 384) { const int jgi = F.tid / 48, r = F.tid % 48, which = r >> 3, e = r & 7; const float* srcp = which < 3 ? F.in[4] + which * 512 : F.in[10 + which - 3]; sC[F.tid] = srcp[h * 64 + jgi * 8 + e]; }
    if (F.tid < 128) { const int jgi = F.tid >> 4, r = F.tid & 15; sLN[F.tid] = (r < 8 ? F.in[13] : F.in[14])[h * 64 + jgi * 8 + (r & 7)]; }
    __syncthreads();
    ScanRows L; scan_load_rows(L, Zrkv, WAG, (size_t)b * SEQ + par * 64 + tt, par * 64 + tt, j0);
    unsigned pend = 0u;
    for (int ch = par; ch < SEQ / 64; ch += 2) {
        const int pos = ch * 64 + tt; const size_t tok = (size_t)b * SEQ + pos;
        const v4u g4 = L.g4;
        float r[8], kp[8], v[8], a[8], ew[8], kk[8];
        float dot = 0.f;
        {
            float k[8];
            float mu_r[8], mu_k[8], mu_v[8], kkw[8], kaw[8], rkw[8];
#pragma unroll
            for (int e = 0; e < 8; ++e) { const LAS float* cp = sC + jg * 48 + e; mu_r[e] = cp[0]; mu_k[e] = cp[8]; mu_v[e] = cp[16]; kkw[e] = cp[24]; kaw[e] = cp[32]; rkw[e] = cp[40]; }
#pragma unroll
            for (int q = 0; q < 4; ++q) {
                const float zr0 = bflo(L.zr[q]), zr1 = bfhi(L.zr[q]), zk0 = bflo(L.zk[q]), zk1 = bfhi(L.zk[q]), zv0 = bflo(L.zv[q]), zv1 = bfhi(L.zv[q]);
                r[2 * q] = zr0 + (bflo(L.pr[q]) - zr0) * mu_r[2 * q]; r[2 * q + 1] = zr1 + (bfhi(L.pr[q]) - zr1) * mu_r[2 * q + 1];
                k[2 * q] = zk0 + (bflo(L.pk[q]) - zk0) * mu_k[2 * q]; k[2 * q + 1] = zk1 + (bfhi(L.pk[q]) - zk1) * mu_k[2 * q + 1];
                v[2 * q] = zv0 + (bflo(L.pv[q]) - zv0) * mu_v[2 * q]; v[2 * q + 1] = zv1 + (bfhi(L.pv[q]) - zv1) * mu_v[2 * q + 1];
                a[2 * q] = bflo(L.a4[q]); a[2 * q + 1] = bfhi(L.a4[q]); ew[2 * q] = bflo(L.ew4[q]); ew[2 * q + 1] = bfhi(L.ew4[q]);
            }
            float ss = 0.f;
#pragma unroll
            for (int e = 0; e < 8; ++e) { kk[e] = k[e] * kkw[e]; ss += kk[e] * kk[e]; }
            ss = sum8(ss);
            const float inv = fminf(__builtin_amdgcn_rsqf(ss), 1e12f);
#pragma unroll
            for (int e = 0; e < 8; ++e) { kk[e] *= inv; kp[e] = k[e] * (1.f + (a[e] - 1.f) * kaw[e]); }
#pragma unroll
            for (int e = 0; e < 8; ++e) dot += r[e] * kp[e] * rkw[e];
            dot = sum8(dot);
        }
        __syncthreads();
        if (F.tid == 0 && pend) __hip_atomic_store(flag, pend, __ATOMIC_RELAXED, __HIP_MEMORY_SCOPE_AGENT);
        {
#pragma unroll
            for (int e = 0; e < 8; ++e) *(LAS unsigned short*)(lds + 11 * SLOT + off(jg * 8 + e, tt)) = (unsigned short)(cvt_pk_bf16(ew[e], 0.f) & 0xffffu);
            unsigned tw[4];
#pragma unroll
            for (int q = 0; q < 4; ++q) tw[q] = ((jg * 8 + 2 * q <= tt) ? 0x3f80u : 0u) | ((jg * 8 + 2 * q + 1 <= tt) ? 0x3f800000u : 0u);
            *(LAS v4u*)(lds + 10 * SLOT + off(tt, jg * 8)) = (v4u){tw[0], tw[1], tw[2], tw[3]};
        }
        __syncthreads();
        { const Acc2 q0 = mm_mul<false>(lds, 11, 10, 0, 0, wave, lane); const int g = lane >> 4, c15 = lane & 15;
#pragma unroll
          for (int jj = 0; jj < 2; ++jj) { const int job = wave + 8 * jj, yt = job >> 2, xt = job & 3; *(LAS f32x4*)(sL + (16 * yt + c15) * 64 + 16 * xt + 4 * g) = -q0.a[jj]; } }
        __syncthreads();
        if (F.tid < 64) sG[F.tid] = __expf(sL[63 * 64 + F.tid]);
        if (ch + 2 < SEQ / 64) scan_load_rows(L, Zrkv, WAG, tok + 128, pos + 128, j0);
        {
            const f32x4 l0 = *(const LAS f32x4*)(sL + tt * 64 + jg * 8), l1 = *(const LAS f32x4*)(sL + tt * 64 + jg * 8 + 4);
            const f32x4 c0 = *(const LAS f32x4*)(sL + 63 * 64 + jg * 8), c1 = *(const LAS f32x4*)(sL + 63 * 64 + jg * 8 + 4);
            float At[8], Bt[8], Kt[8], Rt[8], Bh[8], Kh[8];
#pragma unroll
            for (int e = 0; e < 8; ++e) { const float Lt = e < 4 ? l0[e] : l1[e - 4], LC = e < 4 ? c0[e] : c1[e - 4];
                const float eL = __expf(Lt), eLm1 = __expf(Lt + ew[e]), einv = __builtin_amdgcn_rcpf(eL), eC = __expf(LC) * einv, ba = kk[e] * a[e];
                At[e] = -kk[e] * eLm1; Bt[e] = ba * einv; Kt[e] = kp[e] * einv; Rt[e] = r[e] * eL; Bh[e] = ba * eC; Kh[e] = kp[e] * eC; }
#define RK_ROW(slot, arr) *(LAS v4u*)(lds + (slot) * SLOT + off(tt, jg * 8)) = (v4u){cvt_pk_bf16(arr[0], arr[1]), cvt_pk_bf16(arr[2], arr[3]), cvt_pk_bf16(arr[4], arr[5]), cvt_pk_bf16(arr[6], arr[7])}
#define RK_COL(slot, arr) { _Pragma("unroll") for (int e = 0; e < 8; ++e) *(LAS unsigned short*)(lds + (slot) * SLOT + off(jg * 8 + e, tt)) = (unsigned short)(cvt_pk_bf16(arr[e], 0.f) & 0xffffu); }
            RK_ROW(0, At); RK_COL(1, At); RK_ROW(2, Bt); RK_ROW(3, Kt); RK_ROW(4, Rt); RK_COL(5, Bh); RK_COL(6, Kh); RK_COL(7, v);
#undef RK_ROW
#undef RK_COL
        }
        __syncthreads();
#define MUL1(X_, Y_) mm_mul<false>(lds, X_, Y_, 0, 0, wave, lane)
#define MUL2(X_, Y_, X2_, Y2_) mm_mul<true>(lds, X_, Y_, X2_, Y2_, wave, lane)
#define PUT(E_, R_, Z_, C_) mm_put<E_>(lds, R_, Z_, C_, sG, wave, lane)
        { const Acc2 q0 = MUL1(2, 0), q1 = MUL1(0, 2), q2 = MUL1(3, 0), q3 = MUL1(2, 4), q4 = MUL1(3, 4);
          PUT(1, q0, 8, 13); PUT(2, q1, 14, 0); PUT(1, q2, 10, 15); PUT(3, q3, 11, 0); PUT(3, q4, 12, 0); }
        __syncthreads();
        { const Acc2 q0 = MUL1(14, 8), q1 = MUL1(8, 14); PUT(0, q0, 0, 0); PUT(0, q1, 2, 0); }
        __syncthreads();
        { const Acc2 q0 = MUL1(2, 13), q1 = MUL1(2, 0), q2 = MUL1(0, 2); PUT(4, q0, 3, 13); PUT(0, q1, 8, 0); PUT(0, q2, 14, 0); }
        __syncthreads();
        { const Acc2 q0 = MUL1(14, 3), q1 = MUL1(14, 8), q2 = MUL1(8, 14); PUT(4, q0, 13, 3); PUT(0, q1, 0, 0); PUT(0, q2, 2, 0); }
        __syncthreads();
        { const Acc2 q0 = MUL1(2, 13), q1 = MUL1(2, 0), q2 = MUL1(0, 2); PUT(4, q0, 3, 13); PUT(0, q1, 8, 0); PUT(0, q2, 14, 0); }
        __syncthreads();
        unsigned flag_seen = 0u;
        if (F.tid == 0 && ch > 0) flag_seen = __hip_atomic_load(flag, __ATOMIC_RELAXED, __HIP_MEMORY_SCOPE_AGENT);
        { const Acc2 q0 = MUL1(14, 3), q1 = MUL1(8, 14); PUT(4, q0, 13, 3); PUT(0, q1, 0, 0); }
        __syncthreads();
        { const Acc2 q0 = MUL1(0, 13); PUT(4, q0, 3, 13); }
        __syncthreads();
        { const Acc2 q0 = MUL1(3, 1), q1 = MUL1(10, 7); PUT(0, q0, 8, 0); PUT(0, q1, 0, 0); }
        if (F.tid == 0) *sEarly = (ch > 0 && flag_seen >= (unsigned)ch) ? 1u : 0u;
        __syncthreads();
        const bool early = __builtin_amdgcn_readfirstlane(*sEarly) != 0u;
        unsigned long long ew0 = 0ull, ew1 = 0ull;
        if (early) { const unsigned long long* sp8 = (const unsigned long long*)(SB + (size_t)(ch & 1) * 4096 + F.tid * 8);
            ew0 = __hip_atomic_load(sp8, __ATOMIC_RELAXED, __HIP_MEMORY_SCOPE_AGENT); ew1 = __hip_atomic_load(sp8 + 1, __ATOMIC_RELAXED, __HIP_MEMORY_SCOPE_AGENT); }
        { const Acc2 q0 = MUL1(3, 0); PUT(0, q0, 13, 0); }
        __syncthreads();
        { const Acc2 q0 = MUL1(8, 5), q1 = MUL2(5, 13, 6, 7), q2 = MUL1(8, 11), q3 = MUL2(11, 13, 12, 7);
          PUT(5, q0, 2, 0); PUT(0, q1, 14, 0); PUT(4, q2, 15, 4); PUT(0, q3, 0, 0); }
        __syncthreads();
#undef MUL1
#undef MUL2
#undef PUT
        if (ch == 0) { for (int i = F.tid; i < SLOT / 4; i += NTHREADS) ((LAS unsigned*)(lds + 9 * SLOT))[i] = 0u; }
        else {
            unsigned long long w0 = ew0, w1 = ew1;
            if (!early) {
                if (F.tid == 0) { unsigned sp = 0; while (__hip_atomic_load(flag, __ATOMIC_RELAXED, __HIP_MEMORY_SCOPE_AGENT) < (unsigned)ch && ++sp < (1u << 22)) __builtin_amdgcn_s_sleep(1); }
                __syncthreads();
                const unsigned long long* sp8 = (const unsigned long long*)(SB + (size_t)(ch & 1) * 4096 + F.tid * 8);
                w0 = __hip_atomic_load(sp8, __ATOMIC_RELAXED, __HIP_MEMORY_SCOPE_AGENT); w1 = __hip_atomic_load(sp8 + 1, __ATOMIC_RELAXED, __HIP_MEMORY_SCOPE_AGENT);
            }
            *(LAS v4u*)(lds + 9 * SLOT + off(F.tid >> 3, (F.tid & 7) * 8)) = (v4u){(unsigned)w0, (unsigned)(w0 >> 32), (unsigned)w1, (unsigned)(w1 >> 32)};
        }
        __syncthreads();
        v2u snew[2];
        {
            const int g = lane >> 4, c15 = lane & 15;
#pragma unroll
            for (int jj = 0; jj < 2; ++jj) {
                const int job = wave + 8 * jj, yt = job >> 2, xt = job & 3;
                f32x4 ya = (f32x4){0.f, 0.f, 0.f, 0.f}, sa2 = (f32x4){0.f, 0.f, 0.f, 0.f};
#pragma unroll
                for (int ks = 0; ks < 2; ++ks) {
                    const bf16x8 sf = *(const LAS bf16x8*)(lds + 9 * SLOT + off(16 * yt + c15, ks * 32 + 8 * g));
                    const bf16x8 rf = *(const LAS bf16x8*)(lds + 15 * SLOT + off(16 * xt + c15, ks * 32 + 8 * g)), mf = *(const LAS bf16x8*)(lds + 2 * SLOT + off(16 * xt + c15, ks * 32 + 8 * g));
                    ya = __builtin_amdgcn_mfma_f32_16x16x32_bf16(rf, sf, ya, 0, 0, 0); sa2 = __builtin_amdgcn_mfma_f32_16x16x32_bf16(mf, sf, sa2, 0, 0, 0);
                }
                const int yy = 16 * yt + c15, x0 = 16 * xt + 4 * g;
                const v2u y0w = *(const LAS v2u*)(lds + 0 * SLOT + off(yy, x0)), nw = *(const LAS v2u*)(lds + 14 * SLOT + off(yy, x0));
                ya[0] += bflo(y0w.x); ya[1] += bfhi(y0w.x); ya[2] += bflo(y0w.y); ya[3] += bfhi(y0w.y);
                sa2[0] += bflo(nw.x); sa2[1] += bfhi(nw.x); sa2[2] += bflo(nw.y); sa2[3] += bfhi(nw.y);
#pragma unroll
                for (int e = 0; e < 4; ++e) sY[(x0 + e) * 64 + yy] = ya[e];
                snew[jj] = (v2u){cvt_pk_bf16(sa2[0], sa2[1]), cvt_pk_bf16(sa2[2], sa2[3])};
            }
        }
        {
            const int g = lane >> 4, c15 = lane & 15;
#pragma unroll
            for (int jj = 0; jj < 2; ++jj) { const int job = wave + 8 * jj, yt = job >> 2, xt = job & 3;
                __hip_atomic_store((unsigned long long*)(SB + (size_t)((ch + 1) & 1) * 4096 + (16 * yt + c15) * 64 + 16 * xt + 4 * g), (unsigned long long)snew[jj].x | ((unsigned long long)snew[jj].y << 32), __ATOMIC_RELAXED, __HIP_MEMORY_SCOPE_AGENT); }
            __syncthreads();
            pend = (unsigned)(ch + 1);
        }
        {
            const LAS float* yb = sY + tt * 64 + jg * 8;
            const f32x4 ya = *(const LAS f32x4*)yb, yc = *(const LAS f32x4*)(yb + 4);
            float y[8] = {ya[0], ya[1], ya[2], ya[3], yc[0], yc[1], yc[2], yc[3]};
            float sm = 0.f;
#pragma unroll
            for (int e = 0; e < 8; ++e) sm += y[e];
            const float mean = sum8(sm) * (1.f / 64.f);
            float sv = 0.f;
#pragma unroll
            for (int e = 0; e < 8; ++e) { y[e] -= mean; sv += y[e] * y[e]; }
            const float rstd = rsqrtf(sum8(sv) * (1.f / 64.f) + 64e-5f);
            float lnw[8], lnb[8];
#pragma unroll
            for (int e = 0; e < 8; ++e) { lnw[e] = sLN[jg * 16 + e]; lnb[e] = sLN[jg * 16 + 8 + e]; }
            float o[8];
#pragma unroll
            for (int q = 0; q < 4; ++q) {
                o[2 * q] = (y[2 * q] * rstd * lnw[2 * q] + lnb[2 * q] + dot * v[2 * q]) * bflo(g4[q]);
                o[2 * q + 1] = (y[2 * q + 1] * rstd * lnw[2 * q + 1] + lnb[2 * q + 1] + dot * v[2 * q + 1]) * bfhi(g4[q]);
            }
            asm volatile("s_waitcnt vmcnt(0)" ::: "memory");
            *(v4u*)(YA + tok * 512 + j0) = (v4u){cvt_pk_bf16(o[0], o[1]), cvt_pk_bf16(o[2], o[3]), cvt_pk_bf16(o[4], o[5]), cvt_pk_bf16(o[6], o[7])};
        }
    }
    __syncthreads();
    if (F.tid == 0 && pend) __hip_atomic_store(flag, pend, __ATOMIC_RELAXED, __HIP_MEMORY_SCOPE_AGENT);
}

__device__ __forceinline__ void p5_post(Frame& F) {
    bf16* YA = WSP(bf16, WS_YA); const bf16* YC = WSP(bf16, WS_YC); const bf16* WAG = DOP(bf16, DO_WAG);
    const int gt = F.vcu * NTHREADS + F.tid, NGT = F.G * NTHREADS;
    for (int it = gt; it < T * 64; it += NGT) {
        const size_t tok = (size_t)(it >> 6); const int c0 = (it & 63) * 8;
        const v4u yw = *(const v4u*)(YA + tok * 512 + c0), cw = *(const v4u*)(YC + tok * 512 + c0), gw = *(const v4u*)(WAG + tok * 1536 + 1024 + c0);
        float y[8], sm = 0.f;
#pragma unroll
        for (int q = 0; q < 4; ++q) { y[2 * q] = bflo(yw[q]); y[2 * q + 1] = bfhi(yw[q]); sm += y[2 * q] + y[2 * q + 1]; }
        const float mean = sum8(sm) * (1.f / 64.f); float sv = 0.f;
#pragma unroll
        for (int e = 0; e < 8; ++e) { y[e] -= mean; sv += y[e] * y[e]; }
        const float rstd = rsqrtf(sum8(sv) * (1.f / 64.f) + 64e-5f);
        const f32x4 l0 = *(const f32x4*)(F.in[13] + c0), l1 = *(const f32x4*)(F.in[13] + c0 + 4);
        const float lw[8] = {l0[0], l0[1], l0[2], l0[3], l1[0], l1[1], l1[2], l1[3]};
        float o[8];
#pragma unroll
        for (int q = 0; q < 4; ++q) { o[2 * q] = y[2 * q] * rstd * lw[2 * q] * bflo(gw[q]) + bflo(cw[q]); o[2 * q + 1] = y[2 * q + 1] * rstd * lw[2 * q + 1] * bfhi(gw[q]) + bfhi(cw[q]); }
        *(v4u*)(YA + tok * 512 + c0) = (v4u){cvt_pk_bf16(o[0], o[1]), cvt_pk_bf16(o[2], o[3]), cvt_pk_bf16(o[4], o[5]), cvt_pk_bf16(o[6], o[7])};
    }
}

__device__ __forceinline__ unsigned score_key(float s) {
    s = s + 0.0f;
    const _Float16 hv = (_Float16)s; const unsigned u = (unsigned)__builtin_bit_cast(unsigned short, hv);
    return (u & 0x8000u) ? (~u & 0xffffu) : (u | 0x8000u);
}
__device__ __forceinline__ void find_bin(const LAS unsigned* hist, unsigned need, int lane, unsigned& bsel, unsigned& above) {
    const v4u c = *(const LAS v4u*)(hist + 4 * lane);
    const unsigned sl = c.x + c.y + c.z + c.w;
    unsigned suf = sl;
#pragma unroll
    for (int d = 1; d < 64; d <<= 1) { const unsigned o = (unsigned)__shfl_down((int)suf, d); suf += (lane + d < 64) ? o : 0u; }
    const unsigned long long bal = __ballot(suf >= need);
    const int L = 63 - __builtin_clzll(bal | 1ull);
    unsigned run = suf - sl;
    unsigned bb, ab;
    if (run + c.w >= need) { bb = 3; ab = run; }
    else if (run + c.w + c.z >= need) { bb = 2; ab = run + c.w; }
    else if (run + c.w + c.z + c.y >= need) { bb = 1; ab = run + c.w + c.z; }
    else { bb = 0; ab = run + c.w + c.z + c.y; }
    bsel = (unsigned)__shfl((int)(4 * lane + bb), L); above = (unsigned)__shfl((int)ab, L);
}
constexpr int HP = 260;
constexpr int HIST_WAVE_BYTES = 16 * HP * 4, KBUF_OFF = NWAVES * HIST_WAVE_BYTES;
template <int PASS>
__device__ __forceinline__ void idx_tile(const bf16x8 K0, const bf16x8 K1, const int kt, const bool diag, const bf16x8 (&Q)[4][2], const float (&w)[4], LAS unsigned* hrow, const int g, const int c15,
                                         const unsigned b1, const unsigned thr, const unsigned rr, unsigned& cnt, unsigned& ties, unsigned short* idxrow, unsigned short* sink) {
    float sc[4] = {0.f, 0.f, 0.f, 0.f};
#pragma unroll
    for (int hh = 0; hh < 4; ++hh) {
        f32x4 acc = (f32x4){0.f, 0.f, 0.f, 0.f};
        acc = __builtin_amdgcn_mfma_f32_16x16x32_bf16(K0, Q[hh][0], acc, 0, 0, 0);
        acc = __builtin_amdgcn_mfma_f32_16x16x32_bf16(K1, Q[hh][1], acc, 0, 0, 0);
#pragma unroll
        for (int i = 0; i < 4; ++i) sc[i] += w[hh] * __builtin_amdgcn_fmed3f(acc[i], 0.f, __builtin_inff());
    }
    unsigned key[4]; bool valid[4];
#pragma unroll
    for (int i = 0; i < 4; ++i) { valid[i] = !diag || (4 * g + i <= c15); key[i] = score_key(sc[i]); }
    if (PASS == 0) {
#pragma unroll
        for (int i = 0; i < 4; ++i) lds_add(hrow + (key[i] >> 8), valid[i] ? 1u : 0u);
    } else if (PASS == 1) {
#pragma unroll
        for (int i = 0; i < 4; ++i) if (valid[i] && (key[i] >> 8) == b1) lds_add(hrow + (key[i] & 255u), 1u);
    } else {
        const unsigned long long qmask = 0x0001000100010001ull << c15, lowerG = qmask & ((1ull << (16 * g)) - 1ull);
        bool tie[4]; unsigned tlow = 0;
#pragma unroll
        for (int i = 0; i < 4; ++i) tie[i] = valid[i] && key[i] == thr;
        unsigned tb[4];
#pragma unroll
        for (int i = 0; i < 4; ++i) { const unsigned long long bl = __ballot(tie[i]); tb[i] = (unsigned)__popcll(bl & qmask); tlow += (unsigned)__popcll(bl & lowerG); }
        bool sel[4]; unsigned trun = ties + tlow;
#pragma unroll
        for (int i = 0; i < 4; ++i) { const bool tacc = tie[i] && trun < rr; sel[i] = (valid[i] && key[i] > thr) || tacc; trun += tie[i] ? 1u : 0u; }
        unsigned slow = 0, stot = 0;
#pragma unroll
        for (int i = 0; i < 4; ++i) { const unsigned long long bl = __ballot(sel[i]); stot += (unsigned)__popcll(bl & qmask); slow += (unsigned)__popcll(bl & lowerG); }
        unsigned pos = cnt + slow;
#pragma unroll
        for (int i = 0; i < 4; ++i) { if (sel[i] && pos < 256u) ((LAS unsigned short*)hrow)[pos] = (unsigned short)(kt * 16 + 4 * g + i); pos += sel[i] ? 1u : 0u; }
        cnt += stot; ties += tb[0] + tb[1] + tb[2] + tb[3];
    }
}
template <int PASS>
__device__ __forceinline__ void idx_pass(Frame& F, const bf16* kb_batch  , const int p, const int pmax, const bf16x8 (&Q)[4][2], const float (&w)[4], LAS unsigned* hrow,
                                         const unsigned b1, const unsigned thr, const unsigned rr, unsigned& cnt, unsigned& ties, unsigned short* idxrow, unsigned short* sink) {
    const int g = F.lane >> 4, c15 = F.lane & 15;
    LAS unsigned char* kbuf = F.lds + KBUF_OFF;
    const int skey = F.tid >> 3, sd8 = F.tid & 7;
    const unsigned sdst = (unsigned)((skey >> 4) * 2048 + (sd8 >> 2) * 1024 + (sd8 & 3) * 256 + (skey & 15) * 16);
    const bf16* ssrc = kb_batch + (size_t)skey * 512 + sd8 * 8;
    const int nchunk = (pmax >> 2) + 1;
    v4u st = *(const v4u*)ssrc;
    __syncthreads();
    *(LAS v4u*)(kbuf + sdst) = st;
    for (int c = 0; c < nchunk; ++c) {
        if (c + 1 < nchunk) st = *(const v4u*)(ssrc + (size_t)(c + 1) * 64 * 512);
        __syncthreads();
        const LAS unsigned char* kb = kbuf + (c & 1) * 8192 + g * 256 + c15 * 16;
        if (c * 4 + 3 < p) {
            bf16x8 K0[4], K1[4];
#pragma unroll
            for (int u = 0; u < 4; ++u) { K0[u] = *(const LAS bf16x8*)(kb + u * 2048); K1[u] = *(const LAS bf16x8*)(kb + u * 2048 + 1024); }
#pragma unroll
            for (int u = 0; u < 4; ++u) idx_tile<PASS>(K0[u], K1[u], c * 4 + u, false, Q, w, hrow, g, c15, b1, thr, rr, cnt, ties, idxrow, sink);
        } else {
#pragma unroll
            for (int u = 0; u < 4; ++u) {
                const int kt = c * 4 + u;
                if (kt <= p) {
                    const bf16x8 K0 = *(const LAS bf16x8*)(kb + u * 2048), K1 = *(const LAS bf16x8*)(kb + u * 2048 + 1024);
                    idx_tile<PASS>(K0, K1, kt, kt == p, Q, w, hrow, g, c15, b1, thr, rr, cnt, ties, idxrow, sink);
                }
            }
        }
        if (c + 1 < nchunk) *(LAS v4u*)(kbuf + ((c + 1) & 1) * 8192 + sdst) = st;
    }
}
namespace ix3 {
constexpr int KP = 8208, KEYS_B = 16 * KP, HIST_OFF = KEYS_B, CNT_OFF = HIST_OFF + 16 * HP * 4, QI_OFF = CNT_OFF + 8 * 16 * 2 * 4, END_OFF = QI_OFF + 16 * 4 * 4;
static_assert(END_OFF <= MISC_OFF, "indexer LDS map");
}
__device__ __forceinline__ void p4_indexer(Frame& F) {
    using namespace ix3;
    const bf16* Zd = WSP(bf16, WS_ZD); unsigned short* IDX = WSP(unsigned short, WS_IDX);
    LAS unsigned char* lds = F.lds;
    LAS unsigned* hist = (LAS unsigned*)(lds + HIST_OFF); LAS unsigned* cntt = (LAS unsigned*)(lds + CNT_OFF); LAS unsigned* qi = (LAS unsigned*)(lds + QI_OFF);
    const int lane = F.lane, wave = F.wave, g = lane >> 4, c15 = lane & 15;
    const int b = F.vcu >> 4, vb = F.vcu & 15;
    if (b >= NB) return;
    LAS unsigned* hrow = hist + c15 * HP;
    LAS unsigned char* krow = lds + c15 * KP;
    const unsigned long long qmask = 0x0001000100010001ull << c15, lowerG = qmask & ((1ull << (16 * g)) - 1ull);
    for (int ti = 0; ti < 16; ++ti) {
        const int pr = vb * 8 + (ti & 7), p = (ti & 8) ? 255 - pr : pr;
        const int q0 = p * 16; const size_t tok0 = (size_t)b * SEQ + q0;
        if (p < 16) {
            for (int i = F.tid; i < 16 * 256; i += NTHREADS) { const int r = i >> 8, jx = i & 255; IDX[(tok0 + r) * 256 + jx] = (unsigned short)(jx <= q0 + r ? jx : 0); }
            continue;
        }
        const int np = p + 1, K8 = (np + 7) >> 3, lo = wave * K8, hi = (lo + K8 < np) ? lo + K8 : np;
        for (int z = F.tid; z < 16 * HP; z += NTHREADS) hist[z] = 0u;
        bf16x8 Q[4][2];
#pragma unroll
        for (int hh = 0; hh < 4; ++hh)
#pragma unroll
            for (int ks = 0; ks < 2; ++ks) Q[hh][ks] = *(const bf16x8*)(Zd + (tok0 + c15) * 512 + 256 + hh * 64 + ks * 32 + 8 * g);
        float w[4];
        { const v2u ww = *(const v2u*)(Zd + (tok0 + c15) * 512 + 192); w[0] = bflo(ww.x) * 0.0625f; w[1] = bfhi(ww.x) * 0.0625f; w[2] = bflo(ww.y) * 0.0625f; w[3] = bfhi(ww.y) * 0.0625f; }
        __syncthreads();
        if (lo < hi) {
            const bf16* kbase = Zd + ((size_t)b * SEQ + c15) * 512 + 128 + 8 * g;
            constexpr int NPF = 2;
            bf16x8 R[NPF][2];
#pragma unroll
            for (int u = 0; u < NPF; ++u) { const int kl = lo + u < hi ? lo + u : hi - 1; R[u][0] = *(const bf16x8*)(kbase + (size_t)kl * 8192); R[u][1] = *(const bf16x8*)(kbase + (size_t)kl * 8192 + 32);
                __builtin_amdgcn_sched_barrier(0); }
            auto keys2 = [&](const float s0, const float s1) __attribute__((always_inline)) -> unsigned {
                typedef _Float16 h2_t __attribute__((ext_vector_type(2))); typedef short s2_t __attribute__((ext_vector_type(2)));
                h2_t hv = __builtin_convertvector((f32x2){s0, s1}, h2_t); hv = hv + (h2_t){(_Float16)0.0f, (_Float16)0.0f};
                const s2_t hs = __builtin_bit_cast(s2_t, hv); const s2_t sg = hs >> (s2_t){15, 15};
                return __builtin_bit_cast(unsigned, hs) ^ (__builtin_bit_cast(unsigned, sg) | 0x80008000u);
            };
            for (int kt0 = lo; kt0 < hi; kt0 += NPF) {
#pragma unroll
                for (int u = 0; u < NPF; ++u) {
                    const int kt = kt0 + u;
                    f32x4 acc[4];
#pragma unroll
                    for (int hh = 0; hh < 4; ++hh) {
                        acc[hh] = __builtin_amdgcn_mfma_f32_16x16x32_bf16(R[u][0], Q[hh][0], (f32x4){0.f, 0.f, 0.f, 0.f}, 0, 0, 0);
                        acc[hh] = __builtin_amdgcn_mfma_f32_16x16x32_bf16(R[u][1], Q[hh][1], acc[hh], 0, 0, 0);
                    }
                    { const int kn = kt + NPF, kl = kn < hi ? kn : hi - 1; R[u][0] = *(const bf16x8*)(kbase + (size_t)kl * 8192); R[u][1] = *(const bf16x8*)(kbase + (size_t)kl * 8192 + 32); }
                    float sc[4] = {0.f, 0.f, 0.f, 0.f};
#pragma unroll
                    for (int hh = 0; hh < 4; ++hh)
#pragma unroll
                        for (int i = 0; i < 4; ++i) { const float av = acc[hh][i]; const int ai = __builtin_bit_cast(int, av); const int ar = ai > 0 ? ai : 0; sc[i] += w[hh] * __builtin_bit_cast(float, ar); }
                    if (kt < hi) {
                        const unsigned k01 = keys2(sc[0], sc[1]), k23 = keys2(sc[2], sc[3]);
                        const unsigned bin[4] = {(k01 >> 8) & 255u, k01 >> 24, (k23 >> 8) & 255u, k23 >> 24};
                        if (kt == p) {
                            asm volatile("" ::: "memory");
#pragma unroll
                            for (int i = 0; i < 4; ++i) lds_add(hrow + bin[i], (4 * g + i <= c15) ? 1u : 0u);
                        } else {
#pragma unroll
                            for (int i = 0; i < 4; ++i) lds_add(hrow + bin[i], 1u);
                        }
                        *(LAS v2u*)(krow + (kt * 16 + 4 * g) * 2) = (v2u){k01, k23};
                    }
                }
            }
        }
        __syncthreads();
        {
            LAS unsigned* hq[2]; const LAS unsigned char* kq[2]; unsigned qpos[2], b1[2], ab1[2], thr[2], rr[2];
            const int nsteps = (np * 16 + 255) >> 8;
#pragma unroll
            for (int qq = 0; qq < 2; ++qq) { const int q = 2 * wave + qq; hq[qq] = hist + q * HP; kq[qq] = lds + q * KP; qpos[qq] = (unsigned)(q0 + q); }
#pragma unroll
            for (int qq = 0; qq < 2; ++qq) find_bin(hq[qq], 256u, lane, b1[qq], ab1[qq]);
#pragma unroll
            for (int qq = 0; qq < 2; ++qq) for (int z = lane; z < HP; z += 64) hq[qq][z] = 0u;
            {
                auto step = [&](const int s, const bool mk) __attribute__((always_inline)) {
                    const unsigned k0 = (unsigned)(s * 256 + 4 * lane);
                    v2u kw[2];
#pragma unroll
                    for (int qq = 0; qq < 2; ++qq) kw[qq] = *(const LAS v2u*)(kq[qq] + k0 * 2);
#pragma unroll
                    for (int qq = 0; qq < 2; ++qq) { const unsigned key[4] = {kw[qq].x & 0xffffu, kw[qq].x >> 16, kw[qq].y & 0xffffu, kw[qq].y >> 16};
#pragma unroll
                        for (int i = 0; i < 4; ++i) if ((!mk || k0 + i <= qpos[qq]) && (key[i] >> 8) == b1[qq]) lds_add(hq[qq] + (key[i] & 255u), 1u); }
                };
                for (int s = 0; s < nsteps - 1; ++s) step(s, false);
                step(nsteps - 1, true);
            }
#pragma unroll
            for (int qq = 0; qq < 2; ++qq) { unsigned bs, ab; find_bin(hq[qq], 256u - ab1[qq], lane, bs, ab); thr[qq] = (b1[qq] << 8) | bs; rr[qq] = 256u - (ab1[qq] + ab); }
            unsigned cnt[2] = {0u, 0u}, ties[2] = {0u, 0u};
            {
                auto step = [&](const int s, const bool mk) __attribute__((always_inline)) {
                    const unsigned k0 = (unsigned)(s * 256 + 4 * lane);
                    v2u kw[2];
#pragma unroll
                    for (int qq = 0; qq < 2; ++qq) kw[qq] = *(const LAS v2u*)(kq[qq] + k0 * 2);
                    bool tie[2][4], sel[2][4]; bool anyt = false;
#pragma unroll
                    for (int qq = 0; qq < 2; ++qq) { const unsigned key[4] = {kw[qq].x & 0xffffu, kw[qq].x >> 16, kw[qq].y & 0xffffu, kw[qq].y >> 16};
#pragma unroll
                        for (int i = 0; i < 4; ++i) { const bool valid = !mk || k0 + i <= qpos[qq]; tie[qq][i] = valid && key[i] == thr[qq]; sel[qq][i] = valid && key[i] > thr[qq]; anyt = anyt || tie[qq][i]; } }
                    if (__ballot(anyt) != 0ull) {
                        asm volatile("" ::: "memory");
#pragma unroll
                        for (int qq = 0; qq < 2; ++qq) { unsigned tlow = 0, tall = 0;
#pragma unroll
                            for (int i = 0; i < 4; ++i) { const unsigned long long bm = __ballot(tie[qq][i]); tlow = __builtin_amdgcn_mbcnt_hi((unsigned)(bm >> 32), __builtin_amdgcn_mbcnt_lo((unsigned)bm, tlow)); tall += (unsigned)__popcll(bm); }
                            unsigned trun = ties[qq] + tlow;
#pragma unroll
                            for (int i = 0; i < 4; ++i) { sel[qq][i] = sel[qq][i] || (tie[qq][i] && trun < rr[qq]); trun += tie[qq][i] ? 1u : 0u; }
                            ties[qq] += tall; }
                    }
#pragma unroll
                    for (int qq = 0; qq < 2; ++qq) { LAS unsigned short* list = (LAS unsigned short*)hq[qq];
                        unsigned slow = 0, sall = 0;
#pragma unroll
                        for (int i = 0; i < 4; ++i) { const unsigned long long bm = __ballot(sel[qq][i]); slow = __builtin_amdgcn_mbcnt_hi((unsigned)(bm >> 32), __builtin_amdgcn_mbcnt_lo((unsigned)bm, slow)); sall += (unsigned)__popcll(bm); }
                        unsigned pos = cnt[qq] + slow;
#pragma unroll
                        for (int i = 0; i < 4; ++i) { const unsigned wpos = (sel[qq][i] && pos < 256u) ? pos : 256u + (unsigned)lane; list[wpos] = (unsigned short)(k0 + i); pos += sel[qq][i] ? 1u : 0u; }
                        cnt[qq] += sall; }
                };
                for (int s = 0; s < nsteps - 1; ++s) step(s, false);
                step(nsteps - 1, true);
            }
        }
        __syncthreads();
        { const int q = F.tid >> 5, ch = F.tid & 31; const v4u v = *(const LAS v4u*)((const LAS unsigned char*)(hist + q * HP) + ch * 16); *(v4u*)((unsigned char*)(IDX + (tok0 + q) * 256) + ch * 16) = v; }
        __syncthreads();
    }
}

__device__ __forceinline__ unsigned off_b(unsigned row, unsigned ch) { return 256u * row + 16u * (ch ^ (((row & 3) << 2) | ((row >> 2) & 3))); }
__device__ __forceinline__ void p4_sparse_attn(Frame& F) {
    const bf16* CKV = WSP(bf16, WS_CKV); const unsigned short* IDX = WSP(unsigned short, WS_IDX); bf16* QL = WSP(bf16, WS_QLAT);
    LAS unsigned char* img0 = F.lds + F.wave * 16384;
    const int lane = F.lane, g = lane >> 4, c15 = lane & 15, qq = c15 >> 2, pp = lane & 3;
    const int t0 = F.gw * 32; constexpr int NF = 256;
    v4u ixw; v4u rw[8];
    const unsigned goff = 16u * g, coff = 16u * c15;
#define SA_LOAD_IDX(f_) { const int f2 = (f_) < NF ? (f_) : NF - 1; ixw = *(const v4u*)((const unsigned char*)(IDX + (size_t)(t0 + (f2 >> 3)) * 256 + (f2 & 7) * 32) + goff); }
#define SA_IX(c_) (((c_) & 1) ? (ixw[(c_) >> 1] >> 16) : (ixw[(c_) >> 1] & 0xffffu))
#define SA_LOAD_ROWS(f_) { const int f2 = (f_) < NF ? (f_) : NF - 1; const unsigned char* rbp = (const unsigned char*)(CKV + (size_t)((t0 + (f2 >> 3)) >> 12) * SEQ * 128); \
        _Pragma("unroll") for (int c = 0; c < 8; ++c) rw[c] = *(const v4u*)(rbp + ((SA_IX(c) << 8) + coff)); }
    SA_LOAD_IDX(0); SA_LOAD_ROWS(0); SA_LOAD_IDX(1);
    bf16x8 Bq[4], Bqn[4];
#pragma unroll
    for (int ks = 0; ks < 4; ++ks) { Bqn[ks] = (bf16x8){0, 0, 0, 0, 0, 0, 0, 0}; if (c15 < 8) Bqn[ks] = *(const bf16x8*)(QL + (size_t)t0 * 1024 + c15 * 128 + ks * 32 + 8 * g); Bq[ks] = Bqn[ks]; }
    float mrun = -1e30f, lsum = 0.f;
    f32x4 O[8];
#pragma unroll
    for (int c = 0; c < 8; ++c) O[c] = (f32x4){0.f, 0.f, 0.f, 0.f};
    for (int f = 0; f < NF; ++f) {
        const int t = t0 + (f >> 3), im = f & 7; const int pos = t & (SEQ - 1); const int nsel = pos + 1 < 256 ? pos + 1 : 256;
        LAS unsigned char* img = img0 + (f & 1) * 8192;
#pragma unroll
        for (int c = 0; c < 8; ++c) *(LAS v4u*)(img + off_b(8 * g + c, c15)) = rw[c];
        SA_LOAD_ROWS(f + 1);
        SA_LOAD_IDX(f + 2);
        if (im == 0) {
#pragma unroll
            for (int ks = 0; ks < 4; ++ks) Bq[ks] = Bqn[ks];
            mrun = -1e30f; lsum = 0.f;
#pragma unroll
            for (int c = 0; c < 8; ++c) O[c] = (f32x4){0.f, 0.f, 0.f, 0.f};
        }
        if (im == 2) { const int tn = (t + 1 < t0 + 32) ? t + 1 : t;
#pragma unroll
            for (int ks = 0; ks < 4; ++ks) if (c15 < 8) Bqn[ks] = *(const bf16x8*)(QL + (size_t)tn * 1024 + c15 * 128 + ks * 32 + 8 * g); }
        f32x4 sacc[2];
#pragma unroll
        for (int rb = 0; rb < 2; ++rb) { sacc[rb] = (f32x4){0.f, 0.f, 0.f, 0.f};
#pragma unroll
            for (int ks = 0; ks < 4; ++ks) { const bf16x8 a = *(const LAS bf16x8*)(img + off_b(c15 + 16 * rb, 4 * ks + g)); sacc[rb] = __builtin_amdgcn_mfma_f32_16x16x32_bf16(a, Bq[ks], sacc[rb], 0, 0, 0); } }
        if (nsel < 256) {
            asm volatile("" ::: "memory");
#pragma unroll
            for (int rb = 0; rb < 2; ++rb)
#pragma unroll
                for (int i = 0; i < 4; ++i) { const int j = im * 32 + 16 * rb + 4 * g + i; if (j >= nsel) sacc[rb][i] = -1e30f; }
        }
        float mx = -1e30f;
#pragma unroll
        for (int rb = 0; rb < 2; ++rb)
#pragma unroll
            for (int i = 0; i < 4; ++i) mx = fmaxf(mx, sacc[rb][i]);
        mx = fmaxf(mx, __shfl_xor(mx, 16)); mx = fmaxf(mx, __shfl_xor(mx, 32));
        if (__ballot(mx > mrun + 16.f) != 0ull) {
            asm volatile("" ::: "memory");
            const float mnew = (mx > mrun + 16.f) ? mx : mrun, alpha = __expf(mrun - mnew);
            lsum *= alpha; mrun = mnew;
            float al[4];
#pragma unroll
            for (int i = 0; i < 4; ++i) al[i] = __shfl(alpha, (4 * g + i) & 15);
#pragma unroll
            for (int c = 0; c < 8; ++c)
#pragma unroll
                for (int i = 0; i < 4; ++i) O[c][i] *= al[i];
        }
        const float mneg = -1.4426950408889634f * mrun;
        float ps = 0.f; float pv[8];
#pragma unroll
        for (int rb = 0; rb < 2; ++rb)
#pragma unroll
            for (int i = 0; i < 4; ++i) { const float pe = __builtin_amdgcn_exp2f(__builtin_fmaf(sacc[rb][i], 1.4426950408889634f, mneg)); pv[4 * rb + i] = pe; ps += pe; }
        ps += __shfl_xor(ps, 16); ps += __shfl_xor(ps, 32);
        lsum += ps;
        const v4u pw = (v4u){cvt_pk_bf16(pv[0], pv[1]), cvt_pk_bf16(pv[2], pv[3]), cvt_pk_bf16(pv[4], pv[5]), cvt_pk_bf16(pv[6], pv[7])};
        const bf16x8 pa = __builtin_bit_cast(bf16x8, pw);
#pragma unroll
        for (int c = 0; c < 8; ++c) {
            const s16x4 lo = __builtin_bit_cast(s16x4, __builtin_amdgcn_ds_read_tr16_b64_v4i16((LAS s16x4*)(img + off_b(4 * g + qq, 2 * c + (pp >> 1)) + 8 * (pp & 1))));
            const s16x4 hi = __builtin_bit_cast(s16x4, __builtin_amdgcn_ds_read_tr16_b64_v4i16((LAS s16x4*)(img + off_b(16 + 4 * g + qq, 2 * c + (pp >> 1)) + 8 * (pp & 1))));
            const bf16x8 bv = (bf16x8){lo[0], lo[1], lo[2], lo[3], hi[0], hi[1], hi[2], hi[3]};
            O[c] = __builtin_amdgcn_mfma_f32_16x16x32_bf16(pa, bv, O[c], 0, 0, 0);
        }
        if (im == 7) {
            float inv[4];
#pragma unroll
            for (int i = 0; i < 4; ++i) inv[i] = __builtin_amdgcn_rcpf(__shfl(lsum, (4 * g + i) & 15));
            if (g < 2) {
#pragma unroll
                for (int c = 0; c < 8; ++c)
#pragma unroll
                    for (int i = 0; i < 4; ++i) *(LAS unsigned short*)(img + ((4 * g + i) * 128 + 16 * c + c15) * 2) = (unsigned short)(cvt_pk_bf16(O[c][i] * inv[i], 0.f) & 0xffffu);
            }
            const v4u o0 = *(const LAS v4u*)(img + lane * 32), o1 = *(const LAS v4u*)(img + lane * 32 + 16);
            *(v4u*)(QL + (size_t)t * 1024 + lane * 16) = o0; *(v4u*)(QL + (size_t)t * 1024 + lane * 16 + 8) = o1;
        }
    }
#undef SA_LOAD_IDX
#undef SA_IX
#undef SA_LOAD_ROWS
}

__device__ __forceinline__ void p10_cross_attn(Frame& F) {
    const bf16* QC = WSP(bf16, WS_QC); bf16* XO = WSP(bf16, WS_XO); const bf16* Km = WSP(bf16, WS_KMEM); const bf16* Vt = WSP(bf16, WS_VT);
    const int lane = F.lane, g = lane >> 4, c15 = lane & 15;
    constexpr int RS = 528, BUFB = 64 * RS, NU = NB * 4 * 16;
    const int srow = F.tid >> 5, spc = F.tid & 31;
#define X_SRC(u_, c_) ((c_) < 4 ? (const unsigned char*)(Km + ((size_t)((u_) >> 6) * 256 + (c_) * 64 + srow) * 1024 + (((u_) >> 4) & 3) * 256) + spc * 16 \
                               : (const unsigned char*)(Vt + ((size_t)((u_) >> 4) * 256 + ((c_) - 4) * 64 + srow) * 256) + spc * 16)
#define X_LOAD(st_, u_, c_) { const unsigned char* s_ = X_SRC(u_, c_); _Pragma("unroll") for (int j = 0; j < 4; ++j) st_[j] = *(const v4u*)(s_ + (size_t)j * 16 * ((c_) < 4 ? 2048 : 512)); }
#define X_PUT(st_, bi_) { _Pragma("unroll") for (int j = 0; j < 4; ++j) *(LAS v4u*)(F.lds + (bi_) * BUFB + (srow + 16 * j) * RS + spc * 16) = st_[j]; }
#define X_QROW(u_, t_) (QC + ((size_t)((u_) >> 6) * SEQ + ((u_) & 15) * 256 + F.wave * 32 + (t_) * 16 + c15) * 1024 + (((u_) >> 4) & 3) * 256)
    if (F.vcu >= NU) return;
    v4u st0[4], st1[4];
    bf16x8 Bq[2][8];
    {
        const int u = F.vcu;
        X_LOAD(st0, u, 0); X_LOAD(st1, u, 1);
#pragma unroll
        for (int t = 0; t < 2; ++t) { const bf16* qrow = X_QROW(u, t);
#pragma unroll
            for (int ks = 0; ks < 8; ++ks) Bq[t][ks] = *(const bf16x8*)(qrow + ks * 32 + 8 * g); }
        X_PUT(st0, 0);
    }
    for (int u = F.vcu; u < NU; u += F.G) {
        const int un = (u + F.G < NU) ? u + F.G : u;
        bf16x8 pb[2][8]; float mc[2][4], Ls[2] = {0.f, 0.f}, inv[2] = {0.f, 0.f};
#pragma unroll
        for (int cs = 0; cs < 8; ++cs) {
            if (cs & 1) { if (cs + 2 < 8) { X_LOAD(st1, u, cs + 2); } else { X_LOAD(st1, un, cs + 2 - 8); } }
            else        { if (cs + 2 < 8) { X_LOAD(st0, u, cs + 2); } else { X_LOAD(st0, un, cs + 2 - 8); } }
            __syncthreads();
            const LAS unsigned char* buf = F.lds + (cs & 1) * BUFB;
            if (cs < 4) {
                f32x4 acc[2][4];
                bf16x8 Af[2][4];
                const LAS unsigned char* kb = buf + c15 * RS + 16 * g;
#define X_LDK(gi_) { _Pragma("unroll") for (int q = 0; q < 4; ++q) Af[(gi_) & 1][q] = *(const LAS bf16x8*)(kb + ((gi_) >> 1) * 16 * RS + (((gi_) & 1) * 4 + q) * 64); }
                X_LDK(0);
                f32x4 a0 = (f32x4){0.f, 0.f, 0.f, 0.f}, a1 = a0;
#pragma unroll
                for (int gi = 0; gi < 8; ++gi) {
                    if (gi + 1 < 8) X_LDK(gi + 1);
                    __builtin_amdgcn_sched_barrier(0);
                    if (!(gi & 1)) { a0 = (f32x4){0.f, 0.f, 0.f, 0.f}; a1 = a0; }
#pragma unroll
                    for (int q = 0; q < 4; ++q) { a0 = __builtin_amdgcn_mfma_f32_16x16x32_bf16(Af[gi & 1][q], Bq[0][(gi & 1) * 4 + q], a0, 0, 0, 0); a1 = __builtin_amdgcn_mfma_f32_16x16x32_bf16(Af[gi & 1][q], Bq[1][(gi & 1) * 4 + q], a1, 0, 0, 0); }
                    if (gi & 1) { acc[0][gi >> 1] = a0; acc[1][gi >> 1] = a1; }
                    __builtin_amdgcn_sched_barrier(0);
                }
#undef X_LDK
#pragma unroll
                for (int t = 0; t < 2; ++t) {
                    float mx = -1e30f;
#pragma unroll
                    for (int m4 = 0; m4 < 4; ++m4)
#pragma unroll
                        for (int i = 0; i < 4; ++i) mx = fmaxf(mx, acc[t][m4][i]);
                    mx = fmaxf(mx, __shfl_xor(mx, 16)); mx = fmaxf(mx, __shfl_xor(mx, 32));
                    if (cs > 0) mx = fmaxf(mx, mc[t][cs > 0 ? cs - 1 : 0]);
                    float ps = (cs > 0) ? Ls[t] * __expf(mc[t][cs > 0 ? cs - 1 : 0] - mx) : 0.f;
#pragma unroll
                    for (int s2 = 0; s2 < 2; ++s2) { float e[8];
#pragma unroll
                        for (int i = 0; i < 4; ++i) { e[i] = __expf(acc[t][2 * s2][i] - mx); e[4 + i] = __expf(acc[t][2 * s2 + 1][i] - mx); ps += e[i] + e[4 + i]; }
                        const v4u w = (v4u){cvt_pk_bf16(e[0], e[1]), cvt_pk_bf16(e[2], e[3]), cvt_pk_bf16(e[4], e[5]), cvt_pk_bf16(e[6], e[7])}; pb[t][cs * 2 + s2] = __builtin_bit_cast(bf16x8, w); }
                    mc[t][cs] = mx; Ls[t] = ps;
                }
                if (cs == 3) {
#pragma unroll
                    for (int t = 0; t < 2; ++t) {
                        const float M = mc[t][3];
                        float L = Ls[t];
#pragma unroll
                        for (int c = 0; c < 3; ++c) { const float f = __expf(mc[t][c] - M);
#pragma unroll
                            for (int s2 = 0; s2 < 2; ++s2) { const v4u w = __builtin_bit_cast(v4u, pb[t][c * 2 + s2]);
                                const v4u r = (v4u){cvt_pk_bf16(bflo(w.x) * f, bfhi(w.x) * f), cvt_pk_bf16(bflo(w.y) * f, bfhi(w.y) * f), cvt_pk_bf16(bflo(w.z) * f, bfhi(w.z) * f), cvt_pk_bf16(bflo(w.w) * f, bfhi(w.w) * f)};
                                pb[t][c * 2 + s2] = __builtin_bit_cast(bf16x8, r); } }
                        L += __shfl_xor(L, 16); L += __shfl_xor(L, 32);
                        inv[t] = 1.0f / L;
                    }
#pragma unroll
                    for (int t = 0; t < 2; ++t) { const bf16* qn = X_QROW(un, t);
#pragma unroll
                        for (int ks = 0; ks < 8; ++ks) Bq[t][ks] = *(const bf16x8*)(qn + ks * 32 + 8 * g); }
                }
            } else {
                unsigned char* q0 = (unsigned char*)XO + (X_QROW(u, 0) - QC); unsigned char* q1 = (unsigned char*)XO + (X_QROW(u, 1) - QC);
                v4u Vf[2][4];
                const LAS unsigned char* vb = buf + c15 * RS + 8 * g;
#define X_LDV(gi_) { _Pragma("unroll") for (int q = 0; q < 4; ++q) { const LAS unsigned char* p_ = vb + ((gi_) >> 1) * 16 * RS + (((gi_) & 1) * 4 + q) * 64; \
                        const v2u lo = *(const LAS v2u*)p_, hi = *(const LAS v2u*)(p_ + 32); Vf[(gi_) & 1][q] = (v4u){lo.x, lo.y, hi.x, hi.y}; } }
                X_LDV(0);
                f32x4 o0 = (f32x4){0.f, 0.f, 0.f, 0.f}, o1 = o0;
#pragma unroll
                for (int gi = 0; gi < 8; ++gi) {
                    if (gi + 1 < 8) X_LDV(gi + 1);
                    __builtin_amdgcn_sched_barrier(0);
                    if (!(gi & 1)) { o0 = (f32x4){0.f, 0.f, 0.f, 0.f}; o1 = o0; }
#pragma unroll
                    for (int q = 0; q < 4; ++q) { const bf16x8 av = __builtin_bit_cast(bf16x8, Vf[gi & 1][q]);
                        o0 = __builtin_amdgcn_mfma_f32_16x16x32_bf16(av, pb[0][(gi & 1) * 4 + q], o0, 0, 0, 0); o1 = __builtin_amdgcn_mfma_f32_16x16x32_bf16(av, pb[1][(gi & 1) * 4 + q], o1, 0, 0, 0); }
                    if (gi & 1) { const int d4 = gi >> 1;
                        *(unsigned*)(q0 + ((cs - 4) * 4 + d4) * 16 + 4 * g) = pk4_fp8(o0[0] * inv[0], o0[1] * inv[0], o0[2] * inv[0], o0[3] * inv[0]);
                        *(unsigned*)(q1 + ((cs - 4) * 4 + d4) * 16 + 4 * g) = pk4_fp8(o1[0] * inv[1], o1[1] * inv[1], o1[2] * inv[1], o1[3] * inv[1]); }
                    __builtin_amdgcn_sched_barrier(0);
                }
#undef X_LDV
            }
            if (cs & 1) { X_PUT(st0, 0); } else { X_PUT(st1, 1); }
        }
    }
    __syncthreads();
#undef X_SRC
#undef X_LOAD
#undef X_PUT
#undef X_QROW
}

__device__ __forceinline__ void rms_row16(const bf16* xrow, const float* g, bf16* orow, int lane, unsigned char* o8row) {
    const v4u a = *((const v4u*)xrow + 2 * lane), b = *((const v4u*)xrow + 2 * lane + 1);
    float v[16] = {bflo(a.x), bfhi(a.x), bflo(a.y), bfhi(a.y), bflo(a.z), bfhi(a.z), bflo(a.w), bfhi(a.w), bflo(b.x), bfhi(b.x), bflo(b.y), bfhi(b.y), bflo(b.z), bfhi(b.z), bflo(b.w), bfhi(b.w)};
    float s = 0.f;
#pragma unroll
    for (int e = 0; e < 16; ++e) s += v[e] * v[e];
    const float rstd = rsqrtf(wave_sum(s) * (1.f / 1024.f) + 1e-6f);
    const f32x4* gr = (const f32x4*)g + 4 * lane;
#pragma unroll
    for (int q = 0; q < 4; ++q) { const f32x4 gg = gr[q]; v[4 * q] *= rstd * gg[0]; v[4 * q + 1] *= rstd * gg[1]; v[4 * q + 2] *= rstd * gg[2]; v[4 * q + 3] *= rstd * gg[3]; }
    *((v4u*)orow + 2 * lane) = (v4u){cvt_pk_bf16(v[0], v[1]), cvt_pk_bf16(v[2], v[3]), cvt_pk_bf16(v[4], v[5]), cvt_pk_bf16(v[6], v[7])};
    *((v4u*)orow + 2 * lane + 1) = (v4u){cvt_pk_bf16(v[8], v[9]), cvt_pk_bf16(v[10], v[11]), cvt_pk_bf16(v[12], v[13]), cvt_pk_bf16(v[14], v[15])};
    if (o8row) *((v4u*)o8row + lane) = (v4u){pk4_fp8(v[0], v[1], v[2], v[3]), pk4_fp8(v[4], v[5], v[6], v[7]), pk4_fp8(v[8], v[9], v[10], v[11]), pk4_fp8(v[12], v[13], v[14], v[15])};
}
__device__ __forceinline__ void rms_row16_do(const v4u a, const v4u b, const f32x4 (&gv)[4], bf16* orow, int lane, unsigned char* o8row) {
    float v[16] = {bflo(a.x), bfhi(a.x), bflo(a.y), bfhi(a.y), bflo(a.z), bfhi(a.z), bflo(a.w), bfhi(a.w), bflo(b.x), bfhi(b.x), bflo(b.y), bfhi(b.y), bflo(b.z), bfhi(b.z), bflo(b.w), bfhi(b.w)};
    float s = 0.f;
#pragma unroll
    for (int e = 0; e < 16; ++e) s += v[e] * v[e];
    const float rstd = rsqrtf(wave_sum(s) * (1.f / 1024.f) + 1e-6f);
#pragma unroll
    for (int q = 0; q < 4; ++q) { const f32x4 gg = gv[q]; v[4 * q] *= rstd * gg[0]; v[4 * q + 1] *= rstd * gg[1]; v[4 * q + 2] *= rstd * gg[2]; v[4 * q + 3] *= rstd * gg[3]; }
    if (orow) {
        *((v4u*)orow + 2 * lane) = (v4u){cvt_pk_bf16(v[0], v[1]), cvt_pk_bf16(v[2], v[3]), cvt_pk_bf16(v[4], v[5]), cvt_pk_bf16(v[6], v[7])};
        *((v4u*)orow + 2 * lane + 1) = (v4u){cvt_pk_bf16(v[8], v[9]), cvt_pk_bf16(v[10], v[11]), cvt_pk_bf16(v[12], v[13]), cvt_pk_bf16(v[14], v[15])}; }
    if (o8row) *((v4u*)o8row + lane) = (v4u){pk4_fp8(v[0], v[1], v[2], v[3]), pk4_fp8(v[4], v[5], v[6], v[7]), pk4_fp8(v[8], v[9], v[10], v[11]), pk4_fp8(v[12], v[13], v[14], v[15])};
}
__device__ __forceinline__ void p_norm_rows16(Frame& F, const bf16* src, const float* g, bf16* dst, unsigned char* dst8) {
    const int lane = F.lane, step = F.NGW; int m = F.gw;
    if (m >= T) return;
    f32x4 gv[4];
#pragma unroll
    for (int q = 0; q < 4; ++q) gv[q] = *((const f32x4*)g + 4 * lane + q);
#define NR_LD(a_, b_, m_) { const int mm_ = (m_) < T ? (m_) : m; a_ = *((const v4u*)(src + (size_t)mm_ * D) + 2 * lane); b_ = *((const v4u*)(src + (size_t)mm_ * D) + 2 * lane + 1); __builtin_amdgcn_sched_barrier(0); }
#define NR_DO(a_, b_) { if (m < T) { const v4u ca_ = a_, cb_ = b_; NR_LD(a_, b_, m + 3 * step); rms_row16_do(ca_, cb_, gv, dst ? dst + (size_t)m * D : nullptr, lane, dst8 ? dst8 + (size_t)m * D : nullptr); m += step; } }
    v4u a0, b0, a1, b1, a2, b2;
    NR_LD(a0, b0, m); NR_LD(a1, b1, m + step); NR_LD(a2, b2, m + 2 * step);
    while (m < T) { NR_DO(a0, b0); NR_DO(a1, b1); NR_DO(a2, b2); }
#undef NR_LD
#undef NR_DO
}
__device__ __forceinline__ void p_norm_rows(Frame& F, const float* g, bf16* dst, unsigned char* dst8 = nullptr) {
    for (int m = F.gw; m < T; m += F.NGW) rms_row_to_bf16(F.out + (size_t)m * D, g, dst + (size_t)m * D, F.lane, dst8 ? (unsigned*)(dst8 + (size_t)m * D) : nullptr);
}

struct TokInfo { int e0, e1; float g0, g1; };
__device__ __forceinline__ void p14a_route(Frame& F) {
    const float* L = WSP(float, WS_LOGIT); TokInfo* TI = WSP(TokInfo, WS_ROUTE); const float* bg = F.in[29]; const float* be = F.in[31];
    volatile LAS unsigned* lh = (volatile LAS unsigned*)F.lds;
    if (F.tid < 32) lh[F.tid] = 0u;
    __syncthreads();
    const int t = F.vcu * 256 + F.tid;
    if (F.tid < 256) {
        const float* l = L + (size_t)t * 64;
        float gl[4]; int grp = 0; float gm = -1e30f;
#pragma unroll
        for (int i = 0; i < 4; ++i) { gl[i] = l[i] + bg[i]; if (gl[i] > gm) { gm = gl[i]; grp = i; } }
        float gs = 0.f;
#pragma unroll
        for (int i = 0; i < 4; ++i) gs += __expf(gl[i] - gm);
        const float pgrp = 1.0f / gs;
        float el[8];
#pragma unroll
        for (int i = 0; i < 8; ++i) el[i] = l[4 + grp * 8 + i] + be[grp * 8 + i];
        int i0 = 0; float m0 = -1e30f;
#pragma unroll
        for (int i = 0; i < 8; ++i) if (el[i] > m0) { m0 = el[i]; i0 = i; }
        int i1 = 0; float m1 = -1e30f;
#pragma unroll
        for (int i = 0; i < 8; ++i) if (i != i0 && el[i] > m1) { m1 = el[i]; i1 = i; }
        const float p1 = __expf(m1 - m0);
        TokInfo ti; ti.e0 = grp * 8 + i0; ti.e1 = grp * 8 + i1; ti.g0 = pgrp / (1.f + p1); ti.g1 = pgrp * p1 / (1.f + p1);
        TI[t] = ti;
        lds_add((LAS unsigned*)&lh[ti.e0], 1u); lds_add((LAS unsigned*)&lh[ti.e1], 1u);
    }
    __syncthreads();
    if (F.tid < 32 && lh[F.tid]) atomicAdd(F.ctl + CW_CNT + F.tid, lh[F.tid]);
}
__device__ __forceinline__ void p14r_norm_route(Frame& F) {
    const bf16* H2 = WSP(bf16, WS_H2B); const bf16* WR = WSP(bf16, WS_WR); unsigned char* HN8 = F.ws + WS_HN8; TokInfo* TI = WSP(TokInfo, WS_ROUTE);
    const float* gain = F.in[27]; const float* bg = F.in[29]; const float* be = F.in[31];
    constexpr int WP = 2064;
    LAS unsigned char* sW = F.lds;
    LAS float* sGn = (LAS float*)(F.lds + 48 * WP);
    LAS float* sLg = (LAS float*)(F.lds + 48 * WP + 4096);
    LAS unsigned* lh = (LAS unsigned*)(F.lds + 48 * WP + 4096 + 8 * 16 * 48 * 4);
    for (int i = F.tid; i < 48 * 128; i += NTHREADS) { const int n = i >> 7, k8 = (i & 127) * 8;
        const v4u w = *(const v4u*)(WR + (size_t)n * 1024 + k8); const f32x4 g0 = *(const f32x4*)(gain + k8), g1 = *(const f32x4*)(gain + k8 + 4);
        *(LAS v4u*)(sW + n * WP + k8 * 2) = (v4u){cvt_pk_bf16(bflo(w.x) * g0[0], bfhi(w.x) * g0[1]), cvt_pk_bf16(bflo(w.y) * g0[2], bfhi(w.y) * g0[3]), cvt_pk_bf16(bflo(w.z) * g1[0], bfhi(w.z) * g1[1]), cvt_pk_bf16(bflo(w.w) * g1[2], bfhi(w.w) * g1[3])}; }
    for (int i = F.tid; i < 1024; i += NTHREADS) sGn[i] = gain[i];
    if (F.tid < 32) lh[F.tid] = 0u;
    __syncthreads();
    const int lane = F.lane, g = lane >> 4, c15 = lane & 15;
    LAS float* myLg = sLg + F.wave * 16 * 48;
    for (int it = F.gw; it < T / 16; it += F.NGW) {
        const size_t row0 = (size_t)it * 16;
        const bf16* hp = H2 + (row0 + c15) * 1024 + 8 * g;
        v4u fa[8], fb[8];
        f32x4 acc[3]; float ss = 0.f;
#pragma unroll
        for (int mt = 0; mt < 3; ++mt) acc[mt] = (f32x4){0.f, 0.f, 0.f, 0.f};
        unsigned char* op = HN8 + (row0 + c15) * 1024 + 8 * g;
        float rstd = 0.f;
#define NR_LD(F_, K0_) { _Pragma("unroll") for (int q = 0; q < 8; ++q) F_[q] = *(const v4u*)(hp + 32 * ((K0_) + q)); __builtin_amdgcn_sched_barrier(0); }
#define NR_P1(F_, K0_) { _Pragma("unroll") for (int q = 0; q < 8; ++q) { const int ks = (K0_) + q; const v4u w = F_[q]; const bf16x8 bfrag = __builtin_bit_cast(bf16x8, w); \
            _Pragma("unroll") for (int mt = 0; mt < 3; ++mt) { const bf16x8 a = *(const LAS bf16x8*)(sW + (mt * 16 + c15) * WP + (32 * ks + 8 * g) * 2); acc[mt] = __builtin_amdgcn_mfma_f32_16x16x32_bf16(a, bfrag, acc[mt], 0, 0, 0); } \
            ss += (bflo(w.x) * bflo(w.x) + bfhi(w.x) * bfhi(w.x)) + (bflo(w.y) * bflo(w.y) + bfhi(w.y) * bfhi(w.y)) + (bflo(w.z) * bflo(w.z) + bfhi(w.z) * bfhi(w.z)) + (bflo(w.w) * bflo(w.w) + bfhi(w.w) * bfhi(w.w)); } \
          __builtin_amdgcn_sched_barrier(0); }
#define NR_P2(F_, K0_) { _Pragma("unroll") for (int q = 0; q < 8; ++q) { const int ks = (K0_) + q; const v4u w = F_[q]; const f32x4 q0 = *(const LAS f32x4*)(sGn + 32 * ks + 8 * g), q1 = *(const LAS f32x4*)(sGn + 32 * ks + 8 * g + 4); \
            *(v2u*)(op + 32 * ks) = (v2u){pk4_fp8(bflo(w.x) * rstd * q0[0], bfhi(w.x) * rstd * q0[1], bflo(w.y) * rstd * q0[2], bfhi(w.y) * rstd * q0[3]), pk4_fp8(bflo(w.z) * rstd * q1[0], bfhi(w.z) * rstd * q1[1], bflo(w.w) * rstd * q1[2], bfhi(w.w) * rstd * q1[3])}; } \
          __builtin_amdgcn_sched_barrier(0); }
        NR_LD(fa, 0); NR_LD(fb, 8);
        NR_P1(fa, 0); NR_LD(fa, 16); NR_P1(fb, 8); NR_LD(fb, 24); NR_P1(fa, 16); NR_LD(fa, 0); NR_P1(fb, 24); NR_LD(fb, 8);
        ss += __shfl_xor(ss, 16); ss += __shfl_xor(ss, 32);
        rstd = rsqrtf(ss * (1.f / 1024.f) + 1e-6f);
#pragma unroll
        for (int mt = 0; mt < 3; ++mt) *(LAS f32x4*)(myLg + c15 * 48 + mt * 16 + 4 * g) = acc[mt] * rstd;
        NR_P2(fa, 0); NR_LD(fa, 16); NR_P2(fb, 8); NR_LD(fb, 24); NR_P2(fa, 16); NR_P2(fb, 24);
#undef NR_LD
#undef NR_P1
#undef NR_P2
        if (lane < 16) {
            const LAS float* l = myLg + lane * 48; const size_t t = row0 + lane;
            float gl[4]; int grp = 0; float gm = -1e30f;
#pragma unroll
            for (int i = 0; i < 4; ++i) { gl[i] = l[i] + bg[i]; if (gl[i] > gm) { gm = gl[i]; grp = i; } }
            float gs = 0.f;
#pragma unroll
            for (int i = 0; i < 4; ++i) gs += __expf(gl[i] - gm);
            const float pgrp = 1.0f / gs;
            float el[8];
#pragma unroll
            for (int i = 0; i < 8; ++i) el[i] = l[4 + grp * 8 + i] + be[grp * 8 + i];
            int i0 = 0; float m0 = -1e30f;
#pragma unroll
            for (int i = 0; i < 8; ++i) if (el[i] > m0) { m0 = el[i]; i0 = i; }
            int i1 = 0; float m1 = -1e30f;
#pragma unroll
            for (int i = 0; i < 8; ++i) if (i != i0 && el[i] > m1) { m1 = el[i]; i1 = i; }
            const float p1 = __expf(m1 - m0);
            TokInfo ti; ti.e0 = grp * 8 + i0; ti.e1 = grp * 8 + i1; ti.g0 = pgrp / (1.f + p1); ti.g1 = pgrp * p1 / (1.f + p1);
            TI[t] = ti;
            lds_add(lh + ti.e0, 1u); lds_add(lh + ti.e1, 1u);
        }
    }
    __syncthreads();
    if (F.tid < 32 && lh[F.tid]) atomicAdd(F.ctl + CW_CNT + F.tid, lh[F.tid]);
}
__device__ __forceinline__ void moe_tstart(Frame& F, volatile LAS int* tstart) {
    if (F.tid < 64) {
        const int e = F.tid & 31;
        int nt = (int)((__hip_atomic_load(F.ctl + CW_CNT + e, __ATOMIC_RELAXED, __HIP_MEMORY_SCOPE_AGENT) + 255u) >> 8);
        if (F.tid >= 32) nt = 0;
        int inc = nt;
#pragma unroll
        for (int d = 1; d < 32; d <<= 1) { const int o = __shfl_up(inc, d); inc += (F.tid >= d) ? o : 0; }
        if (F.tid < 32) tstart[F.tid] = inc - nt;
        if (F.tid == 31) tstart[32] = inc;
    }
    __syncthreads();
}
__device__ __forceinline__ void p14b_slots(Frame& F) {
    const TokInfo* TI = WSP(TokInfo, WS_ROUTE); int* TS = (int*)(F.ws + WS_ROUTE + 1 * MiB); int* stok = (int*)(F.ws + WS_ROUTE + 2 * MiB); float* sgate = (float*)(F.ws + WS_ROUTE + 3 * MiB);
    volatile LAS int* tstart = (volatile LAS int*)(F.lds + MISC_OFF + 256);
    volatile LAS unsigned* lh = (volatile LAS unsigned*)F.lds; volatile LAS unsigned* lbase = lh + 32;
    if (F.tid < 32) lh[F.tid] = 0u;
    const int t = F.vcu * 256 + F.tid; TokInfo ti; unsigned r0 = 0, r1 = 0;
    if (F.tid < 256) ti = TI[t];
    moe_tstart(F, tstart);
    if (F.tid < 256) { r0 = lds_add((LAS unsigned*)&lh[ti.e0], 1u); r1 = lds_add((LAS unsigned*)&lh[ti.e1], 1u); }
    __syncthreads();
    if (F.tid < 32) lbase[F.tid] = lh[F.tid] ? atomicAdd(F.ctl + CW_FILL + F.tid, lh[F.tid]) : 0u;
    __syncthreads();
    if (F.tid < 256) {
        const int s0 = tstart[ti.e0] * 256 + (int)(lbase[ti.e0] + r0), s1 = tstart[ti.e1] * 256 + (int)(lbase[ti.e1] + r1);
        stok[s0] = t; sgate[s0] = ti.g0; stok[s1] = t; sgate[s1] = ti.g1; TS[2 * t] = s0; TS[2 * t + 1] = s1;
    }
    if (F.vcu < 32) {
        const int e = F.vcu; const int cnt = (int)__hip_atomic_load(F.ctl + CW_CNT + e, __ATOMIC_RELAXED, __HIP_MEMORY_SCOPE_AGENT); const int base = tstart[e] * 256, end = tstart[e + 1] * 256;
        for (int s = base + cnt + F.tid; s < end; s += NTHREADS) { stok[s] = 0; sgate[s] = 0.f; }
    }
}

__device__ __forceinline__ void p17_final(Frame& F) {
    const int* TS = (const int*)(F.ws + WS_ROUTE + 1 * MiB); const bf16* YS = WSP(bf16, WS_YS); const bf16* H2 = WSP(bf16, WS_H2B); const float* gn = F.in[35];
    const int lane = F.lane, step = F.NGW; int m = F.gw;
    if (m >= T) return;
    f32x4 gg[4];
#pragma unroll
    for (int j = 0; j < 4; ++j) gg[j] = *((const f32x4*)gn + lane + 64 * j);
    struct Row { v2u h[4], a[4], c[4]; f32x2 gt; };
    const unsigned char* TIb = F.ws + WS_ROUTE;
#define FN_IDX(i_, m_) { const int mm_ = (m_) < T ? (m_) : F.gw; i_ = *(const int2*)(TS + 2 * mm_); }
#define FN_LD(r_, i_, m_) { const int mm_ = (m_) < T ? (m_) : F.gw; const v2u* hr = (const v2u*)(H2 + (size_t)mm_ * D) + lane; const v2u* y0 = (const v2u*)(YS + (size_t)i_.x * 1024) + lane; \
        const v2u* y1 = (const v2u*)(YS + (size_t)i_.y * 1024) + lane; r_.gt = *(const f32x2*)(TIb + (size_t)mm_ * 16 + 8); _Pragma("unroll") for (int j = 0; j < 4; ++j) { r_.h[j] = hr[64 * j]; r_.a[j] = y0[64 * j]; r_.c[j] = y1[64 * j]; } __builtin_amdgcn_sched_barrier(0); }
    Row r0, r1; int2 i0, i1, j0, j1;
    FN_IDX(i0, m); FN_IDX(i1, m + step);
    FN_LD(r0, i0, m); FN_LD(r1, i1, m + step);
    FN_IDX(j0, m + 2 * step); FN_IDX(j1, m + 3 * step);
#define FN_DO(r_, jn_) { if (m < T) { const Row q_ = r_; const int2 in_ = jn_; FN_LD(r_, in_, m + 2 * step); FN_IDX(jn_, m + 4 * step); \
        f32x4 v[4]; float s = 0.f; \
        _Pragma("unroll") for (int j = 0; j < 4; ++j) { v[j] = (f32x4){bflo(q_.h[j].x), bfhi(q_.h[j].x), bflo(q_.h[j].y), bfhi(q_.h[j].y)}; \
            v[j].x += q_.gt.x * bflo(q_.a[j].x) + q_.gt.y * bflo(q_.c[j].x); v[j].y += q_.gt.x * bfhi(q_.a[j].x) + q_.gt.y * bfhi(q_.c[j].x); v[j].z += q_.gt.x * bflo(q_.a[j].y) + q_.gt.y * bflo(q_.c[j].y); v[j].w += q_.gt.x * bfhi(q_.a[j].y) + q_.gt.y * bfhi(q_.c[j].y); \
            s += (v[j].x * v[j].x + v[j].y * v[j].y) + (v[j].z * v[j].z + v[j].w * v[j].w); } \
        const float rstd = rsqrtf(wave_sum(s) * (1.f / 1024.f) + 1e-6f); f32x4* xr = (f32x4*)(F.out + (size_t)m * D) + lane; \
        _Pragma("unroll") for (int j = 0; j < 4; ++j) xr[64 * j] = (f32x4){v[j].x * rstd * gg[j].x, v[j].y * rstd * gg[j].y, v[j].z * rstd * gg[j].z, v[j].w * rstd * gg[j].w}; \
        m += step; } }
    while (m < T) { FN_DO(r0, j0); FN_DO(r1, j1); }
#undef FN_IDX
#undef FN_LD
#undef FN_DO
}

__global__ void __launch_bounds__(NTHREADS, 2) hybrid_fwd(Args args) {
    extern __shared__ __attribute__((aligned(16))) unsigned char lds_raw[];
    cg::grid_group grid = cg::this_grid();
    Frame F;
    F.lds = (LAS unsigned char*)lds_raw; F.MISC = (volatile LAS unsigned*)(F.lds + MISC_OFF);
    F.tid = threadIdx.x; F.lane = F.tid & 63; F.wave = __builtin_amdgcn_readfirstlane(F.tid >> 6);
    F.G = gridDim.x; { const int bx = blockIdx.x; F.vcu = (F.G % 8 == 0) ? (bx % 8) * (F.G / 8) + bx / 8 : bx; }
    F.gw = F.vcu * NWAVES + F.wave; F.NGW = F.G * NWAVES;
    F.in = args.in; F.out = args.out; F.ws = args.ws; F.ctl = (unsigned*)(args.ws + WS_CTL);
    for (int u = F.tid; u < (LDS_BYTES - MISC_OFF) / 4; u += NTHREADS) ((LAS unsigned*)(F.lds + MISC_OFF))[u] = 0u;
    __syncthreads();
    XcdBarrier bar = xcd_barrier_post(F.ctl + CW_BAR, F.MISC + 8);
#ifdef USE_CG_BAR
#define GRID_BAR() grid.sync()
#else
#define GRID_BAR() do { xcd_barrier(bar); asm volatile("" : "+v"(F.tid), "+v"(F.lane)); } while (0)
#endif
    const int c = (int)blockIdx.x;

#ifndef PHASE_MASK
#define PHASE_MASK 0xffffffffu
#endif
#ifndef PROBE_DUP
#define PROBE_DUP 0u
#endif
#define PH(n) for (int _rep = 0; _rep < (((PROBE_DUP) >> (n)) & 1u) + 1; ++_rep) if (PHASE_MASK & (1u << (n)))
#ifdef DIAG_FILL
    {
        const size_t n16 = (WS_END - 2 * MiB) / 16; v4u* p = (v4u*)(F.ws + 2 * MiB);
        for (size_t i = (size_t)F.vcu * NTHREADS + F.tid; i < n16; i += (size_t)F.G * NTHREADS) p[i] = (v4u){0, 0, 0, 0};
        const size_t m16 = ((size_t)T * D * 4) / 16; v4u* q = (v4u*)F.out;
        for (size_t i = (size_t)F.vcu * NTHREADS + F.tid; i < m16; i += (size_t)F.G * NTHREADS) q[i] = (v4u){0, 0, 0, 0};
        grid.sync();
    }
#endif
    PH(0) p0_prologue(F);
    grid.sync();
    asm volatile("" : "+v"(F.tid), "+v"(F.lane));
    PH(1) { pg8::StaticOrder S; S.init(F.ws + WS_XN8, F.ws + WS_WR8, T, 1536, 512, F.G, c);
      EpiBf16 E{WSP(bf16, WS_ZRKV), 1536, 1, 0, 0.0625f};
      pg8::gemm_phase<EpiBf16, pg8::StaticOrder, false, true>(F.lds, 512, S, E); }
    PH(1) { pg8::StaticOrder S; S.init(DOP(bf16, DO_XN), WSP(bf16, WS_WIN) + (size_t)1536 * 1024, T, 256, 1024, F.G, c);
      EpiMain E{WSP(bf16, WS_ZRKV), WSP(bf16, WS_ZLORA), WSP(bf16, WS_QLAT), WSP(bf16, WS_ZD), WSP(bf16, WS_G), F.in[20], 6};
      pg8::gemm_phase<EpiMain, pg8::StaticOrder, false>(F.lds, 1024, S, E); }
    PH(1) { pg8::StaticOrder S; S.init(DOP(bf16, DO_XN), WSP(bf16, WS_WIN) + (size_t)2816 * 1024, T, 512, 1024, F.G, c);
      EpiMain E{WSP(bf16, WS_ZRKV), WSP(bf16, WS_ZLORA), WSP(bf16, WS_QLAT), WSP(bf16, WS_ZD), WSP(bf16, WS_G), F.in[20], 11};
      pg8::gemm_phase<EpiMain, pg8::StaticOrder, false>(F.lds, 1024, S, E); }
    PH(1) { pg8::StaticOrder S; S.init(F.ws + WS_XN8, F.ws + WS_WQ8, T, 1024, 512, F.G, c);
      EpiBf16 E{WSP(bf16, WS_QLAT), 1024, 1, 0, 1.0f / 256.f};
      pg8::gemm_phase<EpiBf16, pg8::StaticOrder, false, true>(F.lds, 512, S, E); }
    PH(1) { pg8::SkewOrder S; S.S.init(F.ws + WS_XN8, F.ws + WS_WG8, T, 2048, 512, F.G, c); S.per = 8; S.nlow = (F.G == 256) ? 128 : 0;
      EpiGate8 E{WSP(bf16, WS_G), F.in[20]};
      pg8::gemm_phase<EpiGate8, pg8::SkewOrder, false, true>(F.lds, 512, S, E); }
    PH(2) { pg8::StaticOrder S; S.init(WSP(bf16, WS_MEMN), WSP(bf16, WS_WCKV), NB * 256, 1024, 1024, F.G, c);
      EpiBf16 E{WSP(bf16, WS_KMEM), 1024, 1, 0, 1.0f};
      pg8::gemm_phase<EpiBf16, pg8::StaticOrder, false>(F.lds, 1024, S, E); }
    PH(21) { pg8::StaticOrder S; S.init(WSP(bf16, WS_WCKV) + (size_t)1024 * 1024, WSP(bf16, WS_MEMN), 1024, NB * 256, 1024, F.G, (F.G == 256) ? ((c + 192) & 255) : c);
      EpiBf16 E{WSP(bf16, WS_VT), 256, 0, (size_t)1024 * 256, 1.0f};
      pg8::gemm_phase<EpiBf16, pg8::StaticOrder, false>(F.lds, 1024, S, E); }
    GRID_BAR();
    PH(3) p2_lora_prep(F);
    GRID_BAR();
    PH(4) { pg8::StaticOrder S; S.init(DOP(bf16, DO_ALORA), WSP(bf16, WS_BLORA), T, 1536, 256, F.G, c);
      EpiLora E{DOP(bf16, DO_WAG), F.in[5], F.in[7]};
      pg8::gemm_phase<EpiLora, pg8::StaticOrder, false>(F.lds, 256, S, E); }
    PH(5) p4_indexer(F);
    GRID_BAR();
#ifdef RWKV_CHUNKED
    PH(6) p4_rwkv_chunked(F);
    PH(7) p4_sparse_attn(F);
    GRID_BAR();
#else
    PH(6) p4_scan(F);
    PH(7) p4_sparse_attn(F);
    GRID_BAR();
    PH(22) p5_post(F);
    GRID_BAR();
#endif
    PH(8) { pg8::StaticOrder S; S.init(WSP(bf16, WS_YA), WSP(bf16, WS_WA), T, 1024, 512, F.G, c);
      EpiMix E{WSP(bf16, WS_U), WSP(bf16, WS_G), 0};
      pg8::gemm_phase<EpiMix, pg8::StaticOrder, false>(F.lds, 512, S, E); }
    PH(8) { pg8::StaticOrder S; S.init(WSP(bf16, WS_QLAT), WSP(bf16, WS_WB), T, 1024, 1024, F.G, c);
      EpiMix E{WSP(bf16, WS_U), WSP(bf16, WS_G), 1};
      pg8::gemm_phase<EpiMix, pg8::StaticOrder, false>(F.lds, 1024, S, E); }
    GRID_BAR();
    PH(9) { pg8::StaticOrder S; S.init(WSP(bf16, WS_U), WSP(bf16, WS_WOUT), T, 1024, 1024, F.G, c);
      EpiResN E{F.in[0], WSP(bf16, WS_H1B), F.ws + WS_XO, F.in[22], WSP(float, WS_SSP)};
      pg8::gemm_phase<EpiResN, pg8::StaticOrder, false>(F.lds, 1024, S, E); }
    GRID_BAR();
    PH(11) { pg8::StaticOrder S; S.init(F.ws + WS_XO, F.ws + WS_WCQ, T, 1024, 512, F.G, c);
      EpiBf16R E{WSP(bf16, WS_QC), WSP(float, WS_SSP), 0.0625f * 0.0625f};
      pg8::gemm_phase<EpiBf16R, pg8::StaticOrder, false, true>(F.lds, 512, S, E); }
    GRID_BAR();
    PH(12) p10_cross_attn(F);
    GRID_BAR();
    PH(13) { pg8::StaticOrder S; S.init(F.ws + WS_XO, F.ws + WS_WCO, T, 1024, 512, F.G, c);
      EpiResB E{nullptr, WSP(bf16, WS_H1B), WSP(bf16, WS_H2B), 0.0625f};
      pg8::gemm_phase<EpiResB, pg8::StaticOrder, false, true>(F.lds, 512, S, E); }
    GRID_BAR();
    PH(14) p14r_norm_route(F);
    GRID_BAR();
    PH(17) p14b_slots(F);
    GRID_BAR();
    { volatile LAS int* tstart = (volatile LAS int*)(F.lds + MISC_OFF + 256);
      const int* stok = (const int*)(F.ws + WS_ROUTE + 2 * MiB); const float* sgate = (const float*)(F.ws + WS_ROUTE + 3 * MiB);
      LAS int* texp = (LAS int*)(F.lds + RING_BYTES);
      const int ntile = tstart[32];
      for (int t = F.tid; t < ntile; t += NTHREADS) { int e = 0; for (int j = 1; j < 32; ++j) e += (tstart[j] <= t) ? 1 : 0; texp[t] = e; }
      __syncthreads();
      PH(18) { MoeOrder S{(const char*)(F.ws + WS_HN8), (const char*)(F.ws + WS_WGU), (size_t)1024 * 1024, 512, 4, stok, tstart, F.G, c, true, texp, ntile};
        EpiMoe1 E{F.ws + WS_HID};
        pg8::gemm_phase<EpiMoe1, MoeOrder, true, true>(F.lds, 512, S, E); }
      GRID_BAR();
      PH(19) { MoeOrder S{(const char*)(F.ws + WS_HID), (const char*)(F.ws + WS_WD), (size_t)1024 * 512, 256, 4, stok, tstart, F.G, c, false, texp, ntile};
        EpiMoe2 E{WSP(bf16, WS_YS), sgate};
        pg8::gemm_phase<EpiMoe2, MoeOrder, false, true>(F.lds, 256, S, E); }
    }
    GRID_BAR();
    PH(20) p17_final(F);
}

extern "C" void kernel_launch(void* const* d_in, const int* in_sizes, int n_in, void* d_out, int out_size, void* d_ws, size_t ws_size, hipStream_t stream) {
    static int grid = 0;
    if (grid == 0) {
        if (n_in != 36 || out_size != T * D || ws_size < WS_END) { fprintf(stderr, "kernel_launch: unexpected shapes (n_in %d out %d ws %zu)\n", n_in, out_size, ws_size); grid = -1; return; }
        int dev = 0, cus = 0, per_cu = 0;
        hipGetDevice(&dev); hipDeviceGetAttribute(&cus, hipDeviceAttributeMultiprocessorCount, dev);
        hipFuncSetAttribute((const void*)hybrid_fwd, hipFuncAttributeMaxDynamicSharedMemorySize, LDS_BYTES);
        hipOccupancyMaxActiveBlocksPerMultiprocessor(&per_cu, (const void*)hybrid_fwd, NTHREADS, LDS_BYTES);
        (void)hipGetLastError();
        if (per_cu < 1) { fprintf(stderr, "kernel_launch: occupancy query says %d blocks per CU\n", per_cu); grid = -1; return; }
        grid = cus;
    }
    if (grid < 0) return;
    hipMemsetAsync((char*)d_ws + WS_CTL, 0, CTL_ZERO_BYTES, stream);
    Args a{};
    for (int i = 0; i < 36; ++i) a.in[i] = (const float*)d_in[i];
    a.out = (float*)d_out; a.ws = (unsigned char*)d_ws;
    void* params[] = {&a};
    hipError_t e = hipLaunchCooperativeKernel((const void*)hybrid_fwd, dim3(grid), dim3(NTHREADS), params, LDS_BYTES, stream);
    if (e != hipSuccess) fprintf(stderr, "kernel_launch: cooperative launch failed: %s (grid %d)\n", hipGetErrorString(e), grid);
}
```
